# Optimizing an MI355X kernel written in HIP

```python
import math
import numpy as np
import jax
import jax.numpy as jnp
from jax import lax

D_MODEL = 1024
BATCH = 2
SEQ = 8192
DEPTH = 2

NORM_EPS = 1e-6
D_FF = 2816
FFN_RES_SCALE = 0.5

REL_BUCKETS = 32
REL_MAX_DIST = 128

GDN_HEADS = 4
GDN_DK = 128
GDN_DV = 128
GDN_CONV = 4
GDN_CHUNK = 64

NSA_HEADS = 8
NSA_GROUPS = 2
NSA_DK = 96
NSA_DV = 64
CMP_LEN = 32
CMP_STRIDE = 16
CMP_HIDDEN = 256
SEL_LEN = 64
SEL_TOPK = 16
WINDOW = 512
Q_BLOCK = 128

GLA_HEADS = 4
GLA_DK = 64
GLA_DV = 128
GLA_RANK = 16
GLA_TAU = 16
GLA_CHUNK = 16

N_BRANCH = 3
MASK_VALUE = -1e30

IN_COLUMNS = (
    ('gdn_q', GDN_HEADS * GDN_DK),
    ('gdn_k', GDN_HEADS * GDN_DK),
    ('gdn_v', GDN_HEADS * GDN_DV),
    ('gdn_z', GDN_HEADS * GDN_DV),
    ('gdn_b', GDN_HEADS),
    ('gdn_a', GDN_HEADS),
    ('nsa_q', NSA_HEADS * NSA_DK),
    ('nsa_kv_cmp', NSA_GROUPS * (NSA_DK + NSA_DV)),
    ('nsa_kv_sel', NSA_GROUPS * (NSA_DK + NSA_DV)),
    ('nsa_kv_win', NSA_GROUPS * (NSA_DK + NSA_DV)),
    ('nsa_gate', 3 * NSA_HEADS),
    ('gla_q', GLA_HEADS * GLA_DK),
    ('gla_k', GLA_HEADS * GLA_DK),
    ('gla_v', GLA_HEADS * GLA_DV),
    ('gla_r', GLA_HEADS * GLA_DV),
    ('gla_a', GLA_RANK),
    ('merge_gate', N_BRANCH * D_MODEL),
)
D_IN = sum(width for _, width in IN_COLUMNS)

kernel_name = "hybrid_gdn_nsa_gla_macaron"


def rms_norm(x, w, eps=NORM_EPS):
    xf = x.astype(jnp.float32)
    y = xf * lax.rsqrt(jnp.mean(xf * xf, axis=-1, keepdims=True) + eps)
    return (y * w.astype(jnp.float32)).astype(x.dtype)


def l2_normalize(t, eps=1e-6):
    t = t.astype(jnp.float32)
    return t * lax.rsqrt(jnp.sum(t * t, axis=-1, keepdims=True) + eps)


def swiglu(h, w_gate_up, w_down):
    g, u = jnp.split(h @ w_gate_up, 2, axis=-1)
    return (jax.nn.silu(g) * u) @ w_down


def macaron_ffn(x, norm_pre, w_gate_up, w_down, norm_post):
    y = swiglu(rms_norm(x, norm_pre), w_gate_up, w_down)
    return x + FFN_RES_SCALE * rms_norm(y, norm_post)


def split_columns(p):
    out = {}
    off = 0
    for name, width in IN_COLUMNS:
        out[name] = p[..., off:off + width]
        off += width
    return out


def rel_bucket(dist):
    n = jnp.maximum(dist, 0)
    max_exact = REL_BUCKETS // 2
    nf = jnp.maximum(n, 1).astype(jnp.float32)
    large = max_exact + (jnp.log(nf / max_exact) / math.log(REL_MAX_DIST / max_exact)
                         * (REL_BUCKETS - max_exact)).astype(jnp.int32)
    large = jnp.minimum(large, REL_BUCKETS - 1)
    return jnp.where(n < max_exact, n, large)


def causal_depthwise_conv(x, w):
    k_width, ch = w.shape
    return lax.conv_general_dilated(
        x, w[:, None, :].astype(x.dtype), window_strides=(1,),
        padding=[(k_width - 1, 0)], dimension_numbers=('NWC', 'WIO', 'NWC'),
        feature_group_count=ch)


def gated_deltanet(q, k, v, z, b, a, conv_w, a_log, dt_bias, norm_w):
    B, S, _ = q.shape
    H, dk, dv, C = GDN_HEADS, GDN_DK, GDN_DV, GDN_CHUNK
    N = S // C
    f32 = jnp.float32
    qkv = jax.nn.silu(causal_depthwise_conv(jnp.concatenate([q, k, v], axis=-1), conv_w))
    q, k, v = jnp.split(qkv, [H * dk, 2 * H * dk], axis=-1)
    q = l2_normalize(q.reshape(B, S, H, dk)) * dk ** -0.5
    k = l2_normalize(k.reshape(B, S, H, dk))
    v = v.reshape(B, S, H, dv)
    beta = jax.nn.sigmoid(b.astype(f32))
    g = -jnp.exp(a_log.astype(f32)) * jax.nn.softplus(a.astype(f32) + dt_bias.astype(f32))

    def chunk(t):
        return t.reshape(B, N, C, H, -1).transpose(0, 3, 1, 2, 4).astype(f32)

    qc, kc, vc = chunk(q), chunk(k), chunk(v)
    gc = jnp.cumsum(chunk(g[..., None])[..., 0], axis=-1)
    bc = chunk(beta[..., None])[..., 0]
    lower = jnp.tril(jnp.ones((C, C), bool))
    decay = jnp.exp(jnp.where(lower, gc[..., :, None] - gc[..., None, :], -jnp.inf))
    eye = jnp.eye(C, dtype=f32)
    kb = kc * bc[..., None]
    lmat = jnp.einsum('bhnid,bhnjd->bhnij', kb, kc) * decay * (1.0 - eye)
    rhs = jnp.concatenate([vc * bc[..., None], kb * jnp.exp(gc)[..., None]], axis=-1)
    sol = lax.linalg.triangular_solve(lmat + eye, rhs, left_side=True, lower=True)
    u, w = sol[..., :dv], sol[..., dv:]
    attn = jnp.einsum('bhnid,bhnjd->bhnij', qc, kc) * decay
    q_dec = qc * jnp.exp(gc)[..., None]
    k_dec = kc * jnp.exp(gc[..., -1:] - gc)[..., None]
    c_dec = jnp.exp(gc[..., -1])

    def step(state, xs):
        attn_n, u_n, w_n, q_n, k_n, d_n = xs
        v_new = u_n - jnp.einsum('bhcd,bhde->bhce', w_n, state)
        o = jnp.einsum('bhcd,bhde->bhce', q_n, state) + jnp.einsum('bhij,bhje->bhie', attn_n, v_new)
        state = state * d_n[..., None, None] + jnp.einsum('bhcd,bhce->bhde', k_n, v_new)
        return state, o

    xs = tuple(jnp.moveaxis(t, 2, 0) for t in (attn, u, w, q_dec, k_dec, c_dec))
    _, o = lax.scan(step, jnp.zeros((B, H, dk, dv), f32), xs)
    o = jnp.moveaxis(o, 0, 2).transpose(0, 2, 3, 1, 4).reshape(B, S, H, dv)
    o = rms_norm(o, norm_w) * jax.nn.silu(z.reshape(B, S, H, dv).astype(f32))
    return o.reshape(B, S, H * dv)


def compress_blocks(t, pe, w1, w2):
    B, S, G, d = t.shape
    n_seg = S // CMP_STRIDE
    r = CMP_LEN // CMP_STRIDE
    n_cmp = n_seg - r + 1
    seg = t.reshape(B, n_seg, CMP_STRIDE, G, d)
    blocks = jnp.concatenate([seg[:, j:j + n_cmp] for j in range(r)], axis=2)
    blocks = blocks + pe[None, None, :, None, :]
    flat = blocks.transpose(0, 1, 3, 2, 4).reshape(B, n_cmp, G, CMP_LEN * d)
    return jax.nn.gelu(flat @ w1) @ w2


def native_sparse_attention(q, kv_cmp, kv_sel, kv_win, gate_logits, rel_bias,
                            pe_k, w1_k, w2_k, pe_v, w1_v, w2_v):
    B, S, _ = q.shape
    G, HPG = NSA_GROUPS, NSA_HEADS // NSA_GROUPS
    dk, dv = NSA_DK, NSA_DV
    f32 = jnp.float32
    n_q = S // Q_BLOCK
    n_cmp = (S - CMP_LEN) // CMP_STRIDE + 1
    n_sel = S // SEL_LEN
    k_top = min(SEL_TOPK, n_sel)
    scale = dk ** -0.5

    def split_kv(kv):
        kv = kv.reshape(B, S, G, dk + dv)
        return kv[..., :dk], kv[..., dk:]

    k_c, v_c = split_kv(kv_cmp)
    k_s, v_s = split_kv(kv_sel)
    k_w, v_w = split_kv(kv_win)
    k_cmp = compress_blocks(k_c, pe_k, w1_k, w2_k)
    v_cmp = compress_blocks(v_c, pe_v, w1_v, w2_v)
    k_blk = k_s.reshape(B, n_sel, SEL_LEN, G, dk).transpose(0, 3, 1, 2, 4)
    v_blk = v_s.reshape(B, n_sel, SEL_LEN, G, dv).transpose(0, 3, 1, 2, 4)
    pad = ((0, 0), (WINDOW, 0), (0, 0), (0, 0))
    k_wp, v_wp = jnp.pad(k_w, pad), jnp.pad(v_w, pad)

    cmp_end = jnp.arange(n_cmp) * CMP_STRIDE + CMP_LEN - 1
    c_start = np.arange(n_cmp) * CMP_STRIDE
    s_start = np.arange(n_sel) * SEL_LEN
    overlap = jnp.asarray(((c_start[:, None] < s_start[None, :] + SEL_LEN)
                           & (c_start[:, None] + CMP_LEN > s_start[None, :])).astype(np.float32))
    tbl = rel_bias.astype(f32)
    tbl_g = tbl.reshape(REL_BUCKETS, G, HPG).transpose(1, 0, 2)
    bi = jnp.arange(B)[:, None, None, None]
    gi = jnp.arange(G)[None, None, :, None]
    sel_ids = jnp.arange(n_sel)
    kw_off = jnp.arange(WINDOW + Q_BLOCK) - WINDOW

    def head_bias(dist):
        bias = tbl[rel_bucket(dist)]
        return bias.reshape(dist.shape[0], dist.shape[1], G, HPG).transpose(2, 3, 0, 1)

    def block(args):
        i, qb, gb = args
        q0 = i * Q_BLOCK
        t = q0 + jnp.arange(Q_BLOCK)
        dist_c = t[:, None] - cmp_end[None, :]
        valid_c = dist_c >= 0
        s_c = jnp.einsum('bghqd,bngd->bghqn', qb, k_cmp).astype(f32) * scale + head_bias(dist_c)
        p_c = jax.nn.softmax(jnp.where(valid_c, s_c, MASK_VALUE), axis=-1)
        p_c = p_c * jnp.any(valid_c, axis=-1)[:, None]
        o_c = jnp.einsum('bghqn,bngd->bqghd', p_c.astype(v_cmp.dtype), v_cmp)
        imp = jnp.einsum('bghqn,ns->bqgs', p_c, overlap)
        blk_t = (t // SEL_LEN)[:, None]
        forced = (sel_ids == 0) | (sel_ids == blk_t) | (sel_ids == blk_t - 1)
        future = sel_ids > blk_t
        imp = jnp.where(forced[:, None, :], jnp.inf, jnp.where(future[:, None, :], -jnp.inf, imp))
        _, sel = lax.top_k(imp, k_top)
        k_g = k_blk[bi, gi, sel].reshape(B, Q_BLOCK, G, k_top * SEL_LEN, dk)
        v_g = v_blk[bi, gi, sel].reshape(B, Q_BLOCK, G, k_top * SEL_LEN, dv)
        pos = (sel[..., None] * SEL_LEN + jnp.arange(SEL_LEN)).reshape(B, Q_BLOCK, G, k_top * SEL_LEN)
        dist_s = t[None, :, None, None] - pos
        bias_s = tbl_g[gi, rel_bucket(dist_s)].transpose(0, 2, 4, 1, 3)
        s_s = jnp.einsum('bghqd,bqgsd->bghqs', qb, k_g).astype(f32) * scale + bias_s
        valid_s = (dist_s >= 0).transpose(0, 2, 1, 3)[:, :, None]
        p_s = jax.nn.softmax(jnp.where(valid_s, s_s, MASK_VALUE), axis=-1)
        o_s = jnp.einsum('bghqs,bqgsd->bqghd', p_s.astype(v_g.dtype), v_g)
        k_wb = lax.dynamic_slice_in_dim(k_wp, q0, WINDOW + Q_BLOCK, axis=1)
        v_wb = lax.dynamic_slice_in_dim(v_wp, q0, WINDOW + Q_BLOCK, axis=1)
        kpos = q0 + kw_off
        dist_w = t[:, None] - kpos[None, :]
        valid_w = (dist_w >= 0) & (dist_w < WINDOW) & (kpos[None, :] >= 0)
        s_w = jnp.einsum('bghqd,bkgd->bghqk', qb, k_wb).astype(f32) * scale + head_bias(dist_w)
        p_w = jax.nn.softmax(jnp.where(valid_w, s_w, MASK_VALUE), axis=-1)
        o_w = jnp.einsum('bghqk,bkgd->bqghd', p_w.astype(v_wb.dtype), v_wb)
        gb = gb.reshape(B, Q_BLOCK, G, HPG, 3)
        o = gb[..., 0:1] * o_c + gb[..., 1:2] * o_s + gb[..., 2:3] * o_w
        return o.reshape(B, Q_BLOCK, NSA_HEADS * dv)

    qb = q.reshape(B, n_q, Q_BLOCK, G, HPG, dk).transpose(1, 0, 3, 4, 2, 5)
    gates = jax.nn.sigmoid(gate_logits.astype(f32)).reshape(B, S, NSA_HEADS, 3)
    gb = gates.reshape(B, n_q, Q_BLOCK, NSA_HEADS, 3).transpose(1, 0, 2, 3, 4)
    out = lax.map(block, (jnp.arange(n_q), qb, gb))
    return out.transpose(1, 0, 2, 3).reshape(B, S, NSA_HEADS * dv)


def gated_linear_attention(q, k, v, r, a_low, gate_w, gate_b, norm_w):
    B, S, _ = q.shape
    H, dk, dv, C = GLA_HEADS, GLA_DK, GLA_DV, GLA_CHUNK
    N = S // C
    f32 = jnp.float32
    log_a = jax.nn.log_sigmoid((a_low @ gate_w + gate_b).astype(f32)) / GLA_TAU

    def chunk(t, d):
        return t.reshape(B, N, C, H, d).transpose(0, 3, 1, 2, 4).astype(f32)

    qc = chunk(q, dk) * dk ** -0.5
    kc = chunk(k, dk)
    vc = chunk(v, dv)
    bc = jnp.cumsum(chunk(log_a, dk), axis=-2)
    lower = jnp.tril(jnp.ones((C, C), bool))[..., None]
    dec = jnp.exp(jnp.where(lower, bc[..., :, None, :] - bc[..., None, :, :], -jnp.inf))
    attn = jnp.einsum('bhnid,bhnjd,bhnijd->bhnij', qc, kc, dec)
    o_intra = jnp.einsum('bhnij,bhnje->bhnie', attn, vc)
    q_dec = qc * jnp.exp(bc)
    k_dec = kc * jnp.exp(bc[..., -1:, :] - bc)
    c_dec = jnp.exp(bc[..., -1, :])

    def step(state, xs):
        q_n, k_n, v_n, d_n = xs
        o = jnp.einsum('bhcd,bhde->bhce', q_n, state)
        state = state * d_n[..., None] + jnp.einsum('bhcd,bhce->bhde', k_n, v_n)
        return state, o

    xs = tuple(jnp.moveaxis(t, 2, 0) for t in (q_dec, k_dec, vc, c_dec))
    _, o_inter = lax.scan(step, jnp.zeros((B, H, dk, dv), f32), xs)
    o = jnp.moveaxis(o_inter, 0, 2) + o_intra
    o = o.transpose(0, 2, 3, 1, 4).reshape(B, S, H, dv)
    o = rms_norm(o, norm_w) * jax.nn.silu(r.reshape(B, S, H, dv).astype(f32))
    return o.reshape(B, S, H * dv)


def token_mixing(h, rel_bias, w_in, gdn_conv_w, gdn_a_log, gdn_dt_bias, gdn_norm_w,
                 nsa_pe_k, nsa_cmp_k_w1, nsa_cmp_k_w2, nsa_pe_v, nsa_cmp_v_w1, nsa_cmp_v_w2,
                 gla_gate_w, gla_gate_b, gla_norm_w,
                 w_branch_gdn, w_branch_nsa, w_branch_gla, w_out):
    B, S, D = h.shape
    p = split_columns(h @ w_in)
    o_a = gated_deltanet(p['gdn_q'], p['gdn_k'], p['gdn_v'], p['gdn_z'], p['gdn_b'], p['gdn_a'],
                         gdn_conv_w, gdn_a_log, gdn_dt_bias, gdn_norm_w).astype(h.dtype)
    o_b = native_sparse_attention(p['nsa_q'], p['nsa_kv_cmp'], p['nsa_kv_sel'], p['nsa_kv_win'],
                                  p['nsa_gate'], rel_bias, nsa_pe_k, nsa_cmp_k_w1, nsa_cmp_k_w2,
                                  nsa_pe_v, nsa_cmp_v_w1, nsa_cmp_v_w2).astype(h.dtype)
    o_c = gated_linear_attention(p['gla_q'], p['gla_k'], p['gla_v'], p['gla_r'], p['gla_a'],
                                 gla_gate_w, gla_gate_b, gla_norm_w).astype(h.dtype)
    gates = jax.nn.sigmoid(p['merge_gate'].astype(jnp.float32)).astype(h.dtype).reshape(B, S, N_BRANCH, D)
    merged = (gates[:, :, 0] * (o_a @ w_branch_gdn)
              + gates[:, :, 1] * (o_b @ w_branch_nsa)
              + gates[:, :, 2] * (o_c @ w_branch_gla))
    return merged @ w_out


def setup_inputs(seed: int = 0) -> dict:
    key = jax.random.key(seed)
    keys = iter(jax.random.split(key, 40))
    f32 = jnp.float32
    L = DEPTH

    def dense(shape, fan_in):
        return jax.random.normal(next(keys), shape, f32) * fan_in ** -0.5

    def gain(shape):
        return 1.0 + 0.05 * jax.random.normal(next(keys), shape, f32)

    x = jax.random.normal(next(keys), (BATCH, SEQ, D_MODEL), f32)
    rel_bias = 0.2 * jax.random.normal(next(keys), (REL_BUCKETS, NSA_HEADS), f32)
    gdn_a_log = jnp.log(jax.random.uniform(next(keys), (L, GDN_HEADS), f32, minval=1.0, maxval=16.0))
    dt = jnp.exp(jax.random.uniform(next(keys), (L, GDN_HEADS), f32,
                                    minval=math.log(1e-3), maxval=math.log(1e-1)))
    gdn_dt_bias = dt + jnp.log(-jnp.expm1(-dt))
    return {
        "x": x,
        "rel_bias": rel_bias,
        "ffn1_norm_pre": gain((L, D_MODEL)),
        "ffn1_w_gate_up": dense((L, D_MODEL, 2 * D_FF), D_MODEL),
        "ffn1_w_down": dense((L, D_FF, D_MODEL), D_FF),
        "ffn1_norm_post": gain((L, D_MODEL)),
        "mix_norm_pre": gain((L, D_MODEL)),
        "w_in": dense((L, D_MODEL, D_IN), D_MODEL),
        "gdn_conv_w": dense((L, GDN_CONV, GDN_HEADS * (2 * GDN_DK + GDN_DV)), GDN_CONV),
        "gdn_a_log": gdn_a_log,
        "gdn_dt_bias": gdn_dt_bias,
        "gdn_norm_w": gain((L, GDN_DV)),
        "nsa_pe_k": dense((L, CMP_LEN, NSA_DK), NSA_DK),
        "nsa_cmp_k_w1": dense((L, CMP_LEN * NSA_DK, CMP_HIDDEN), CMP_LEN * NSA_DK),
        "nsa_cmp_k_w2": dense((L, CMP_HIDDEN, NSA_DK), CMP_HIDDEN),
        "nsa_pe_v": dense((L, CMP_LEN, NSA_DV), NSA_DV),
        "nsa_cmp_v_w1": dense((L, CMP_LEN * NSA_DV, CMP_HIDDEN), CMP_LEN * NSA_DV),
        "nsa_cmp_v_w2": dense((L, CMP_HIDDEN, NSA_DV), CMP_HIDDEN),
        "gla_gate_w": dense((L, GLA_RANK, GLA_HEADS * GLA_DK), GLA_RANK),
        "gla_gate_b": 0.1 * jax.random.normal(next(keys), (L, GLA_HEADS * GLA_DK), f32),
        "gla_norm_w": gain((L, GLA_DV)),
        "w_branch_gdn": dense((L, GDN_HEADS * GDN_DV, D_MODEL), GDN_HEADS * GDN_DV),
        "w_branch_nsa": dense((L, NSA_HEADS * NSA_DV, D_MODEL), NSA_HEADS * NSA_DV),
        "w_branch_gla": dense((L, GLA_HEADS * GLA_DV, D_MODEL), GLA_HEADS * GLA_DV),
        "w_out": dense((L, D_MODEL, D_MODEL), D_MODEL),
        "mix_norm_post": gain((L, D_MODEL)),
        "ffn2_norm_pre": gain((L, D_MODEL)),
        "ffn2_w_gate_up": dense((L, D_MODEL, 2 * D_FF), D_MODEL),
        "ffn2_w_down": dense((L, D_FF, D_MODEL), D_FF),
        "ffn2_norm_post": gain((L, D_MODEL)),
    }


def reference(x, rel_bias,
              ffn1_norm_pre, ffn1_w_gate_up, ffn1_w_down, ffn1_norm_post,
              mix_norm_pre, w_in, gdn_conv_w, gdn_a_log, gdn_dt_bias, gdn_norm_w,
              nsa_pe_k, nsa_cmp_k_w1, nsa_cmp_k_w2, nsa_pe_v, nsa_cmp_v_w1, nsa_cmp_v_w2,
              gla_gate_w, gla_gate_b, gla_norm_w,
              w_branch_gdn, w_branch_nsa, w_branch_gla, w_out, mix_norm_post,
              ffn2_norm_pre, ffn2_w_gate_up, ffn2_w_down, ffn2_norm_post):
    for l in range(DEPTH):
        x = macaron_ffn(x, ffn1_norm_pre[l], ffn1_w_gate_up[l], ffn1_w_down[l], ffn1_norm_post[l])
        y = token_mixing(rms_norm(x, mix_norm_pre[l]), rel_bias, w_in[l],
                         gdn_conv_w[l], gdn_a_log[l], gdn_dt_bias[l], gdn_norm_w[l],
                         nsa_pe_k[l], nsa_cmp_k_w1[l], nsa_cmp_k_w2[l],
                         nsa_pe_v[l], nsa_cmp_v_w1[l], nsa_cmp_v_w2[l],
                         gla_gate_w[l], gla_gate_b[l], gla_norm_w[l],
                         w_branch_gdn[l], w_branch_nsa[l], w_branch_gla[l], w_out[l])
        x = x + rms_norm(y, mix_norm_post[l])
        x = macaron_ffn(x, ffn2_norm_pre[l], ffn2_w_gate_up[l], ffn2_w_down[l], ffn2_norm_post[l])
    return x
```

```cpp
#include <hip/hip_runtime.h>
#include <cstdio>
#include <cstdint>
#ifndef MK_ONE_LAUNCH
#define MK_ONE_LAUNCH 0
#endif
namespace pg8 {
#define PG8_LAS __attribute__((address_space(3)))
typedef unsigned short bf16_t;
typedef short bf16x8 __attribute__((ext_vector_type(8)));
typedef float f32x4 __attribute__((ext_vector_type(4)));
typedef unsigned u32x4 __attribute__((ext_vector_type(4)));
typedef unsigned u32x2 __attribute__((ext_vector_type(2)));
constexpr int BM = 256, BK = 64, HALF = 128, HTB = HALF * BK * 2  , STAGE_BYTES = 8 * HTB, NXCD = 8, WGM = 8;

__host__ __device__ __forceinline__ int lds_byte(int r, int c) { const int st = (r >> 4) * 2 + (c >> 5), rr = r & 15, cc = c & 31, ob = rr * 64 + cc * 2; return st * 1024 + (ob ^ (((ob >> 9) & 1) << 5)); }
__host__ __device__ __forceinline__ void stage_rc(int b, int& R, int& C) { const int st = b / 1024, sb = b % 1024, swz = sb ^ (((sb >> 9) & 1) << 5); R = (st >> 1) * 16 + swz / 64; C = (st & 1) * 32 + (swz % 64) / 2; }
__host__ __device__ __forceinline__ int perm32(int rho) { const int n = rho >> 4, i = rho & 15; return 8 * (i >> 2) + 4 * n + (i & 3); }

struct Unit { int pm, pn; };
struct Gemm { const bf16_t* A; const bf16_t* Bt; int M, N, K; };

struct StaticOrder {
    int nM, nN, nwg, G, c;
    __host__ __device__ void init(int M, int N, int G_, int c_) { nM = M / BM; nN = N / BM; nwg = nM * nN; G = G_; c = c_; }
    __host__ __device__ bool next(int i, Unit& u) const {
        const long L = (long)i * G + c; if (L >= nwg) return false;
        int wgid = (int)L; { const int q = nwg / NXCD, r = nwg % NXCD, xcd = wgid % NXCD, off = wgid / NXCD; wgid = (xcd < r ? xcd * (q + 1) : r * (q + 1) + (xcd - r) * q) + off; }
        const int nig = WGM * nN, gid = wgid / nig, fm = gid * WGM, gsz = (nM - fm) < WGM ? (nM - fm) : WGM;
        u.pm = fm + ((wgid % nig) % gsz); u.pn = (wgid % nig) / gsz; return true;
    }
    __device__ __forceinline__ void a_ready(const Unit&) const {}
    __device__ __forceinline__ void done(const Unit&) const {}
};

__device__ __forceinline__ unsigned cvt_pk_bf16(float lo, float hi) { unsigned r; asm volatile("v_cvt_pk_bf16_f32 %0, %1, %2" : "=v"(r) : "v"(lo), "v"(hi)); return r; }
__device__ __forceinline__ float bflo(unsigned w) { return __uint_as_float(w << 16); }
__device__ __forceinline__ float bfhi(unsigned w) { return __uint_as_float(w & 0xffff0000u); }
__device__ __forceinline__ float sigmoid_f(float x) { return __builtin_amdgcn_rcpf(1.f + __expf(-x)); }

struct EpiSwiglu {
    static constexpr bool PERM = true, AFTER_DRAIN = false;
    bf16_t* H; int ldh;
    __device__ __forceinline__ void operator()(const f32x4 (&acc)[2][2][4][2], const Unit& u, int wr, int wc, int fr, int fq) const {
        const int row0 = u.pm * BM + wr * 64 + fr, j0 = u.pn * HALF + wc * 32 + 8 * fq;
#pragma unroll
        for (int ai = 0; ai < 2; ++ai)
#pragma unroll
            for (int m = 0; m < 4; ++m) {
                bf16_t* p = H + (size_t)(row0 + ai * HALF + m * 16) * ldh + j0;
                float h[8];
#pragma unroll
                for (int n = 0; n < 2; ++n)
#pragma unroll
                    for (int i = 0; i < 4; ++i) { const float g = acc[ai][0][m][n][i], uu = acc[ai][1][m][n][i]; h[n * 4 + i] = g * sigmoid_f(g) * uu; }
                u32x4 w; w.x = cvt_pk_bf16(h[0], h[1]); w.y = cvt_pk_bf16(h[2], h[3]); w.z = cvt_pk_bf16(h[4], h[5]); w.w = cvt_pk_bf16(h[6], h[7]);
                *(u32x4*)p = w;
            }
    }
};
struct EpiF32 {
    static constexpr bool PERM = false, AFTER_DRAIN = false;
    float* Y; int ldc;
    __device__ __forceinline__ void operator()(const f32x4 (&acc)[2][2][4][2], const Unit& u, int wr, int wc, int fr, int fq) const {
        const int row0 = u.pm * BM + wr * 64 + fr, col0 = u.pn * BM + wc * 32 + 4 * fq;
#pragma unroll
        for (int ai = 0; ai < 2; ++ai)
#pragma unroll
            for (int m = 0; m < 4; ++m) { float* p = Y + (size_t)(row0 + ai * HALF + m * 16) * ldc + col0;
#pragma unroll
                for (int bj = 0; bj < 2; ++bj)
#pragma unroll
                    for (int n = 0; n < 2; ++n) *(f32x4*)(p + bj * HALF + n * 16) = acc[ai][bj][m][n]; }
    }
};
struct EpiWin {
    static constexpr bool PERM = true, AFTER_DRAIN = false;
    bf16_t* PA; float* SM; bf16_t* G;
    __device__ __forceinline__ void operator()(const f32x4 (&acc)[2][2][4][2], const Unit& u, int wr, int wc, int fr, int fq) const {
        const int row0 = u.pm * BM + wr * 64 + fr, cw = wc * 32 + 8 * fq;
        const bool gate = u.pn >= 21;
#pragma unroll
        for (int ai = 0; ai < 2; ++ai)
#pragma unroll
            for (int m = 0; m < 4; ++m) { const size_t row = (size_t)(row0 + ai * HALF + m * 16);
#pragma unroll
                for (int bj = 0; bj < 2; ++bj) {
                    f32x4 v0 = acc[ai][bj][m][0], v1 = acc[ai][bj][m][1];
                    if (gate) {
#pragma unroll
                        for (int i = 0; i < 4; ++i) { v0[i] = sigmoid_f(v0[i]); v1[i] = sigmoid_f(v1[i]); }
                    }
                    u32x4 w; w.x = cvt_pk_bf16(v0[0], v0[1]); w.y = cvt_pk_bf16(v0[2], v0[3]); w.z = cvt_pk_bf16(v1[0], v1[1]); w.w = cvt_pk_bf16(v1[2], v1[3]);
                    if (gate) *(u32x4*)(G + row * 3072 + (u.pn - 21) * BM + bj * HALF + cw) = w;
                    else {
                        const int col = u.pn * BM + bj * HALF + cw;
                        *(u32x4*)(PA + row * 5376 + col) = w;
                        if (col >= 5312) { float* s = SM + row * 64 + (col - 5312); *(f32x4*)s = v0; *(f32x4*)(s + 4) = v1; }
                    }
                }
            }
    }
};
struct EpiMerge {
    static constexpr bool PERM = false, AFTER_DRAIN = false;
    const bf16_t* G; float* RMW; bf16_t* MG; int STEP;
    __device__ __forceinline__ void operator()(const f32x4 (&acc)[2][2][4][2], const Unit& u, int wr, int wc, int fr, int fq) const {
        const int row0 = u.pm * BM + wr * 64 + fr, col0 = u.pn * BM + wc * 32 + 4 * fq;
#pragma unroll
        for (int ai = 0; ai < 2; ++ai)
#pragma unroll
            for (int m = 0; m < 4; ++m) { const size_t row = (size_t)(row0 + ai * HALF + m * 16);
#pragma unroll
                for (int bj = 0; bj < 2; ++bj)
#pragma unroll
                    for (int n = 0; n < 2; ++n) { const int c = col0 + bj * HALF + n * 16;
                        const u32x2 gw = *(const u32x2*)(G + row * 3072 + c);
                        f32x4 v = acc[ai][bj][m][n]; v[0] *= bflo(gw.x); v[1] *= bfhi(gw.x); v[2] *= bflo(gw.y); v[3] *= bfhi(gw.y);
                        float* r = RMW + row * 1024 + c;
                        if (STEP == 0) *(f32x4*)r = v;
                        else if (STEP == 1) *(f32x4*)r = *(const f32x4*)r + v;
                        else { v = *(const f32x4*)r + v; u32x2 w; w.x = cvt_pk_bf16(v[0], v[1]); w.y = cvt_pk_bf16(v[2], v[3]); *(u32x2*)(MG + row * 1024 + c) = w; }
                    }
            }
    }
};

template <class Epi, class Sched, bool ALIGN_EPI = false, bool SP2 = false>
__device__ __forceinline__ void gemm_phase(PG8_LAS unsigned char* lds, const Gemm g, const Sched& S, const Epi& E) {
    int tid_ = threadIdx.x; asm volatile("" : "+v"(tid_));
    const int tid = tid_, wid = __builtin_amdgcn_readfirstlane(tid >> 6), lane = tid & 63, wr = wid >> 2, wc = wid & 3, fr = lane & 15, fq = lane >> 4;
    const int K = g.K, nt = K / BK;
    unsigned voffA[2], voffB[2];
#pragma unroll
    for (int i = 0; i < 2; ++i) { int R, C; stage_rc(tid * 16 + i * 8192, R, C); const int Rb = Epi::PERM ? ((R & ~31) + perm32(R & 31)) : R;
        voffA[i] = (unsigned)(R * K + C) * 2u; voffB[i] = (unsigned)(Rb * K + C) * 2u; }
    const size_t kstep = (size_t)(BK * 2);
    const size_t hstep = (size_t)HALF * K * 2;
    const size_t tstep = 2 * hstep;
    const unsigned ldsw = (unsigned)wid * 1024u;
    const int aoff = lds_byte(wr * 64 + fr, fq * 8), boff = lds_byte(wc * 32 + fr, fq * 8);
#define PG8_SA(b, h) (((b) * 2 + (h)) * HTB)
#define PG8_SB(b, h) ((4 + (b) * 2 + (h)) * HTB)
#define PG8_STAGE(bufoff, gbase, voff) do { _Pragma("unroll") for (int _i = 0; _i < 2; ++_i) \
        __builtin_amdgcn_global_load_lds((const unsigned*)((const char*)(gbase) + (voff)[_i]), (PG8_LAS unsigned*)(lds + (bufoff) + ldsw + _i * 8192), 16, 0, 0); } while (0)
#define PG8_LDA(dst, b, h) do { _Pragma("unroll") for (int m = 0; m < 4; ++m) _Pragma("unroll") for (int k = 0; k < 2; ++k) dst[m][k] = *(const PG8_LAS bf16x8*)(lds + PG8_SA(b, h) + aoff + m * 2048 + k * 1024); } while (0)
#define PG8_LDB(dst, b, h) do { _Pragma("unroll") for (int n = 0; n < 2; ++n) _Pragma("unroll") for (int k = 0; k < 2; ++k) dst[n][k] = *(const PG8_LAS bf16x8*)(lds + PG8_SB(b, h) + boff + n * 2048 + k * 1024); } while (0)
#define PG8_MMA(ai, bj, At, Bt) do { __builtin_amdgcn_s_setprio(1); _Pragma("unroll") for (int m = 0; m < 4; ++m) _Pragma("unroll") for (int n = 0; n < 2; ++n) _Pragma("unroll") for (int k = 0; k < 2; ++k) \
        acc[ai][bj][m][n] = __builtin_amdgcn_mfma_f32_16x16x32_bf16(Bt[n][k], At[m][k], acc[ai][bj][m][n], 0, 0, 0); __builtin_amdgcn_s_setprio(0); } while (0)
#define PG8_WAIT_V(n) asm volatile("s_waitcnt vmcnt(" #n ")" ::: "memory")
#define PG8_WAIT_L(n) asm volatile("s_waitcnt lgkmcnt(" #n ")" ::: "memory")
#define PG8_BAR __builtin_amdgcn_s_barrier()
#define PG8_SCHED __builtin_amdgcn_sched_barrier(0)
    Unit cur, nxt; int ui = 0;
    if (!S.next(0, cur)) return;
    f32x4 acc[2][2][4][2];
#pragma unroll
    for (int a = 0; a < 2; ++a)
#pragma unroll
        for (int b = 0; b < 2; ++b)
#pragma unroll
            for (int m = 0; m < 4; ++m)
#pragma unroll
                for (int n = 0; n < 2; ++n) acc[a][b][m][n] = (f32x4){0.f, 0.f, 0.f, 0.f};
    bf16x8 At[4][2], B0[2][2], B1[2][2];
    const char* cA = (const char*)g.A + (size_t)cur.pm * tstep; const char* cB = (const char*)g.Bt + (size_t)cur.pn * tstep;
    S.a_ready(cur);
    if constexpr (SP2) {
        PG8_STAGE(PG8_SB(0, 0), cB, voffB); PG8_STAGE(PG8_SB(0, 1), cB + hstep, voffB); PG8_STAGE(PG8_SA(0, 0), cA, voffA); PG8_STAGE(PG8_SA(0, 1), cA + hstep, voffA);
        if (wr == 1) PG8_BAR;
        PG8_WAIT_V(2); PG8_BAR;
        PG8_STAGE(PG8_SB(1, 0), cB + kstep, voffB); PG8_STAGE(PG8_SA(1, 0), cA + kstep, voffA); PG8_STAGE(PG8_SB(1, 1), cB + hstep + kstep, voffB);
        PG8_WAIT_V(6); PG8_BAR;
    } else {
        PG8_STAGE(PG8_SB(0, 0), cB, voffB); PG8_STAGE(PG8_SA(0, 0), cA, voffA); PG8_STAGE(PG8_SB(0, 1), cB + hstep, voffB); PG8_STAGE(PG8_SA(0, 1), cA + hstep, voffA);
        if (wr == 1) PG8_BAR;
        PG8_WAIT_V(4); PG8_BAR;
        PG8_STAGE(PG8_SB(1, 0), cB + kstep, voffB); PG8_STAGE(PG8_SA(1, 0), cA + kstep, voffA); PG8_STAGE(PG8_SB(1, 1), cB + hstep + kstep, voffB);
        PG8_WAIT_V(6); PG8_BAR;
    }
    for (;;) {
        const bool has_next = S.next(ui + 1, nxt);
        const char* nA = has_next ? (const char*)g.A + (size_t)nxt.pm * tstep : cA; const char* nB = has_next ? (const char*)g.Bt + (size_t)nxt.pn * tstep : cB;
        for (int t = 0; t < nt; t += 2) {
            const bool last = (t == nt - 2);
            const char* a1 = cA + (size_t)(t + 1) * kstep;
            const char* a2 = last ? nA : cA + (size_t)(t + 2) * kstep; const char* b2 = last ? nB : cB + (size_t)(t + 2) * kstep;
            const char* a3 = a2 + kstep; const char* b3 = b2 + kstep;
            if (last && has_next) S.a_ready(nxt);
            if constexpr (SP2) {
            PG8_LDB(B0, 0, 0); PG8_LDB(B1, 0, 1); PG8_SCHED; PG8_LDA(At, 0, 0); PG8_STAGE(PG8_SA(1, 1), a1 + hstep, voffA);
            PG8_WAIT_V(8); PG8_WAIT_L(0); PG8_BAR; PG8_MMA(0, 0, At, B0); PG8_MMA(0, 1, At, B1); PG8_BAR; PG8_SCHED;
            PG8_LDA(At, 0, 1); PG8_STAGE(PG8_SB(0, 0), b2, voffB); PG8_STAGE(PG8_SB(0, 1), b2 + hstep, voffB); PG8_STAGE(PG8_SA(0, 0), a2, voffA);
            PG8_WAIT_V(8); PG8_WAIT_L(0); PG8_BAR; PG8_MMA(1, 0, At, B0); PG8_MMA(1, 1, At, B1); PG8_BAR; PG8_SCHED;
            PG8_LDB(B0, 1, 0); PG8_LDB(B1, 1, 1); PG8_SCHED; PG8_LDA(At, 1, 0); PG8_STAGE(PG8_SA(0, 1), a2 + hstep, voffA);
            PG8_WAIT_V(8); PG8_WAIT_L(0); PG8_BAR; PG8_MMA(0, 0, At, B0); PG8_MMA(0, 1, At, B1); PG8_BAR; PG8_SCHED;
            PG8_LDA(At, 1, 1); PG8_STAGE(PG8_SB(1, 0), b3, voffB); PG8_STAGE(PG8_SB(1, 1), b3 + hstep, voffB); PG8_STAGE(PG8_SA(1, 0), a3, voffA);
            PG8_WAIT_V(8); PG8_WAIT_L(0); PG8_BAR; PG8_MMA(1, 0, At, B0); PG8_MMA(1, 1, At, B1); PG8_BAR; PG8_SCHED;
            } else {
            PG8_LDB(B0, 0, 0); PG8_SCHED; PG8_LDA(At, 0, 0); PG8_STAGE(PG8_SA(1, 1), a1 + hstep, voffA);
            PG8_WAIT_L(8); PG8_BAR; PG8_WAIT_L(0); PG8_MMA(0, 0, At, B0); PG8_BAR; PG8_SCHED;
            PG8_LDB(B1, 0, 1); PG8_STAGE(PG8_SB(0, 0), b2, voffB);
            PG8_BAR; PG8_WAIT_L(0); PG8_MMA(0, 1, At, B1); PG8_BAR;
            PG8_LDA(At, 0, 1); PG8_STAGE(PG8_SA(0, 0), a2, voffA);
            PG8_BAR; PG8_WAIT_L(0); PG8_MMA(1, 0, At, B0); PG8_BAR; PG8_SCHED;
            PG8_STAGE(PG8_SB(0, 1), b2 + hstep, voffB);
            PG8_WAIT_V(6); PG8_BAR; PG8_MMA(1, 1, At, B1); PG8_BAR;
            PG8_LDB(B0, 1, 0); PG8_SCHED; PG8_LDA(At, 1, 0); PG8_STAGE(PG8_SA(0, 1), a2 + hstep, voffA);
            PG8_WAIT_L(8); PG8_BAR; PG8_WAIT_L(0); PG8_MMA(0, 0, At, B0); PG8_BAR; PG8_SCHED;
            PG8_LDB(B1, 1, 1); PG8_STAGE(PG8_SB(1, 0), b3, voffB);
            PG8_BAR; PG8_WAIT_L(0); PG8_MMA(0, 1, At, B1); PG8_BAR;
            PG8_LDA(At, 1, 1); PG8_STAGE(PG8_SA(1, 0), a3, voffA);
            PG8_BAR; PG8_WAIT_L(0); PG8_MMA(1, 0, At, B0); PG8_BAR; PG8_SCHED;
            PG8_STAGE(PG8_SB(1, 1), b3 + hstep, voffB);
            PG8_WAIT_V(6); PG8_BAR; PG8_MMA(1, 1, At, B1); PG8_BAR;
            }
        }
        if constexpr (ALIGN_EPI) { if (wr == 0) PG8_BAR; }
        if constexpr (!Epi::AFTER_DRAIN) { E(acc, cur, wr, wc, fr, fq); S.done(cur); }
        if (!has_next) break;
#pragma unroll
        for (int a = 0; a < 2; ++a)
#pragma unroll
            for (int b = 0; b < 2; ++b)
#pragma unroll
                for (int m = 0; m < 4; ++m)
#pragma unroll
                    for (int n = 0; n < 2; ++n) acc[a][b][m][n] = (f32x4){0.f, 0.f, 0.f, 0.f};
        cur = nxt; cA = nA; cB = nB; ++ui;
        if constexpr (ALIGN_EPI) { if (wr == 1) PG8_BAR; }
    }
    PG8_WAIT_V(0);
    if constexpr (!ALIGN_EPI) { if (wr == 0) PG8_BAR; }
    PG8_BAR;
    if constexpr (Epi::AFTER_DRAIN) { E.fused(acc, cur, wr, wc, fr, fq, lds, wid, lane); S.done(cur); }
#undef PG8_SA
#undef PG8_SB
#undef PG8_STAGE
#undef PG8_LDA
#undef PG8_LDB
#undef PG8_MMA
#undef PG8_WAIT_V
#undef PG8_WAIT_L
#undef PG8_BAR
#undef PG8_SCHED
}
}

constexpr int NWAVES = 8, NTHR = 512;
constexpr int NBATCH = 2, SEQ = 8192, MTOK = NBATCH * SEQ, DM = 1024, DFF = 2816, DIN_SRC = 8432, NIN = 8448, NPA = 5376, NMG = 3072, DEPTH = 2;
constexpr float NORM_EPS = 1e-6f;
constexpr int PA_GQ = 0, PA_GK = 512, PA_GV = 1024, PA_GZ = 1536, PA_NQ = 2048, PA_KC = 2816, PA_KS = 3136, PA_KW = 3456, PA_LQ = 3776, PA_LK = 4032, PA_LV = 4288, PA_LR = 4800, PA_SM = 5312;
constexpr size_t MiB = 1u << 20;
constexpr size_t WS_CTL = 0, CTL_ZERO_BYTES = 1 * MiB;
constexpr size_t WS_WGU = 1 * MiB, WS_WD = 12 * MiB, WS_WIN = WS_WD + 5632 * 1024, WS_WB = WS_WIN + (size_t)NIN * DM * 2, WS_WO = WS_WB + 3 * MiB;
constexpr size_t WS_XN = 40 * MiB, WS_A = 72 * MiB, WS_G = 160 * MiB, WS_O = 208 * MiB, WS_QKV = 232 * MiB, WS_SM = 256 * MiB, WS_GATES = 258 * MiB, WS_ORAW = 259 * MiB, WS_KCMP = 275 * MiB, WS_VCMP = WS_KCMP + 512 * 1024, WS_END = 276 * MiB;
constexpr size_t WS_H = WS_A, WS_Y = WS_G;
constexpr size_t WS_RMW = WS_A, WS_MG = WS_A + 32 * MiB, WS_YB = WS_A + 48 * MiB;
static_assert(WS_WO + 2 * MiB <= WS_XN && WS_Y + 64 * MiB <= WS_QKV && WS_YB + 32 * MiB <= WS_G, "ws map");
constexpr int CW_BAR = 4096;
constexpr int RING_BYTES = 131072, LDSCTL_OFF = RING_BYTES, MISC_OFF = LDSCTL_OFF + 320, BTAB_OFF = RING_BYTES + 1024, LDS_BYTES = 147456;

#define GAS __attribute__((address_space(1)))
#define LAS __attribute__((address_space(3)))
typedef unsigned short bf16;
typedef unsigned v4u __attribute__((ext_vector_type(4)));
typedef unsigned v2u __attribute__((ext_vector_type(2)));
typedef float f32x4 __attribute__((ext_vector_type(4)));
#define LDS_WAIT() asm volatile("s_waitcnt lgkmcnt(0)" ::: "memory")
__device__ __forceinline__ unsigned f2bf(float f) { unsigned u = __builtin_bit_cast(unsigned, f); return (u + 0x7fffu + ((u >> 16) & 1u)) >> 16; }
__device__ __forceinline__ unsigned pk2(float lo, float hi) { return f2bf(lo) | (f2bf(hi) << 16); }
__device__ __forceinline__ float bf2f(bf16 h) { return __uint_as_float((unsigned)h << 16); }
__device__ __forceinline__ float bflo(unsigned w) { return __uint_as_float(w << 16); }
__device__ __forceinline__ float bfhi(unsigned w) { return __uint_as_float(w & 0xffff0000u); }
__device__ __forceinline__ float wave_sum(float v) {
#pragma unroll
    for (int o = 1; o < 64; o <<= 1) v += __shfl_xor(v, o);
    return v;
}
__device__ __forceinline__ float wave_max(float v) {
#pragma unroll
    for (int o = 1; o < 64; o <<= 1) v = fmaxf(v, __shfl_xor(v, o));
    return v;
}
__device__ __forceinline__ float sigmoidf_(float x) { return 1.f / (1.f + expf(-x)); }
__device__ __forceinline__ float siluf_(float x) { return x / (1.f + expf(-x)); }
__device__ __forceinline__ float softplusf_(float x) { return x > 20.f ? x : log1pf(expf(x)); }
__device__ __forceinline__ float logsigmoidf_(float x) { return fminf(x, 0.f) - log1pf(expf(-fabsf(x))); }
__device__ __forceinline__ float gelu_tanhf_(float x) { return 0.5f * x * (1.f + tanhf(0.7978845608028654f * (x + 0.044715f * x * x * x))); }

#define XB_TMO      128
#define XB_XCNT(j)  (256  + 64 * (j))
#define XB_XSUB(j)  (1280 + 64 * (j))
#define XB_XGEN(j)  (2304 + 64 * (j))
#define XB_TOP      3328
#define XB_TOPGEN   3392
#define XCD_BAR_WORDS 3456
#define XB_SPIN_CAP (1u << 22)
__device__ __forceinline__ unsigned xb_ld(unsigned* p)              { return __hip_atomic_load(p, __ATOMIC_RELAXED, __HIP_MEMORY_SCOPE_AGENT); }
__device__ __forceinline__ unsigned xb_add(unsigned* p, unsigned v) { return __hip_atomic_fetch_add(p, v, __ATOMIC_RELAXED, __HIP_MEMORY_SCOPE_AGENT); }
__device__ __forceinline__ unsigned xb_xcc_id() { return (unsigned)__builtin_amdgcn_s_getreg((3 << 11) | 20) & 0xFu; }
#define XB_SPIN(cond, bar) do { unsigned _sp = 0; while (cond) { __builtin_amdgcn_s_sleep(1); \
    if ((++_sp & 255u) == 0u) { if (xb_ld(&(bar)[XB_TMO])) break; if (_sp > XB_SPIN_CAP) { atomicAdd(&(bar)[XB_TMO], 1u); break; } } } } while (0)
struct XcdBarrier { unsigned* bar; unsigned x; volatile LAS unsigned* st; };
__device__ __forceinline__ XcdBarrier xcd_barrier_post(unsigned* bar, volatile LAS unsigned* st) {
    XcdBarrier b; b.bar = bar; b.x = xb_xcc_id(); b.st = st;
    if (threadIdx.x == 0) (void)xb_add(&bar[XB_XCNT(b.x)], 1u);
    return b;
}
__device__ __forceinline__ void xcd_barrier_complete(unsigned* bar, unsigned x, unsigned& nloc, unsigned& nx) {
    const unsigned G = gridDim.x * gridDim.y * gridDim.z;
    unsigned sum, cnt, mine, sp = 0u;
    for (;;) {
        sum = 0u; cnt = 0u; mine = 0u;
#pragma unroll
        for (unsigned j = 0; j < 16; ++j) { const unsigned c = xb_ld(&bar[XB_XCNT(j)]); sum += c; cnt += (c > 0u) ? 1u : 0u; mine = (j == x) ? c : mine; }
        if (sum == G) break;
        __builtin_amdgcn_s_sleep(1);
        if ((++sp & 255u) == 0u) { if (xb_ld(&bar[XB_TMO])) break; if (sp > XB_SPIN_CAP) { atomicAdd(&bar[XB_TMO], 1u); break; } }
    }
    nloc = mine > 0u ? mine : 1u; nx = cnt > 0u ? cnt : 1u;
}
__device__ __forceinline__ void xcd_barrier(const XcdBarrier& b) {
    asm volatile("s_waitcnt vmcnt(0)" ::: "memory");
    __syncthreads();
    if (threadIdx.x == 0) {
        unsigned* bar = b.bar;
        __builtin_amdgcn_s_waitcnt(0);
        unsigned nloc = b.st[0], nx = b.st[1];
        if (nloc == 0u) { xcd_barrier_complete(bar, b.x, nloc, nx); b.st[0] = nloc; b.st[1] = nx; }
        const unsigned old = xb_add(&bar[XB_XSUB(b.x)], 1u);
        const unsigned gen = old / nloc;
        if (old + 1u == (gen + 1u) * nloc) {
            __builtin_amdgcn_fence(__ATOMIC_RELEASE, "agent");
            asm volatile("s_waitcnt vmcnt(0)" ::: "memory");
            const unsigned og = xb_add(&bar[XB_TOP], 1u);
            const unsigned tg = og / nx;
            if (og + 1u == (tg + 1u) * nx) xb_add(&bar[XB_TOPGEN], 1u);
            else XB_SPIN(xb_ld(&bar[XB_TOPGEN]) == tg, bar);
            __builtin_amdgcn_fence(__ATOMIC_ACQUIRE, "agent");
            xb_add(&bar[XB_XGEN(b.x)], 1u);
            asm volatile("s_waitcnt vmcnt(0)" ::: "memory");
        } else {
            XB_SPIN(xb_ld(&bar[XB_XGEN(b.x)]) == gen, bar);
            __builtin_amdgcn_fence(__ATOMIC_ACQUIRE, "agent");
            asm volatile("s_waitcnt vmcnt(0)" ::: "memory");
        }
    }
    __syncthreads();
}

struct Args { const float* in[30]; float* out; unsigned char* ws; int ph_lo, ph_hi; };
enum { I_X = 0, I_RELB, I_F1PRE, I_F1GU, I_F1D, I_F1POST, I_MPRE, I_WIN, I_CONVW, I_ALOG, I_DTB, I_GDNNW, I_PEK, I_W1K, I_W2K, I_PEV, I_W1V, I_W2V, I_GGW, I_GGB, I_GLANW, I_WBG, I_WBN, I_WBL, I_WOUT, I_MPOST, I_F2PRE, I_F2GU, I_F2D, I_F2POST };

template <class RowMap>
__device__ __forceinline__ void transpose_item(const float* W, int K, int N, bf16* WT, LAS float* scr, int item, int lane, const RowMap& rm) {
    const int nblk = (N + 31) / 32, kb = item / nblk, nb = item % nblk, k0 = 64 * kb, n0 = 32 * nb;
    const bool okc = (n0 + (lane & 31)) < N;
#pragma unroll 8
    for (int i = 0; i < 32; ++i) { const int kk = 2 * i + (lane >> 5); scr[kk * 33 + (lane & 31)] = okc ? W[(size_t)(k0 + kk) * N + n0 + (lane & 31)] : 0.f; }
    LDS_WAIT(); asm volatile("" ::: "memory");
    const int c = lane & 7;
#pragma unroll
    for (int j = 0; j < 4; ++j) { const int n = (lane >> 3) + 8 * j; const LAS float* s = scr + (8 * c) * 33 + n;
        v4u o; o.x = pk2(s[0 * 33], s[1 * 33]); o.y = pk2(s[2 * 33], s[3 * 33]); o.z = pk2(s[4 * 33], s[5 * 33]); o.w = pk2(s[6 * 33], s[7 * 33]);
        if (n0 + n < N) *(v4u*)(WT + (size_t)rm(n0 + n) * K + k0 + 8 * c) = o; }
    LDS_WAIT(); asm volatile("" ::: "memory");
}
struct MapId { __device__ __forceinline__ int operator()(int n) const { return n; } };
struct MapGU { __device__ __forceinline__ int operator()(int n) const { const int u = n >= DFF, j = u ? n - DFF : n; return 256 * (j >> 7) + 128 * u + (j & 127); } };
struct MapWin { __device__ __forceinline__ int operator()(int c) const {
    if (c < 2048) return c;
    if (c < 2056) return PA_SM + (c - 2048);
    if (c < 2824) return PA_NQ + (c - 2056);
    if (c < 3784) return PA_KC + (c - 2824);
    if (c < 3808) return PA_SM + 8 + (c - 3784);
    if (c < 5344) return PA_LQ + (c - 3808);
    if (c < 5360) return PA_SM + 32 + (c - 5344);
    return NPA + (c - 5360); } };

__device__ __forceinline__ void row_pass(const float* xin, const float* y, const float* wpost, float scale, float* xout, const float* wnext, bf16* xn, int lane) {
    f32x4 v[4];
#pragma unroll
    for (int j = 0; j < 4; ++j) v[j] = ((const f32x4*)xin)[lane + 64 * j];
    if (y) {
        f32x4 yv[4]; float s = 0.f;
#pragma unroll
        for (int j = 0; j < 4; ++j) { yv[j] = ((const f32x4*)y)[lane + 64 * j]; s += (yv[j].x * yv[j].x + yv[j].y * yv[j].y) + (yv[j].z * yv[j].z + yv[j].w * yv[j].w); }
        const float r = scale / sqrtf(wave_sum(s) * (1.f / DM) + NORM_EPS);
#pragma unroll
        for (int j = 0; j < 4; ++j) { const f32x4 w = ((const f32x4*)wpost)[lane + 64 * j]; v[j] = v[j] + yv[j] * w * r; }
    }
    if (xout) {
#pragma unroll
        for (int j = 0; j < 4; ++j) ((f32x4*)xout)[lane + 64 * j] = v[j];
    }
    if (xn) {
        float s = 0.f;
#pragma unroll
        for (int j = 0; j < 4; ++j) s += (v[j].x * v[j].x + v[j].y * v[j].y) + (v[j].z * v[j].z + v[j].w * v[j].w);
        const float r = 1.f / sqrtf(wave_sum(s) * (1.f / DM) + NORM_EPS);
#pragma unroll
        for (int j = 0; j < 4; ++j) { const f32x4 w = ((const f32x4*)wnext)[lane + 64 * j]; const f32x4 o = v[j] * w * r;
            v2u pk; pk.x = pk2(o.x, o.y); pk.y = pk2(o.z, o.w); ((v2u*)xn)[lane + 64 * j] = pk; }
    }
}

__device__ __forceinline__ void gdn_prep_item(const bf16* PA, const float* convw, const float* alog, const float* dtb, const float* SM, bf16* QKV, float* GATES, int t, int h, int lane) {
    float val[3][2];
#pragma unroll
    for (int w = 0; w < 3; ++w) {
        const int c0 = w * 512 + h * 128 + 2 * lane;
        float a0 = 0.f, a1 = 0.f;
#pragma unroll
        for (int j = 0; j < 4; ++j) { const int tt = t - 3 + j;
            if (tt >= 0) { const unsigned x = *(const unsigned*)(PA + (size_t)tt * NPA + c0); a0 += convw[j * 1536 + c0] * bflo(x); a1 += convw[j * 1536 + c0 + 1] * bfhi(x); } }
        val[w][0] = siluf_(a0); val[w][1] = siluf_(a1);
    }
    const float sq = wave_sum(val[0][0] * val[0][0] + val[0][1] * val[0][1]), sk = wave_sum(val[1][0] * val[1][0] + val[1][1] * val[1][1]);
    const float rq = 0.08838834764831845f / sqrtf(sq + 1e-6f), rk = 1.f / sqrtf(sk + 1e-6f);
    bf16* o = QKV + (size_t)t * 1536 + h * 128 + 2 * lane;
    *(unsigned*)(o) = pk2(val[0][0] * rq, val[0][1] * rq);
    *(unsigned*)(o + 512) = pk2(val[1][0] * rk, val[1][1] * rk);
    *(unsigned*)(o + 1024) = pk2(val[2][0], val[2][1]);
    if (lane == 0) {
        GATES[t * 8 + h] = -expf(alog[h]) * softplusf_(SM[(size_t)t * 64 + 4 + h] + dtb[h]);
        GATES[t * 8 + 4 + h] = sigmoidf_(SM[(size_t)t * 64 + h]);
    }
}
__device__ __forceinline__ void nsa_compress_item(const bf16* PA, const float* pek, const float* w1k, const float* w2k, const float* pev, const float* w1v, const float* w2v,
                                                  float* KCMP, float* VCMP, int n, int g, float* sf, int tid) {
    __syncthreads();
    for (int i = tid; i < 32 * 160; i += NTHR) { const int tl = i / 160, c = i % 160; const float x = bf2f(PA[(size_t)(16 * n + tl) * NPA + PA_KC + g * 160 + c]);
        if (c < 96) sf[tl * 96 + c] = x + pek[tl * 96 + c]; else sf[3072 + tl * 64 + (c - 96)] = x + pev[tl * 64 + (c - 96)]; }
    __syncthreads();
    const int j = tid & 255, half = tid >> 8;
    float a0 = 0.f, a1 = 0.f, a2 = 0.f, a3 = 0.f;
    if (half == 0) {
#pragma unroll 4
        for (int i = 0; i < 3072; i += 4) { a0 += sf[i] * w1k[(size_t)i * 256 + j]; a1 += sf[i + 1] * w1k[(size_t)(i + 1) * 256 + j]; a2 += sf[i + 2] * w1k[(size_t)(i + 2) * 256 + j]; a3 += sf[i + 3] * w1k[(size_t)(i + 3) * 256 + j]; }
    } else {
#pragma unroll 4
        for (int i = 0; i < 2048; i += 4) { a0 += sf[3072 + i] * w1v[(size_t)i * 256 + j]; a1 += sf[3072 + i + 1] * w1v[(size_t)(i + 1) * 256 + j]; a2 += sf[3072 + i + 2] * w1v[(size_t)(i + 2) * 256 + j]; a3 += sf[3072 + i + 3] * w1v[(size_t)(i + 3) * 256 + j]; }
    }
    float* sh = sf + 5120;
    sh[tid] = gelu_tanhf_((a0 + a1) + (a2 + a3));
    __syncthreads();
    if (tid < 96) { float a = 0.f; for (int q = 0; q < 256; ++q) a += sh[q] * w2k[q * 96 + tid]; KCMP[(n * 2 + g) * 96 + tid] = a; }
    else if (tid >= 256 && tid < 320) { const int d = tid - 256; float a = 0.f; for (int q = 0; q < 256; ++q) a += sh[256 + q] * w2v[q * 64 + d]; VCMP[(n * 2 + g) * 64 + d] = a; }
}
__device__ __forceinline__ void gdn_scan_wave(const bf16* QKV, const float* GATES, float* ORAW, int h, int half, float* wl, int lane) {
    float S[128];
#pragma unroll
    for (int d = 0; d < 128; ++d) S[d] = 0.f;
    const int e = half * 64 + lane;
    unsigned pq[8], pk[8]; float pv[8], pg = 0.f;
#define GDN_FETCH(T0) do { _Pragma("unroll") for (int tt = 0; tt < 8; ++tt) { const bf16* row = QKV + (size_t)((T0) + tt) * 1536 + h * 128; \
        pq[tt] = *(const unsigned*)(row + 2 * lane); pk[tt] = *(const unsigned*)(row + 512 + 2 * lane); pv[tt] = bf2f(row[1024 + e]); } \
        if (lane < 16) pg = GATES[((T0) + (lane & 7)) * 8 + (lane >> 3) * 4 + h]; } while (0)
    GDN_FETCH(0);
    for (int t0 = 0; t0 < SEQ; t0 += 8) {
#pragma unroll
        for (int tt = 0; tt < 8; ++tt) { wl[tt * 256 + 2 * lane] = bflo(pq[tt]); wl[tt * 256 + 2 * lane + 1] = bfhi(pq[tt]);
            wl[tt * 256 + 128 + 2 * lane] = bflo(pk[tt]); wl[tt * 256 + 128 + 2 * lane + 1] = bfhi(pk[tt]); wl[2048 + tt * 64 + lane] = pv[tt]; }
        if (lane < 16) wl[2048 + 512 + lane] = pg;
        if (t0 + 8 < SEQ) GDN_FETCH(t0 + 8);
        LDS_WAIT(); asm volatile("" ::: "memory");
#pragma unroll 1
        for (int tt = 0; tt < 8; ++tt) {
            const f32x4* q4 = (const f32x4*)(wl + tt * 256); const f32x4* k4 = q4 + 32;
            const float a = expf(wl[2048 + 512 + tt]), beta = wl[2048 + 512 + 8 + tt], vv = wl[2048 + tt * 64 + lane];
            float s0 = 0.f, s1 = 0.f, s2 = 0.f, s3 = 0.f;
#pragma unroll
            for (int d = 0; d < 32; ++d) { const f32x4 kd = k4[d]; s0 += kd.x * S[4 * d]; s1 += kd.y * S[4 * d + 1]; s2 += kd.z * S[4 * d + 2]; s3 += kd.w * S[4 * d + 3]; if ((d & 7) == 7) __builtin_amdgcn_sched_barrier(0); }
            const float vn = beta * (vv - a * ((s0 + s1) + (s2 + s3)));
            float o0 = 0.f, o1 = 0.f, o2 = 0.f, o3 = 0.f;
#pragma unroll
            for (int d = 0; d < 32; ++d) { const f32x4 kd = k4[d], qd = q4[d];
                S[4 * d] = a * S[4 * d] + kd.x * vn; S[4 * d + 1] = a * S[4 * d + 1] + kd.y * vn; S[4 * d + 2] = a * S[4 * d + 2] + kd.z * vn; S[4 * d + 3] = a * S[4 * d + 3] + kd.w * vn;
                o0 += qd.x * S[4 * d]; o1 += qd.y * S[4 * d + 1]; o2 += qd.z * S[4 * d + 2]; o3 += qd.w * S[4 * d + 3]; if ((d & 3) == 3) __builtin_amdgcn_sched_barrier(0); }
            ORAW[(size_t)(t0 + tt) * 512 + h * 128 + e] = (o0 + o1) + (o2 + o3);
        }
        asm volatile("" ::: "memory");
    }
#undef GDN_FETCH
}
__device__ __forceinline__ void gla_alpha_item(const float* SM, const float* ggw, const float* ggb, float* ALPHA, int idx) {
    const int t = idx >> 8, c = idx & 255; const float* al = SM + (size_t)t * 64 + 32;
    float x = ggb[c];
#pragma unroll
    for (int r = 0; r < 16; ++r) x += al[r] * ggw[r * 256 + c];
    ALPHA[idx] = expf(logsigmoidf_(x) * (1.f / 16.f));
}
__device__ __forceinline__ void gla_scan_wave(const bf16* PA, const float* ALPHA, const float* nw, bf16* OC, int h, float* wl, int lane) {
    float S0[64], S1[64];
#pragma unroll
    for (int d = 0; d < 64; ++d) { S0[d] = 0.f; S1[d] = 0.f; }
    const float nw0 = nw[lane], nw1 = nw[lane + 64];
    float pa[4], pk[4], pq[4], pv0[4], pv1[4], pr0[4], pr1[4];
#define GLA_FETCH(T0) do { _Pragma("unroll") for (int tt = 0; tt < 4; ++tt) { const bf16* row = PA + (size_t)((T0) + tt) * NPA; \
        pa[tt] = ALPHA[(size_t)((T0) + tt) * 256 + h * 64 + lane]; pk[tt] = bf2f(row[PA_LK + h * 64 + lane]); pq[tt] = bf2f(row[PA_LQ + h * 64 + lane]) * 0.125f; \
        pv0[tt] = bf2f(row[PA_LV + h * 128 + lane]); pv1[tt] = bf2f(row[PA_LV + h * 128 + 64 + lane]); pr0[tt] = bf2f(row[PA_LR + h * 128 + lane]); pr1[tt] = bf2f(row[PA_LR + h * 128 + 64 + lane]); } } while (0)
    GLA_FETCH(0);
    for (int t0 = 0; t0 < SEQ; t0 += 4) {
#pragma unroll
        for (int tt = 0; tt < 4; ++tt) { wl[tt * 192 + lane] = pa[tt]; wl[tt * 192 + 64 + lane] = pk[tt]; wl[tt * 192 + 128 + lane] = pq[tt];
            wl[768 + tt * 256 + lane] = pv0[tt]; wl[768 + tt * 256 + 64 + lane] = pv1[tt]; wl[768 + tt * 256 + 128 + lane] = pr0[tt]; wl[768 + tt * 256 + 192 + lane] = pr1[tt]; }
        if (t0 + 4 < SEQ) GLA_FETCH(t0 + 4);
        LDS_WAIT(); asm volatile("" ::: "memory");
#pragma unroll 1
        for (int tt = 0; tt < 4; ++tt) {
            const f32x4* a4 = (const f32x4*)(wl + tt * 192); const f32x4* k4 = a4 + 16; const f32x4* q4 = a4 + 32;
            const float v0 = wl[768 + tt * 256 + lane], v1 = wl[768 + tt * 256 + 64 + lane], r0 = wl[768 + tt * 256 + 128 + lane], r1 = wl[768 + tt * 256 + 192 + lane];
            float o0 = 0.f, o1 = 0.f, p0 = 0.f, p1 = 0.f;
#pragma unroll
            for (int d = 0; d < 16; ++d) { const f32x4 ad = a4[d], kd = k4[d], qd = q4[d];
                S0[4 * d] = ad.x * S0[4 * d] + kd.x * v0; S1[4 * d] = ad.x * S1[4 * d] + kd.x * v1;
                S0[4 * d + 1] = ad.y * S0[4 * d + 1] + kd.y * v0; S1[4 * d + 1] = ad.y * S1[4 * d + 1] + kd.y * v1;
                S0[4 * d + 2] = ad.z * S0[4 * d + 2] + kd.z * v0; S1[4 * d + 2] = ad.z * S1[4 * d + 2] + kd.z * v1;
                S0[4 * d + 3] = ad.w * S0[4 * d + 3] + kd.w * v0; S1[4 * d + 3] = ad.w * S1[4 * d + 3] + kd.w * v1;
                o0 += qd.x * S0[4 * d]; p0 += qd.x * S1[4 * d]; o1 += qd.y * S0[4 * d + 1]; p1 += qd.y * S1[4 * d + 1];
                o0 += qd.z * S0[4 * d + 2]; p0 += qd.z * S1[4 * d + 2]; o1 += qd.w * S0[4 * d + 3]; p1 += qd.w * S1[4 * d + 3]; }
            const float oa = o0 + o1, ob = p0 + p1;
            const float rr = 1.f / sqrtf(wave_sum(oa * oa + ob * ob) * (1.f / 128.f) + NORM_EPS);
            bf16* o = OC + (size_t)(t0 + tt) * 512 + h * 128;
            o[lane] = (bf16)f2bf(oa * rr * nw0 * siluf_(r0)); o[lane + 64] = (bf16)f2bf(ob * rr * nw1 * siluf_(r1));
        }
        asm volatile("" ::: "memory");
    }
#undef GLA_FETCH
}
__device__ __forceinline__ void nsa_block64(const bf16* PA, int kcol, int pos, bool valid, int t, int g, const float* relb, const LAS int* btab, const float* qs, float* ps, float (&m)[4], float (&l)[4], float (&o)[4], int pos0, int lane) {
    float s[4] = {0.f, 0.f, 0.f, 0.f};
    if (valid) {
        const v4u* kp = (const v4u*)(PA + (size_t)pos * NPA + kcol + g * 160);
#pragma unroll 1
        for (int c4 = 0; c4 < 3; ++c4) {
            v4u kv[4];
#pragma unroll
            for (int c = 0; c < 4; ++c) kv[c] = kp[c4 * 4 + c];
#pragma unroll
            for (int c = 0; c < 4; ++c) { const v4u kk = kv[c];
                const float k0 = bflo(kk.x), k1 = bfhi(kk.x), k2 = bflo(kk.y), k3 = bfhi(kk.y), k4 = bflo(kk.z), k5 = bfhi(kk.z), k6 = bflo(kk.w), k7 = bfhi(kk.w);
#pragma unroll
                for (int hh = 0; hh < 4; ++hh) { const f32x4 qa = *(const f32x4*)(qs + hh * 96 + (c4 * 4 + c) * 8), qb = *(const f32x4*)(qs + hh * 96 + (c4 * 4 + c) * 8 + 4);
                    s[hh] += (qa.x * k0 + qa.y * k1) + (qa.z * k2 + qa.w * k3) + (qb.x * k4 + qb.y * k5) + (qb.z * k6 + qb.w * k7); } }
        }
        const int dist = t - pos; const int bk = dist < 128 ? btab[dist] : 31;
#pragma unroll
        for (int hh = 0; hh < 4; ++hh) s[hh] += relb[bk * 8 + g * 4 + hh];
    }
    float corr[4];
#pragma unroll
    for (int hh = 0; hh < 4; ++hh) {
        const float bm = wave_max(valid ? s[hh] : -INFINITY);
        const float mn = fmaxf(m[hh], bm);
        corr[hh] = expf(m[hh] - mn);
        const float p = valid ? expf(s[hh] - mn) : 0.f;
        l[hh] = l[hh] * corr[hh] + wave_sum(p); m[hh] = mn;
        ps[lane * 4 + hh] = p;
        o[hh] *= corr[hh];
    }
    LDS_WAIT(); asm volatile("" ::: "memory");
    const bf16* vp = PA + kcol + g * 160 + 96 + lane;
#pragma unroll 4
    for (int key = 0; key < 64; ++key) {
        const f32x4 pv = *(const f32x4*)(ps + key * 4);
        const int kp2 = pos0 + key;
        if (kp2 >= 0 && kp2 <= t) { const float v = bf2f(vp[(size_t)kp2 * NPA]); o[0] += pv.x * v; o[1] += pv.y * v; o[2] += pv.z * v; o[3] += pv.w * v; }
    }
    asm volatile("" ::: "memory");
}
__device__ __forceinline__ void nsa_item(const bf16* PA, const float* SM, const float* KCMP, const float* VCMP, const float* relb, const LAS int* btab, bf16* OB, int t, int g, float* wl, int lane) {
    float* qs = wl; float* ps = wl + 384; float* imp = wl + 384 + 2048; int* sidx = (int*)(wl + 384 + 2048 + 128);
    const float scale = 0.10206207261596577f;
#pragma unroll
    for (int i = 0; i < 6; ++i) qs[lane + 64 * i] = bf2f(PA[(size_t)t * NPA + PA_NQ + g * 384 + lane + 64 * i]) * scale;
    LDS_WAIT(); asm volatile("" ::: "memory");
    const int ncv = t >= 31 ? (t - 31) / 16 + 1 : 0;
    float oc[4] = {0.f, 0.f, 0.f, 0.f};
    imp[lane] = 0.f; imp[lane + 64] = 0.f;
    if (ncv > 0) {
#pragma unroll 1
        for (int i = 0; i < 8; ++i) { const int n = lane + 64 * i;
            float a[4] = {-INFINITY, -INFINITY, -INFINITY, -INFINITY};
            if (n < ncv) {
                const f32x4* kc = (const f32x4*)(KCMP + (size_t)(n * 2 + g) * 96);
                a[0] = 0.f; a[1] = 0.f; a[2] = 0.f; a[3] = 0.f;
#pragma unroll 4
                for (int c = 0; c < 24; ++c) { const f32x4 kk = kc[c];
#pragma unroll
                    for (int hh = 0; hh < 4; ++hh) { const f32x4 qa = *(const f32x4*)(qs + hh * 96 + c * 4); a[hh] += (qa.x * kk.x + qa.y * kk.y) + (qa.z * kk.z + qa.w * kk.w); } }
                const int dist = t - (16 * n + 31); const int bk = dist < 128 ? btab[dist] : 31;
#pragma unroll
                for (int hh = 0; hh < 4; ++hh) a[hh] += relb[bk * 8 + g * 4 + hh];
            }
#pragma unroll
            for (int hh = 0; hh < 4; ++hh) ps[hh * 512 + n] = a[hh];
        }
        LDS_WAIT(); asm volatile("" ::: "memory");
#pragma unroll 1
        for (int hh = 0; hh < 4; ++hh) {
            float mx = -INFINITY;
#pragma unroll
            for (int i = 0; i < 8; ++i) mx = fmaxf(mx, ps[hh * 512 + lane + 64 * i]);
            mx = wave_max(mx);
            float ev[8]; float sum = 0.f;
#pragma unroll
            for (int i = 0; i < 8; ++i) { ev[i] = (lane + 64 * i < ncv) ? expf(ps[hh * 512 + lane + 64 * i] - mx) : 0.f; sum += ev[i]; }
            const float inv = 1.f / wave_sum(sum);
#pragma unroll
            for (int i = 0; i < 8; ++i) ps[hh * 512 + lane + 64 * i] = ev[i] * inv;
        }
        LDS_WAIT(); asm volatile("" ::: "memory");
#pragma unroll 4
        for (int n = 0; n < ncv; ++n) { const float v = VCMP[(size_t)(n * 2 + g) * 64 + lane];
            oc[0] += ps[n] * v; oc[1] += ps[512 + n] * v; oc[2] += ps[1024 + n] * v; oc[3] += ps[1536 + n] * v; }
#pragma unroll
        for (int i = 0; i < 2; ++i) { const int s = lane + 64 * i; float a = 0.f;
#pragma unroll
            for (int dn = -1; dn <= 3; ++dn) { const int n = 4 * s + dn; if (n >= 0 && n < ncv) a += (ps[n] + ps[512 + n]) + (ps[1024 + n] + ps[1536 + n]); }
            imp[s] = a; }
    }
    const int blk_t = t >> 6; const int nsel = blk_t + 1 < 16 ? blk_t + 1 : 16;
    float v0, v1;
    { const int s0 = lane, s1 = lane + 64;
      v0 = (s0 == 0 || s0 == blk_t || s0 == blk_t - 1) ? INFINITY : (s0 > blk_t ? -INFINITY : imp[s0]);
      v1 = (s1 == blk_t || s1 == blk_t - 1) ? INFINITY : (s1 > blk_t ? -INFINITY : imp[s1]); }
#pragma unroll 1
    for (int r = 0; r < nsel; ++r) {
        float bv; int bi;
        if (v0 >= v1) { bv = v0; bi = lane; } else { bv = v1; bi = lane + 64; }
#pragma unroll
        for (int off = 32; off >= 1; off >>= 1) { const float ov = __shfl_xor(bv, off); const int oi = __shfl_xor(bi, off); if (ov > bv || (ov == bv && oi < bi)) { bv = ov; bi = oi; } }
        if (lane == 0) sidx[r] = bi;
        if (bi == lane) v0 = -INFINITY; else if (bi == lane + 64) v1 = -INFINITY;
    }
    LDS_WAIT(); asm volatile("" ::: "memory");
    float ms[4], ls[4], os[4];
#pragma unroll
    for (int hh = 0; hh < 4; ++hh) { ms[hh] = -INFINITY; ls[hh] = 0.f; os[hh] = 0.f; }
#pragma unroll 1
    for (int r = 0; r < nsel; ++r) {
        const int sb = __builtin_amdgcn_readfirstlane(sidx[r]);
        const int pos = 64 * sb + lane;
        nsa_block64(PA, PA_KS, pos, pos <= t, t, g, relb, btab, qs, ps, ms, ls, os, 64 * sb, lane);
    }
    float mw[4], lw[4], ow[4];
#pragma unroll
    for (int hh = 0; hh < 4; ++hh) { mw[hh] = -INFINITY; lw[hh] = 0.f; ow[hh] = 0.f; }
#pragma unroll 1
    for (int c = 0; c < 8; ++c) {
        const int p0 = t - 511 + 64 * c; if (p0 + 63 < 0) continue;
        const int pos = p0 + lane;
        nsa_block64(PA, PA_KW, pos, pos >= 0, t, g, relb, btab, qs, ps, mw, lw, ow, p0, lane);
    }
    const float* gl = SM + (size_t)t * 64 + 8 + g * 12;
#pragma unroll
    for (int hh = 0; hh < 4; ++hh) {
        const float gc = sigmoidf_(gl[hh * 3]), gs = sigmoidf_(gl[hh * 3 + 1]), gw = sigmoidf_(gl[hh * 3 + 2]);
        const float o = gc * oc[hh] + gs * os[hh] / ls[hh] + gw * ow[hh] / lw[hh];
        OB[(size_t)t * 512 + (g * 4 + hh) * 64 + lane] = (bf16)f2bf(o);
    }
    asm volatile("" ::: "memory");
}
__device__ __forceinline__ void gdn_out_item(const float* ORAW, const bf16* PA, const float* nw, bf16* OA, int t, int h, int lane) {
    const float o0 = ORAW[(size_t)t * 512 + h * 128 + 2 * lane], o1 = ORAW[(size_t)t * 512 + h * 128 + 2 * lane + 1];
    const float rr = 1.f / sqrtf(wave_sum(o0 * o0 + o1 * o1) * (1.f / 128.f) + NORM_EPS);
    const unsigned z = *(const unsigned*)(PA + (size_t)t * NPA + PA_GZ + h * 128 + 2 * lane);
    *(unsigned*)(OA + (size_t)t * 512 + h * 128 + 2 * lane) = pk2(o0 * rr * nw[2 * lane] * siluf_(bflo(z)), o1 * rr * nw[2 * lane + 1] * siluf_(bfhi(z)));
}

constexpr int PH_PER_LAYER = 22, NPHASES = DEPTH * PH_PER_LAYER;
enum { K_CONV = 0, K_F1, K_GF32, K_ROWS, K_M1, K_M2, K_M3, K_M4, K_M5 };
constexpr size_t ALPHA_OFF = 276 * MiB;
__global__ void __launch_bounds__(NTHR, 2) mk_fwd(Args args) {
    extern __shared__ __attribute__((aligned(16))) unsigned char lds[];
    LAS unsigned char* ldsl = (LAS unsigned char*)lds;
    {
        const int tid = threadIdx.x;
        for (int u = tid; u < (LDS_BYTES - LDSCTL_OFF) / 4; u += NTHR) ((LAS unsigned*)(ldsl + LDSCTL_OFF))[u] = 0u;
        __syncthreads();
        LAS int* btab = (LAS int*)(ldsl + BTAB_OFF);
        if (tid < 128) { int b = tid; if (tid >= 16) { const float v = logf((float)tid / 16.f) / 2.0794415416798357f * 16.f; b = 16 + (int)v; if (b > 31) b = 31; } btab[tid] = b; }
        __syncthreads();
    }
#if MK_ONE_LAUNCH
    XcdBarrier bar = xcd_barrier_post((unsigned*)(args.ws + WS_CTL) + CW_BAR, (volatile LAS unsigned*)(ldsl + MISC_OFF) + 8);
#endif
#pragma unroll 1
    for (int pc = args.ph_lo; pc < args.ph_hi; ++pc) {
        const int l = pc / PH_PER_LAYER, idx = pc % PH_PER_LAYER;
        int kind, sub = 0, b = 0;
        if (idx < 4) { kind = idx == 0 ? K_CONV : idx == 1 ? K_F1 : idx == 2 ? K_GF32 : K_ROWS; }
        else if (idx >= 18) { sub = 1; kind = idx == 18 ? K_CONV : idx == 19 ? K_F1 : idx == 20 ? K_GF32 : K_ROWS; }
        else { b = (idx - 4) / 7; const int j = (idx - 4) % 7; kind = j == 0 ? K_M1 : j == 1 ? K_M2 : j == 2 ? K_M3 : j == 3 ? K_M4 : j == 4 ? K_M5 : j == 5 ? K_GF32 : K_ROWS; }
        const bool mixer = idx >= 4 && idx < 18;
        unsigned char* ws = args.ws;
        int tid_ = threadIdx.x; asm volatile("" : "+v"(tid_));
        const int tid = tid_, lane = tid & 63, wave = __builtin_amdgcn_readfirstlane(tid >> 6);
        const int G = gridDim.x, bx = blockIdx.x;
        const int vcu = (G % 8 == 0) ? (bx % 8) * (G / 8) + bx / 8 : bx;
        const int gw = vcu * NWAVES + wave, NGW = G * NWAVES;
        switch (kind) {
        case K_CONV: {
            bf16* WGU = (bf16*)(ws + WS_WGU); bf16* WD = (bf16*)(ws + WS_WD); bf16* WIN = (bf16*)(ws + WS_WIN); bf16* WB = (bf16*)(ws + WS_WB); bf16* WO = (bf16*)(ws + WS_WO);
            LAS float* scr = (LAS float*)(ldsl + wave * 16384);
            const float* w_gu = args.in[sub ? I_F2GU : I_F1GU] + (size_t)l * DM * 2 * DFF;
            const float* w_dn = args.in[sub ? I_F2D : I_F1D] + (size_t)l * DFF * DM;
            constexpr int I_GU = (DM / 64) * (2 * DFF / 32), I_DN = (DFF / 64) * (DM / 32), I_IN = (DM / 64) * ((DIN_SRC + 31) / 32), I_BR = (512 / 64) * (DM / 32), I_OUT = (DM / 64) * (DM / 32);
            const int nitems = I_GU + I_DN + (sub == 0 ? I_IN + 3 * I_BR + I_OUT : 0);
            for (int it = gw; it < nitems; it += NGW) {
                int r = it;
                if (r < I_GU) { transpose_item(w_gu, DM, 2 * DFF, WGU, scr, r, lane, MapGU()); continue; } r -= I_GU;
                if (r < I_DN) { transpose_item(w_dn, DFF, DM, WD, scr, r, lane, MapId()); continue; } r -= I_DN;
                if (r < I_IN) { transpose_item(args.in[I_WIN] + (size_t)l * DM * DIN_SRC, DM, DIN_SRC, WIN, scr, r, lane, MapWin()); continue; } r -= I_IN;
                if (r < 3 * I_BR) { const int br = r / I_BR; transpose_item(args.in[I_WBG + br] + (size_t)l * 512 * DM, 512, DM, WB + (size_t)br * 512 * 1024, scr, r % I_BR, lane, MapId()); continue; } r -= 3 * I_BR;
                transpose_item(args.in[I_WOUT] + (size_t)l * DM * DM, DM, DM, WO, scr, r, lane, MapId());
            }
            if (sub == 0) { for (int i = gw * 64 + lane; i < 16 * DM / 2; i += NGW * 64) ((unsigned*)(WIN + (size_t)(PA_SM + 48) * DM))[i] = 0u; }
            if (l == 0 && sub == 0) { const float* n_pre = args.in[I_F1PRE]; bf16* XN = (bf16*)(ws + WS_XN);
                for (int m = gw; m < MTOK; m += NGW) row_pass(args.in[I_X] + (size_t)m * DM, nullptr, nullptr, 0.f, nullptr, n_pre, XN + (size_t)m * DM, lane); }
        } break;
        case K_F1: {
            pg8::Gemm g{(const bf16*)(ws + WS_XN), (const bf16*)(ws + WS_WGU), MTOK, 2 * DFF, DM}; pg8::StaticOrder S; S.init(MTOK, 2 * DFF, G, bx); pg8::EpiSwiglu E{(bf16*)(ws + WS_H), DFF};
            pg8::gemm_phase<pg8::EpiSwiglu, pg8::StaticOrder, true, true>(ldsl, g, S, E);
        } break;
        case K_GF32: {
            pg8::Gemm g; pg8::EpiF32 E; pg8::StaticOrder S;
            if (mixer) { g = pg8::Gemm{(const bf16*)(ws + WS_MG), (const bf16*)(ws + WS_WO), SEQ, DM, DM}; E = pg8::EpiF32{(float*)(ws + WS_YB), DM}; S.init(SEQ, DM, G, bx); }
            else { g = pg8::Gemm{(const bf16*)(ws + WS_H), (const bf16*)(ws + WS_WD), MTOK, DM, DFF}; E = pg8::EpiF32{(float*)(ws + WS_Y), DM}; S.init(MTOK, DM, G, bx); }
            pg8::gemm_phase<pg8::EpiF32, pg8::StaticOrder, true, true>(ldsl, g, S, E);
        } break;
        case K_ROWS: {
            float* xres = args.out; bf16* XN = (bf16*)(ws + WS_XN);
            if (mixer) {
                const float* YB = (const float*)(ws + WS_YB);
                for (int m = gw; m < SEQ; m += NGW) { const size_t r = (size_t)b * SEQ + m;
                    row_pass(xres + r * DM, YB + (size_t)m * DM, args.in[I_MPOST] + l * DM, 1.0f, xres + r * DM, args.in[I_F2PRE] + l * DM, XN + r * DM, lane); }
            } else {
                const float* Y = (const float*)(ws + WS_Y);
                const float* n_post = args.in[sub ? I_F2POST : I_F1POST] + l * DM;
                const float* xin = (l == 0 && sub == 0) ? args.in[I_X] : xres;
                const float* wnext = sub == 0 ? args.in[I_MPRE] + l * DM : (l + 1 < DEPTH ? args.in[I_F1PRE] + (l + 1) * DM : nullptr);
                for (int m = gw; m < MTOK; m += NGW) row_pass(xin + (size_t)m * DM, Y + (size_t)m * DM, n_post, 0.5f, xres + (size_t)m * DM, wnext, wnext ? XN + (size_t)m * DM : nullptr, lane);
            }
        } break;
        case K_M1: {
            pg8::Gemm g{(const bf16*)(ws + WS_XN) + (size_t)b * SEQ * DM, (const bf16*)(ws + WS_WIN), SEQ, NIN, DM}; pg8::StaticOrder S; S.init(SEQ, NIN, G, bx);
            pg8::EpiWin E{(bf16*)(ws + WS_A), (float*)(ws + WS_SM), (bf16*)(ws + WS_G)};
            pg8::gemm_phase<pg8::EpiWin, pg8::StaticOrder, true, true>(ldsl, g, S, E);
        } break;
        case K_M2: {
            const bf16* PA = (const bf16*)(ws + WS_A); const float* SM = (const float*)(ws + WS_SM);
            for (int it = bx; it < 511 * 2; it += G)
                nsa_compress_item(PA, args.in[I_PEK] + l * 32 * 96, args.in[I_W1K] + (size_t)l * 3072 * 256, args.in[I_W2K] + l * 256 * 96,
                                  args.in[I_PEV] + l * 32 * 64, args.in[I_W1V] + (size_t)l * 2048 * 256, args.in[I_W2V] + l * 256 * 64, (float*)(ws + WS_KCMP), (float*)(ws + WS_VCMP), it >> 1, it & 1, (float*)lds, tid);
            for (int it = gw; it < SEQ * 4; it += NGW)
                gdn_prep_item(PA, args.in[I_CONVW] + l * 4 * 1536, args.in[I_ALOG] + l * 4, args.in[I_DTB] + l * 4, SM, (bf16*)(ws + WS_QKV), (float*)(ws + WS_GATES), it >> 2, it & 3, lane);
            for (int it = (vcu * NTHR + tid); it < SEQ * 256; it += G * NTHR)
                gla_alpha_item(SM, args.in[I_GGW] + l * 16 * 256, args.in[I_GGB] + l * 256, (float*)(ws + ALPHA_OFF), it);
        } break;
        case K_M3: {
            const bf16* PA = (const bf16*)(ws + WS_A); bf16* OB3 = (bf16*)(ws + WS_O);
            float* wl = (float*)(lds + wave * 16384);
            if (bx == 0) gdn_scan_wave((const bf16*)(ws + WS_QKV), (const float*)(ws + WS_GATES), (float*)(ws + WS_ORAW), wave >> 1, wave & 1, wl, lane);
            else if (bx == 1) { if (wave < 4) gla_scan_wave(PA, (const float*)(ws + ALPHA_OFF), args.in[I_GLANW] + l * 128, OB3 + 2 * (size_t)SEQ * 512, wave, wl, lane); }
            else { const LAS int* btab = (const LAS int*)(ldsl + BTAB_OFF);
                for (int it = (bx - 2) * NWAVES + wave; it < SEQ * 2; it += (G - 2) * NWAVES)
                    nsa_item(PA, (const float*)(ws + WS_SM), (const float*)(ws + WS_KCMP), (const float*)(ws + WS_VCMP), args.in[I_RELB], btab, OB3 + (size_t)SEQ * 512, it >> 1, it & 1, wl, lane); }
        } break;
        case K_M4: {
            for (int it = gw; it < SEQ * 4; it += NGW) gdn_out_item((const float*)(ws + WS_ORAW), (const bf16*)(ws + WS_A), args.in[I_GDNNW] + l * 128, (bf16*)(ws + WS_O), it >> 2, it & 3, lane);
        } break;
        case K_M5: {
#pragma unroll 1
            for (int br = 0; br < 3; ++br) {
                pg8::StaticOrder S; S.init(SEQ, DM, G, bx);
                pg8::Gemm g{(const bf16*)(ws + WS_O) + (size_t)br * SEQ * 512, (const bf16*)(ws + WS_WB) + (size_t)br * 512 * 1024, SEQ, DM, 512};
                pg8::EpiMerge E{(const bf16*)(ws + WS_G) + br * 1024, (float*)(ws + WS_RMW), (bf16*)(ws + WS_MG), br};
                pg8::gemm_phase<pg8::EpiMerge, pg8::StaticOrder, true, true>(ldsl, g, S, E);
            }
        } break;
        default: break;
        }
#if MK_ONE_LAUNCH
        if (pc + 1 < args.ph_hi) xcd_barrier(bar);
#endif
    }
}

extern "C" void kernel_launch(void* const* d_in, const int* in_sizes, int n_in, void* d_out, int out_size, void* d_ws, size_t ws_size, hipStream_t stream) {
    static int grid = 0;
    if (grid == 0) {
        if (n_in != 30 || out_size != MTOK * DM || ws_size < ALPHA_OFF + 8 * MiB) { fprintf(stderr, "kernel_launch: unexpected shapes (n_in %d out %d ws %zu)\n", n_in, out_size, ws_size); grid = -1; return; }
        int dev = 0, cus = 0, per_cu = 0;
        if (hipGetDevice(&dev) != hipSuccess || hipDeviceGetAttribute(&cus, hipDeviceAttributeMultiprocessorCount, dev) != hipSuccess) { grid = -1; return; }
        if (hipFuncSetAttribute((const void*)mk_fwd, hipFuncAttributeMaxDynamicSharedMemorySize, LDS_BYTES) != hipSuccess) { fprintf(stderr, "kernel_launch: hipFuncSetAttribute failed\n"); grid = -1; return; }
        if (hipOccupancyMaxActiveBlocksPerMultiprocessor(&per_cu, (const void*)mk_fwd, NTHR, LDS_BYTES) != hipSuccess || per_cu < 1) { fprintf(stderr, "kernel_launch: occupancy query says %d blocks per CU\n", per_cu); grid = -1; (void)hipGetLastError(); return; }
        (void)hipGetLastError();
        grid = cus;
    }
    if (grid < 0) return;
    (void)hipMemsetAsync((char*)d_ws + WS_CTL, 0, CTL_ZERO_BYTES, stream);
    Args a{};
    for (int i = 0; i < 30; ++i) a.in[i] = (const float*)d_in[i];
    a.out = (float*)d_out; a.ws = (unsigned char*)d_ws;
#if MK_ONE_LAUNCH
    a.ph_lo = 0; a.ph_hi = NPHASES;
    hipLaunchKernelGGL(mk_fwd, dim3(grid), dim3(NTHR), LDS_BYTES, stream, a);
#else
    for (int p = 0; p < NPHASES; ++p) { a.ph_lo = p; a.ph_hi = p + 1; hipLaunchKernelGGL(mk_fwd, dim3(grid), dim3(NTHR), LDS_BYTES, stream, a); }
#endif
}
```

```cpp
#include <hip/hip_runtime.h>
#include <cstdio>
#include <cstdint>
#ifndef MK_ONE_LAUNCH
#define MK_ONE_LAUNCH 1
#endif
namespace pg8 {
#define PG8_LAS __attribute__((address_space(3)))
typedef unsigned short bf16_t;
typedef short bf16x8 __attribute__((ext_vector_type(8)));
typedef float f32x4 __attribute__((ext_vector_type(4)));
typedef unsigned u32x4 __attribute__((ext_vector_type(4)));
typedef unsigned u32x2 __attribute__((ext_vector_type(2)));
constexpr int BM = 256, BK = 64, HALF = 128, HTB = HALF * BK * 2  , STAGE_BYTES = 8 * HTB, NXCD = 8, WGM = 8;

__host__ __device__ __forceinline__ int lds_byte(int r, int c) { const int st = (r >> 4) * 2 + (c >> 5), rr = r & 15, cc = c & 31, ob = rr * 64 + cc * 2; return st * 1024 + (ob ^ (((ob >> 9) & 1) << 5)); }
__host__ __device__ __forceinline__ void stage_rc(int b, int& R, int& C) { const int st = b / 1024, sb = b % 1024, swz = sb ^ (((sb >> 9) & 1) << 5); R = (st >> 1) * 16 + swz / 64; C = (st & 1) * 32 + (swz % 64) / 2; }
__host__ __device__ __forceinline__ int perm32(int rho) { const int n = rho >> 4, i = rho & 15; return 8 * (i >> 2) + 4 * n + (i & 3); }

struct Unit { int pm, pn; };
struct Gemm { const bf16_t* A; const bf16_t* Bt; int M, N, K; };

struct StaticOrder {
    int nM, nN, nwg, G, c;
    __host__ __device__ void init(int M, int N, int G_, int c_) { nM = M / BM; nN = N / BM; nwg = nM * nN; G = G_; c = c_; }
    __host__ __device__ bool next(int i, Unit& u) const {
        const long L = (long)i * G + c; if (L >= nwg) return false;
        int wgid = (int)L; { const int q = nwg / NXCD, r = nwg % NXCD, xcd = wgid % NXCD, off = wgid / NXCD; wgid = (xcd < r ? xcd * (q + 1) : r * (q + 1) + (xcd - r) * q) + off; }
        const int nig = WGM * nN, gid = wgid / nig, fm = gid * WGM, gsz = (nM - fm) < WGM ? (nM - fm) : WGM;
        u.pm = fm + ((wgid % nig) % gsz); u.pn = (wgid % nig) / gsz; return true;
    }
    __device__ __forceinline__ void a_ready(const Unit&) const {}
    __device__ __forceinline__ void done(const Unit&) const {}
};

__device__ __forceinline__ unsigned cvt_pk_bf16(float lo, float hi) { unsigned r; asm volatile("v_cvt_pk_bf16_f32 %0, %1, %2" : "=v"(r) : "v"(lo), "v"(hi)); return r; }
__device__ __forceinline__ float bflo(unsigned w) { return __uint_as_float(w << 16); }
__device__ __forceinline__ float bfhi(unsigned w) { return __uint_as_float(w & 0xffff0000u); }
__device__ __forceinline__ float sigmoid_f(float x) { return __builtin_amdgcn_rcpf(1.f + __expf(-x)); }

struct EpiSwiglu {
    static constexpr bool PERM = true, AFTER_DRAIN = false;
    bf16_t* H; int ldh;
    __device__ __forceinline__ void operator()(const f32x4 (&acc)[2][2][4][2], const Unit& u, int wr, int wc, int fr, int fq) const {
        const int row0 = u.pm * BM + wr * 64 + fr, j0 = u.pn * HALF + wc * 32 + 8 * fq;
#pragma unroll
        for (int ai = 0; ai < 2; ++ai)
#pragma unroll
            for (int m = 0; m < 4; ++m) {
                bf16_t* p = H + (size_t)(row0 + ai * HALF + m * 16) * ldh + j0;
                float h[8];
#pragma unroll
                for (int n = 0; n < 2; ++n)
#pragma unroll
                    for (int i = 0; i < 4; ++i) { const float g = acc[ai][0][m][n][i], uu = acc[ai][1][m][n][i]; h[n * 4 + i] = g * sigmoid_f(g) * uu; }
                u32x4 w; w.x = cvt_pk_bf16(h[0], h[1]); w.y = cvt_pk_bf16(h[2], h[3]); w.z = cvt_pk_bf16(h[4], h[5]); w.w = cvt_pk_bf16(h[6], h[7]);
                *(u32x4*)p = w;
                asm volatile("" ::: "memory");
            }
    }
};
struct EpiF32 {
    static constexpr bool PERM = false, AFTER_DRAIN = false;
    float* Y; int ldc;
    __device__ __forceinline__ void operator()(const f32x4 (&acc)[2][2][4][2], const Unit& u, int wr, int wc, int fr, int fq) const {
        const int row0 = u.pm * BM + wr * 64 + fr, col0 = u.pn * BM + wc * 32 + 4 * fq;
#pragma unroll
        for (int ai = 0; ai < 2; ++ai)
#pragma unroll
            for (int m = 0; m < 4; ++m) { float* p = Y + (size_t)(row0 + ai * HALF + m * 16) * ldc + col0;
#pragma unroll
                for (int bj = 0; bj < 2; ++bj)
#pragma unroll
                    for (int n = 0; n < 2; ++n) *(f32x4*)(p + bj * HALF + n * 16) = acc[ai][bj][m][n]; }
    }
};
struct EpiWin {
    static constexpr bool PERM = true, AFTER_DRAIN = false;
    bf16_t* PA; float* SM; bf16_t* G;
    __device__ __forceinline__ void operator()(const f32x4 (&acc)[2][2][4][2], const Unit& u, int wr, int wc, int fr, int fq) const {
        const int row0 = u.pm * BM + wr * 64 + fr, cw = wc * 32 + 8 * fq;
        const bool gate = u.pn >= 21;
#pragma unroll
        for (int ai = 0; ai < 2; ++ai)
#pragma unroll
            for (int m = 0; m < 4; ++m) { const size_t row = (size_t)(row0 + ai * HALF + m * 16);
#pragma unroll
                for (int bj = 0; bj < 2; ++bj) {
                    f32x4 v0 = acc[ai][bj][m][0], v1 = acc[ai][bj][m][1];
                    if (gate) {
#pragma unroll
                        for (int i = 0; i < 4; ++i) { v0[i] = sigmoid_f(v0[i]); v1[i] = sigmoid_f(v1[i]); }
                    }
                    u32x4 w; w.x = cvt_pk_bf16(v0[0], v0[1]); w.y = cvt_pk_bf16(v0[2], v0[3]); w.z = cvt_pk_bf16(v1[0], v1[1]); w.w = cvt_pk_bf16(v1[2], v1[3]);
                    if (gate) *(u32x4*)(G + row * 3072 + (u.pn - 21) * BM + bj * HALF + cw) = w;
                    else {
                        const int col = u.pn * BM + bj * HALF + cw;
                        *(u32x4*)(PA + row * 5376 + col) = w;
                        if (col >= 5312) { float* s = SM + row * 64 + (col - 5312); *(f32x4*)s = v0; *(f32x4*)(s + 4) = v1; }
                    }
                    asm volatile("" ::: "memory");
                }
            }
    }
};
struct EpiMerge {
    static constexpr bool PERM = false, AFTER_DRAIN = false;
    const bf16_t* G; float* RMW; bf16_t* MG; int STEP;
    __device__ __forceinline__ void operator()(const f32x4 (&acc)[2][2][4][2], const Unit& u, int wr, int wc, int fr, int fq) const {
        const int row0 = u.pm * BM + wr * 64 + fr, col0 = u.pn * BM + wc * 32 + 4 * fq;
#pragma unroll
        for (int ai = 0; ai < 2; ++ai)
#pragma unroll
            for (int m = 0; m < 4; ++m) { const size_t row = (size_t)(row0 + ai * HALF + m * 16);
#pragma unroll
                for (int bj = 0; bj < 2; ++bj)
#pragma unroll
                    for (int n = 0; n < 2; ++n) { const int c = col0 + bj * HALF + n * 16;
                        const u32x2 gw = *(const u32x2*)(G + row * 3072 + c);
                        f32x4 v = acc[ai][bj][m][n]; v[0] *= bflo(gw.x); v[1] *= bfhi(gw.x); v[2] *= bflo(gw.y); v[3] *= bfhi(gw.y);
                        float* r = RMW + row * 1024 + c;
                        if (STEP == 0) *(f32x4*)r = v;
                        else if (STEP == 1) *(f32x4*)r = *(const f32x4*)r + v;
                        else { v = *(const f32x4*)r + v; u32x2 w; w.x = cvt_pk_bf16(v[0], v[1]); w.y = cvt_pk_bf16(v[2], v[3]); *(u32x2*)(MG + row * 1024 + c) = w; }
                    }
            }
    }
};

template <class Epi, class Sched, bool ALIGN_EPI = false, bool SP2 = false>
__device__ __forceinline__ void gemm_phase(PG8_LAS unsigned char* lds, const Gemm g, const Sched& S, const Epi& E) {
    int tid_ = threadIdx.x; asm volatile("" : "+v"(tid_));
    const int tid = tid_, wid = __builtin_amdgcn_readfirstlane(tid >> 6), lane = tid & 63, wr = wid >> 2, wc = wid & 3, fr = lane & 15, fq = lane >> 4;
    const int K = g.K, nt = K / BK;
    unsigned voffA[2], voffB[2];
#pragma unroll
    for (int i = 0; i < 2; ++i) { int R, C; stage_rc(tid * 16 + i * 8192, R, C); const int Rb = Epi::PERM ? ((R & ~31) + perm32(R & 31)) : R;
        voffA[i] = (unsigned)(R * K + C) * 2u; voffB[i] = (unsigned)(Rb * K + C) * 2u; }
    const size_t kstep = (size_t)(BK * 2);
    const size_t hstep = (size_t)HALF * K * 2;
    const size_t tstep = 2 * hstep;
    const unsigned ldsw = (unsigned)wid * 1024u;
    const int aoff = lds_byte(wr * 64 + fr, fq * 8), boff = lds_byte(wc * 32 + fr, fq * 8);
#define PG8_SA(b, h) (((b) * 2 + (h)) * HTB)
#define PG8_SB(b, h) ((4 + (b) * 2 + (h)) * HTB)
#define PG8_STAGE(bufoff, gbase, voff) do { _Pragma("unroll") for (int _i = 0; _i < 2; ++_i) \
        __builtin_amdgcn_global_load_lds((const unsigned*)((const char*)(gbase) + (voff)[_i]), (PG8_LAS unsigned*)(lds + (bufoff) + ldsw + _i * 8192), 16, 0, 0); } while (0)
#define PG8_LDA(dst, b, h) do { _Pragma("unroll") for (int m = 0; m < 4; ++m) _Pragma("unroll") for (int k = 0; k < 2; ++k) dst[m][k] = *(const PG8_LAS bf16x8*)(lds + PG8_SA(b, h) + aoff + m * 2048 + k * 1024); } while (0)
#define PG8_LDB(dst, b, h) do { _Pragma("unroll") for (int n = 0; n < 2; ++n) _Pragma("unroll") for (int k = 0; k < 2; ++k) dst[n][k] = *(const PG8_LAS bf16x8*)(lds + PG8_SB(b, h) + boff + n * 2048 + k * 1024); } while (0)
#define PG8_MMA(ai, bj, At, Bt) do { __builtin_amdgcn_s_setprio(1); _Pragma("unroll") for (int m = 0; m < 4; ++m) _Pragma("unroll") for (int n = 0; n < 2; ++n) _Pragma("unroll") for (int k = 0; k < 2; ++k) \
        acc[ai][bj][m][n] = __builtin_amdgcn_mfma_f32_16x16x32_bf16(Bt[n][k], At[m][k], acc[ai][bj][m][n], 0, 0, 0); __builtin_amdgcn_s_setprio(0); } while (0)
#define PG8_WAIT_V(n) asm volatile("s_waitcnt vmcnt(" #n ")" ::: "memory")
#define PG8_WAIT_L(n) asm volatile("s_waitcnt lgkmcnt(" #n ")" ::: "memory")
#define PG8_BAR __builtin_amdgcn_s_barrier()
#define PG8_SCHED __builtin_amdgcn_sched_barrier(0)
    Unit cur, nxt; int ui = 0;
    if (!S.next(0, cur)) return;
    f32x4 acc[2][2][4][2];
#pragma unroll
    for (int a = 0; a < 2; ++a)
#pragma unroll
        for (int b = 0; b < 2; ++b)
#pragma unroll
            for (int m = 0; m < 4; ++m)
#pragma unroll
                for (int n = 0; n < 2; ++n) acc[a][b][m][n] = (f32x4){0.f, 0.f, 0.f, 0.f};
    bf16x8 At[4][2], B0[2][2], B1[2][2];
    const char* cA = (const char*)g.A + (size_t)cur.pm * tstep; const char* cB = (const char*)g.Bt + (size_t)cur.pn * tstep;
    S.a_ready(cur);
    if constexpr (SP2) {
        PG8_STAGE(PG8_SB(0, 0), cB, voffB); PG8_STAGE(PG8_SB(0, 1), cB + hstep, voffB); PG8_STAGE(PG8_SA(0, 0), cA, voffA); PG8_STAGE(PG8_SA(0, 1), cA + hstep, voffA);
        if (wr == 1) PG8_BAR;
        PG8_WAIT_V(2); PG8_BAR;
        PG8_STAGE(PG8_SB(1, 0), cB + kstep, voffB); PG8_STAGE(PG8_SA(1, 0), cA + kstep, voffA); PG8_STAGE(PG8_SB(1, 1), cB + hstep + kstep, voffB);
        PG8_WAIT_V(6); PG8_BAR;
    } else {
        PG8_STAGE(PG8_SB(0, 0), cB, voffB); PG8_STAGE(PG8_SA(0, 0), cA, voffA); PG8_STAGE(PG8_SB(0, 1), cB + hstep, voffB); PG8_STAGE(PG8_SA(0, 1), cA + hstep, voffA);
        if (wr == 1) PG8_BAR;
        PG8_WAIT_V(4); PG8_BAR;
        PG8_STAGE(PG8_SB(1, 0), cB + kstep, voffB); PG8_STAGE(PG8_SA(1, 0), cA + kstep, voffA); PG8_STAGE(PG8_SB(1, 1), cB + hstep + kstep, voffB);
        PG8_WAIT_V(6); PG8_BAR;
    }
    for (;;) {
        const bool has_next = S.next(ui + 1, nxt);
        const char* nA = has_next ? (const char*)g.A + (size_t)nxt.pm * tstep : cA; const char* nB = has_next ? (const char*)g.Bt + (size_t)nxt.pn * tstep : cB;
        for (int t = 0; t < nt; t += 2) {
            const bool last = (t == nt - 2);
            const char* a1 = cA + (size_t)(t + 1) * kstep;
            const char* a2 = last ? nA : cA + (size_t)(t + 2) * kstep; const char* b2 = last ? nB : cB + (size_t)(t + 2) * kstep;
            const char* a3 = a2 + kstep; const char* b3 = b2 + kstep;
            if (last && has_next) S.a_ready(nxt);
            if constexpr (SP2) {
            PG8_LDB(B0, 0, 0); PG8_LDB(B1, 0, 1); PG8_SCHED; PG8_LDA(At, 0, 0); PG8_STAGE(PG8_SA(1, 1), a1 + hstep, voffA);
            PG8_WAIT_V(8); PG8_WAIT_L(0); PG8_BAR; PG8_MMA(0, 0, At, B0); PG8_MMA(0, 1, At, B1); PG8_BAR; PG8_SCHED;
            PG8_LDA(At, 0, 1); PG8_STAGE(PG8_SB(0, 0), b2, voffB); PG8_STAGE(PG8_SB(0, 1), b2 + hstep, voffB); PG8_STAGE(PG8_SA(0, 0), a2, voffA);
            PG8_WAIT_V(8); PG8_WAIT_L(0); PG8_BAR; PG8_MMA(1, 0, At, B0); PG8_MMA(1, 1, At, B1); PG8_BAR; PG8_SCHED;
            PG8_LDB(B0, 1, 0); PG8_LDB(B1, 1, 1); PG8_SCHED; PG8_LDA(At, 1, 0); PG8_STAGE(PG8_SA(0, 1), a2 + hstep, voffA);
            PG8_WAIT_V(8); PG8_WAIT_L(0); PG8_BAR; PG8_MMA(0, 0, At, B0); PG8_MMA(0, 1, At, B1); PG8_BAR; PG8_SCHED;
            PG8_LDA(At, 1, 1); PG8_STAGE(PG8_SB(1, 0), b3, voffB); PG8_STAGE(PG8_SB(1, 1), b3 + hstep, voffB); PG8_STAGE(PG8_SA(1, 0), a3, voffA);
            PG8_WAIT_V(8); PG8_WAIT_L(0); PG8_BAR; PG8_MMA(1, 0, At, B0); PG8_MMA(1, 1, At, B1); PG8_BAR; PG8_SCHED;
            } else {
            PG8_LDB(B0, 0, 0); PG8_SCHED; PG8_LDA(At, 0, 0); PG8_STAGE(PG8_SA(1, 1), a1 + hstep, voffA);
            PG8_WAIT_L(8); PG8_BAR; PG8_WAIT_L(0); PG8_MMA(0, 0, At, B0); PG8_BAR; PG8_SCHED;
            PG8_LDB(B1, 0, 1); PG8_STAGE(PG8_SB(0, 0), b2, voffB);
            PG8_BAR; PG8_WAIT_L(0); PG8_MMA(0, 1, At, B1); PG8_BAR;
            PG8_LDA(At, 0, 1); PG8_STAGE(PG8_SA(0, 0), a2, voffA);
            PG8_BAR; PG8_WAIT_L(0); PG8_MMA(1, 0, At, B0); PG8_BAR; PG8_SCHED;
            PG8_STAGE(PG8_SB(0, 1), b2 + hstep, voffB);
            PG8_WAIT_V(6); PG8_BAR; PG8_MMA(1, 1, At, B1); PG8_BAR;
            PG8_LDB(B0, 1, 0); PG8_SCHED; PG8_LDA(At, 1, 0); PG8_STAGE(PG8_SA(0, 1), a2 + hstep, voffA);
            PG8_WAIT_L(8); PG8_BAR; PG8_WAIT_L(0); PG8_MMA(0, 0, At, B0); PG8_BAR; PG8_SCHED;
            PG8_LDB(B1, 1, 1); PG8_STAGE(PG8_SB(1, 0), b3, voffB);
            PG8_BAR; PG8_WAIT_L(0); PG8_MMA(0, 1, At, B1); PG8_BAR;
            PG8_LDA(At, 1, 1); PG8_STAGE(PG8_SA(1, 0), a3, voffA);
            PG8_BAR; PG8_WAIT_L(0); PG8_MMA(1, 0, At, B0); PG8_BAR; PG8_SCHED;
            PG8_STAGE(PG8_SB(1, 1), b3 + hstep, voffB);
            PG8_WAIT_V(6); PG8_BAR; PG8_MMA(1, 1, At, B1); PG8_BAR;
            }
        }
        if constexpr (ALIGN_EPI) { if (wr == 0) PG8_BAR; }
        if constexpr (!Epi::AFTER_DRAIN) { E(acc, cur, wr, wc, fr, fq); S.done(cur); }
        if (!has_next) break;
#pragma unroll
        for (int a = 0; a < 2; ++a)
#pragma unroll
            for (int b = 0; b < 2; ++b)
#pragma unroll
                for (int m = 0; m < 4; ++m)
#pragma unroll
                    for (int n = 0; n < 2; ++n) acc[a][b][m][n] = (f32x4){0.f, 0.f, 0.f, 0.f};
        cur = nxt; cA = nA; cB = nB; ++ui;
        if constexpr (ALIGN_EPI) { if (wr == 1) PG8_BAR; }
    }
    PG8_WAIT_V(0);
    if constexpr (!ALIGN_EPI) { if (wr == 0) PG8_BAR; }
    PG8_BAR;
    if constexpr (Epi::AFTER_DRAIN) { E.fused(acc, cur, wr, wc, fr, fq, lds, wid, lane); S.done(cur); }
#undef PG8_SA
#undef PG8_SB
#undef PG8_STAGE
#undef PG8_LDA
#undef PG8_LDB
#undef PG8_MMA
#undef PG8_WAIT_V
#undef PG8_WAIT_L
#undef PG8_BAR
#undef PG8_SCHED
}
}

constexpr int NWAVES = 8, NTHR = 512;
constexpr int NBATCH = 2, SEQ = 8192, MTOK = NBATCH * SEQ, DM = 1024, DFF = 2816, DIN_SRC = 8432, NIN = 8448, NPA = 5376, NMG = 3072, DEPTH = 2;
constexpr float NORM_EPS = 1e-6f;
constexpr int PA_GQ = 0, PA_GK = 512, PA_GV = 1024, PA_GZ = 1536, PA_NQ = 2048, PA_KC = 2816, PA_KS = 3136, PA_KW = 3456, PA_LQ = 3776, PA_LK = 4032, PA_LV = 4288, PA_LR = 4800, PA_SM = 5312;
constexpr size_t MiB = 1u << 20;
constexpr size_t WS_CTL = 0, CTL_ZERO_BYTES = 1 * MiB;
constexpr size_t WS_WGU = 1 * MiB, WS_WD = 12 * MiB, WS_WIN = WS_WD + 5632 * 1024, WS_WB = WS_WIN + (size_t)NIN * DM * 2, WS_WO = WS_WB + 3 * MiB;
constexpr size_t WS_XN = 40 * MiB, WS_A = 72 * MiB, WS_G = 160 * MiB, WS_O = 208 * MiB, WS_QKV = 232 * MiB, WS_SM = 290 * MiB, WS_GATES = 258 * MiB, WS_ORAW = 259 * MiB, WS_KCMP = 275 * MiB, WS_VCMP = WS_KCMP + 512 * 1024, WS_END = 276 * MiB;
constexpr size_t WS_H = WS_A, WS_Y = WS_G;
constexpr size_t WS_RMW = WS_A, WS_MG = WS_A + 32 * MiB, WS_YB = WS_A + 48 * MiB;
static_assert(WS_WO + 2 * MiB <= WS_XN && WS_Y + 64 * MiB <= WS_QKV && WS_YB + 32 * MiB <= WS_G, "ws map");
constexpr int CW_BAR = 4096;
constexpr int RING_BYTES = 131072, LDSCTL_OFF = RING_BYTES, MISC_OFF = LDSCTL_OFF + 320, BTAB_OFF = RING_BYTES + 1024, LDS_BYTES = 147456;

#define GAS __attribute__((address_space(1)))
#define LAS __attribute__((address_space(3)))
typedef unsigned short bf16;
typedef unsigned v4u __attribute__((ext_vector_type(4)));
typedef unsigned v2u __attribute__((ext_vector_type(2)));
typedef float f32x4 __attribute__((ext_vector_type(4)));
#define LDS_WAIT() asm volatile("s_waitcnt lgkmcnt(0)" ::: "memory")
__device__ __forceinline__ unsigned f2bf(float f) { unsigned u = __builtin_bit_cast(unsigned, f); return (u + 0x7fffu + ((u >> 16) & 1u)) >> 16; }
__device__ __forceinline__ unsigned pk2(float lo, float hi) { return f2bf(lo) | (f2bf(hi) << 16); }
__device__ __forceinline__ float bf2f(bf16 h) { return __uint_as_float((unsigned)h << 16); }
__device__ __forceinline__ float bflo(unsigned w) { return __uint_as_float(w << 16); }
__device__ __forceinline__ float bfhi(unsigned w) { return __uint_as_float(w & 0xffff0000u); }
__device__ __forceinline__ float wave_sum(float v) {
#pragma unroll
    for (int o = 1; o < 64; o <<= 1) v += __shfl_xor(v, o);
    return v;
}
__device__ __forceinline__ float wave_max(float v) {
#pragma unroll
    for (int o = 1; o < 64; o <<= 1) v = fmaxf(v, __shfl_xor(v, o));
    return v;
}
__device__ __forceinline__ float sigmoidf_(float x) { return 1.f / (1.f + expf(-x)); }
__device__ __forceinline__ float siluf_(float x) { return x / (1.f + expf(-x)); }
__device__ __forceinline__ float softplusf_(float x) { return x > 20.f ? x : log1pf(expf(x)); }
__device__ __forceinline__ float logsigmoidf_(float x) { return fminf(x, 0.f) - log1pf(expf(-fabsf(x))); }
__device__ __forceinline__ float gelu_tanhf_(float x) { return 0.5f * x * (1.f + tanhf(0.7978845608028654f * (x + 0.044715f * x * x * x))); }

#define XB_TMO      128
#define XB_XCNT(j)  (256  + 64 * (j))
#define XB_XSUB(j)  (1280 + 64 * (j))
#define XB_XGEN(j)  (2304 + 64 * (j))
#define XB_TOP      3328
#define XB_TOPGEN   3392
#define XCD_BAR_WORDS 3456
#define XB_SPIN_CAP (1u << 22)
__device__ __forceinline__ unsigned xb_ld(unsigned* p)              { return __hip_atomic_load(p, __ATOMIC_RELAXED, __HIP_MEMORY_SCOPE_AGENT); }
__device__ __forceinline__ unsigned xb_add(unsigned* p, unsigned v) { return __hip_atomic_fetch_add(p, v, __ATOMIC_RELAXED, __HIP_MEMORY_SCOPE_AGENT); }
__device__ __forceinline__ unsigned xb_xcc_id() { return (unsigned)__builtin_amdgcn_s_getreg((3 << 11) | 20) & 0xFu; }
#define XB_SPIN(cond, bar) do { unsigned _sp = 0; while (cond) { __builtin_amdgcn_s_sleep(1); \
    if ((++_sp & 255u) == 0u) { if (xb_ld(&(bar)[XB_TMO])) break; if (_sp > XB_SPIN_CAP) { atomicAdd(&(bar)[XB_TMO], 1u); break; } } } } while (0)
struct XcdBarrier { unsigned* bar; unsigned x; volatile LAS unsigned* st; };
__device__ __forceinline__ XcdBarrier xcd_barrier_post(unsigned* bar, volatile LAS unsigned* st) {
    XcdBarrier b; b.bar = bar; b.x = xb_xcc_id(); b.st = st;
    if (threadIdx.x == 0) (void)xb_add(&bar[XB_XCNT(b.x)], 1u);
    return b;
}
__device__ __forceinline__ void xcd_barrier_complete(unsigned* bar, unsigned x, unsigned& nloc, unsigned& nx) {
    const unsigned G = gridDim.x * gridDim.y * gridDim.z;
    unsigned sum, cnt, mine, sp = 0u;
    for (;;) {
        sum = 0u; cnt = 0u; mine = 0u;
#pragma unroll
        for (unsigned j = 0; j < 16; ++j) { const unsigned c = xb_ld(&bar[XB_XCNT(j)]); sum += c; cnt += (c > 0u) ? 1u : 0u; mine = (j == x) ? c : mine; }
        if (sum == G) break;
        __builtin_amdgcn_s_sleep(1);
        if ((++sp & 255u) == 0u) { if (xb_ld(&bar[XB_TMO])) break; if (sp > XB_SPIN_CAP) { atomicAdd(&bar[XB_TMO], 1u); break; } }
    }
    nloc = mine > 0u ? mine : 1u; nx = cnt > 0u ? cnt : 1u;
}
__device__ __forceinline__ void xcd_barrier(const XcdBarrier& b) {
    asm volatile("s_waitcnt vmcnt(0)" ::: "memory");
    __syncthreads();
    if (threadIdx.x == 0) {
        unsigned* bar = b.bar;
        __builtin_amdgcn_s_waitcnt(0);
        unsigned nloc = b.st[0], nx = b.st[1];
        if (nloc == 0u) { xcd_barrier_complete(bar, b.x, nloc, nx); b.st[0] = nloc; b.st[1] = nx; }
        const unsigned old = xb_add(&bar[XB_XSUB(b.x)], 1u);
        const unsigned gen = old / nloc;
        if (old + 1u == (gen + 1u) * nloc) {
            __builtin_amdgcn_fence(__ATOMIC_RELEASE, "agent");
            asm volatile("s_waitcnt vmcnt(0)" ::: "memory");
            const unsigned og = xb_add(&bar[XB_TOP], 1u);
            const unsigned tg = og / nx;
            if (og + 1u == (tg + 1u) * nx) xb_add(&bar[XB_TOPGEN], 1u);
            else XB_SPIN(xb_ld(&bar[XB_TOPGEN]) == tg, bar);
            __builtin_amdgcn_fence(__ATOMIC_ACQUIRE, "agent");
            xb_add(&bar[XB_XGEN(b.x)], 1u);
            asm volatile("s_waitcnt vmcnt(0)" ::: "memory");
        } else {
            XB_SPIN(xb_ld(&bar[XB_XGEN(b.x)]) == gen, bar);
            __builtin_amdgcn_fence(__ATOMIC_ACQUIRE, "agent");
            asm volatile("s_waitcnt vmcnt(0)" ::: "memory");
        }
    }
    __syncthreads();
}

struct Args { const float* in[30]; float* out; unsigned char* ws; int ph_lo, ph_hi; };
enum { I_X = 0, I_RELB, I_F1PRE, I_F1GU, I_F1D, I_F1POST, I_MPRE, I_WIN, I_CONVW, I_ALOG, I_DTB, I_GDNNW, I_PEK, I_W1K, I_W2K, I_PEV, I_W1V, I_W2V, I_GGW, I_GGB, I_GLANW, I_WBG, I_WBN, I_WBL, I_WOUT, I_MPOST, I_F2PRE, I_F2GU, I_F2D, I_F2POST };

template <class RowMap>
__device__ __forceinline__ void transpose_item(const float* W, int K, int N, bf16* WT, LAS float* scr, int item, int lane, const RowMap& rm) {
    const int nblk = (N + 31) / 32, kb = item / nblk, nb = item % nblk, k0 = 64 * kb, n0 = 32 * nb;
    const bool okc = (n0 + (lane & 31)) < N;
#pragma unroll 8
    for (int i = 0; i < 32; ++i) { const int kk = 2 * i + (lane >> 5); scr[kk * 33 + (lane & 31)] = okc ? W[(size_t)(k0 + kk) * N + n0 + (lane & 31)] : 0.f; }
    LDS_WAIT(); asm volatile("" ::: "memory");
    const int c = lane & 7;
#pragma unroll
    for (int j = 0; j < 4; ++j) { const int n = (lane >> 3) + 8 * j; const LAS float* s = scr + (8 * c) * 33 + n;
        v4u o; o.x = pk2(s[0 * 33], s[1 * 33]); o.y = pk2(s[2 * 33], s[3 * 33]); o.z = pk2(s[4 * 33], s[5 * 33]); o.w = pk2(s[6 * 33], s[7 * 33]);
        if (n0 + n < N) *(v4u*)(WT + (size_t)rm(n0 + n) * K + k0 + 8 * c) = o; }
    LDS_WAIT(); asm volatile("" ::: "memory");
}
struct MapId { __device__ __forceinline__ int operator()(int n) const { return n; } };
struct MapGU { __device__ __forceinline__ int operator()(int n) const { const int u = n >= DFF, j = u ? n - DFF : n; return 256 * (j >> 7) + 128 * u + (j & 127); } };
struct MapWin { __device__ __forceinline__ int operator()(int c) const {
    if (c < 2048) return c;
    if (c < 2056) return PA_SM + (c - 2048);
    if (c < 2824) return PA_NQ + (c - 2056);
    if (c < 3784) return PA_KC + (c - 2824);
    if (c < 3808) return PA_SM + 8 + (c - 3784);
    if (c < 5344) return PA_LQ + (c - 3808);
    if (c < 5360) return PA_SM + 32 + (c - 5344);
    return NPA + (c - 5360); } };

__device__ __forceinline__ void row_pass(const float* xin, const float* y, const float* wpost, float scale, float* xout, const float* wnext, bf16* xn, int lane) {
    f32x4 v[4];
#pragma unroll
    for (int j = 0; j < 4; ++j) v[j] = ((const f32x4*)xin)[lane + 64 * j];
    if (y) {
        f32x4 yv[4]; float s = 0.f;
#pragma unroll
        for (int j = 0; j < 4; ++j) { yv[j] = ((const f32x4*)y)[lane + 64 * j]; s += (yv[j].x * yv[j].x + yv[j].y * yv[j].y) + (yv[j].z * yv[j].z + yv[j].w * yv[j].w); }
        const float r = scale / sqrtf(wave_sum(s) * (1.f / DM) + NORM_EPS);
#pragma unroll
        for (int j = 0; j < 4; ++j) { const f32x4 w = ((const f32x4*)wpost)[lane + 64 * j]; v[j] = v[j] + yv[j] * w * r; }
    }
    if (xout) {
#pragma unroll
        for (int j = 0; j < 4; ++j) ((f32x4*)xout)[lane + 64 * j] = v[j];
    }
    if (xn) {
        float s = 0.f;
#pragma unroll
        for (int j = 0; j < 4; ++j) s += (v[j].x * v[j].x + v[j].y * v[j].y) + (v[j].z * v[j].z + v[j].w * v[j].w);
        const float r = 1.f / sqrtf(wave_sum(s) * (1.f / DM) + NORM_EPS);
#pragma unroll
        for (int j = 0; j < 4; ++j) { const f32x4 w = ((const f32x4*)wnext)[lane + 64 * j]; const f32x4 o = v[j] * w * r;
            v2u pk; pk.x = pk2(o.x, o.y); pk.y = pk2(o.z, o.w); ((v2u*)xn)[lane + 64 * j] = pk; }
    }
}

__device__ __forceinline__ void gdn_prep_item(const bf16* PA, const float* convw, const float* alog, const float* dtb, const float* SM, bf16* QKV, float* GATES, int t, int h, int lane) {
    float val[3][2];
#pragma unroll
    for (int w = 0; w < 3; ++w) {
        const int c0 = w * 512 + h * 128 + 2 * lane;
        float a0 = 0.f, a1 = 0.f;
#pragma unroll
        for (int j = 0; j < 4; ++j) { const int tt = t - 3 + j;
            if (tt >= 0) { const unsigned x = *(const unsigned*)(PA + (size_t)tt * NPA + c0); a0 += convw[j * 1536 + c0] * bflo(x); a1 += convw[j * 1536 + c0 + 1] * bfhi(x); } }
        val[w][0] = siluf_(a0); val[w][1] = siluf_(a1);
    }
    const float sq = wave_sum(val[0][0] * val[0][0] + val[0][1] * val[0][1]), sk = wave_sum(val[1][0] * val[1][0] + val[1][1] * val[1][1]);
    const float rq = 0.08838834764831845f / sqrtf(sq + 1e-6f), rk = 1.f / sqrtf(sk + 1e-6f);
    bf16* o = QKV + (size_t)t * 1536 + h * 128 + 2 * lane;
    *(unsigned*)(o) = pk2(val[0][0] * rq, val[0][1] * rq);
    *(unsigned*)(o + 512) = pk2(val[1][0] * rk, val[1][1] * rk);
    *(unsigned*)(o + 1024) = pk2(val[2][0], val[2][1]);
    if (lane == 0) {
        GATES[t * 8 + h] = -expf(alog[h]) * softplusf_(SM[(size_t)t * 64 + 4 + h] + dtb[h]);
        GATES[t * 8 + 4 + h] = sigmoidf_(SM[(size_t)t * 64 + h]);
    }
}
__device__ __forceinline__ void nsa_compress_item(const bf16* PA, const float* pek, const float* w1k, const float* w2k, const float* pev, const float* w1v, const float* w2v,
                                                  float* KCMP, float* VCMP, int n, int g, float* sf, int tid) {
    __syncthreads();
    for (int i = tid; i < 32 * 160; i += NTHR) { const int tl = i / 160, c = i % 160; const float x = bf2f(PA[(size_t)(16 * n + tl) * NPA + PA_KC + g * 160 + c]);
        if (c < 96) sf[tl * 96 + c] = x + pek[tl * 96 + c]; else sf[3072 + tl * 64 + (c - 96)] = x + pev[tl * 64 + (c - 96)]; }
    __syncthreads();
    const int j = tid & 255, half = tid >> 8;
    float a0 = 0.f, a1 = 0.f, a2 = 0.f, a3 = 0.f;
    if (half == 0) {
#pragma unroll 4
        for (int i = 0; i < 3072; i += 4) { a0 += sf[i] * w1k[(size_t)i * 256 + j]; a1 += sf[i + 1] * w1k[(size_t)(i + 1) * 256 + j]; a2 += sf[i + 2] * w1k[(size_t)(i + 2) * 256 + j]; a3 += sf[i + 3] * w1k[(size_t)(i + 3) * 256 + j]; }
    } else {
#pragma unroll 4
        for (int i = 0; i < 2048; i += 4) { a0 += sf[3072 + i] * w1v[(size_t)i * 256 + j]; a1 += sf[3072 + i + 1] * w1v[(size_t)(i + 1) * 256 + j]; a2 += sf[3072 + i + 2] * w1v[(size_t)(i + 2) * 256 + j]; a3 += sf[3072 + i + 3] * w1v[(size_t)(i + 3) * 256 + j]; }
    }
    float* sh = sf + 5120;
    sh[tid] = gelu_tanhf_((a0 + a1) + (a2 + a3));
    __syncthreads();
    if (tid < 96) { float a = 0.f; for (int q = 0; q < 256; ++q) a += sh[q] * w2k[q * 96 + tid]; KCMP[(n * 2 + g) * 96 + tid] = a; }
    else if (tid >= 256 && tid < 320) { const int d = tid - 256; float a = 0.f; for (int q = 0; q < 256; ++q) a += sh[256 + q] * w2v[q * 64 + d]; VCMP[(n * 2 + g) * 64 + d] = a; }
}
__device__ __forceinline__ void gdn_scan_wave(const bf16* QKV, const float* GATES, float* ORAW, int h, int half, float* wl, int lane) {
    float S[128];
#pragma unroll
    for (int d = 0; d < 128; ++d) S[d] = 0.f;
    const int e = half * 64 + lane;
    unsigned pq[8], pk[8]; float pv[8], pg = 0.f;
#define GDN_FETCH(T0) do { _Pragma("unroll") for (int tt = 0; tt < 8; ++tt) { const bf16* row = QKV + (size_t)((T0) + tt) * 1536 + h * 128; \
        pq[tt] = *(const unsigned*)(row + 2 * lane); pk[tt] = *(const unsigned*)(row + 512 + 2 * lane); pv[tt] = bf2f(row[1024 + e]); } \
        if (lane < 16) pg = GATES[((T0) + (lane & 7)) * 8 + (lane >> 3) * 4 + h]; } while (0)
    GDN_FETCH(0);
    for (int t0 = 0; t0 < SEQ; t0 += 8) {
#pragma unroll
        for (int tt = 0; tt < 8; ++tt) { wl[tt * 256 + 2 * lane] = bflo(pq[tt]); wl[tt * 256 + 2 * lane + 1] = bfhi(pq[tt]);
            wl[tt * 256 + 128 + 2 * lane] = bflo(pk[tt]); wl[tt * 256 + 128 + 2 * lane + 1] = bfhi(pk[tt]); wl[2048 + tt * 64 + lane] = pv[tt]; }
        if (lane < 16) wl[2048 + 512 + lane] = pg;
        if (t0 + 8 < SEQ) GDN_FETCH(t0 + 8);
        LDS_WAIT(); asm volatile("" ::: "memory");
#pragma unroll 1
        for (int tt = 0; tt < 8; ++tt) {
            const f32x4* q4 = (const f32x4*)(wl + tt * 256); const f32x4* k4 = q4 + 32;
            const float a = expf(wl[2048 + 512 + tt]), beta = wl[2048 + 512 + 8 + tt], vv = wl[2048 + tt * 64 + lane];
            float s0 = 0.f, s1 = 0.f, s2 = 0.f, s3 = 0.f;
#pragma unroll
            for (int d = 0; d < 32; ++d) { const f32x4 kd = k4[d]; s0 += kd.x * S[4 * d]; s1 += kd.y * S[4 * d + 1]; s2 += kd.z * S[4 * d + 2]; s3 += kd.w * S[4 * d + 3]; if ((d & 7) == 7) __builtin_amdgcn_sched_barrier(0); }
            const float vn = beta * (vv - a * ((s0 + s1) + (s2 + s3)));
            float o0 = 0.f, o1 = 0.f, o2 = 0.f, o3 = 0.f;
#pragma unroll
            for (int d = 0; d < 32; ++d) { const f32x4 kd = k4[d], qd = q4[d];
                S[4 * d] = a * S[4 * d] + kd.x * vn; S[4 * d + 1] = a * S[4 * d + 1] + kd.y * vn; S[4 * d + 2] = a * S[4 * d + 2] + kd.z * vn; S[4 * d + 3] = a * S[4 * d + 3] + kd.w * vn;
                o0 += qd.x * S[4 * d]; o1 += qd.y * S[4 * d + 1]; o2 += qd.z * S[4 * d + 2]; o3 += qd.w * S[4 * d + 3]; if ((d & 3) == 3) __builtin_amdgcn_sched_barrier(0); }
            ORAW[(size_t)(t0 + tt) * 512 + h * 128 + e] = (o0 + o1) + (o2 + o3);
        }
        asm volatile("" ::: "memory");
    }
#undef GDN_FETCH
}
__device__ __forceinline__ void gla_alpha_item(const float* SM, const float* ggw, const float* ggb, float* ALPHA, int idx) {
    const int t = idx >> 8, c = idx & 255; const float* al = SM + (size_t)t * 64 + 32;
    float x = ggb[c];
#pragma unroll
    for (int r = 0; r < 16; ++r) x += al[r] * ggw[r * 256 + c];
    ALPHA[idx] = expf(logsigmoidf_(x) * (1.f / 16.f));
}
__device__ __forceinline__ void gla_scan_wave(const bf16* PA, const float* ALPHA, const float* nw, bf16* OC, int h, float* wl, int lane) {
    float S0[64], S1[64];
#pragma unroll
    for (int d = 0; d < 64; ++d) { S0[d] = 0.f; S1[d] = 0.f; }
    const float nw0 = nw[lane], nw1 = nw[lane + 64];
    float pa[4], pk[4], pq[4], pv0[4], pv1[4], pr0[4], pr1[4];
#define GLA_FETCH(T0) do { _Pragma("unroll") for (int tt = 0; tt < 4; ++tt) { const bf16* row = PA + (size_t)((T0) + tt) * NPA; \
        pa[tt] = ALPHA[(size_t)((T0) + tt) * 256 + h * 64 + lane]; pk[tt] = bf2f(row[PA_LK + h * 64 + lane]); pq[tt] = bf2f(row[PA_LQ + h * 64 + lane]) * 0.125f; \
        pv0[tt] = bf2f(row[PA_LV + h * 128 + lane]); pv1[tt] = bf2f(row[PA_LV + h * 128 + 64 + lane]); pr0[tt] = bf2f(row[PA_LR + h * 128 + lane]); pr1[tt] = bf2f(row[PA_LR + h * 128 + 64 + lane]); } } while (0)
    GLA_FETCH(0);
    for (int t0 = 0; t0 < SEQ; t0 += 4) {
#pragma unroll
        for (int tt = 0; tt < 4; ++tt) { wl[tt * 192 + lane] = pa[tt]; wl[tt * 192 + 64 + lane] = pk[tt]; wl[tt * 192 + 128 + lane] = pq[tt];
            wl[768 + tt * 256 + lane] = pv0[tt]; wl[768 + tt * 256 + 64 + lane] = pv1[tt]; wl[768 + tt * 256 + 128 + lane] = pr0[tt]; wl[768 + tt * 256 + 192 + lane] = pr1[tt]; }
        if (t0 + 4 < SEQ) GLA_FETCH(t0 + 4);
        LDS_WAIT(); asm volatile("" ::: "memory");
#pragma unroll 1
        for (int tt = 0; tt < 4; ++tt) {
            const f32x4* a4 = (const f32x4*)(wl + tt * 192); const f32x4* k4 = a4 + 16; const f32x4* q4 = a4 + 32;
            const float v0 = wl[768 + tt * 256 + lane], v1 = wl[768 + tt * 256 + 64 + lane], r0 = wl[768 + tt * 256 + 128 + lane], r1 = wl[768 + tt * 256 + 192 + lane];
            float o0 = 0.f, o1 = 0.f, p0 = 0.f, p1 = 0.f;
#pragma unroll
            for (int d = 0; d < 16; ++d) { const f32x4 ad = a4[d], kd = k4[d], qd = q4[d];
                S0[4 * d] = ad.x * S0[4 * d] + kd.x * v0; S1[4 * d] = ad.x * S1[4 * d] + kd.x * v1;
                S0[4 * d + 1] = ad.y * S0[4 * d + 1] + kd.y * v0; S1[4 * d + 1] = ad.y * S1[4 * d + 1] + kd.y * v1;
                S0[4 * d + 2] = ad.z * S0[4 * d + 2] + kd.z * v0; S1[4 * d + 2] = ad.z * S1[4 * d + 2] + kd.z * v1;
                S0[4 * d + 3] = ad.w * S0[4 * d + 3] + kd.w * v0; S1[4 * d + 3] = ad.w * S1[4 * d + 3] + kd.w * v1;
                o0 += qd.x * S0[4 * d]; p0 += qd.x * S1[4 * d]; o1 += qd.y * S0[4 * d + 1]; p1 += qd.y * S1[4 * d + 1];
                o0 += qd.z * S0[4 * d + 2]; p0 += qd.z * S1[4 * d + 2]; o1 += qd.w * S0[4 * d + 3]; p1 += qd.w * S1[4 * d + 3]; }
            const float oa = o0 + o1, ob = p0 + p1;
            const float rr = 1.f / sqrtf(wave_sum(oa * oa + ob * ob) * (1.f / 128.f) + NORM_EPS);
            bf16* o = OC + (size_t)(t0 + tt) * 512 + h * 128;
            o[lane] = (bf16)f2bf(oa * rr * nw0 * siluf_(r0)); o[lane + 64] = (bf16)f2bf(ob * rr * nw1 * siluf_(r1));
        }
        asm volatile("" ::: "memory");
    }
#undef GLA_FETCH
}
__device__ __forceinline__ void nsa_block64(const bf16* PA, int kcol, int pos, bool valid, int t, int g, const float* relb, const LAS int* btab, const float* qs, float* ps, float (&m)[4], float (&l)[4], float (&o)[4], int pos0, int lane) {
    float s[4] = {0.f, 0.f, 0.f, 0.f};
    if (valid) {
        const v4u* kp = (const v4u*)(PA + (size_t)pos * NPA + kcol + g * 160);
#pragma unroll 1
        for (int c4 = 0; c4 < 3; ++c4) {
            v4u kv[4];
#pragma unroll
            for (int c = 0; c < 4; ++c) kv[c] = kp[c4 * 4 + c];
#pragma unroll
            for (int c = 0; c < 4; ++c) { const v4u kk = kv[c];
                const float k0 = bflo(kk.x), k1 = bfhi(kk.x), k2 = bflo(kk.y), k3 = bfhi(kk.y), k4 = bflo(kk.z), k5 = bfhi(kk.z), k6 = bflo(kk.w), k7 = bfhi(kk.w);
#pragma unroll
                for (int hh = 0; hh < 4; ++hh) { const f32x4 qa = *(const f32x4*)(qs + hh * 96 + (c4 * 4 + c) * 8), qb = *(const f32x4*)(qs + hh * 96 + (c4 * 4 + c) * 8 + 4);
                    s[hh] += (qa.x * k0 + qa.y * k1) + (qa.z * k2 + qa.w * k3) + (qb.x * k4 + qb.y * k5) + (qb.z * k6 + qb.w * k7); } }
        }
        const int dist = t - pos; const int bk = dist < 128 ? btab[dist] : 31;
#pragma unroll
        for (int hh = 0; hh < 4; ++hh) s[hh] += relb[bk * 8 + g * 4 + hh];
    }
    float corr[4];
#pragma unroll
    for (int hh = 0; hh < 4; ++hh) {
        const float bm = wave_max(valid ? s[hh] : -INFINITY);
        const float mn = fmaxf(m[hh], bm);
        corr[hh] = expf(m[hh] - mn);
        const float p = valid ? expf(s[hh] - mn) : 0.f;
        l[hh] = l[hh] * corr[hh] + wave_sum(p); m[hh] = mn;
        ps[lane * 4 + hh] = p;
        o[hh] *= corr[hh];
    }
    LDS_WAIT(); asm volatile("" ::: "memory");
    const bf16* vp = PA + kcol + g * 160 + 96 + lane;
#pragma unroll 4
    for (int key = 0; key < 64; ++key) {
        const f32x4 pv = *(const f32x4*)(ps + key * 4);
        const int kp2 = pos0 + key;
        if (kp2 >= 0 && kp2 <= t) { const float v = bf2f(vp[(size_t)kp2 * NPA]); o[0] += pv.x * v; o[1] += pv.y * v; o[2] += pv.z * v; o[3] += pv.w * v; }
    }
    asm volatile("" ::: "memory");
}
__device__ __forceinline__ void nsa_item(const bf16* PA, const float* SM, const float* KCMP, const float* VCMP, const float* relb, const LAS int* btab, bf16* OB, int t, int g, float* wl, int lane) {
    float* qs = wl; float* ps = wl + 384; float* imp = wl + 384 + 2048; int* sidx = (int*)(wl + 384 + 2048 + 128);
    const float scale = 0.10206207261596577f;
#pragma unroll
    for (int i = 0; i < 6; ++i) qs[lane + 64 * i] = bf2f(PA[(size_t)t * NPA + PA_NQ + g * 384 + lane + 64 * i]) * scale;
    LDS_WAIT(); asm volatile("" ::: "memory");
    const int ncv = t >= 31 ? (t - 31) / 16 + 1 : 0;
    float oc[4] = {0.f, 0.f, 0.f, 0.f};
    imp[lane] = 0.f; imp[lane + 64] = 0.f;
    if (ncv > 0) {
#pragma unroll 1
        for (int i = 0; i < 8; ++i) { const int n = lane + 64 * i;
            float a[4] = {-INFINITY, -INFINITY, -INFINITY, -INFINITY};
            if (n < ncv) {
                const f32x4* kc = (const f32x4*)(KCMP + (size_t)(n * 2 + g) * 96);
                a[0] = 0.f; a[1] = 0.f; a[2] = 0.f; a[3] = 0.f;
#pragma unroll 4
                for (int c = 0; c < 24; ++c) { const f32x4 kk = kc[c];
#pragma unroll
                    for (int hh = 0; hh < 4; ++hh) { const f32x4 qa = *(const f32x4*)(qs + hh * 96 + c * 4); a[hh] += (qa.x * kk.x + qa.y * kk.y) + (qa.z * kk.z + qa.w * kk.w); } }
                const int dist = t - (16 * n + 31); const int bk = dist < 128 ? btab[dist] : 31;
#pragma unroll
                for (int hh = 0; hh < 4; ++hh) a[hh] += relb[bk * 8 + g * 4 + hh];
            }
#pragma unroll
            for (int hh = 0; hh < 4; ++hh) ps[hh * 512 + n] = a[hh];
        }
        LDS_WAIT(); asm volatile("" ::: "memory");
#pragma unroll 1
        for (int hh = 0; hh < 4; ++hh) {
            float mx = -INFINITY;
#pragma unroll
            for (int i = 0; i < 8; ++i) mx = fmaxf(mx, ps[hh * 512 + lane + 64 * i]);
            mx = wave_max(mx);
            float ev[8]; float sum = 0.f;
#pragma unroll
            for (int i = 0; i < 8; ++i) { ev[i] = (lane + 64 * i < ncv) ? expf(ps[hh * 512 + lane + 64 * i] - mx) : 0.f; sum += ev[i]; }
            const float inv = 1.f / wave_sum(sum);
#pragma unroll
            for (int i = 0; i < 8; ++i) ps[hh * 512 + lane + 64 * i] = ev[i] * inv;
        }
        LDS_WAIT(); asm volatile("" ::: "memory");
#pragma unroll 4
        for (int n = 0; n < ncv; ++n) { const float v = VCMP[(size_t)(n * 2 + g) * 64 + lane];
            oc[0] += ps[n] * v; oc[1] += ps[512 + n] * v; oc[2] += ps[1024 + n] * v; oc[3] += ps[1536 + n] * v; }
#pragma unroll
        for (int i = 0; i < 2; ++i) { const int s = lane + 64 * i; float a = 0.f;
#pragma unroll
            for (int dn = -1; dn <= 3; ++dn) { const int n = 4 * s + dn; if (n >= 0 && n < ncv) a += (ps[n] + ps[512 + n]) + (ps[1024 + n] + ps[1536 + n]); }
            imp[s] = a; }
    }
    const int blk_t = t >> 6; const int nsel = blk_t + 1 < 16 ? blk_t + 1 : 16;
    float v0, v1;
    { const int s0 = lane, s1 = lane + 64;
      v0 = (s0 == 0 || s0 == blk_t || s0 == blk_t - 1) ? INFINITY : (s0 > blk_t ? -INFINITY : imp[s0]);
      v1 = (s1 == blk_t || s1 == blk_t - 1) ? INFINITY : (s1 > blk_t ? -INFINITY : imp[s1]); }
#pragma unroll 1
    for (int r = 0; r < nsel; ++r) {
        float bv; int bi;
        if (v0 >= v1) { bv = v0; bi = lane; } else { bv = v1; bi = lane + 64; }
#pragma unroll
        for (int off = 32; off >= 1; off >>= 1) { const float ov = __shfl_xor(bv, off); const int oi = __shfl_xor(bi, off); if (ov > bv || (ov == bv && oi < bi)) { bv = ov; bi = oi; } }
        if (lane == 0) sidx[r] = bi;
        if (bi == lane) v0 = -INFINITY; else if (bi == lane + 64) v1 = -INFINITY;
    }
    LDS_WAIT(); asm volatile("" ::: "memory");
    float ms[4], ls[4], os[4];
#pragma unroll
    for (int hh = 0; hh < 4; ++hh) { ms[hh] = -INFINITY; ls[hh] = 0.f; os[hh] = 0.f; }
#pragma unroll 1
    for (int r = 0; r < nsel; ++r) {
        const int sb = __builtin_amdgcn_readfirstlane(sidx[r]);
        const int pos = 64 * sb + lane;
        nsa_block64(PA, PA_KS, pos, pos <= t, t, g, relb, btab, qs, ps, ms, ls, os, 64 * sb, lane);
    }
    float mw[4], lw[4], ow[4];
#pragma unroll
    for (int hh = 0; hh < 4; ++hh) { mw[hh] = -INFINITY; lw[hh] = 0.f; ow[hh] = 0.f; }
#pragma unroll 1
    for (int c = 0; c < 8; ++c) {
        const int p0 = t - 511 + 64 * c; if (p0 + 63 < 0) continue;
        const int pos = p0 + lane;
        nsa_block64(PA, PA_KW, pos, pos >= 0, t, g, relb, btab, qs, ps, mw, lw, ow, p0, lane);
    }
    const float* gl = SM + (size_t)t * 64 + 8 + g * 12;
#pragma unroll
    for (int hh = 0; hh < 4; ++hh) {
        const float gc = sigmoidf_(gl[hh * 3]), gs = sigmoidf_(gl[hh * 3 + 1]), gw = sigmoidf_(gl[hh * 3 + 2]);
        const float o = gc * oc[hh] + gs * os[hh] / ls[hh] + gw * ow[hh] / lw[hh];
        OB[(size_t)t * 512 + (g * 4 + hh) * 64 + lane] = (bf16)f2bf(o);
    }
    asm volatile("" ::: "memory");
}
__device__ __forceinline__ void gdn_out_item(const float* ORAW, const bf16* PA, const float* nw, bf16* OA, int t, int h, int lane) {
    const float o0 = ORAW[(size_t)t * 512 + h * 128 + 2 * lane], o1 = ORAW[(size_t)t * 512 + h * 128 + 2 * lane + 1];
    const float rr = 1.f / sqrtf(wave_sum(o0 * o0 + o1 * o1) * (1.f / 128.f) + NORM_EPS);
    const unsigned z = *(const unsigned*)(PA + (size_t)t * NPA + PA_GZ + h * 128 + 2 * lane);
    *(unsigned*)(OA + (size_t)t * 512 + h * 128 + 2 * lane) = pk2(o0 * rr * nw[2 * lane] * siluf_(bflo(z)), o1 * rr * nw[2 * lane + 1] * siluf_(bfhi(z)));
}

typedef short bf16x8 __attribute__((ext_vector_type(8)));
#define MFMA16(a, b, c) __builtin_amdgcn_mfma_f32_16x16x32_bf16((a), (b), (c), 0, 0, 0)
__device__ __forceinline__ int kperm32(int p) { const int q = p >> 3, j = p & 7; return j < 4 ? 4 * q + j : 16 + 4 * q + (j - 4); }
__device__ __forceinline__ bf16x8 pack_ctiles(const f32x4& t0, const f32x4& t1) {
    v4u w; w.x = pk2(t0[0], t0[1]); w.y = pk2(t0[2], t0[3]); w.z = pk2(t1[0], t1[1]); w.w = pk2(t1[2], t1[3]); return __builtin_bit_cast(bf16x8, w);
}
constexpr int GLA_CH = 64, NCHUNK = SEQ / 64;
constexpr size_t GLA_QD = 0, GLA_KT = GLA_QD + (size_t)NCHUNK * 4 * 8192, GLA_AI = GLA_KT + (size_t)NCHUNK * 4 * 8192, GLA_CD = GLA_AI + (size_t)NCHUNK * 4 * 8192, GLA_BYTES = GLA_CD + (size_t)NCHUNK * 4 * 256, GLA_VBYTES = (size_t)NCHUNK * 4 * 16384;
__device__ __forceinline__ void gla_prep_item(const bf16* PA, const float* SM, const float* ggw, const float* ggb, unsigned char* img, unsigned char* imgv, int n, int h, float* sl, int tid) {
    float* Qs = sl; float* Ks = sl + 64 * 65; float* BC = sl + 2 * 64 * 65; bf16* Vs = (bf16*)(sl + 3 * 64 * 65);
    const int t0 = n * 64, ch = n * 4 + h, lane = tid & 63, wave = tid >> 6;
    __syncthreads();
    {
        const int c = tid >> 3, dg = tid & 7;
        const bf16* row = PA + (size_t)(t0 + c) * NPA;
        const v4u q8 = *(const v4u*)(row + PA_LQ + h * 64 + dg * 8), k8 = *(const v4u*)(row + PA_LK + h * 64 + dg * 8);
        const float qv[8] = {bflo(q8.x), bfhi(q8.x), bflo(q8.y), bfhi(q8.y), bflo(q8.z), bfhi(q8.z), bflo(q8.w), bfhi(q8.w)};
        const float kv[8] = {bflo(k8.x), bfhi(k8.x), bflo(k8.y), bfhi(k8.y), bflo(k8.z), bfhi(k8.z), bflo(k8.w), bfhi(k8.w)};
        const float* al = SM + (size_t)(t0 + c) * 64 + 32;
        float x[8];
#pragma unroll
        for (int j = 0; j < 8; ++j) x[j] = ggb[h * 64 + dg * 8 + j];
#pragma unroll
        for (int r = 0; r < 16; ++r) { const float a = al[r];
#pragma unroll
            for (int j = 0; j < 8; ++j) x[j] += a * ggw[r * 256 + h * 64 + dg * 8 + j]; }
#pragma unroll
        for (int j = 0; j < 8; ++j) { const int d = dg * 8 + j; Qs[c * 65 + d] = qv[j] * 0.125f; Ks[c * 65 + d] = kv[j]; BC[c * 65 + d] = logsigmoidf_(x[j]) * (1.f / 16.f); }
        const v4u va = *(const v4u*)(row + PA_LV + h * 128 + dg * 16), vb = *(const v4u*)(row + PA_LV + h * 128 + dg * 16 + 8);
        *(v4u*)(Vs + c * 136 + dg * 16) = va; *(v4u*)(Vs + c * 136 + dg * 16 + 8) = vb;
    }
    __syncthreads();
    if (tid < 64) { float run = 0.f; for (int c = 0; c < 64; ++c) { run += BC[c * 65 + tid]; BC[c * 65 + tid] = run; } }
    __syncthreads();
    {
        bf16* QD = (bf16*)(img + GLA_QD) + (size_t)ch * 4096; bf16* KT = (bf16*)(img + GLA_KT) + (size_t)ch * 4096; float* CD = (float*)(img + GLA_CD) + (size_t)ch * 64;
        const int r = tid >> 3, pg = tid & 7;
        float o[8];
#pragma unroll
        for (int j = 0; j < 8; ++j) { const int p = pg * 8 + j, d = (p & 32) + kperm32(p & 31); o[j] = Qs[r * 65 + d] * expf(BC[r * 65 + d]); }
        v4u w; w.x = pk2(o[0], o[1]); w.y = pk2(o[2], o[3]); w.z = pk2(o[4], o[5]); w.w = pk2(o[6], o[7]);
        *(v4u*)(QD + r * 64 + pg * 8) = w;
#pragma unroll
        for (int j = 0; j < 8; ++j) { const int c = pg * 8 + j; o[j] = Ks[c * 65 + r] * expf(BC[63 * 65 + r] - BC[c * 65 + r]); }
        w.x = pk2(o[0], o[1]); w.y = pk2(o[2], o[3]); w.z = pk2(o[4], o[5]); w.w = pk2(o[6], o[7]);
        *(v4u*)(KT + r * 64 + pg * 8) = w;
        if (tid < 64) CD[tid] = expf(BC[63 * 65 + tid]);
        bf16* VI = (bf16*)(imgv) + (size_t)ch * 8192;
#pragma unroll
        for (int i = 0; i < 2; ++i) { const int f = tid + 512 * i, ws = f >> 7, kk = (f >> 6) & 1, l = f & 63, q = l >> 4, col = l & 15;
            unsigned short e[8];
#pragma unroll
            for (int j = 0; j < 8; ++j) e[j] = Vs[(32 * kk + 8 * q + j) * 136 + 16 * ws + col];
            v4u vw; vw.x = e[0] | ((unsigned)e[1] << 16); vw.y = e[2] | ((unsigned)e[3] << 16); vw.z = e[4] | ((unsigned)e[5] << 16); vw.w = e[6] | ((unsigned)e[7] << 16);
            *(v4u*)(VI + (size_t)f * 8) = vw; }
    }
    {
        bf16* AI = (bf16*)(img + GLA_AI) + (size_t)ch * 4096;
        const int q = lane >> 4, fr = lane & 15;
#pragma unroll 1
        for (int i = 0; i < 2; ++i) { const int tl = wave + 8 * i, ib = tl >> 2, jb = tl & 3;
            f32x4 acc = {0.f, 0.f, 0.f, 0.f};
            if (jb <= ib) {
#pragma unroll
                for (int kk = 0; kk < 2; ++kk) { float a[8], b[8];
#pragma unroll
                    for (int j = 0; j < 8; ++j) { const int d = 32 * kk + 8 * q + j; const float ref = ib > 0 ? BC[(16 * ib - 1) * 65 + d] : 0.f;
                        a[j] = Qs[(16 * ib + fr) * 65 + d] * expf(BC[(16 * ib + fr) * 65 + d] - ref);
                        b[j] = Ks[(16 * jb + fr) * 65 + d] * expf(ref - BC[(16 * jb + fr) * 65 + d]); }
                    v4u aw, bw; aw.x = pk2(a[0], a[1]); aw.y = pk2(a[2], a[3]); aw.z = pk2(a[4], a[5]); aw.w = pk2(a[6], a[7]);
                    bw.x = pk2(b[0], b[1]); bw.y = pk2(b[2], b[3]); bw.z = pk2(b[4], b[5]); bw.w = pk2(b[6], b[7]);
                    acc = MFMA16(__builtin_bit_cast(bf16x8, aw), __builtin_bit_cast(bf16x8, bw), acc); }
            }
#pragma unroll
            for (int r = 0; r < 4; ++r) { const int row = 4 * q + r; float v = acc[r]; if (jb == ib && fr > row) v = 0.f; AI[(16 * ib + row) * 64 + 16 * jb + fr] = (bf16)f2bf(v); }
        }
    }
}
constexpr int GLA_BUF = 3 * 64 * 144 + 256;
__device__ __forceinline__ void gla_scan_block(const unsigned char* img, const unsigned char* imgv, bf16* OC, int h, unsigned char* lds, int tid) {
    const int lane = tid & 63, ws = __builtin_amdgcn_readfirstlane(tid >> 6), q = lane >> 4, fr = lane & 15;
    f32x4 S[4];
#pragma unroll
    for (int i = 0; i < 4; ++i) S[i] = (f32x4){0.f, 0.f, 0.f, 0.f};
    v4u st[3]; v4u stc = {0u, 0u, 0u, 0u}; v4u vB[2];
#define GLA_FETCH(N) do { const int ch_ = (N) * 4 + h; \
        st[0] = *(const v4u*)(img + GLA_QD + (size_t)ch_ * 8192 + tid * 16); st[1] = *(const v4u*)(img + GLA_AI + (size_t)ch_ * 8192 + tid * 16); st[2] = *(const v4u*)(img + GLA_KT + (size_t)ch_ * 8192 + tid * 16); \
        if (tid < 16) stc = *(const v4u*)(img + GLA_CD + (size_t)ch_ * 256 + tid * 16); \
        vB[0] = *(const v4u*)(imgv + (size_t)ch_ * 16384 + (ws * 2 + 0) * 1024 + lane * 16); vB[1] = *(const v4u*)(imgv + (size_t)ch_ * 16384 + (ws * 2 + 1) * 1024 + lane * 16); } while (0)
#define GLA_PUT(B) do { unsigned char* b_ = lds + (B) * GLA_BUF; const int r_ = tid >> 3, c_ = tid & 7; \
        *(v4u*)(b_ + r_ * 144 + c_ * 16) = st[0]; *(v4u*)(b_ + 64 * 144 + r_ * 144 + c_ * 16) = st[1]; *(v4u*)(b_ + 2 * 64 * 144 + r_ * 144 + c_ * 16) = st[2]; \
        if (tid < 16) *(v4u*)(b_ + 3 * 64 * 144 + tid * 16) = stc; } while (0)
    __syncthreads();
    GLA_FETCH(0); GLA_PUT(0);
    __syncthreads();
    for (int n = 0; n < NCHUNK; ++n) {
        const unsigned char* b = lds + (n & 1) * GLA_BUF;
        const v4u vb0 = vB[0], vb1 = vB[1];
        if (n + 1 < NCHUNK) GLA_FETCH(n + 1);
        const bf16x8 v0 = __builtin_bit_cast(bf16x8, vb0), v1 = __builtin_bit_cast(bf16x8, vb1);
        const bf16x8 s0 = pack_ctiles(S[0], S[1]), s1 = pack_ctiles(S[2], S[3]);
        f32x4 o[4];
#pragma unroll
        for (int m = 0; m < 4; ++m) {
            const unsigned char* ar = b + (16 * m + fr) * 144 + q * 16;
            const bf16x8 qa0 = *(const bf16x8*)(ar), qa1 = *(const bf16x8*)(ar + 64);
            const bf16x8 aa0 = *(const bf16x8*)(ar + 64 * 144);
            f32x4 acc = {0.f, 0.f, 0.f, 0.f};
            acc = MFMA16(qa0, s0, acc); acc = MFMA16(qa1, s1, acc); acc = MFMA16(aa0, v0, acc);
            if (m >= 2) { const bf16x8 aa1 = *(const bf16x8*)(ar + 64 * 144 + 64); acc = MFMA16(aa1, v1, acc); }
            o[m] = acc;
        }
#pragma unroll
        for (int dt = 0; dt < 4; ++dt) {
            const unsigned char* kr = b + 2 * 64 * 144 + (16 * dt + fr) * 144 + q * 16;
            const bf16x8 k0 = *(const bf16x8*)(kr), k1 = *(const bf16x8*)(kr + 64);
            const f32x4 cd = *(const f32x4*)(b + 3 * 64 * 144 + (16 * dt + 4 * q) * 4);
            f32x4 acc = S[dt] * cd;
            acc = MFMA16(k0, v0, acc); acc = MFMA16(k1, v1, acc);
            S[dt] = acc;
        }
#pragma unroll
        for (int m = 0; m < 4; ++m)
#pragma unroll
            for (int r = 0; r < 4; ++r) OC[(size_t)(64 * n + 16 * m + 4 * q + r) * 512 + h * 128 + 16 * ws + fr] = (bf16)f2bf(o[m][r]);
        if (n + 1 < NCHUNK) GLA_PUT((n + 1) & 1);
        __syncthreads();
    }
#undef GLA_FETCH
#undef GLA_PUT
}
__device__ __forceinline__ void out_norm_item(bf16* O, const bf16* PA, int gcol, const float* nw, int t, int h, int lane) {
    const unsigned ow = *(const unsigned*)(O + (size_t)t * 512 + h * 128 + 2 * lane);
    const float o0 = bflo(ow), o1 = bfhi(ow);
    const float rr = 1.f / sqrtf(wave_sum(o0 * o0 + o1 * o1) * (1.f / 128.f) + NORM_EPS);
    const unsigned z = *(const unsigned*)(PA + (size_t)t * NPA + gcol + h * 128 + 2 * lane);
    *(unsigned*)(O + (size_t)t * 512 + h * 128 + 2 * lane) = pk2(o0 * rr * nw[2 * lane] * siluf_(bflo(z)), o1 * rr * nw[2 * lane + 1] * siluf_(bfhi(z)));
}

constexpr size_t GDN_WI = 0, GDN_QI = GDN_WI + (size_t)NCHUNK * 4 * 16384, GDN_AT = GDN_QI + (size_t)NCHUNK * 4 * 16384, GDN_KT = GDN_AT + (size_t)NCHUNK * 4 * 8192,
                 GDN_UI = GDN_KT + (size_t)NCHUNK * 4 * 16384, GDN_DV = GDN_UI + (size_t)NCHUNK * 4 * 16384, GDN_BYTES = GDN_DV + (size_t)NCHUNK * 4 * 768;
__device__ __forceinline__ int pperm32(int k) { const int half = (k >> 4) & 1, fr = k & 15; return 8 * (fr >> 2) + 4 * half + (fr & 3); }
__device__ __forceinline__ void gdn_prep_chunk(const bf16* PA, const float* SM, const float* convw, const float* alog, const float* dtb, unsigned char* img, int n, int h, unsigned char* lds, int tid) {
    bf16* Qn = (bf16*)lds; bf16* Kn = (bf16*)(lds + 17408); bf16* Rt = (bf16*)(lds + 34816); bf16* Ts = (bf16*)(lds + 71680); float* Ls = (float*)(lds + 80896); float* gv = (float*)(lds + 98304);
    const int t0 = n * 64, ch = n * 4 + h, lane = tid & 63, wave = tid >> 6, q = lane >> 4, fr = lane & 15;
    __syncthreads();
    {
        const int c = tid >> 3, g8 = tid & 7, t = t0 + c;
        float val[3][16];
#pragma unroll
        for (int w = 0; w < 3; ++w) {
            const int c0 = w * 512 + h * 128 + g8 * 16;
#pragma unroll
            for (int i = 0; i < 16; ++i) val[w][i] = 0.f;
#pragma unroll
            for (int j = 0; j < 4; ++j) { const int tt = t - 3 + j;
                if (tt >= 0) {
                    const v4u xa = *(const v4u*)(PA + (size_t)tt * NPA + c0), xb = *(const v4u*)(PA + (size_t)tt * NPA + c0 + 8);
                    const float x[16] = {bflo(xa.x), bfhi(xa.x), bflo(xa.y), bfhi(xa.y), bflo(xa.z), bfhi(xa.z), bflo(xa.w), bfhi(xa.w), bflo(xb.x), bfhi(xb.x), bflo(xb.y), bfhi(xb.y), bflo(xb.z), bfhi(xb.z), bflo(xb.w), bfhi(xb.w)};
                    const f32x4* wp = (const f32x4*)(convw + j * 1536 + c0);
#pragma unroll
                    for (int i4 = 0; i4 < 4; ++i4) { const f32x4 wv = wp[i4]; val[w][4 * i4] += wv.x * x[4 * i4]; val[w][4 * i4 + 1] += wv.y * x[4 * i4 + 1]; val[w][4 * i4 + 2] += wv.z * x[4 * i4 + 2]; val[w][4 * i4 + 3] += wv.w * x[4 * i4 + 3]; }
                } }
#pragma unroll
            for (int i = 0; i < 16; ++i) val[w][i] = siluf_(val[w][i]);
        }
        float sq = 0.f, sk = 0.f;
#pragma unroll
        for (int i = 0; i < 16; ++i) { sq += val[0][i] * val[0][i]; sk += val[1][i] * val[1][i]; }
        sq += __shfl_xor(sq, 1); sq += __shfl_xor(sq, 2); sq += __shfl_xor(sq, 4);
        sk += __shfl_xor(sk, 1); sk += __shfl_xor(sk, 2); sk += __shfl_xor(sk, 4);
        const float rq = 0.08838834764831845f / sqrtf(sq + 1e-6f), rk = 1.f / sqrtf(sk + 1e-6f);
        const float beta = sigmoidf_(SM[(size_t)t * 64 + h]);
        v4u w0, w1;
        w0.x = pk2(val[0][0] * rq, val[0][1] * rq); w0.y = pk2(val[0][2] * rq, val[0][3] * rq); w0.z = pk2(val[0][4] * rq, val[0][5] * rq); w0.w = pk2(val[0][6] * rq, val[0][7] * rq);
        w1.x = pk2(val[0][8] * rq, val[0][9] * rq); w1.y = pk2(val[0][10] * rq, val[0][11] * rq); w1.z = pk2(val[0][12] * rq, val[0][13] * rq); w1.w = pk2(val[0][14] * rq, val[0][15] * rq);
        *(v4u*)(Qn + c * 136 + g8 * 16) = w0; *(v4u*)(Qn + c * 136 + g8 * 16 + 8) = w1;
        w0.x = pk2(val[1][0] * rk, val[1][1] * rk); w0.y = pk2(val[1][2] * rk, val[1][3] * rk); w0.z = pk2(val[1][4] * rk, val[1][5] * rk); w0.w = pk2(val[1][6] * rk, val[1][7] * rk);
        w1.x = pk2(val[1][8] * rk, val[1][9] * rk); w1.y = pk2(val[1][10] * rk, val[1][11] * rk); w1.z = pk2(val[1][12] * rk, val[1][13] * rk); w1.w = pk2(val[1][14] * rk, val[1][15] * rk);
        *(v4u*)(Kn + c * 136 + g8 * 16) = w0; *(v4u*)(Kn + c * 136 + g8 * 16 + 8) = w1;
#pragma unroll
        for (int i = 0; i < 16; ++i) Rt[(g8 * 16 + i) * 72 + c] = (bf16)f2bf(beta * val[2][i]);
        if (g8 == 0) { gv[c] = -expf(alog[h]) * softplusf_(SM[(size_t)t * 64 + 4 + h] + dtb[h]); gv[64 + c] = beta; }
    }
    __syncthreads();
    if (wave == 0) {
        float x = gv[lane];
#pragma unroll
        for (int off = 1; off < 64; off <<= 1) { const float y = __shfl_up(x, off); if (lane >= off) x += y; }
        gv[128 + lane] = x; gv[192 + lane] = expf(x);
    }
    __syncthreads();
    {
        const int c = tid >> 3, g8 = tid & 7; const float s = gv[64 + c] * gv[192 + c];
#pragma unroll
        for (int i = 0; i < 16; ++i) Rt[(128 + g8 * 16 + i) * 72 + c] = (bf16)f2bf(s * bf2f(Kn[c * 136 + g8 * 16 + i]));
    }
    {
        bf16* AT = (bf16*)(img + GDN_AT) + (size_t)ch * 4096;
#pragma unroll 1
        for (int job = wave; job < 26; job += 8) {
            int ib, jb; const bool isq = job >= 10;
            if (!isq) { int r = job; ib = 0; while (r > ib) { r -= ib + 1; ++ib; } jb = r; } else { ib = (job - 10) >> 2; jb = (job - 10) & 3; }
            f32x4 acc = {0.f, 0.f, 0.f, 0.f};
            if (jb <= ib) {
                const bf16* ap = (isq ? Qn : Kn) + (16 * ib + fr) * 136 + q * 8; const bf16* bp = Kn + (16 * jb + fr) * 136 + q * 8;
#pragma unroll
                for (int kk = 0; kk < 4; ++kk) acc = MFMA16(*(const bf16x8*)(ap + 32 * kk), *(const bf16x8*)(bp + 32 * kk), acc);
            }
            const int j = 16 * jb + fr; const float gj = gv[128 + j];
#pragma unroll
            for (int r = 0; r < 4; ++r) { const int i = 16 * ib + 4 * q + r; const float dec = expf(fminf(gv[128 + i] - gj, 0.f));
                if (!isq) Ls[i * 68 + j] = (j < i) ? gv[64 + i] * acc[r] * dec : 0.f;
                else AT[i * 64 + 32 * (jb >> 1) + 8 * (fr >> 2) + 4 * (jb & 1) + (fr & 3)] = (bf16)f2bf(j <= i ? acc[r] * dec : 0.f); }
        }
    }
    __syncthreads();
    if (wave == 0) {
        float T[64];
        int vz = 0; asm volatile("" : "+v"(vz));
        const float* Lz = Ls + vz;
#pragma unroll
        for (int i = 0; i < 64; ++i) {
            float a0 = fmaxf(0.f, 1.f - fabsf((float)(lane - i))), a1 = 0.f, a2 = 0.f, a3 = 0.f;
#pragma unroll
            for (int m4 = 0; m4 < (i + 3) / 4; ++m4) { const f32x4 lv = *(const f32x4*)(Lz + i * 68 + 4 * m4);
                if (4 * m4 < i) a0 -= lv.x * T[4 * m4]; if (4 * m4 + 1 < i) a1 -= lv.y * T[4 * m4 + 1]; if (4 * m4 + 2 < i) a2 -= lv.z * T[4 * m4 + 2]; if (4 * m4 + 3 < i) a3 -= lv.w * T[4 * m4 + 3]; }
            T[i] = (a0 + a1) + (a2 + a3);
            Ts[i * 72 + lane] = (bf16)f2bf(T[i]);
        }
    } else {
        const int t2 = tid - 64;
        bf16* QI = (bf16*)(img + GDN_QI) + (size_t)ch * 8192; bf16* KT = (bf16*)(img + GDN_KT) + (size_t)ch * 8192; float* DV = (float*)(img + GDN_DV) + (size_t)ch * 192;
        for (int it = t2; it < 64 * 16; it += 448) { const int c = it >> 4, pg = it & 15;
            unsigned short e[8];
#pragma unroll
            for (int j = 0; j < 8; ++j) { const int p = pg * 8 + j; e[j] = Qn[c * 136 + (p & ~31) + kperm32(p & 31)]; }
            v4u w; w.x = e[0] | ((unsigned)e[1] << 16); w.y = e[2] | ((unsigned)e[3] << 16); w.z = e[4] | ((unsigned)e[5] << 16); w.w = e[6] | ((unsigned)e[7] << 16);
            *(v4u*)(QI + c * 128 + pg * 8) = w; }
        for (int it = t2; it < 128 * 8; it += 448) { const int d = it >> 3, pg = it & 7;
            unsigned short e[8];
#pragma unroll
            for (int j = 0; j < 8; ++j) { const int p = pg * 8 + j; e[j] = Kn[((p & ~31) + kperm32(p & 31)) * 136 + d]; }
            v4u w; w.x = e[0] | ((unsigned)e[1] << 16); w.y = e[2] | ((unsigned)e[3] << 16); w.z = e[4] | ((unsigned)e[5] << 16); w.w = e[6] | ((unsigned)e[7] << 16);
            *(v4u*)(KT + d * 64 + pg * 8) = w; }
        if (t2 < 64) { DV[t2] = gv[192 + t2]; DV[64 + t2] = expf(gv[128 + 63] - gv[128 + t2]); if (t2 == 0) DV[128] = gv[192 + 63]; }
    }
    __syncthreads();
    {
        bf16x8 tf[4][2];
#pragma unroll
        for (int m = 0; m < 4; ++m)
#pragma unroll
            for (int kk = 0; kk < 2; ++kk) tf[m][kk] = *(const bf16x8*)(Ts + (16 * m + fr) * 72 + 32 * kk + q * 8);
#pragma unroll
        for (int cc = 0; cc < 2; ++cc) { const int ct = 2 * wave + cc;
            const bf16x8 r0 = *(const bf16x8*)(Rt + (16 * ct + fr) * 72 + q * 8), r1 = *(const bf16x8*)(Rt + (16 * ct + fr) * 72 + 32 + q * 8);
#pragma unroll
            for (int m = 0; m < 4; ++m) { f32x4 acc = {0.f, 0.f, 0.f, 0.f}; acc = MFMA16(tf[m][0], r0, acc); acc = MFMA16(tf[m][1], r1, acc);
                if (ct < 8) { v2u w; w.x = pk2(acc[0], acc[1]); w.y = pk2(acc[2], acc[3]); *(v2u*)(img + GDN_UI + (size_t)ch * 16384 + ((ct * 4 + m) * 64 + lane) * 8) = w; }
                else { const int dt = ct - 8; bf16* WI = (bf16*)(img + GDN_WI) + (size_t)ch * 8192;
#pragma unroll
                    for (int r = 0; r < 4; ++r) WI[(16 * m + 4 * q + r) * 128 + 32 * (dt >> 1) + 8 * (fr >> 2) + 4 * (dt & 1) + (fr & 3)] = (bf16)f2bf(-acc[r]); }
            } }
    }
}
constexpr int GDN_BUF = 2 * 17408 + 9216 + 18432 + 768;
__device__ __forceinline__ void gdn_scan_block(const unsigned char* img, bf16* OA, int h, unsigned char* lds, int tid) {
    const int lane = tid & 63, ws = __builtin_amdgcn_readfirstlane(tid >> 6), q = lane >> 4, fr = lane & 15;
    f32x4 S[8];
#pragma unroll
    for (int i = 0; i < 8; ++i) S[i] = (f32x4){0.f, 0.f, 0.f, 0.f};
    v4u st[7]; v4u stc = {0u, 0u, 0u, 0u}; v2u ub[4];
#define GDN_FETCH(N) do { const int ch_ = (N) * 4 + h; \
        st[0] = *(const v4u*)(img + GDN_WI + (size_t)ch_ * 16384 + tid * 16); st[1] = *(const v4u*)(img + GDN_WI + (size_t)ch_ * 16384 + 8192 + tid * 16); \
        st[2] = *(const v4u*)(img + GDN_QI + (size_t)ch_ * 16384 + tid * 16); st[3] = *(const v4u*)(img + GDN_QI + (size_t)ch_ * 16384 + 8192 + tid * 16); \
        st[4] = *(const v4u*)(img + GDN_AT + (size_t)ch_ * 8192 + tid * 16); \
        st[5] = *(const v4u*)(img + GDN_KT + (size_t)ch_ * 16384 + tid * 16); st[6] = *(const v4u*)(img + GDN_KT + (size_t)ch_ * 16384 + 8192 + tid * 16); \
        if (tid < 48) stc = *(const v4u*)(img + GDN_DV + (size_t)ch_ * 768 + tid * 16); \
        _Pragma("unroll") for (int m_ = 0; m_ < 4; ++m_) ub[m_] = *(const v2u*)(img + GDN_UI + (size_t)ch_ * 16384 + ((ws * 4 + m_) * 64 + lane) * 8); } while (0)
#define GDN_PUT(B) do { unsigned char* b_ = lds + (B) * GDN_BUF; const int r16 = tid >> 4, c16 = tid & 15, r8 = tid >> 3, c8 = tid & 7; \
        *(v4u*)(b_ + r16 * 272 + c16 * 16) = st[0]; *(v4u*)(b_ + (32 + r16) * 272 + c16 * 16) = st[1]; \
        *(v4u*)(b_ + 17408 + r16 * 272 + c16 * 16) = st[2]; *(v4u*)(b_ + 17408 + (32 + r16) * 272 + c16 * 16) = st[3]; \
        *(v4u*)(b_ + 34816 + r8 * 144 + c8 * 16) = st[4]; \
        *(v4u*)(b_ + 44032 + r8 * 144 + c8 * 16) = st[5]; *(v4u*)(b_ + 44032 + (64 + r8) * 144 + c8 * 16) = st[6]; \
        if (tid < 48) *(v4u*)(b_ + 62464 + tid * 16) = stc; } while (0)
    __syncthreads();
    GDN_FETCH(0); GDN_PUT(0);
    __syncthreads();
    for (int n = 0; n < NCHUNK; ++n) {
        const unsigned char* b = lds + (n & 1) * GDN_BUF;
        const float* DV = (const float*)(b + 62464);
        f32x4 vn[4], o[4];
#pragma unroll
        for (int m = 0; m < 4; ++m) vn[m] = (f32x4){bflo(ub[m].x), bfhi(ub[m].x), bflo(ub[m].y), bfhi(ub[m].y)};
        if (n + 1 < NCHUNK) GDN_FETCH(n + 1);
        bf16x8 sB[4];
#pragma unroll
        for (int kk = 0; kk < 4; ++kk) sB[kk] = pack_ctiles(S[2 * kk], S[2 * kk + 1]);
#pragma unroll
        for (int m = 0; m < 4; ++m) {
            const unsigned char* wr_ = b + (16 * m + fr) * 272 + q * 16;
            f32x4 oi = {0.f, 0.f, 0.f, 0.f};
#pragma unroll
            for (int kk = 0; kk < 4; ++kk) { vn[m] = MFMA16(*(const bf16x8*)(wr_ + 64 * kk), sB[kk], vn[m]); oi = MFMA16(*(const bf16x8*)(wr_ + 17408 + 64 * kk), sB[kk], oi); }
            o[m] = oi * *(const f32x4*)(DV + 16 * m + 4 * q);
        }
        const bf16x8 vb0 = pack_ctiles(vn[0], vn[1]), vb1 = pack_ctiles(vn[2], vn[3]);
#pragma unroll
        for (int m = 0; m < 4; ++m) {
            const unsigned char* ar = b + 34816 + (16 * m + fr) * 144 + q * 16;
            o[m] = MFMA16(*(const bf16x8*)(ar), vb0, o[m]);
            if (m >= 2) o[m] = MFMA16(*(const bf16x8*)(ar + 64), vb1, o[m]);
        }
#pragma unroll
        for (int m = 0; m < 4; ++m) vn[m] = vn[m] * *(const f32x4*)(DV + 64 + 16 * m + 4 * q);
        const bf16x8 xs0 = pack_ctiles(vn[0], vn[1]), xs1 = pack_ctiles(vn[2], vn[3]);
        const float cdec = DV[128];
#pragma unroll
        for (int dt = 0; dt < 8; ++dt) {
            const unsigned char* kr = b + 44032 + (16 * dt + fr) * 144 + q * 16;
            f32x4 acc = S[dt] * cdec;
            acc = MFMA16(*(const bf16x8*)(kr), xs0, acc); acc = MFMA16(*(const bf16x8*)(kr + 64), xs1, acc);
            S[dt] = acc;
        }
#pragma unroll
        for (int m = 0; m < 4; ++m)
#pragma unroll
            for (int r = 0; r < 4; ++r) OA[(size_t)(64 * n + 16 * m + 4 * q + r) * 512 + h * 128 + 16 * ws + fr] = (bf16)f2bf(o[m][r]);
        if (n + 1 < NCHUNK) GDN_PUT((n + 1) & 1);
        __syncthreads();
    }
#undef GDN_FETCH
#undef GDN_PUT
}

constexpr int PH_PER_LAYER = 22, NPHASES = DEPTH * PH_PER_LAYER;
enum { K_CONV = 0, K_F1, K_GF32, K_ROWS, K_M1, K_M2, K_M3, K_M4, K_M5 };
constexpr size_t ALPHA_OFF = 276 * MiB;
static_assert(ALPHA_OFF + GLA_BYTES <= 290 * MiB && WS_WGU + GLA_VBYTES <= WS_WD && WS_QKV + GDN_BYTES <= WS_KCMP, "gla/gdn images");
__global__ void __launch_bounds__(NTHR, 2) mk_fwd(Args args) {
    extern __shared__ __attribute__((aligned(16))) unsigned char lds[];
    LAS unsigned char* ldsl = (LAS unsigned char*)lds;
    {
        const int tid = threadIdx.x;
        for (int u = tid; u < (LDS_BYTES - LDSCTL_OFF) / 4; u += NTHR) ((LAS unsigned*)(ldsl + LDSCTL_OFF))[u] = 0u;
        __syncthreads();
        LAS int* btab = (LAS int*)(ldsl + BTAB_OFF);
        if (tid < 128) { int b = tid; if (tid >= 16) { const float v = logf((float)tid / 16.f) / 2.0794415416798357f * 16.f; b = 16 + (int)v; if (b > 31) b = 31; } btab[tid] = b; }
        __syncthreads();
    }
#if MK_ONE_LAUNCH
    XcdBarrier bar = xcd_barrier_post((unsigned*)(args.ws + WS_CTL) + CW_BAR, (volatile LAS unsigned*)(ldsl + MISC_OFF) + 8);
#endif
#pragma unroll 1
    for (int pc = args.ph_lo; pc < args.ph_hi; ++pc) {
        const int l = pc / PH_PER_LAYER, idx = pc % PH_PER_LAYER;
        int kind, sub = 0, b = 0;
        if (idx < 4) { kind = idx == 0 ? K_CONV : idx == 1 ? K_F1 : idx == 2 ? K_GF32 : K_ROWS; }
        else if (idx >= 18) { sub = 1; kind = idx == 18 ? K_CONV : idx == 19 ? K_F1 : idx == 20 ? K_GF32 : K_ROWS; }
        else { b = (idx - 4) / 7; const int j = (idx - 4) % 7; kind = j == 0 ? K_M1 : j == 1 ? K_M2 : j == 2 ? K_M3 : j == 3 ? K_M4 : j == 4 ? K_M5 : j == 5 ? K_GF32 : K_ROWS; }
        const bool mixer = idx >= 4 && idx < 18;
        unsigned char* ws = args.ws;
        int tid_ = threadIdx.x; asm volatile("" : "+v"(tid_));
        const int tid = tid_, lane = tid & 63, wave = __builtin_amdgcn_readfirstlane(tid >> 6);
        const int G = gridDim.x, bx = blockIdx.x;
        const int vcu = (G % 8 == 0) ? (bx % 8) * (G / 8) + bx / 8 : bx;
        const int gw = vcu * NWAVES + wave, NGW = G * NWAVES;
        switch (kind) {
        case K_CONV: {
            bf16* WGU = (bf16*)(ws + WS_WGU); bf16* WD = (bf16*)(ws + WS_WD); bf16* WIN = (bf16*)(ws + WS_WIN); bf16* WB = (bf16*)(ws + WS_WB); bf16* WO = (bf16*)(ws + WS_WO);
            LAS float* scr = (LAS float*)(ldsl + wave * 16384);
            const float* w_gu = args.in[sub ? I_F2GU : I_F1GU] + (size_t)l * DM * 2 * DFF;
            const float* w_dn = args.in[sub ? I_F2D : I_F1D] + (size_t)l * DFF * DM;
            constexpr int I_GU = (DM / 64) * (2 * DFF / 32), I_DN = (DFF / 64) * (DM / 32), I_IN = (DM / 64) * ((DIN_SRC + 31) / 32), I_BR = (512 / 64) * (DM / 32), I_OUT = (DM / 64) * (DM / 32);
            const int nitems = I_GU + I_DN + (sub == 0 ? I_IN + 3 * I_BR + I_OUT : 0);
            for (int it = gw; it < nitems; it += NGW) {
                int r = it;
                if (r < I_GU) { transpose_item(w_gu, DM, 2 * DFF, WGU, scr, r, lane, MapGU()); continue; } r -= I_GU;
                if (r < I_DN) { transpose_item(w_dn, DFF, DM, WD, scr, r, lane, MapId()); continue; } r -= I_DN;
                if (r < I_IN) { transpose_item(args.in[I_WIN] + (size_t)l * DM * DIN_SRC, DM, DIN_SRC, WIN, scr, r, lane, MapWin()); continue; } r -= I_IN;
                if (r < 3 * I_BR) { const int br = r / I_BR; transpose_item(args.in[I_WBG + br] + (size_t)l * 512 * DM, 512, DM, WB + (size_t)br * 512 * 1024, scr, r % I_BR, lane, MapId()); continue; } r -= 3 * I_BR;
                transpose_item(args.in[I_WOUT] + (size_t)l * DM * DM, DM, DM, WO, scr, r, lane, MapId());
            }
            if (sub == 0) { for (int i = gw * 64 + lane; i < 16 * DM / 2; i += NGW * 64) ((unsigned*)(WIN + (size_t)(PA_SM + 48) * DM))[i] = 0u; }
            if (l == 0 && sub == 0) { const float* n_pre = args.in[I_F1PRE]; bf16* XN = (bf16*)(ws + WS_XN);
                for (int m = gw; m < MTOK; m += NGW) row_pass(args.in[I_X] + (size_t)m * DM, nullptr, nullptr, 0.f, nullptr, n_pre, XN + (size_t)m * DM, lane); }
        } break;
        case K_F1: {
            pg8::Gemm g{(const bf16*)(ws + WS_XN), (const bf16*)(ws + WS_WGU), MTOK, 2 * DFF, DM}; pg8::StaticOrder S; S.init(MTOK, 2 * DFF, G, bx); pg8::EpiSwiglu E{(bf16*)(ws + WS_H), DFF};
            pg8::gemm_phase<pg8::EpiSwiglu, pg8::StaticOrder, true, true>(ldsl, g, S, E);
        } break;
        case K_GF32: {
            pg8::Gemm g; pg8::EpiF32 E; pg8::StaticOrder S;
            if (mixer) { g = pg8::Gemm{(const bf16*)(ws + WS_MG), (const bf16*)(ws + WS_WO), SEQ, DM, DM}; E = pg8::EpiF32{(float*)(ws + WS_YB), DM}; S.init(SEQ, DM, G, bx); }
            else { g = pg8::Gemm{(const bf16*)(ws + WS_H), (const bf16*)(ws + WS_WD), MTOK, DM, DFF}; E = pg8::EpiF32{(float*)(ws + WS_Y), DM}; S.init(MTOK, DM, G, bx); }
            pg8::gemm_phase<pg8::EpiF32, pg8::StaticOrder, true, true>(ldsl, g, S, E);
        } break;
        case K_ROWS: {
            float* xres = args.out; bf16* XN = (bf16*)(ws + WS_XN);
            if (mixer) {
                const float* YB = (const float*)(ws + WS_YB);
                for (int m = gw; m < SEQ; m += NGW) { const size_t r = (size_t)b * SEQ + m;
                    row_pass(xres + r * DM, YB + (size_t)m * DM, args.in[I_MPOST] + l * DM, 1.0f, xres + r * DM, args.in[I_F2PRE] + l * DM, XN + r * DM, lane); }
            } else {
                const float* Y = (const float*)(ws + WS_Y);
                const float* n_post = args.in[sub ? I_F2POST : I_F1POST] + l * DM;
                const float* xin = (l == 0 && sub == 0) ? args.in[I_X] : xres;
                const float* wnext = sub == 0 ? args.in[I_MPRE] + l * DM : (l + 1 < DEPTH ? args.in[I_F1PRE] + (l + 1) * DM : nullptr);
                for (int m = gw; m < MTOK; m += NGW) row_pass(xin + (size_t)m * DM, Y + (size_t)m * DM, n_post, 0.5f, xres + (size_t)m * DM, wnext, wnext ? XN + (size_t)m * DM : nullptr, lane);
            }
        } break;
        case K_M1: {
            pg8::Gemm g{(const bf16*)(ws + WS_XN) + (size_t)b * SEQ * DM, (const bf16*)(ws + WS_WIN), SEQ, NIN, DM}; pg8::StaticOrder S; S.init(SEQ, NIN, G, bx);
            pg8::EpiWin E{(bf16*)(ws + WS_A), (float*)(ws + WS_SM), (bf16*)(ws + WS_G)};
            pg8::gemm_phase<pg8::EpiWin, pg8::StaticOrder, true, true>(ldsl, g, S, E);
        } break;
        case K_M2: {
            const bf16* PA = (const bf16*)(ws + WS_A); const float* SM = (const float*)(ws + WS_SM);
            for (int it = bx; it < 511 * 2; it += G)
                nsa_compress_item(PA, args.in[I_PEK] + l * 32 * 96, args.in[I_W1K] + (size_t)l * 3072 * 256, args.in[I_W2K] + l * 256 * 96,
                                  args.in[I_PEV] + l * 32 * 64, args.in[I_W1V] + (size_t)l * 2048 * 256, args.in[I_W2V] + l * 256 * 64, (float*)(ws + WS_KCMP), (float*)(ws + WS_VCMP), it >> 1, it & 1, (float*)lds, tid);
            for (int it = bx; it < NCHUNK * 4; it += G)
                gdn_prep_chunk(PA, SM, args.in[I_CONVW] + l * 4 * 1536, args.in[I_ALOG] + l * 4, args.in[I_DTB] + l * 4, ws + WS_QKV, it >> 2, it & 3, lds, tid);
            for (int it = bx; it < NCHUNK * 4; it += G)
                gla_prep_item(PA, SM, args.in[I_GGW] + l * 16 * 256, args.in[I_GGB] + l * 256, ws + ALPHA_OFF, ws + WS_WGU, it >> 2, it & 3, (float*)lds, tid);
        } break;
        case K_M3: {
            const bf16* PA = (const bf16*)(ws + WS_A); bf16* OB3 = (bf16*)(ws + WS_O);
            float* wl = (float*)(lds + wave * 16384);
            if (bx < 4) gdn_scan_block(ws + WS_QKV, OB3, bx, lds, tid);
            else if (bx < 8) gla_scan_block(ws + ALPHA_OFF, ws + WS_WGU, OB3 + 2 * (size_t)SEQ * 512, bx - 4, lds, tid);
            else { const LAS int* btab = (const LAS int*)(ldsl + BTAB_OFF);
                for (int it = (bx - 8) * NWAVES + wave; it < SEQ * 2; it += (G - 8) * NWAVES)
                    nsa_item(PA, (const float*)(ws + WS_SM), (const float*)(ws + WS_KCMP), (const float*)(ws + WS_VCMP), args.in[I_RELB], btab, OB3 + (size_t)SEQ * 512, it >> 1, it & 1, wl, lane); }
        } break;
        case K_M4: {
            for (int it = gw; it < SEQ * 4; it += NGW) out_norm_item((bf16*)(ws + WS_O), (const bf16*)(ws + WS_A), PA_GZ, args.in[I_GDNNW] + l * 128, it >> 2, it & 3, lane);
            for (int it = gw; it < SEQ * 4; it += NGW) out_norm_item((bf16*)(ws + WS_O) + 2 * (size_t)SEQ * 512, (const bf16*)(ws + WS_A), PA_LR, args.in[I_GLANW] + l * 128, it >> 2, it & 3, lane);
        } break;
        case K_M5: {
#pragma unroll 1
            for (int br = 0; br < 3; ++br) {
                pg8::StaticOrder S; S.init(SEQ, DM, G, bx);
                pg8::Gemm g{(const bf16*)(ws + WS_O) + (size_t)br * SEQ * 512, (const bf16*)(ws + WS_WB) + (size_t)br * 512 * 1024, SEQ, DM, 512};
                pg8::EpiMerge E{(const bf16*)(ws + WS_G) + br * 1024, (float*)(ws + WS_RMW), (bf16*)(ws + WS_MG), br};
                pg8::gemm_phase<pg8::EpiMerge, pg8::StaticOrder, true, true>(ldsl, g, S, E);
            }
        } break;
        default: break;
        }
#if MK_ONE_LAUNCH
        if (pc + 1 < args.ph_hi) xcd_barrier(bar);
#endif
    }
}

extern "C" void kernel_launch(void* const* d_in, const int* in_sizes, int n_in, void* d_out, int out_size, void* d_ws, size_t ws_size, hipStream_t stream) {
    static int grid = 0;
    if (grid == 0) {
        if (n_in != 30 || out_size != MTOK * DM || ws_size < 292 * MiB) { fprintf(stderr, "kernel_launch: unexpected shapes (n_in %d out %d ws %zu)\n", n_in, out_size, ws_size); grid = -1; return; }
        int dev = 0, cus = 0, per_cu = 0;
        if (hipGetDevice(&dev) != hipSuccess || hipDeviceGetAttribute(&cus, hipDeviceAttributeMultiprocessorCount, dev) != hipSuccess) { grid = -1; return; }
        if (hipFuncSetAttribute((const void*)mk_fwd, hipFuncAttributeMaxDynamicSharedMemorySize, LDS_BYTES) != hipSuccess) { fprintf(stderr, "kernel_launch: hipFuncSetAttribute failed\n"); grid = -1; return; }
        if (hipOccupancyMaxActiveBlocksPerMultiprocessor(&per_cu, (const void*)mk_fwd, NTHR, LDS_BYTES) != hipSuccess || per_cu < 1) { fprintf(stderr, "kernel_launch: occupancy query says %d blocks per CU\n", per_cu); grid = -1; (void)hipGetLastError(); return; }
        (void)hipGetLastError();
        grid = cus;
    }
    if (grid < 0) return;
    (void)hipMemsetAsync((char*)d_ws + WS_CTL, 0, CTL_ZERO_BYTES, stream);
    Args a{};
    for (int i = 0; i < 30; ++i) a.in[i] = (const float*)d_in[i];
    a.out = (float*)d_out; a.ws = (unsigned char*)d_ws;
#if MK_ONE_LAUNCH
    a.ph_lo = 0; a.ph_hi = NPHASES;
    hipLaunchKernelGGL(mk_fwd, dim3(grid), dim3(NTHR), LDS_BYTES, stream, a);
#else
    for (int p = 0; p < NPHASES; ++p) { a.ph_lo = p; a.ph_hi = p + 1; hipLaunchKernelGGL(mk_fwd, dim3(grid), dim3(NTHR), LDS_BYTES, stream, a); }
#endif
}
```

```cpp
#include <hip/hip_runtime.h>
#include <cstdio>
#include <cstdint>
#ifndef MK_ONE_LAUNCH
#define MK_ONE_LAUNCH 1
#endif
namespace pg8 {
#define PG8_LAS __attribute__((address_space(3)))
typedef unsigned short bf16_t;
typedef short bf16x8 __attribute__((ext_vector_type(8)));
typedef float f32x4 __attribute__((ext_vector_type(4)));
typedef unsigned u32x4 __attribute__((ext_vector_type(4)));
typedef unsigned u32x2 __attribute__((ext_vector_type(2)));
constexpr int BM = 256, BK = 64, HALF = 128, HTB = HALF * BK * 2  , STAGE_BYTES = 8 * HTB, NXCD = 8, WGM = 8;

__host__ __device__ __forceinline__ int lds_byte(int r, int c) { const int st = (r >> 4) * 2 + (c >> 5), rr = r & 15, cc = c & 31, ob = rr * 64 + cc * 2; return st * 1024 + (ob ^ (((ob >> 9) & 1) << 5)); }
__host__ __device__ __forceinline__ void stage_rc(int b, int& R, int& C) { const int st = b / 1024, sb = b % 1024, swz = sb ^ (((sb >> 9) & 1) << 5); R = (st >> 1) * 16 + swz / 64; C = (st & 1) * 32 + (swz % 64) / 2; }
__host__ __device__ __forceinline__ int perm32(int rho) { const int n = rho >> 4, i = rho & 15; return 8 * (i >> 2) + 4 * n + (i & 3); }

struct Unit { int pm, pn; };
struct Gemm { const bf16_t* A; const bf16_t* Bt; int M, N, K, lda; };

struct StaticOrder {
    int nM, nN, nwg, G, c;
    __host__ __device__ void init(int M, int N, int G_, int c_) { nM = M / BM; nN = N / BM; nwg = nM * nN; G = G_; c = c_; }
    __host__ __device__ bool next(int i, Unit& u) const {
        const long L = (long)i * G + c; if (L >= nwg) return false;
        int wgid = (int)L; { const int q = nwg / NXCD, r = nwg % NXCD, xcd = wgid % NXCD, off = wgid / NXCD; wgid = (xcd < r ? xcd * (q + 1) : r * (q + 1) + (xcd - r) * q) + off; }
        const int nig = WGM * nN, gid = wgid / nig, fm = gid * WGM, gsz = (nM - fm) < WGM ? (nM - fm) : WGM;
        u.pm = fm + ((wgid % nig) % gsz); u.pn = (wgid % nig) / gsz; return true;
    }
    __device__ __forceinline__ void a_ready(const Unit&) const {}
    __device__ __forceinline__ void done(const Unit&) const {}
};

struct OneTile { int pm, pn; __device__ __forceinline__ bool next(int i, Unit& u) const { if (i) return false; u.pm = pm; u.pn = pn; return true; }
    __device__ __forceinline__ void a_ready(const Unit&) const {} __device__ __forceinline__ void done(const Unit&) const {} };
__device__ __forceinline__ unsigned cvt_pk_bf16(float lo, float hi) { unsigned r; asm volatile("v_cvt_pk_bf16_f32 %0, %1, %2" : "=v"(r) : "v"(lo), "v"(hi)); return r; }
__device__ __forceinline__ float bflo(unsigned w) { return __uint_as_float(w << 16); }
__device__ __forceinline__ float bfhi(unsigned w) { return __uint_as_float(w & 0xffff0000u); }
__device__ __forceinline__ float sigmoid_f(float x) { return __builtin_amdgcn_rcpf(1.f + __expf(-x)); }

struct EpiSwiglu {
    static constexpr bool PERM = true, AFTER_DRAIN = false;
    bf16_t* H; int ldh;
    __device__ __forceinline__ void operator()(const f32x4 (&acc)[2][2][4][2], const Unit& u, int wr, int wc, int fr, int fq) const {
        const int row0 = u.pm * BM + wr * 64 + fr, j0 = u.pn * HALF + wc * 32 + 8 * fq;
#pragma unroll
        for (int ai = 0; ai < 2; ++ai)
#pragma unroll
            for (int m = 0; m < 4; ++m) {
                bf16_t* p = H + (size_t)(row0 + ai * HALF + m * 16) * ldh + j0;
                float h[8];
#pragma unroll
                for (int n = 0; n < 2; ++n)
#pragma unroll
                    for (int i = 0; i < 4; ++i) { const float g = acc[ai][0][m][n][i], uu = acc[ai][1][m][n][i]; h[n * 4 + i] = g * sigmoid_f(g) * uu; }
                u32x4 w; w.x = cvt_pk_bf16(h[0], h[1]); w.y = cvt_pk_bf16(h[2], h[3]); w.z = cvt_pk_bf16(h[4], h[5]); w.w = cvt_pk_bf16(h[6], h[7]);
                *(u32x4*)p = w;
                asm volatile("" ::: "memory");
            }
    }
};
struct EpiGelu {
    static constexpr bool PERM = false, AFTER_DRAIN = false;
    bf16_t* Hd; const float* bias;
    __device__ __forceinline__ void operator()(const f32x4 (&acc)[2][2][4][2], const Unit& u, int wr, int wc, int fr, int fq) const {
        const int row0 = u.pm * BM + wr * 64 + fr, col0 = wc * 32 + 4 * fq;
#pragma unroll
        for (int bj = 0; bj < 2; ++bj)
#pragma unroll
            for (int n = 0; n < 2; ++n) { const int c = col0 + bj * HALF + n * 16; const f32x4 bv = *(const f32x4*)(bias + c);
#pragma unroll
                for (int ai = 0; ai < 2; ++ai)
#pragma unroll
                    for (int m = 0; m < 4; ++m) { f32x4 v = acc[ai][bj][m][n] + bv;
#pragma unroll
                        for (int i = 0; i < 4; ++i) { const float x = v[i]; const float u2 = 1.5957691216057308f * (x + 0.044715f * x * x * x); v[i] = x * (1.f - __builtin_amdgcn_rcpf(1.f + __expf(u2))); }
                        u32x2 w; w.x = cvt_pk_bf16(v[0], v[1]); w.y = cvt_pk_bf16(v[2], v[3]);
                        *(u32x2*)(Hd + (size_t)(row0 + ai * HALF + m * 16) * 256 + c) = w; asm volatile("" ::: "memory"); } }
    }
};
struct EpiF32 {
    static constexpr bool PERM = false, AFTER_DRAIN = false;
    float* Y; int ldc;
    __device__ __forceinline__ void operator()(const f32x4 (&acc)[2][2][4][2], const Unit& u, int wr, int wc, int fr, int fq) const {
        const int row0 = u.pm * BM + wr * 64 + fr, col0 = u.pn * BM + wc * 32 + 4 * fq;
#pragma unroll
        for (int ai = 0; ai < 2; ++ai)
#pragma unroll
            for (int m = 0; m < 4; ++m) { float* p = Y + (size_t)(row0 + ai * HALF + m * 16) * ldc + col0;
#pragma unroll
                for (int bj = 0; bj < 2; ++bj)
#pragma unroll
                    for (int n = 0; n < 2; ++n) *(f32x4*)(p + bj * HALF + n * 16) = acc[ai][bj][m][n]; }
    }
};
struct EpiWin {
    static constexpr bool PERM = true, AFTER_DRAIN = false;
    bf16_t* PA; float* SM; bf16_t* G;
    __device__ __forceinline__ void operator()(const f32x4 (&acc)[2][2][4][2], const Unit& u, int wr, int wc, int fr, int fq) const {
        const int row0 = u.pm * BM + wr * 64 + fr, cw = wc * 32 + 8 * fq;
        const bool gate = u.pn >= 21;
#pragma unroll
        for (int ai = 0; ai < 2; ++ai)
#pragma unroll
            for (int m = 0; m < 4; ++m) { const size_t row = (size_t)(row0 + ai * HALF + m * 16);
#pragma unroll
                for (int bj = 0; bj < 2; ++bj) {
                    f32x4 v0 = acc[ai][bj][m][0], v1 = acc[ai][bj][m][1];
                    if (gate) {
#pragma unroll
                        for (int i = 0; i < 4; ++i) { v0[i] = sigmoid_f(v0[i]); v1[i] = sigmoid_f(v1[i]); }
                    }
                    u32x4 w; w.x = cvt_pk_bf16(v0[0], v0[1]); w.y = cvt_pk_bf16(v0[2], v0[3]); w.z = cvt_pk_bf16(v1[0], v1[1]); w.w = cvt_pk_bf16(v1[2], v1[3]);
                    if (gate) *(u32x4*)(G + row * 3072 + (u.pn - 21) * BM + bj * HALF + cw) = w;
                    else {
                        const int col = u.pn * BM + bj * HALF + cw;
                        *(u32x4*)(PA + row * 5376 + col) = w;
                        if (col >= 5312) { float* s = SM + row * 64 + (col - 5312); *(f32x4*)s = v0; *(f32x4*)(s + 4) = v1; }
                    }
                    asm volatile("" ::: "memory");
                }
            }
    }
};
struct EpiMerge {
    static constexpr bool PERM = false, AFTER_DRAIN = false;
    const bf16_t* G; float* RMW; bf16_t* MG; int STEP;
    __device__ __forceinline__ void operator()(const f32x4 (&acc)[2][2][4][2], const Unit& u, int wr, int wc, int fr, int fq) const {
        const int row0 = u.pm * BM + wr * 64 + fr, col0 = u.pn * BM + wc * 32 + 4 * fq;
#pragma unroll
        for (int ai = 0; ai < 2; ++ai)
#pragma unroll
            for (int m = 0; m < 4; ++m) { const size_t row = (size_t)(row0 + ai * HALF + m * 16);
#pragma unroll
                for (int bj = 0; bj < 2; ++bj)
#pragma unroll
                    for (int n = 0; n < 2; ++n) { const int c = col0 + bj * HALF + n * 16;
                        const u32x2 gw = *(const u32x2*)(G + row * 3072 + c);
                        f32x4 v = acc[ai][bj][m][n]; v[0] *= bflo(gw.x); v[1] *= bfhi(gw.x); v[2] *= bflo(gw.y); v[3] *= bfhi(gw.y);
                        float* r = RMW + row * 1024 + c;
                        if (STEP == 0) *(f32x4*)r = v;
                        else if (STEP == 1) *(f32x4*)r = *(const f32x4*)r + v;
                        else { v = *(const f32x4*)r + v; u32x2 w; w.x = cvt_pk_bf16(v[0], v[1]); w.y = cvt_pk_bf16(v[2], v[3]); *(u32x2*)(MG + row * 1024 + c) = w; }
                    }
            }
    }
};

template <class Epi, class Sched, bool ALIGN_EPI = false, bool SP2 = false>
__device__ __forceinline__ void gemm_phase(PG8_LAS unsigned char* lds, const Gemm g, const Sched& S, const Epi& E) {
    int tid_ = threadIdx.x; asm volatile("" : "+v"(tid_));
    const int tid = tid_, wid = __builtin_amdgcn_readfirstlane(tid >> 6), lane = tid & 63, wr = wid >> 2, wc = wid & 3, fr = lane & 15, fq = lane >> 4;
    const int K = g.K, nt = K / BK, lda = g.lda;
    unsigned voffA[2], voffB[2];
#pragma unroll
    for (int i = 0; i < 2; ++i) { int R, C; stage_rc(tid * 16 + i * 8192, R, C); const int Rb = Epi::PERM ? ((R & ~31) + perm32(R & 31)) : R;
        voffA[i] = (unsigned)(R * lda + C) * 2u; voffB[i] = (unsigned)(Rb * K + C) * 2u; }
    const size_t kstep = (size_t)(BK * 2);
    const size_t hstepA = (size_t)HALF * lda * 2, tstepA = 2 * hstepA;
    const size_t hstep = (size_t)HALF * K * 2;
    const size_t tstep = 2 * hstep;
    const unsigned ldsw = (unsigned)wid * 1024u;
    const int aoff = lds_byte(wr * 64 + fr, fq * 8), boff = lds_byte(wc * 32 + fr, fq * 8);
#define PG8_SA(b, h) (((b) * 2 + (h)) * HTB)
#define PG8_SB(b, h) ((4 + (b) * 2 + (h)) * HTB)
#define PG8_STAGE(bufoff, gbase, voff) do { _Pragma("unroll") for (int _i = 0; _i < 2; ++_i) \
        __builtin_amdgcn_global_load_lds((const unsigned*)((const char*)(gbase) + (voff)[_i]), (PG8_LAS unsigned*)(lds + (bufoff) + ldsw + _i * 8192), 16, 0, 0); } while (0)
#define PG8_LDA(dst, b, h) do { _Pragma("unroll") for (int m = 0; m < 4; ++m) _Pragma("unroll") for (int k = 0; k < 2; ++k) dst[m][k] = *(const PG8_LAS bf16x8*)(lds + PG8_SA(b, h) + aoff + m * 2048 + k * 1024); } while (0)
#define PG8_LDB(dst, b, h) do { _Pragma("unroll") for (int n = 0; n < 2; ++n) _Pragma("unroll") for (int k = 0; k < 2; ++k) dst[n][k] = *(const PG8_LAS bf16x8*)(lds + PG8_SB(b, h) + boff + n * 2048 + k * 1024); } while (0)
#define PG8_MMA(ai, bj, At, Bt) do { __builtin_amdgcn_s_setprio(1); _Pragma("unroll") for (int m = 0; m < 4; ++m) _Pragma("unroll") for (int n = 0; n < 2; ++n) _Pragma("unroll") for (int k = 0; k < 2; ++k) \
        acc[ai][bj][m][n] = __builtin_amdgcn_mfma_f32_16x16x32_bf16(Bt[n][k], At[m][k], acc[ai][bj][m][n], 0, 0, 0); __builtin_amdgcn_s_setprio(0); } while (0)
#define PG8_WAIT_V(n) asm volatile("s_waitcnt vmcnt(" #n ")" ::: "memory")
#define PG8_WAIT_L(n) asm volatile("s_waitcnt lgkmcnt(" #n ")" ::: "memory")
#define PG8_BAR __builtin_amdgcn_s_barrier()
#define PG8_SCHED __builtin_amdgcn_sched_barrier(0)
    Unit cur, nxt; int ui = 0;
    if (!S.next(0, cur)) return;
    f32x4 acc[2][2][4][2];
#pragma unroll
    for (int a = 0; a < 2; ++a)
#pragma unroll
        for (int b = 0; b < 2; ++b)
#pragma unroll
            for (int m = 0; m < 4; ++m)
#pragma unroll
                for (int n = 0; n < 2; ++n) acc[a][b][m][n] = (f32x4){0.f, 0.f, 0.f, 0.f};
    bf16x8 At[4][2], B0[2][2], B1[2][2];
    const char* cA = (const char*)g.A + (size_t)cur.pm * tstepA; const char* cB = (const char*)g.Bt + (size_t)cur.pn * tstep;
    S.a_ready(cur);
    if constexpr (SP2) {
        PG8_STAGE(PG8_SB(0, 0), cB, voffB); PG8_STAGE(PG8_SB(0, 1), cB + hstep, voffB); PG8_STAGE(PG8_SA(0, 0), cA, voffA); PG8_STAGE(PG8_SA(0, 1), cA + hstepA, voffA);
        if (wr == 1) PG8_BAR;
        PG8_WAIT_V(2); PG8_BAR;
        PG8_STAGE(PG8_SB(1, 0), cB + kstep, voffB); PG8_STAGE(PG8_SA(1, 0), cA + kstep, voffA); PG8_STAGE(PG8_SB(1, 1), cB + hstep + kstep, voffB);
        PG8_WAIT_V(6); PG8_BAR;
    } else {
        PG8_STAGE(PG8_SB(0, 0), cB, voffB); PG8_STAGE(PG8_SA(0, 0), cA, voffA); PG8_STAGE(PG8_SB(0, 1), cB + hstep, voffB); PG8_STAGE(PG8_SA(0, 1), cA + hstepA, voffA);
        if (wr == 1) PG8_BAR;
        PG8_WAIT_V(4); PG8_BAR;
        PG8_STAGE(PG8_SB(1, 0), cB + kstep, voffB); PG8_STAGE(PG8_SA(1, 0), cA + kstep, voffA); PG8_STAGE(PG8_SB(1, 1), cB + hstep + kstep, voffB);
        PG8_WAIT_V(6); PG8_BAR;
    }
    for (;;) {
        const bool has_next = S.next(ui + 1, nxt);
        const char* nA = has_next ? (const char*)g.A + (size_t)nxt.pm * tstepA : cA; const char* nB = has_next ? (const char*)g.Bt + (size_t)nxt.pn * tstep : cB;
        for (int t = 0; t < nt; t += 2) {
            const bool last = (t == nt - 2);
            const char* a1 = cA + (size_t)(t + 1) * kstep;
            const char* a2 = last ? nA : cA + (size_t)(t + 2) * kstep; const char* b2 = last ? nB : cB + (size_t)(t + 2) * kstep;
            const char* a3 = a2 + kstep; const char* b3 = b2 + kstep;
            if (last && has_next) S.a_ready(nxt);
            if constexpr (SP2) {
            PG8_LDB(B0, 0, 0); PG8_LDB(B1, 0, 1); PG8_SCHED; PG8_LDA(At, 0, 0); PG8_STAGE(PG8_SA(1, 1), a1 + hstepA, voffA);
            PG8_WAIT_V(8); PG8_WAIT_L(0); PG8_BAR; PG8_MMA(0, 0, At, B0); PG8_MMA(0, 1, At, B1); PG8_BAR; PG8_SCHED;
            PG8_LDA(At, 0, 1); PG8_STAGE(PG8_SB(0, 0), b2, voffB); PG8_STAGE(PG8_SB(0, 1), b2 + hstep, voffB); PG8_STAGE(PG8_SA(0, 0), a2, voffA);
            PG8_WAIT_V(8); PG8_WAIT_L(0); PG8_BAR; PG8_MMA(1, 0, At, B0); PG8_MMA(1, 1, At, B1); PG8_BAR; PG8_SCHED;
            PG8_LDB(B0, 1, 0); PG8_LDB(B1, 1, 1); PG8_SCHED; PG8_LDA(At, 1, 0); PG8_STAGE(PG8_SA(0, 1), a2 + hstepA, voffA);
            PG8_WAIT_V(8); PG8_WAIT_L(0); PG8_BAR; PG8_MMA(0, 0, At, B0); PG8_MMA(0, 1, At, B1); PG8_BAR; PG8_SCHED;
            PG8_LDA(At, 1, 1); PG8_STAGE(PG8_SB(1, 0), b3, voffB); PG8_STAGE(PG8_SB(1, 1), b3 + hstep, voffB); PG8_STAGE(PG8_SA(1, 0), a3, voffA);
            PG8_WAIT_V(8); PG8_WAIT_L(0); PG8_BAR; PG8_MMA(1, 0, At, B0); PG8_MMA(1, 1, At, B1); PG8_BAR; PG8_SCHED;
            } else {
            PG8_LDB(B0, 0, 0); PG8_SCHED; PG8_LDA(At, 0, 0); PG8_STAGE(PG8_SA(1, 1), a1 + hstepA, voffA);
            PG8_WAIT_L(8); PG8_BAR; PG8_WAIT_L(0); PG8_MMA(0, 0, At, B0); PG8_BAR; PG8_SCHED;
            PG8_LDB(B1, 0, 1); PG8_STAGE(PG8_SB(0, 0), b2, voffB);
            PG8_BAR; PG8_WAIT_L(0); PG8_MMA(0, 1, At, B1); PG8_BAR;
            PG8_LDA(At, 0, 1); PG8_STAGE(PG8_SA(0, 0), a2, voffA);
            PG8_BAR; PG8_WAIT_L(0); PG8_MMA(1, 0, At, B0); PG8_BAR; PG8_SCHED;
            PG8_STAGE(PG8_SB(0, 1), b2 + hstep, voffB);
            PG8_WAIT_V(6); PG8_BAR; PG8_MMA(1, 1, At, B1); PG8_BAR;
            PG8_LDB(B0, 1, 0); PG8_SCHED; PG8_LDA(At, 1, 0); PG8_STAGE(PG8_SA(0, 1), a2 + hstepA, voffA);
            PG8_WAIT_L(8); PG8_BAR; PG8_WAIT_L(0); PG8_MMA(0, 0, At, B0); PG8_BAR; PG8_SCHED;
            PG8_LDB(B1, 1, 1); PG8_STAGE(PG8_SB(1, 0), b3, voffB);
            PG8_BAR; PG8_WAIT_L(0); PG8_MMA(0, 1, At, B1); PG8_BAR;
            PG8_LDA(At, 1, 1); PG8_STAGE(PG8_SA(1, 0), a3, voffA);
            PG8_BAR; PG8_WAIT_L(0); PG8_MMA(1, 0, At, B0); PG8_BAR; PG8_SCHED;
            PG8_STAGE(PG8_SB(1, 1), b3 + hstep, voffB);
            PG8_WAIT_V(6); PG8_BAR; PG8_MMA(1, 1, At, B1); PG8_BAR;
            }
        }
        if constexpr (ALIGN_EPI) { if (wr == 0) PG8_BAR; }
        if constexpr (!Epi::AFTER_DRAIN) { E(acc, cur, wr, wc, fr, fq); S.done(cur); }
        if (!has_next) break;
#pragma unroll
        for (int a = 0; a < 2; ++a)
#pragma unroll
            for (int b = 0; b < 2; ++b)
#pragma unroll
                for (int m = 0; m < 4; ++m)
#pragma unroll
                    for (int n = 0; n < 2; ++n) acc[a][b][m][n] = (f32x4){0.f, 0.f, 0.f, 0.f};
        cur = nxt; cA = nA; cB = nB; ++ui;
        if constexpr (ALIGN_EPI) { if (wr == 1) PG8_BAR; }
    }
    PG8_WAIT_V(0);
    if constexpr (!ALIGN_EPI) { if (wr == 0) PG8_BAR; }
    PG8_BAR;
    if constexpr (Epi::AFTER_DRAIN) { E.fused(acc, cur, wr, wc, fr, fq, lds, wid, lane); S.done(cur); }
#undef PG8_SA
#undef PG8_SB
#undef PG8_STAGE
#undef PG8_LDA
#undef PG8_LDB
#undef PG8_MMA
#undef PG8_WAIT_V
#undef PG8_WAIT_L
#undef PG8_BAR
#undef PG8_SCHED
}
}

constexpr int NWAVES = 8, NTHR = 512;
constexpr int NBATCH = 2, SEQ = 8192, MTOK = NBATCH * SEQ, DM = 1024, DFF = 2816, DIN_SRC = 8432, NIN = 8448, NPA = 5376, NMG = 3072, DEPTH = 2;
constexpr float NORM_EPS = 1e-6f;
constexpr int PA_GQ = 0, PA_GK = 512, PA_GV = 1024, PA_GZ = 1536, PA_NQ = 2048, PA_KC = 2816, PA_KS = 3136, PA_KW = 3456, PA_LQ = 3776, PA_LK = 4032, PA_LV = 4288, PA_LR = 4800, PA_SM = 5312;
constexpr size_t MiB = 1u << 20;
constexpr size_t WS_CTL = 0, CTL_ZERO_BYTES = 1 * MiB;
constexpr size_t WS_WGU = 1 * MiB, WS_WD = 12 * MiB, WS_WIN = WS_WD + 5632 * 1024, WS_WB = WS_WIN + (size_t)NIN * DM * 2, WS_WO = WS_WB + 3 * MiB;
constexpr size_t WS_XN = 40 * MiB, WS_A = 72 * MiB, WS_G = 160 * MiB, WS_O = 208 * MiB, WS_QKV = 232 * MiB, WS_SM = 290 * MiB, WS_GATES = 258 * MiB, WS_ORAW = 259 * MiB, WS_VTS = 270 * MiB, WS_VTW = 272 * MiB, WS_KCMP = 275 * MiB, WS_KCL = WS_KCMP + 256 * 1024, WS_VCT = WS_KCMP + 512 * 1024, WS_END = 276 * MiB;
constexpr size_t WS_H = WS_A, WS_Y = WS_G;
constexpr size_t WS_RMW = WS_A, WS_MG = WS_A + 32 * MiB, WS_YB = WS_A + 48 * MiB;
static_assert(WS_WO + 2 * MiB <= WS_XN && WS_Y + 64 * MiB <= WS_QKV && WS_YB + 32 * MiB <= WS_G, "ws map");
constexpr int CW_BAR = 4096;
constexpr int RING_BYTES = 131072, LDSCTL_OFF = RING_BYTES, MISC_OFF = LDSCTL_OFF + 320, BTAB_OFF = RING_BYTES + 1024, RELB_OFF = RING_BYTES + 1536, LDS_BYTES = 147456;

#define GAS __attribute__((address_space(1)))
#define LAS __attribute__((address_space(3)))
typedef unsigned short bf16;
typedef unsigned v4u __attribute__((ext_vector_type(4)));
typedef unsigned v2u __attribute__((ext_vector_type(2)));
typedef float f32x4 __attribute__((ext_vector_type(4)));
#define LDS_WAIT() asm volatile("s_waitcnt lgkmcnt(0)" ::: "memory")
__device__ __forceinline__ unsigned f2bf(float f) { unsigned u = __builtin_bit_cast(unsigned, f); return (u + 0x7fffu + ((u >> 16) & 1u)) >> 16; }
__device__ __forceinline__ unsigned pk2(float lo, float hi) { return f2bf(lo) | (f2bf(hi) << 16); }
__device__ __forceinline__ float bf2f(bf16 h) { return __uint_as_float((unsigned)h << 16); }
__device__ __forceinline__ float bflo(unsigned w) { return __uint_as_float(w << 16); }
__device__ __forceinline__ float bfhi(unsigned w) { return __uint_as_float(w & 0xffff0000u); }
__device__ __forceinline__ float wave_sum(float v) {
#pragma unroll
    for (int o = 1; o < 64; o <<= 1) v += __shfl_xor(v, o);
    return v;
}
__device__ __forceinline__ float wave_max(float v) {
#pragma unroll
    for (int o = 1; o < 64; o <<= 1) v = fmaxf(v, __shfl_xor(v, o));
    return v;
}
__device__ __forceinline__ float sigmoidf_(float x) { return 1.f / (1.f + expf(-x)); }
__device__ __forceinline__ float siluf_(float x) { return x / (1.f + expf(-x)); }
__device__ __forceinline__ float softplusf_(float x) { return x > 20.f ? x : log1pf(expf(x)); }
__device__ __forceinline__ float logsigmoidf_(float x) { return fminf(x, 0.f) - log1pf(expf(-fabsf(x))); }
__device__ __forceinline__ float gelu_tanhf_(float x) { return 0.5f * x * (1.f + tanhf(0.7978845608028654f * (x + 0.044715f * x * x * x))); }

#define XB_TMO      128
#define XB_XCNT(j)  (256  + 64 * (j))
#define XB_XSUB(j)  (1280 + 64 * (j))
#define XB_XGEN(j)  (2304 + 64 * (j))
#define XB_TOP      3328
#define XB_TOPGEN   3392
#define XCD_BAR_WORDS 3456
#define XB_SPIN_CAP (1u << 22)
__device__ __forceinline__ unsigned xb_ld(unsigned* p)              { return __hip_atomic_load(p, __ATOMIC_RELAXED, __HIP_MEMORY_SCOPE_AGENT); }
__device__ __forceinline__ unsigned xb_add(unsigned* p, unsigned v) { return __hip_atomic_fetch_add(p, v, __ATOMIC_RELAXED, __HIP_MEMORY_SCOPE_AGENT); }
__device__ __forceinline__ unsigned xb_xcc_id() { return (unsigned)__builtin_amdgcn_s_getreg((3 << 11) | 20) & 0xFu; }
#define XB_SPIN(cond, bar) do { unsigned _sp = 0; while (cond) { __builtin_amdgcn_s_sleep(1); \
    if ((++_sp & 255u) == 0u) { if (xb_ld(&(bar)[XB_TMO])) break; if (_sp > XB_SPIN_CAP) { atomicAdd(&(bar)[XB_TMO], 1u); break; } } } } while (0)
struct XcdBarrier { unsigned* bar; unsigned x; volatile LAS unsigned* st; };
__device__ __forceinline__ XcdBarrier xcd_barrier_post(unsigned* bar, volatile LAS unsigned* st) {
    XcdBarrier b; b.bar = bar; b.x = xb_xcc_id(); b.st = st;
    if (threadIdx.x == 0) (void)xb_add(&bar[XB_XCNT(b.x)], 1u);
    return b;
}
__device__ __forceinline__ void xcd_barrier_complete(unsigned* bar, unsigned x, unsigned& nloc, unsigned& nx) {
    const unsigned G = gridDim.x * gridDim.y * gridDim.z;
    unsigned sum, cnt, mine, sp = 0u;
    for (;;) {
        sum = 0u; cnt = 0u; mine = 0u;
#pragma unroll
        for (unsigned j = 0; j < 16; ++j) { const unsigned c = xb_ld(&bar[XB_XCNT(j)]); sum += c; cnt += (c > 0u) ? 1u : 0u; mine = (j == x) ? c : mine; }
        if (sum == G) break;
        __builtin_amdgcn_s_sleep(1);
        if ((++sp & 255u) == 0u) { if (xb_ld(&bar[XB_TMO])) break; if (sp > XB_SPIN_CAP) { atomicAdd(&bar[XB_TMO], 1u); break; } }
    }
    nloc = mine > 0u ? mine : 1u; nx = cnt > 0u ? cnt : 1u;
}
__device__ __forceinline__ void xcd_barrier(const XcdBarrier& b) {
    asm volatile("s_waitcnt vmcnt(0)" ::: "memory");
    __syncthreads();
    if (threadIdx.x == 0) {
        unsigned* bar = b.bar;
        __builtin_amdgcn_s_waitcnt(0);
        unsigned nloc = b.st[0], nx = b.st[1];
        if (nloc == 0u) { xcd_barrier_complete(bar, b.x, nloc, nx); b.st[0] = nloc; b.st[1] = nx; }
        const unsigned old = xb_add(&bar[XB_XSUB(b.x)], 1u);
        const unsigned gen = old / nloc;
        if (old + 1u == (gen + 1u) * nloc) {
            __builtin_amdgcn_fence(__ATOMIC_RELEASE, "agent");
            asm volatile("s_waitcnt vmcnt(0)" ::: "memory");
            const unsigned og = xb_add(&bar[XB_TOP], 1u);
            const unsigned tg = og / nx;
            if (og + 1u == (tg + 1u) * nx) xb_add(&bar[XB_TOPGEN], 1u);
            else XB_SPIN(xb_ld(&bar[XB_TOPGEN]) == tg, bar);
            __builtin_amdgcn_fence(__ATOMIC_ACQUIRE, "agent");
            xb_add(&bar[XB_XGEN(b.x)], 1u);
            asm volatile("s_waitcnt vmcnt(0)" ::: "memory");
        } else {
            XB_SPIN(xb_ld(&bar[XB_XGEN(b.x)]) == gen, bar);
            __builtin_amdgcn_fence(__ATOMIC_ACQUIRE, "agent");
            asm volatile("s_waitcnt vmcnt(0)" ::: "memory");
        }
    }
    __syncthreads();
}

constexpr int MAXPH = 128;
struct Args { const float* in[30]; float* out; unsigned char* ws; int ph_lo, ph_hi; unsigned char prog[MAXPH]; };
enum { I_X = 0, I_RELB, I_F1PRE, I_F1GU, I_F1D, I_F1POST, I_MPRE, I_WIN, I_CONVW, I_ALOG, I_DTB, I_GDNNW, I_PEK, I_W1K, I_W2K, I_PEV, I_W1V, I_W2V, I_GGW, I_GGB, I_GLANW, I_WBG, I_WBN, I_WBL, I_WOUT, I_MPOST, I_F2PRE, I_F2GU, I_F2D, I_F2POST };

template <class RowMap>
__device__ __forceinline__ void transpose_item(const float* W, int K, int N, bf16* WT, LAS float* scr, int item, int lane, const RowMap& rm) {
    const int nblk = (N + 31) / 32, kb = item / nblk, nb = item % nblk, k0 = 64 * kb, n0 = 32 * nb;
    const bool okc = (n0 + (lane & 31)) < N;
#pragma unroll 8
    for (int i = 0; i < 32; ++i) { const int kk = 2 * i + (lane >> 5); scr[kk * 33 + (lane & 31)] = okc ? W[(size_t)(k0 + kk) * N + n0 + (lane & 31)] : 0.f; }
    LDS_WAIT(); asm volatile("" ::: "memory");
    const int c = lane & 7;
#pragma unroll
    for (int j = 0; j < 4; ++j) { const int n = (lane >> 3) + 8 * j; const LAS float* s = scr + (8 * c) * 33 + n;
        v4u o; o.x = pk2(s[0 * 33], s[1 * 33]); o.y = pk2(s[2 * 33], s[3 * 33]); o.z = pk2(s[4 * 33], s[5 * 33]); o.w = pk2(s[6 * 33], s[7 * 33]);
        if (n0 + n < N) *(v4u*)(WT + (size_t)rm(n0 + n) * K + k0 + 8 * c) = o; }
    LDS_WAIT(); asm volatile("" ::: "memory");
}
struct MapId { __device__ __forceinline__ int operator()(int n) const { return n; } };
struct MapGU { __device__ __forceinline__ int operator()(int n) const { const int u = n >= DFF, j = u ? n - DFF : n; return 256 * (j >> 7) + 128 * u + (j & 127); } };
struct MapWin { __device__ __forceinline__ int operator()(int c) const {
    if (c < 2048) return c;
    if (c < 2056) return PA_SM + (c - 2048);
    if (c < 2824) return PA_NQ + (c - 2056);
    if (c < 3784) return PA_KC + (c - 2824);
    if (c < 3808) return PA_SM + 8 + (c - 3784);
    if (c < 5344) return PA_LQ + (c - 3808);
    if (c < 5360) return PA_SM + 32 + (c - 5344);
    return NPA + (c - 5360); } };

__device__ __forceinline__ void row_pass(const float* xin, const float* y, const float* wpost, float scale, float* xout, const float* wnext, bf16* xn, int lane) {
    f32x4 v[4];
#pragma unroll
    for (int j = 0; j < 4; ++j) v[j] = ((const f32x4*)xin)[lane + 64 * j];
    if (y) {
        f32x4 yv[4]; float s = 0.f;
#pragma unroll
        for (int j = 0; j < 4; ++j) { yv[j] = ((const f32x4*)y)[lane + 64 * j]; s += (yv[j].x * yv[j].x + yv[j].y * yv[j].y) + (yv[j].z * yv[j].z + yv[j].w * yv[j].w); }
        const float r = scale / sqrtf(wave_sum(s) * (1.f / DM) + NORM_EPS);
#pragma unroll
        for (int j = 0; j < 4; ++j) { const f32x4 w = ((const f32x4*)wpost)[lane + 64 * j]; v[j] = v[j] + yv[j] * w * r; }
    }
    if (xout) {
#pragma unroll
        for (int j = 0; j < 4; ++j) ((f32x4*)xout)[lane + 64 * j] = v[j];
    }
    if (xn) {
        float s = 0.f;
#pragma unroll
        for (int j = 0; j < 4; ++j) s += (v[j].x * v[j].x + v[j].y * v[j].y) + (v[j].z * v[j].z + v[j].w * v[j].w);
        const float r = 1.f / sqrtf(wave_sum(s) * (1.f / DM) + NORM_EPS);
#pragma unroll
        for (int j = 0; j < 4; ++j) { const f32x4 w = ((const f32x4*)wnext)[lane + 64 * j]; const f32x4 o = v[j] * w * r;
            v2u pk; pk.x = pk2(o.x, o.y); pk.y = pk2(o.z, o.w); ((v2u*)xn)[lane + 64 * j] = pk; }
    }
}

__device__ __forceinline__ void gdn_out_item(const float* ORAW, const bf16* PA, const float* nw, bf16* OA, int t, int h, int lane) {
    const float o0 = ORAW[(size_t)t * 512 + h * 128 + 2 * lane], o1 = ORAW[(size_t)t * 512 + h * 128 + 2 * lane + 1];
    const float rr = 1.f / sqrtf(wave_sum(o0 * o0 + o1 * o1) * (1.f / 128.f) + NORM_EPS);
    const unsigned z = *(const unsigned*)(PA + (size_t)t * NPA + PA_GZ + h * 128 + 2 * lane);
    *(unsigned*)(OA + (size_t)t * 512 + h * 128 + 2 * lane) = pk2(o0 * rr * nw[2 * lane] * siluf_(bflo(z)), o1 * rr * nw[2 * lane + 1] * siluf_(bfhi(z)));
}

typedef short bf16x8 __attribute__((ext_vector_type(8)));
#define MFMA16(a, b, c) __builtin_amdgcn_mfma_f32_16x16x32_bf16((a), (b), (c), 0, 0, 0)
__device__ __forceinline__ int kperm32(int p) { const int q = p >> 3, j = p & 7; return j < 4 ? 4 * q + j : 16 + 4 * q + (j - 4); }
__device__ __forceinline__ bf16x8 pack_ctiles(const f32x4& t0, const f32x4& t1) {
    v4u w; w.x = pk2(t0[0], t0[1]); w.y = pk2(t0[2], t0[3]); w.z = pk2(t1[0], t1[1]); w.w = pk2(t1[2], t1[3]); return __builtin_bit_cast(bf16x8, w);
}
constexpr int GLA_CH = 64, NCHUNK = SEQ / 64;
constexpr size_t GLA_QD = 0, GLA_KT = GLA_QD + (size_t)NCHUNK * 4 * 8192, GLA_AI = GLA_KT + (size_t)NCHUNK * 4 * 8192, GLA_CD = GLA_AI + (size_t)NCHUNK * 4 * 8192, GLA_BYTES = GLA_CD + (size_t)NCHUNK * 4 * 256, GLA_VBYTES = (size_t)NCHUNK * 4 * 16384;
__device__ __forceinline__ void gla_prep_item(const bf16* PA, const float* SM, const float* ggw, const float* ggb, unsigned char* img, unsigned char* imgv, int n, int h, float* sl, int tid) {
    float* Qs = sl; float* Ks = sl + 64 * 65; float* BC = sl + 2 * 64 * 65; bf16* Vs = (bf16*)(sl + 3 * 64 * 65);
    const int t0 = n * 64, ch = n * 4 + h, lane = tid & 63, wave = tid >> 6;
    __syncthreads();
    {
        const int c = tid >> 3, dg = tid & 7;
        const bf16* row = PA + (size_t)(t0 + c) * NPA;
        const v4u q8 = *(const v4u*)(row + PA_LQ + h * 64 + dg * 8), k8 = *(const v4u*)(row + PA_LK + h * 64 + dg * 8);
        const float qv[8] = {bflo(q8.x), bfhi(q8.x), bflo(q8.y), bfhi(q8.y), bflo(q8.z), bfhi(q8.z), bflo(q8.w), bfhi(q8.w)};
        const float kv[8] = {bflo(k8.x), bfhi(k8.x), bflo(k8.y), bfhi(k8.y), bflo(k8.z), bfhi(k8.z), bflo(k8.w), bfhi(k8.w)};
        const float* al = SM + (size_t)(t0 + c) * 64 + 32;
        float x[8];
#pragma unroll
        for (int j = 0; j < 8; ++j) x[j] = ggb[h * 64 + dg * 8 + j];
#pragma unroll
        for (int r = 0; r < 16; ++r) { const float a = al[r];
#pragma unroll
            for (int j = 0; j < 8; ++j) x[j] += a * ggw[r * 256 + h * 64 + dg * 8 + j]; }
#pragma unroll
        for (int j = 0; j < 8; ++j) { const int d = dg * 8 + j; Qs[c * 65 + d] = qv[j] * 0.125f; Ks[c * 65 + d] = kv[j]; BC[c * 65 + d] = logsigmoidf_(x[j]) * (1.f / 16.f); }
        const v4u va = *(const v4u*)(row + PA_LV + h * 128 + dg * 16), vb = *(const v4u*)(row + PA_LV + h * 128 + dg * 16 + 8);
        *(v4u*)(Vs + c * 136 + dg * 16) = va; *(v4u*)(Vs + c * 136 + dg * 16 + 8) = vb;
    }
    __syncthreads();
    if (tid < 64) { float run = 0.f; for (int c = 0; c < 64; ++c) { run += BC[c * 65 + tid]; BC[c * 65 + tid] = run; } }
    __syncthreads();
    {
        bf16* QD = (bf16*)(img + GLA_QD) + (size_t)ch * 4096; bf16* KT = (bf16*)(img + GLA_KT) + (size_t)ch * 4096; float* CD = (float*)(img + GLA_CD) + (size_t)ch * 64;
        const int r = tid >> 3, pg = tid & 7;
        float o[8];
#pragma unroll
        for (int j = 0; j < 8; ++j) { const int p = pg * 8 + j, d = (p & 32) + kperm32(p & 31); o[j] = Qs[r * 65 + d] * expf(BC[r * 65 + d]); }
        v4u w; w.x = pk2(o[0], o[1]); w.y = pk2(o[2], o[3]); w.z = pk2(o[4], o[5]); w.w = pk2(o[6], o[7]);
        *(v4u*)(QD + r * 64 + pg * 8) = w;
#pragma unroll
        for (int j = 0; j < 8; ++j) { const int c = pg * 8 + j; o[j] = Ks[c * 65 + r] * expf(BC[63 * 65 + r] - BC[c * 65 + r]); }
        w.x = pk2(o[0], o[1]); w.y = pk2(o[2], o[3]); w.z = pk2(o[4], o[5]); w.w = pk2(o[6], o[7]);
        *(v4u*)(KT + r * 64 + pg * 8) = w;
        if (tid < 64) CD[tid] = expf(BC[63 * 65 + tid]);
        bf16* VI = (bf16*)(imgv) + (size_t)ch * 8192;
#pragma unroll
        for (int i = 0; i < 2; ++i) { const int f = tid + 512 * i, ws = f >> 7, kk = (f >> 6) & 1, l = f & 63, q = l >> 4, col = l & 15;
            unsigned short e[8];
#pragma unroll
            for (int j = 0; j < 8; ++j) e[j] = Vs[(32 * kk + 8 * q + j) * 136 + 16 * ws + col];
            v4u vw; vw.x = e[0] | ((unsigned)e[1] << 16); vw.y = e[2] | ((unsigned)e[3] << 16); vw.z = e[4] | ((unsigned)e[5] << 16); vw.w = e[6] | ((unsigned)e[7] << 16);
            *(v4u*)(VI + (size_t)f * 8) = vw; }
    }
    {
        bf16* AI = (bf16*)(img + GLA_AI) + (size_t)ch * 4096;
        const int q = lane >> 4, fr = lane & 15;
#pragma unroll 1
        for (int i = 0; i < 2; ++i) { const int tl = wave + 8 * i, ib = tl >> 2, jb = tl & 3;
            f32x4 acc = {0.f, 0.f, 0.f, 0.f};
            if (jb <= ib) {
#pragma unroll
                for (int kk = 0; kk < 2; ++kk) { float a[8], b[8];
#pragma unroll
                    for (int j = 0; j < 8; ++j) { const int d = 32 * kk + 8 * q + j; const float ref = ib > 0 ? BC[(16 * ib - 1) * 65 + d] : 0.f;
                        a[j] = Qs[(16 * ib + fr) * 65 + d] * expf(BC[(16 * ib + fr) * 65 + d] - ref);
                        b[j] = Ks[(16 * jb + fr) * 65 + d] * expf(ref - BC[(16 * jb + fr) * 65 + d]); }
                    v4u aw, bw; aw.x = pk2(a[0], a[1]); aw.y = pk2(a[2], a[3]); aw.z = pk2(a[4], a[5]); aw.w = pk2(a[6], a[7]);
                    bw.x = pk2(b[0], b[1]); bw.y = pk2(b[2], b[3]); bw.z = pk2(b[4], b[5]); bw.w = pk2(b[6], b[7]);
                    acc = MFMA16(__builtin_bit_cast(bf16x8, aw), __builtin_bit_cast(bf16x8, bw), acc); }
            }
#pragma unroll
            for (int r = 0; r < 4; ++r) { const int row = 4 * q + r; float v = acc[r]; if (jb == ib && fr > row) v = 0.f; AI[(16 * ib + row) * 64 + 16 * jb + fr] = (bf16)f2bf(v); }
        }
    }
}
constexpr int GLA_BUF = 3 * 64 * 144 + 256;
__device__ __forceinline__ void gla_scan_block(const unsigned char* img, const unsigned char* imgv, bf16* OC, int h, unsigned char* lds, int tid) {
    const int lane = tid & 63, ws = __builtin_amdgcn_readfirstlane(tid >> 6), q = lane >> 4, fr = lane & 15;
    f32x4 S[4];
#pragma unroll
    for (int i = 0; i < 4; ++i) S[i] = (f32x4){0.f, 0.f, 0.f, 0.f};
    v4u st[3]; v4u stc = {0u, 0u, 0u, 0u}; v4u vB[2];
#define GLA_FETCH(N) do { const int ch_ = (N) * 4 + h; \
        st[0] = *(const v4u*)(img + GLA_QD + (size_t)ch_ * 8192 + tid * 16); st[1] = *(const v4u*)(img + GLA_AI + (size_t)ch_ * 8192 + tid * 16); st[2] = *(const v4u*)(img + GLA_KT + (size_t)ch_ * 8192 + tid * 16); \
        if (tid < 16) stc = *(const v4u*)(img + GLA_CD + (size_t)ch_ * 256 + tid * 16); \
        vB[0] = *(const v4u*)(imgv + (size_t)ch_ * 16384 + (ws * 2 + 0) * 1024 + lane * 16); vB[1] = *(const v4u*)(imgv + (size_t)ch_ * 16384 + (ws * 2 + 1) * 1024 + lane * 16); } while (0)
#define GLA_PUT(B) do { unsigned char* b_ = lds + (B) * GLA_BUF; const int r_ = tid >> 3, c_ = tid & 7; \
        *(v4u*)(b_ + r_ * 144 + c_ * 16) = st[0]; *(v4u*)(b_ + 64 * 144 + r_ * 144 + c_ * 16) = st[1]; *(v4u*)(b_ + 2 * 64 * 144 + r_ * 144 + c_ * 16) = st[2]; \
        if (tid < 16) *(v4u*)(b_ + 3 * 64 * 144 + tid * 16) = stc; } while (0)
    __syncthreads();
    GLA_FETCH(0); GLA_PUT(0);
    __syncthreads();
    for (int n = 0; n < NCHUNK; ++n) {
        const unsigned char* b = lds + (n & 1) * GLA_BUF;
        const v4u vb0 = vB[0], vb1 = vB[1];
        if (n + 1 < NCHUNK) GLA_FETCH(n + 1);
        const bf16x8 v0 = __builtin_bit_cast(bf16x8, vb0), v1 = __builtin_bit_cast(bf16x8, vb1);
        const bf16x8 s0 = pack_ctiles(S[0], S[1]), s1 = pack_ctiles(S[2], S[3]);
        f32x4 o[4];
#pragma unroll
        for (int m = 0; m < 4; ++m) {
            const unsigned char* ar = b + (16 * m + fr) * 144 + q * 16;
            const bf16x8 qa0 = *(const bf16x8*)(ar), qa1 = *(const bf16x8*)(ar + 64);
            const bf16x8 aa0 = *(const bf16x8*)(ar + 64 * 144);
            f32x4 acc = {0.f, 0.f, 0.f, 0.f};
            acc = MFMA16(qa0, s0, acc); acc = MFMA16(qa1, s1, acc); acc = MFMA16(aa0, v0, acc);
            if (m >= 2) { const bf16x8 aa1 = *(const bf16x8*)(ar + 64 * 144 + 64); acc = MFMA16(aa1, v1, acc); }
            o[m] = acc;
        }
#pragma unroll
        for (int dt = 0; dt < 4; ++dt) {
            const unsigned char* kr = b + 2 * 64 * 144 + (16 * dt + fr) * 144 + q * 16;
            const bf16x8 k0 = *(const bf16x8*)(kr), k1 = *(const bf16x8*)(kr + 64);
            const f32x4 cd = *(const f32x4*)(b + 3 * 64 * 144 + (16 * dt + 4 * q) * 4);
            f32x4 acc = S[dt] * cd;
            acc = MFMA16(k0, v0, acc); acc = MFMA16(k1, v1, acc);
            S[dt] = acc;
        }
#pragma unroll
        for (int m = 0; m < 4; ++m)
#pragma unroll
            for (int r = 0; r < 4; ++r) OC[(size_t)(64 * n + 16 * m + 4 * q + r) * 512 + h * 128 + 16 * ws + fr] = (bf16)f2bf(o[m][r]);
        if (n + 1 < NCHUNK) GLA_PUT((n + 1) & 1);
        __syncthreads();
    }
#undef GLA_FETCH
#undef GLA_PUT
}
__device__ __forceinline__ void out_norm_item(bf16* O, const bf16* PA, int gcol, const float* nw, int t, int h, int lane) {
    const unsigned ow = *(const unsigned*)(O + (size_t)t * 512 + h * 128 + 2 * lane);
    const float o0 = bflo(ow), o1 = bfhi(ow);
    const float rr = 1.f / sqrtf(wave_sum(o0 * o0 + o1 * o1) * (1.f / 128.f) + NORM_EPS);
    const unsigned z = *(const unsigned*)(PA + (size_t)t * NPA + gcol + h * 128 + 2 * lane);
    *(unsigned*)(O + (size_t)t * 512 + h * 128 + 2 * lane) = pk2(o0 * rr * nw[2 * lane] * siluf_(bflo(z)), o1 * rr * nw[2 * lane + 1] * siluf_(bfhi(z)));
}

constexpr size_t GDN_WI = 0, GDN_QI = GDN_WI + (size_t)NCHUNK * 4 * 16384, GDN_AT = GDN_QI + (size_t)NCHUNK * 4 * 16384, GDN_KT = GDN_AT + (size_t)NCHUNK * 4 * 8192,
                 GDN_UI = GDN_KT + (size_t)NCHUNK * 4 * 16384, GDN_DV = GDN_UI + (size_t)NCHUNK * 4 * 16384, GDN_BYTES = GDN_DV + (size_t)NCHUNK * 4 * 768;
__device__ __forceinline__ int pperm32(int k) { const int half = (k >> 4) & 1, fr = k & 15; return 8 * (fr >> 2) + 4 * half + (fr & 3); }
__device__ __forceinline__ void gdn_prep_chunk(const bf16* PA, const float* SM, const float* convw, const float* alog, const float* dtb, unsigned char* img, int n, int h, unsigned char* lds, int tid) {
    bf16* Qn = (bf16*)lds; bf16* Kn = (bf16*)(lds + 17408); bf16* Rt = (bf16*)(lds + 34816); bf16* Ts = (bf16*)(lds + 71680); float* Ls = (float*)(lds + 80896); float* gv = (float*)(lds + 98304);
    const int t0 = n * 64, ch = n * 4 + h, lane = tid & 63, wave = tid >> 6, q = lane >> 4, fr = lane & 15;
    __syncthreads();
    {
        const int c = tid >> 3, g8 = tid & 7, t = t0 + c;
        float val[3][16];
#pragma unroll
        for (int w = 0; w < 3; ++w) {
            const int c0 = w * 512 + h * 128 + g8 * 16;
#pragma unroll
            for (int i = 0; i < 16; ++i) val[w][i] = 0.f;
#pragma unroll
            for (int j = 0; j < 4; ++j) { const int tt = t - 3 + j;
                if (tt >= 0) {
                    const v4u xa = *(const v4u*)(PA + (size_t)tt * NPA + c0), xb = *(const v4u*)(PA + (size_t)tt * NPA + c0 + 8);
                    const float x[16] = {bflo(xa.x), bfhi(xa.x), bflo(xa.y), bfhi(xa.y), bflo(xa.z), bfhi(xa.z), bflo(xa.w), bfhi(xa.w), bflo(xb.x), bfhi(xb.x), bflo(xb.y), bfhi(xb.y), bflo(xb.z), bfhi(xb.z), bflo(xb.w), bfhi(xb.w)};
                    const f32x4* wp = (const f32x4*)(convw + j * 1536 + c0);
#pragma unroll
                    for (int i4 = 0; i4 < 4; ++i4) { const f32x4 wv = wp[i4]; val[w][4 * i4] += wv.x * x[4 * i4]; val[w][4 * i4 + 1] += wv.y * x[4 * i4 + 1]; val[w][4 * i4 + 2] += wv.z * x[4 * i4 + 2]; val[w][4 * i4 + 3] += wv.w * x[4 * i4 + 3]; }
                } }
#pragma unroll
            for (int i = 0; i < 16; ++i) val[w][i] = siluf_(val[w][i]);
        }
        float sq = 0.f, sk = 0.f;
#pragma unroll
        for (int i = 0; i < 16; ++i) { sq += val[0][i] * val[0][i]; sk += val[1][i] * val[1][i]; }
        sq += __shfl_xor(sq, 1); sq += __shfl_xor(sq, 2); sq += __shfl_xor(sq, 4);
        sk += __shfl_xor(sk, 1); sk += __shfl_xor(sk, 2); sk += __shfl_xor(sk, 4);
        const float rq = 0.08838834764831845f / sqrtf(sq + 1e-6f), rk = 1.f / sqrtf(sk + 1e-6f);
        const float beta = sigmoidf_(SM[(size_t)t * 64 + h]);
        v4u w0, w1;
        w0.x = pk2(val[0][0] * rq, val[0][1] * rq); w0.y = pk2(val[0][2] * rq, val[0][3] * rq); w0.z = pk2(val[0][4] * rq, val[0][5] * rq); w0.w = pk2(val[0][6] * rq, val[0][7] * rq);
        w1.x = pk2(val[0][8] * rq, val[0][9] * rq); w1.y = pk2(val[0][10] * rq, val[0][11] * rq); w1.z = pk2(val[0][12] * rq, val[0][13] * rq); w1.w = pk2(val[0][14] * rq, val[0][15] * rq);
        *(v4u*)(Qn + c * 136 + g8 * 16) = w0; *(v4u*)(Qn + c * 136 + g8 * 16 + 8) = w1;
        w0.x = pk2(val[1][0] * rk, val[1][1] * rk); w0.y = pk2(val[1][2] * rk, val[1][3] * rk); w0.z = pk2(val[1][4] * rk, val[1][5] * rk); w0.w = pk2(val[1][6] * rk, val[1][7] * rk);
        w1.x = pk2(val[1][8] * rk, val[1][9] * rk); w1.y = pk2(val[1][10] * rk, val[1][11] * rk); w1.z = pk2(val[1][12] * rk, val[1][13] * rk); w1.w = pk2(val[1][14] * rk, val[1][15] * rk);
        *(v4u*)(Kn + c * 136 + g8 * 16) = w0; *(v4u*)(Kn + c * 136 + g8 * 16 + 8) = w1;
#pragma unroll
        for (int i = 0; i < 16; ++i) Rt[(g8 * 16 + i) * 72 + c] = (bf16)f2bf(beta * val[2][i]);
        if (g8 == 0) { gv[c] = -expf(alog[h]) * softplusf_(SM[(size_t)t * 64 + 4 + h] + dtb[h]); gv[64 + c] = beta; }
    }
    __syncthreads();
    if (wave == 0) {
        float x = gv[lane];
#pragma unroll
        for (int off = 1; off < 64; off <<= 1) { const float y = __shfl_up(x, off); if (lane >= off) x += y; }
        gv[128 + lane] = x; gv[192 + lane] = expf(x);
    }
    __syncthreads();
    {
        const int c = tid >> 3, g8 = tid & 7; const float s = gv[64 + c] * gv[192 + c];
#pragma unroll
        for (int i = 0; i < 16; ++i) Rt[(128 + g8 * 16 + i) * 72 + c] = (bf16)f2bf(s * bf2f(Kn[c * 136 + g8 * 16 + i]));
    }
    {
        bf16* AT = (bf16*)(img + GDN_AT) + (size_t)ch * 4096;
#pragma unroll 1
        for (int job = wave; job < 26; job += 8) {
            int ib, jb; const bool isq = job >= 10;
            if (!isq) { int r = job; ib = 0; while (r > ib) { r -= ib + 1; ++ib; } jb = r; } else { ib = (job - 10) >> 2; jb = (job - 10) & 3; }
            f32x4 acc = {0.f, 0.f, 0.f, 0.f};
            if (jb <= ib) {
                const bf16* ap = (isq ? Qn : Kn) + (16 * ib + fr) * 136 + q * 8; const bf16* bp = Kn + (16 * jb + fr) * 136 + q * 8;
#pragma unroll
                for (int kk = 0; kk < 4; ++kk) acc = MFMA16(*(const bf16x8*)(ap + 32 * kk), *(const bf16x8*)(bp + 32 * kk), acc);
            }
            const int j = 16 * jb + fr; const float gj = gv[128 + j];
#pragma unroll
            for (int r = 0; r < 4; ++r) { const int i = 16 * ib + 4 * q + r; const float dec = expf(fminf(gv[128 + i] - gj, 0.f));
                if (!isq) Ls[i * 68 + j] = (j < i) ? gv[64 + i] * acc[r] * dec : 0.f;
                else AT[i * 64 + 32 * (jb >> 1) + 8 * (fr >> 2) + 4 * (jb & 1) + (fr & 3)] = (bf16)f2bf(j <= i ? acc[r] * dec : 0.f); }
        }
    }
    __syncthreads();
    if (wave == 0) {
        float T[64];
        int vz = 0; asm volatile("" : "+v"(vz));
        const float* Lz = Ls + vz;
#pragma unroll
        for (int i = 0; i < 64; ++i) {
            float a0 = fmaxf(0.f, 1.f - fabsf((float)(lane - i))), a1 = 0.f, a2 = 0.f, a3 = 0.f;
#pragma unroll
            for (int m4 = 0; m4 < (i + 3) / 4; ++m4) { const f32x4 lv = *(const f32x4*)(Lz + i * 68 + 4 * m4);
                if (4 * m4 < i) a0 -= lv.x * T[4 * m4]; if (4 * m4 + 1 < i) a1 -= lv.y * T[4 * m4 + 1]; if (4 * m4 + 2 < i) a2 -= lv.z * T[4 * m4 + 2]; if (4 * m4 + 3 < i) a3 -= lv.w * T[4 * m4 + 3]; }
            T[i] = (a0 + a1) + (a2 + a3);
            Ts[i * 72 + lane] = (bf16)f2bf(T[i]);
        }
    } else {
        const int t2 = tid - 64;
        bf16* QI = (bf16*)(img + GDN_QI) + (size_t)ch * 8192; bf16* KT = (bf16*)(img + GDN_KT) + (size_t)ch * 8192; float* DV = (float*)(img + GDN_DV) + (size_t)ch * 192;
        for (int it = t2; it < 64 * 16; it += 448) { const int c = it >> 4, pg = it & 15;
            unsigned short e[8];
#pragma unroll
            for (int j = 0; j < 8; ++j) { const int p = pg * 8 + j; e[j] = Qn[c * 136 + (p & ~31) + kperm32(p & 31)]; }
            v4u w; w.x = e[0] | ((unsigned)e[1] << 16); w.y = e[2] | ((unsigned)e[3] << 16); w.z = e[4] | ((unsigned)e[5] << 16); w.w = e[6] | ((unsigned)e[7] << 16);
            *(v4u*)(QI + c * 128 + pg * 8) = w; }
        for (int it = t2; it < 128 * 8; it += 448) { const int d = it >> 3, pg = it & 7;
            unsigned short e[8];
#pragma unroll
            for (int j = 0; j < 8; ++j) { const int p = pg * 8 + j; e[j] = Kn[((p & ~31) + kperm32(p & 31)) * 136 + d]; }
            v4u w; w.x = e[0] | ((unsigned)e[1] << 16); w.y = e[2] | ((unsigned)e[3] << 16); w.z = e[4] | ((unsigned)e[5] << 16); w.w = e[6] | ((unsigned)e[7] << 16);
            *(v4u*)(KT + d * 64 + pg * 8) = w; }
        if (t2 < 64) { DV[t2] = gv[192 + t2]; DV[64 + t2] = expf(gv[128 + 63] - gv[128 + t2]); if (t2 == 0) DV[128] = gv[192 + 63]; }
    }
    __syncthreads();
    {
        bf16x8 tf[4][2];
#pragma unroll
        for (int m = 0; m < 4; ++m)
#pragma unroll
            for (int kk = 0; kk < 2; ++kk) tf[m][kk] = *(const bf16x8*)(Ts + (16 * m + fr) * 72 + 32 * kk + q * 8);
#pragma unroll
        for (int cc = 0; cc < 2; ++cc) { const int ct = 2 * wave + cc;
            const bf16x8 r0 = *(const bf16x8*)(Rt + (16 * ct + fr) * 72 + q * 8), r1 = *(const bf16x8*)(Rt + (16 * ct + fr) * 72 + 32 + q * 8);
#pragma unroll
            for (int m = 0; m < 4; ++m) { f32x4 acc = {0.f, 0.f, 0.f, 0.f}; acc = MFMA16(tf[m][0], r0, acc); acc = MFMA16(tf[m][1], r1, acc);
                if (ct < 8) { v2u w; w.x = pk2(acc[0], acc[1]); w.y = pk2(acc[2], acc[3]); *(v2u*)(img + GDN_UI + (size_t)ch * 16384 + ((ct * 4 + m) * 64 + lane) * 8) = w; }
                else { const int dt = ct - 8; bf16* WI = (bf16*)(img + GDN_WI) + (size_t)ch * 8192;
#pragma unroll
                    for (int r = 0; r < 4; ++r) WI[(16 * m + 4 * q + r) * 128 + 32 * (dt >> 1) + 8 * (fr >> 2) + 4 * (dt & 1) + (fr & 3)] = (bf16)f2bf(-acc[r]); }
            } }
    }
}
constexpr int GDN_BUF = 2 * 17408 + 9216 + 18432 + 768;
__device__ __forceinline__ void gdn_scan_block(const unsigned char* img, bf16* OA, int h, unsigned char* lds, int tid) {
    const int lane = tid & 63, ws = __builtin_amdgcn_readfirstlane(tid >> 6), q = lane >> 4, fr = lane & 15;
    f32x4 S[8];
#pragma unroll
    for (int i = 0; i < 8; ++i) S[i] = (f32x4){0.f, 0.f, 0.f, 0.f};
    v4u st[7]; v4u stc = {0u, 0u, 0u, 0u}; v2u ub[4];
#define GDN_FETCH(N) do { const int ch_ = (N) * 4 + h; \
        st[0] = *(const v4u*)(img + GDN_WI + (size_t)ch_ * 16384 + tid * 16); st[1] = *(const v4u*)(img + GDN_WI + (size_t)ch_ * 16384 + 8192 + tid * 16); \
        st[2] = *(const v4u*)(img + GDN_QI + (size_t)ch_ * 16384 + tid * 16); st[3] = *(const v4u*)(img + GDN_QI + (size_t)ch_ * 16384 + 8192 + tid * 16); \
        st[4] = *(const v4u*)(img + GDN_AT + (size_t)ch_ * 8192 + tid * 16); \
        st[5] = *(const v4u*)(img + GDN_KT + (size_t)ch_ * 16384 + tid * 16); st[6] = *(const v4u*)(img + GDN_KT + (size_t)ch_ * 16384 + 8192 + tid * 16); \
        if (tid < 48) stc = *(const v4u*)(img + GDN_DV + (size_t)ch_ * 768 + tid * 16); \
        _Pragma("unroll") for (int m_ = 0; m_ < 4; ++m_) ub[m_] = *(const v2u*)(img + GDN_UI + (size_t)ch_ * 16384 + ((ws * 4 + m_) * 64 + lane) * 8); } while (0)
#define GDN_PUT(B) do { unsigned char* b_ = lds + (B) * GDN_BUF; const int r16 = tid >> 4, c16 = tid & 15, r8 = tid >> 3, c8 = tid & 7; \
        *(v4u*)(b_ + r16 * 272 + c16 * 16) = st[0]; *(v4u*)(b_ + (32 + r16) * 272 + c16 * 16) = st[1]; \
        *(v4u*)(b_ + 17408 + r16 * 272 + c16 * 16) = st[2]; *(v4u*)(b_ + 17408 + (32 + r16) * 272 + c16 * 16) = st[3]; \
        *(v4u*)(b_ + 34816 + r8 * 144 + c8 * 16) = st[4]; \
        *(v4u*)(b_ + 44032 + r8 * 144 + c8 * 16) = st[5]; *(v4u*)(b_ + 44032 + (64 + r8) * 144 + c8 * 16) = st[6]; \
        if (tid < 48) *(v4u*)(b_ + 62464 + tid * 16) = stc; } while (0)
    __syncthreads();
    GDN_FETCH(0); GDN_PUT(0);
    __syncthreads();
    for (int n = 0; n < NCHUNK; ++n) {
        const unsigned char* b = lds + (n & 1) * GDN_BUF;
        const float* DV = (const float*)(b + 62464);
        f32x4 vn[4], o[4];
#pragma unroll
        for (int m = 0; m < 4; ++m) vn[m] = (f32x4){bflo(ub[m].x), bfhi(ub[m].x), bflo(ub[m].y), bfhi(ub[m].y)};
        if (n + 1 < NCHUNK) GDN_FETCH(n + 1);
        bf16x8 sB[4];
#pragma unroll
        for (int kk = 0; kk < 4; ++kk) sB[kk] = pack_ctiles(S[2 * kk], S[2 * kk + 1]);
#pragma unroll
        for (int m = 0; m < 4; ++m) {
            const unsigned char* wr_ = b + (16 * m + fr) * 272 + q * 16;
            f32x4 oi = {0.f, 0.f, 0.f, 0.f};
#pragma unroll
            for (int kk = 0; kk < 4; ++kk) { vn[m] = MFMA16(*(const bf16x8*)(wr_ + 64 * kk), sB[kk], vn[m]); oi = MFMA16(*(const bf16x8*)(wr_ + 17408 + 64 * kk), sB[kk], oi); }
            o[m] = oi * *(const f32x4*)(DV + 16 * m + 4 * q);
        }
        const bf16x8 vb0 = pack_ctiles(vn[0], vn[1]), vb1 = pack_ctiles(vn[2], vn[3]);
#pragma unroll
        for (int m = 0; m < 4; ++m) {
            const unsigned char* ar = b + 34816 + (16 * m + fr) * 144 + q * 16;
            o[m] = MFMA16(*(const bf16x8*)(ar), vb0, o[m]);
            if (m >= 2) o[m] = MFMA16(*(const bf16x8*)(ar + 64), vb1, o[m]);
        }
#pragma unroll
        for (int m = 0; m < 4; ++m) vn[m] = vn[m] * *(const f32x4*)(DV + 64 + 16 * m + 4 * q);
        const bf16x8 xs0 = pack_ctiles(vn[0], vn[1]), xs1 = pack_ctiles(vn[2], vn[3]);
        const float cdec = DV[128];
#pragma unroll
        for (int dt = 0; dt < 8; ++dt) {
            const unsigned char* kr = b + 44032 + (16 * dt + fr) * 144 + q * 16;
            f32x4 acc = S[dt] * cdec;
            acc = MFMA16(*(const bf16x8*)(kr), xs0, acc); acc = MFMA16(*(const bf16x8*)(kr + 64), xs1, acc);
            S[dt] = acc;
        }
#pragma unroll
        for (int m = 0; m < 4; ++m)
#pragma unroll
            for (int r = 0; r < 4; ++r) OA[(size_t)(64 * n + 16 * m + 4 * q + r) * 512 + h * 128 + 16 * ws + fr] = (bf16)f2bf(o[m][r]);
        if (n + 1 < NCHUNK) GDN_PUT((n + 1) & 1);
        __syncthreads();
    }
#undef GDN_FETCH
#undef GDN_PUT
}

struct NsaCol { float m, l; };
__device__ __forceinline__ float col_max4(const f32x4 (&s)[4]) {
    float a = fmaxf(fmaxf(s[0][0], s[0][1]), fmaxf(s[0][2], s[0][3]));
#pragma unroll
    for (int i = 1; i < 4; ++i) a = fmaxf(a, fmaxf(fmaxf(s[i][0], s[i][1]), fmaxf(s[i][2], s[i][3])));
    a = fmaxf(a, __shfl_xor(a, 16)); a = fmaxf(a, __shfl_xor(a, 32)); return a;
}
template <bool WINDOW>
__device__ __forceinline__ void nsa_mfma_block(const bf16* PA, int kcol, const bf16* VT, int pos0, int t, bool colsel, int g, int head, const bf16x8 (&qf)[3],
                                               const LAS float* relb, const LAS int* btab, float& m, float& l, f32x4 (&o)[4], int lane) {
    const int q = lane >> 4, fr = lane & 15;
    const float scale = 0.10206207261596577f;
    f32x4 s[4];
#pragma unroll
    for (int rt = 0; rt < 4; ++rt) {
        const bf16* kp = PA + (size_t)(pos0 + 16 * rt + fr) * NPA + kcol + g * 160 + q * 8;
        f32x4 acc = {0.f, 0.f, 0.f, 0.f};
#pragma unroll
        for (int kk = 0; kk < 3; ++kk) acc = MFMA16(*(const bf16x8*)(kp + 32 * kk), qf[kk], acc);
        s[rt] = acc;
    }
    const bool far = !WINDOW && (pos0 + 63 + 128 <= t);
    const float bfar = relb[31 * 8 + head];
#pragma unroll
    for (int rt = 0; rt < 4; ++rt)
#pragma unroll
        for (int r = 0; r < 4; ++r) { const int pos = pos0 + 16 * rt + 4 * q + r, dist = t - pos;
            bool ok = colsel && dist >= 0; if (WINDOW) ok = ok && dist < 512;
            float bias = bfar; if (!far) { const int dd = dist < 0 ? 0 : dist; bias = relb[(dd < 128 ? btab[dd] : 31) * 8 + head]; }
            s[rt][r] = ok ? s[rt][r] * scale + bias : -INFINITY; }
    const float bm = col_max4(s);
    const float mn = fmaxf(m, bm);
    const float corr = (mn == -INFINITY) ? 1.f : expf(m - mn);
    float ps = 0.f;
#pragma unroll
    for (int rt = 0; rt < 4; ++rt)
#pragma unroll
        for (int r = 0; r < 4; ++r) { const float p = (s[rt][r] == -INFINITY) ? 0.f : expf(s[rt][r] - mn); s[rt][r] = p; ps += p; }
    ps += __shfl_xor(ps, 16); ps += __shfl_xor(ps, 32);
    l = l * corr + ps; m = mn;
    const bf16x8 pb0 = pack_ctiles(s[0], s[1]), pb1 = pack_ctiles(s[2], s[3]);
#pragma unroll
    for (int dt = 0; dt < 4; ++dt) {
        const bf16* vp = VT + (size_t)(g * 64 + 16 * dt + fr) * SEQ + pos0 + 4 * q;
        const v2u a0 = *(const v2u*)(vp), a1 = *(const v2u*)(vp + 16), a2 = *(const v2u*)(vp + 32), a3 = *(const v2u*)(vp + 48);
        v4u w0; w0.x = a0.x; w0.y = a0.y; w0.z = a1.x; w0.w = a1.y;
        v4u w1; w1.x = a2.x; w1.y = a2.y; w1.z = a3.x; w1.w = a3.y;
        f32x4 acc = o[dt] * corr;
        acc = MFMA16(__builtin_bit_cast(bf16x8, w0), pb0, acc); acc = MFMA16(__builtin_bit_cast(bf16x8, w1), pb1, acc);
        o[dt] = acc;
    }
}
__device__ __forceinline__ void nsa_quad(const bf16* PA, const float* SM, const bf16* KCH, const bf16* KCL, const bf16* VCT, const bf16* VTS, const bf16* VTW,
                                         const LAS float* relb, const LAS int* btab, bf16* OB, int t0, int g, float* wl, int lane) {
    const int q = lane >> 4, fr = lane & 15, tl = fr >> 2, hh = fr & 3, t = t0 + tl, head = g * 4 + hh;
    const float scale = 0.10206207261596577f;
    bf16x8 qf[3];
#pragma unroll
    for (int kk = 0; kk < 3; ++kk) qf[kk] = *(const bf16x8*)(PA + (size_t)t * NPA + PA_NQ + head * 96 + 32 * kk + q * 8);
    float* imp = wl;
#pragma unroll
    for (int i = 0; i < 8; ++i) imp[lane + 64 * i] = 0.f;
    const int ncv = t >= 31 ? (t - 31) / 16 + 1 : 0;
    const int ncvmax = (t0 + 3) >= 31 ? (t0 + 3 - 31) / 16 + 1 : 0;
    const int ntile = (ncvmax + 15) >> 4;
    f32x4 oc[4];
#pragma unroll
    for (int dt = 0; dt < 4; ++dt) oc[dt] = (f32x4){0.f, 0.f, 0.f, 0.f};
    if (ntile > 0) {
        float m = -INFINITY, l = 0.f;
#pragma unroll 1
        for (int T = 0; T < ntile; ++T) {
            const bf16* kh = KCH + (size_t)((16 * T + fr) * 2 + g) * 96 + q * 8; const bf16* kl = KCL + (size_t)((16 * T + fr) * 2 + g) * 96 + q * 8;
            f32x4 acc = {0.f, 0.f, 0.f, 0.f};
#pragma unroll
            for (int kk = 0; kk < 3; ++kk) { acc = MFMA16(*(const bf16x8*)(kh + 32 * kk), qf[kk], acc); acc = MFMA16(*(const bf16x8*)(kl + 32 * kk), qf[kk], acc); }
            float sv[4]; float bm = -INFINITY;
#pragma unroll
            for (int r = 0; r < 4; ++r) { const int n = 16 * T + 4 * q + r; const int dist = t - (16 * n + 31); const int dd = dist < 0 ? 0 : dist;
                sv[r] = (n < ncv) ? acc[r] * scale + relb[(dd < 128 ? btab[dd] : 31) * 8 + head] : -INFINITY; bm = fmaxf(bm, sv[r]); }
            const float mn = fmaxf(m, bm);
            if (mn != -INFINITY) { float ps = 0.f;
#pragma unroll
                for (int r = 0; r < 4; ++r) ps += (sv[r] == -INFINITY) ? 0.f : expf(sv[r] - mn);
                l = l * expf(m - mn) + ps; m = mn; }
        }
        float M = fmaxf(m, __shfl_xor(m, 16)); M = fmaxf(M, __shfl_xor(M, 32));
        float lt = (m == -INFINITY) ? 0.f : l * expf(m - M);
        lt += __shfl_xor(lt, 16); lt += __shfl_xor(lt, 32);
        const float inv = lt > 0.f ? 1.f / lt : 0.f;
        float carry = 0.f;
#pragma unroll 1
        for (int T2 = 0; T2 < ntile; T2 += 2) {
            f32x4 pt[2];
#pragma unroll
            for (int u = 0; u < 2; ++u) { const int T = T2 + u;
                f32x4 acc = {0.f, 0.f, 0.f, 0.f};
                if (T < ntile) {
                    const bf16* kh = KCH + (size_t)((16 * T + fr) * 2 + g) * 96 + q * 8; const bf16* kl = KCL + (size_t)((16 * T + fr) * 2 + g) * 96 + q * 8;
#pragma unroll
                    for (int kk = 0; kk < 3; ++kk) { acc = MFMA16(*(const bf16x8*)(kh + 32 * kk), qf[kk], acc); acc = MFMA16(*(const bf16x8*)(kl + 32 * kk), qf[kk], acc); }
                }
#pragma unroll
                for (int r = 0; r < 4; ++r) { const int n = 16 * T + 4 * q + r; const int dist = t - (16 * n + 31); const int dd = dist < 0 ? 0 : dist;
                    const bool ok = (T < ntile) && (n < ncv);
                    pt[u][r] = ok ? expf(acc[r] * scale + relb[(dd < 128 ? btab[dd] : 31) * 8 + head] - M) * inv : 0.f; }
                const float x3 = pt[u][3];
                float prev = __shfl(x3, (lane + 48) & 63);
                const float nxt = __shfl(x3, 48 + fr);
                if (q == 0) prev = carry;
                carry = nxt;
                float v = ((pt[u][0] + pt[u][1]) + (pt[u][2] + pt[u][3])) + prev;
                v += __shfl_xor(v, 1); v += __shfl_xor(v, 2);
                if (hh == 0 && T < ntile) imp[tl * 128 + 4 * T + q] = v;
            }
            const bf16x8 pb = pack_ctiles(pt[0], pt[1]);
#pragma unroll
            for (int dt = 0; dt < 4; ++dt) {
                const bf16* vp = VCT + (size_t)(g * 64 + 16 * dt + fr) * 512 + 16 * T2 + 4 * q;
                const v2u a0 = *(const v2u*)(vp), a1 = *(const v2u*)(vp + 16);
                v4u w0; w0.x = a0.x; w0.y = a0.y; w0.z = a1.x; w0.w = a1.y;
                oc[dt] = MFMA16(__builtin_bit_cast(bf16x8, w0), pb, oc[dt]);
            }
        }
    }
    LDS_WAIT(); asm volatile("" ::: "memory");
    const int blk_t = t0 >> 6; const int nsel = blk_t + 1 < 16 ? blk_t + 1 : 16;
    unsigned long long msk_lo[4], msk_hi[4];
#pragma unroll
    for (int tk = 0; tk < 4; ++tk) {
        float v0, v1; { const int s0 = lane, s1 = lane + 64;
            v0 = (s0 == 0 || s0 == blk_t || s0 == blk_t - 1) ? INFINITY : (s0 > blk_t ? -INFINITY : imp[tk * 128 + s0]);
            v1 = (s1 == blk_t || s1 == blk_t - 1) ? INFINITY : (s1 > blk_t ? -INFINITY : imp[tk * 128 + s1]); }
        unsigned long long lo = 0ull, hi = 0ull;
#pragma unroll 1
        for (int r = 0; r < nsel; ++r) {
            float bv; int bi;
            if (v0 >= v1) { bv = v0; bi = lane; } else { bv = v1; bi = lane + 64; }
#pragma unroll
            for (int off = 32; off >= 1; off >>= 1) { const float ov = __shfl_xor(bv, off); const int oi = __shfl_xor(bi, off); if (ov > bv || (ov == bv && oi < bi)) { bv = ov; bi = oi; } }
            bi = __builtin_amdgcn_readfirstlane(bi);
            if (bi < 64) lo |= 1ull << bi; else hi |= 1ull << (bi - 64);
            if (bi == lane) v0 = -INFINITY; else if (bi == lane + 64) v1 = -INFINITY;
        }
        msk_lo[tk] = lo; msk_hi[tk] = hi;
    }
    f32x4 os[4]; float ms = -INFINITY, ls = 0.f;
#pragma unroll
    for (int dt = 0; dt < 4; ++dt) os[dt] = (f32x4){0.f, 0.f, 0.f, 0.f};
    const unsigned long long mylo = tl == 0 ? msk_lo[0] : tl == 1 ? msk_lo[1] : tl == 2 ? msk_lo[2] : msk_lo[3];
    const unsigned long long myhi = tl == 0 ? msk_hi[0] : tl == 1 ? msk_hi[1] : tl == 2 ? msk_hi[2] : msk_hi[3];
#pragma unroll 1
    for (int half = 0; half < 2; ++half) {
        unsigned long long un = half ? ((msk_hi[0] | msk_hi[1]) | (msk_hi[2] | msk_hi[3])) : ((msk_lo[0] | msk_lo[1]) | (msk_lo[2] | msk_lo[3]));
        const unsigned long long mine = half ? myhi : mylo;
        while (un) {
            const int bit = __builtin_ctzll(un); un &= un - 1;
            const int sb = half * 64 + bit;
            nsa_mfma_block<false>(PA, PA_KS, VTS, 64 * sb, t, (mine >> bit) & 1ull, g, head, qf, relb, btab, ms, ls, os, lane);
        }
    }
    f32x4 ow[4]; float mw = -INFINITY, lw = 0.f;
#pragma unroll
    for (int dt = 0; dt < 4; ++dt) ow[dt] = (f32x4){0.f, 0.f, 0.f, 0.f};
    { const int b0 = (t0 - 511) < 0 ? 0 : (t0 - 511) >> 6, b1 = (t0 + 3) >> 6;
#pragma unroll 1
      for (int bi = b0; bi <= b1; ++bi) nsa_mfma_block<true>(PA, PA_KW, VTW, 64 * bi, t, true, g, head, qf, relb, btab, mw, lw, ow, lane); }
    const float* gl = SM + (size_t)t * 64 + 8 + head * 3;
    const float gc = sigmoidf_(gl[0]), gs = sigmoidf_(gl[1]) / ls, gw = sigmoidf_(gl[2]) / lw;
#pragma unroll
    for (int dt = 0; dt < 4; ++dt) { const f32x4 o = oc[dt] * gc + os[dt] * gs + ow[dt] * gw;
        v2u w; w.x = pk2(o[0], o[1]); w.y = pk2(o[2], o[3]);
        *(v2u*)(OB + (size_t)t * 512 + head * 64 + 16 * dt + 4 * q) = w; }
    asm volatile("" ::: "memory");
}
__device__ __forceinline__ void nsa_vt_item(const bf16* PA, bf16* VTS, bf16* VTW, int item, unsigned short* wl, int lane) {
    const int chunk = item >> 2, g = (item >> 1) & 1, which = item & 1;
    const int kcol = which ? PA_KW : PA_KS; bf16* VT = which ? VTW : VTS;
    for (int i = 0; i < 8; ++i) { const int tt = i * 8 + (lane >> 3), c8 = lane & 7;
        const v4u x = *(const v4u*)(PA + (size_t)(chunk * 64 + tt) * NPA + kcol + g * 160 + 96 + c8 * 8);
        unsigned* d = (unsigned*)(wl + tt * 66 + c8 * 8); d[0] = x.x; d[1] = x.y; d[2] = x.z; d[3] = x.w; }
    LDS_WAIT(); asm volatile("" ::: "memory");
    for (int i = 0; i < 8; ++i) { const int dv = i * 8 + (lane >> 3), c8 = lane & 7;
        unsigned short e[8];
#pragma unroll
        for (int j = 0; j < 8; ++j) e[j] = wl[(c8 * 8 + j) * 66 + dv];
        v4u w; w.x = e[0] | ((unsigned)e[1] << 16); w.y = e[2] | ((unsigned)e[3] << 16); w.z = e[4] | ((unsigned)e[5] << 16); w.w = e[6] | ((unsigned)e[7] << 16);
        *(v4u*)(VT + (size_t)(g * 64 + dv) * SEQ + chunk * 64 + c8 * 8) = w; }
    LDS_WAIT(); asm volatile("" ::: "memory");
}

constexpr size_t CMP_KCF = 0, CMP_VCF = 3328 * 1024, CMP_H1K = 5632 * 1024, CMP_H1V = 6144 * 1024;
constexpr size_t CW_W1K = 0, CW_W1V = 1536 * 1024, CW_BPART = 2560 * 1024, CW_BIAS = CW_BPART + 2 * 16 * 256 * 4;
template <int ND>
__device__ __forceinline__ void cmp_layer2(const bf16* H1, const float* w2, int nd_total, int pm, int tid, float (&acc)[ND]) {
    const int r = pm * 256 + (tid >> 1), d0 = (tid & 1) * ND;
#pragma unroll
    for (int i = 0; i < ND; ++i) acc[i] = 0.f;
#pragma unroll 1
    for (int j = 0; j < 256; ++j) {
        const float hv = bf2f(H1[(size_t)r * 256 + j]);
        const f32x4* wp = (const f32x4*)(w2 + (size_t)j * nd_total + d0);
#pragma unroll
        for (int i4 = 0; i4 < ND / 4; ++i4) { const f32x4 wv = wp[i4]; acc[4 * i4] += hv * wv.x; acc[4 * i4 + 1] += hv * wv.y; acc[4 * i4 + 2] += hv * wv.z; acc[4 * i4 + 3] += hv * wv.w; }
    }
}

constexpr int PH_PER_LAYER = 22, NPHASES = DEPTH * PH_PER_LAYER;
enum { K_CONV = 0, K_F1, K_GF32, K_ROWS, K_M1, K_M2, K_M3, K_M4, K_M5, K_M2B };
constexpr size_t ALPHA_OFF = 276 * MiB;
static_assert(ALPHA_OFF + GLA_BYTES <= 290 * MiB && WS_WGU + GLA_VBYTES <= WS_WD && WS_QKV + GDN_BYTES <= WS_KCMP, "gla/gdn images");
__global__ void __launch_bounds__(NTHR, 2) mk_fwd(Args args) {
    extern __shared__ __attribute__((aligned(16))) unsigned char lds[];
    LAS unsigned char* ldsl = (LAS unsigned char*)lds;
    {
        const int tid = threadIdx.x;
        for (int u = tid; u < (LDS_BYTES - LDSCTL_OFF) / 4; u += NTHR) ((LAS unsigned*)(ldsl + LDSCTL_OFF))[u] = 0u;
        __syncthreads();
        LAS int* btab = (LAS int*)(ldsl + BTAB_OFF);
        if (tid < 128) { int b = tid; if (tid >= 16) { const float v = logf((float)tid / 16.f) / 2.0794415416798357f * 16.f; b = 16 + (int)v; if (b > 31) b = 31; } btab[tid] = b; }
        if (tid < 256) ((LAS float*)(ldsl + RELB_OFF))[tid] = args.in[I_RELB][tid];
        __syncthreads();
    }
#if MK_ONE_LAUNCH
    XcdBarrier bar = xcd_barrier_post((unsigned*)(args.ws + WS_CTL) + CW_BAR, (volatile LAS unsigned*)(ldsl + MISC_OFF) + 8);
#endif
#pragma unroll 1
    for (int pc = args.ph_lo; pc < args.ph_hi; ++pc) {
        const unsigned pe = args.prog[pc];
        const int kind = pe & 15, sub = (pe >> 4) & 1, b = (pe >> 5) & 1, l = (pe >> 6) & 1; const bool mixer = (pe >> 7) & 1;
        unsigned char* ws = args.ws;
        int tid_ = threadIdx.x; asm volatile("" : "+v"(tid_));
        const int tid = tid_, lane = tid & 63, wave = __builtin_amdgcn_readfirstlane(tid >> 6);
        const int G = gridDim.x, bx = blockIdx.x;
        const int vcu = (G % 8 == 0) ? (bx % 8) * (G / 8) + bx / 8 : bx;
        const int gw = vcu * NWAVES + wave, NGW = G * NWAVES;
        switch (kind) {
        case K_CONV: {
            bf16* WGU = (bf16*)(ws + WS_WGU); bf16* WD = (bf16*)(ws + WS_WD); bf16* WIN = (bf16*)(ws + WS_WIN); bf16* WB = (bf16*)(ws + WS_WB); bf16* WO = (bf16*)(ws + WS_WO);
            LAS float* scr = (LAS float*)(ldsl + wave * 16384);
            const float* w_gu = args.in[sub ? I_F2GU : I_F1GU] + (size_t)l * DM * 2 * DFF;
            const float* w_dn = args.in[sub ? I_F2D : I_F1D] + (size_t)l * DFF * DM;
            constexpr int I_GU = (DM / 64) * (2 * DFF / 32), I_DN = (DFF / 64) * (DM / 32), I_IN = (DM / 64) * ((DIN_SRC + 31) / 32), I_BR = (512 / 64) * (DM / 32), I_OUT = (DM / 64) * (DM / 32);
            const int nitems = I_GU + I_DN + (sub == 0 ? I_IN + 3 * I_BR + I_OUT : 0);
            for (int it = gw; it < nitems; it += NGW) {
                int r = it;
                if (r < I_GU) { transpose_item(w_gu, DM, 2 * DFF, WGU, scr, r, lane, MapGU()); continue; } r -= I_GU;
                if (r < I_DN) { transpose_item(w_dn, DFF, DM, WD, scr, r, lane, MapId()); continue; } r -= I_DN;
                if (r < I_IN) { transpose_item(args.in[I_WIN] + (size_t)l * DM * DIN_SRC, DM, DIN_SRC, WIN, scr, r, lane, MapWin()); continue; } r -= I_IN;
                if (r < 3 * I_BR) { const int br = r / I_BR; transpose_item(args.in[I_WBG + br] + (size_t)l * 512 * DM, 512, DM, WB + (size_t)br * 512 * 1024, scr, r % I_BR, lane, MapId()); continue; } r -= 3 * I_BR;
                transpose_item(args.in[I_WOUT] + (size_t)l * DM * DM, DM, DM, WO, scr, r, lane, MapId());
            }
            if (sub == 0) { for (int i = gw * 64 + lane; i < 16 * DM / 2; i += NGW * 64) ((unsigned*)(WIN + (size_t)(PA_SM + 48) * DM))[i] = 0u; }
            if (l == 0 && sub == 0) { const float* n_pre = args.in[I_F1PRE]; bf16* XN = (bf16*)(ws + WS_XN);
                for (int m = gw; m < MTOK; m += NGW) row_pass(args.in[I_X] + (size_t)m * DM, nullptr, nullptr, 0.f, nullptr, n_pre, XN + (size_t)m * DM, lane); }
        } break;
        case K_F1: {
            pg8::Gemm g{(const bf16*)(ws + WS_XN), (const bf16*)(ws + WS_WGU), MTOK, 2 * DFF, DM, DM}; pg8::StaticOrder S; S.init(MTOK, 2 * DFF, G, bx); pg8::EpiSwiglu E{(bf16*)(ws + WS_H), DFF};
            pg8::gemm_phase<pg8::EpiSwiglu, pg8::StaticOrder, true, true>(ldsl, g, S, E);
        } break;
        case K_GF32: {
            pg8::Gemm g; pg8::EpiF32 E; pg8::StaticOrder S;
            if (mixer) { g = pg8::Gemm{(const bf16*)(ws + WS_MG), (const bf16*)(ws + WS_WO), SEQ, DM, DM, DM}; E = pg8::EpiF32{(float*)(ws + WS_YB), DM}; S.init(SEQ, DM, G, bx); }
            else { g = pg8::Gemm{(const bf16*)(ws + WS_H), (const bf16*)(ws + WS_WD), MTOK, DM, DFF, DFF}; E = pg8::EpiF32{(float*)(ws + WS_Y), DM}; S.init(MTOK, DM, G, bx); }
            pg8::gemm_phase<pg8::EpiF32, pg8::StaticOrder, true, true>(ldsl, g, S, E);
        } break;
        case K_ROWS: {
            float* xres = args.out; bf16* XN = (bf16*)(ws + WS_XN);
            if (mixer) {
                const float* YB = (const float*)(ws + WS_YB);
                for (int m = gw; m < SEQ; m += NGW) { const size_t r = (size_t)b * SEQ + m;
                    row_pass(xres + r * DM, YB + (size_t)m * DM, args.in[I_MPOST] + l * DM, 1.0f, xres + r * DM, args.in[I_F2PRE] + l * DM, XN + r * DM, lane); }
            } else {
                const float* Y = (const float*)(ws + WS_Y);
                const float* n_post = args.in[sub ? I_F2POST : I_F1POST] + l * DM;
                const float* xin = (l == 0 && sub == 0) ? args.in[I_X] : xres;
                const float* wnext = sub == 0 ? args.in[I_MPRE] + l * DM : (l + 1 < DEPTH ? args.in[I_F1PRE] + (l + 1) * DM : nullptr);
                for (int m = gw; m < MTOK; m += NGW) row_pass(xin + (size_t)m * DM, Y + (size_t)m * DM, n_post, 0.5f, xres + (size_t)m * DM, wnext, wnext ? XN + (size_t)m * DM : nullptr, lane);
                if (sub == 0) {
                    LAS float* scr = (LAS float*)(ldsl + wave * 16384);
                    const float* w1k = args.in[I_W1K] + (size_t)l * 3072 * 256; const float* w1v = args.in[I_W1V] + (size_t)l * 2048 * 256;
                    for (int it = gw; it < 48 * 8 + 32 * 8; it += NGW) {
                        if (it < 384) transpose_item(w1k, 3072, 256, (bf16*)(ws + WS_WD + CW_W1K), scr, it, lane, MapId());
                        else transpose_item(w1v, 2048, 256, (bf16*)(ws + WS_WD + CW_W1V), scr, it - 384, lane, MapId()); }
                    if (bx < 32) { const int which = bx >> 4, part = bx & 15, j = tid & 255, hf = tid >> 8;
                        const int per = which ? 128 : 192, i0 = part * per + hf * (per / 2);
                        const float* pe = which ? args.in[I_PEV] + l * 32 * 64 : args.in[I_PEK] + l * 32 * 96; const float* w1 = which ? w1v : w1k;
                        float a = 0.f;
                        for (int i = i0; i < i0 + per / 2; ++i) a += pe[i] * w1[(size_t)i * 256 + j];
                        float* red = (float*)lds; __syncthreads(); red[tid] = a; __syncthreads();
                        if (tid < 256) ((float*)(ws + WS_WD + CW_BPART))[(which * 16 + part) * 256 + tid] = red[tid] + red[tid + 256];
                    }
                }
            }
        } break;
        case K_M1: {
            pg8::Gemm g{(const bf16*)(ws + WS_XN) + (size_t)b * SEQ * DM, (const bf16*)(ws + WS_WIN), SEQ, NIN, DM, DM}; pg8::StaticOrder S; S.init(SEQ, NIN, G, bx);
            pg8::EpiWin E{(bf16*)(ws + WS_A), (float*)(ws + WS_SM), (bf16*)(ws + WS_G)};
            pg8::gemm_phase<pg8::EpiWin, pg8::StaticOrder, true, true>(ldsl, g, S, E);
        } break;
        case K_M2: {
            const bf16* PA = (const bf16*)(ws + WS_A); const float* SM = (const float*)(ws + WS_SM);
            if (bx == 0) { const int which = tid >> 8, j = tid & 255; float a = 0.f; const float* bp = (const float*)(ws + WS_WD + CW_BPART) + which * 16 * 256 + j;
                for (int p = 0; p < 16; ++p) a += bp[p * 256];
                ((float*)(ws + WS_WD + CW_BIAS))[which * 256 + j] = a; }
            {
                bf16* KCF = (bf16*)(ws + WS_O + CMP_KCF); bf16* VCF = (bf16*)(ws + WS_O + CMP_VCF);
                for (int it = vcu * NTHR + tid; it < SEQ * 2 * 20; it += G * NTHR) { const int c = it % 20, tg = it / 20, g = tg & 1, t = tg >> 1;
                    const v4u x = *(const v4u*)(PA + (size_t)t * NPA + PA_KC + g * 160 + c * 8);
                    if (c < 12) *(v4u*)(KCF + ((size_t)g * SEQ + t) * 96 + c * 8) = x; else *(v4u*)(VCF + ((size_t)g * SEQ + t) * 64 + (c - 12) * 8) = x; }
                if (bx == 1) { const v4u z = {0u, 0u, 0u, 0u}; if (tid < 192) *(v4u*)(KCF + (size_t)2 * SEQ * 96 + tid * 8) = z; else if (tid < 320) *(v4u*)(VCF + (size_t)2 * SEQ * 64 + (tid - 192) * 8) = z; }
            }
            for (int it = gw; it < NCHUNK * 4; it += NGW) nsa_vt_item(PA, (bf16*)(ws + WS_VTS), (bf16*)(ws + WS_VTW), it, (unsigned short*)(lds + wave * 16384), lane);
            for (int it = bx; it < NCHUNK * 4; it += G)
                gla_prep_item(PA, SM, args.in[I_GGW] + l * 16 * 256, args.in[I_GGB] + l * 256, ws + ALPHA_OFF, ws + WS_WGU, it >> 2, it & 3, (float*)lds, tid);
        } break;
        case K_M2B: {
            if (bx < 8) {
                const int kv = bx >> 2, pm = bx & 3;
                bf16* H1 = (bf16*)(ws + WS_O + (kv ? CMP_H1V : CMP_H1K));
                pg8::Gemm g = kv ? pg8::Gemm{(const bf16*)(ws + WS_O + CMP_VCF), (const bf16*)(ws + WS_WD + CW_W1V), 1024, 256, 2048, 1024}
                                 : pg8::Gemm{(const bf16*)(ws + WS_O + CMP_KCF), (const bf16*)(ws + WS_WD + CW_W1K), 1024, 256, 3072, 1536};
                pg8::OneTile S{pm, 0}; pg8::EpiGelu E{H1, (const float*)(ws + WS_WD + CW_BIAS) + kv * 256};
                pg8::gemm_phase<pg8::EpiGelu, pg8::OneTile, false, true>(ldsl, g, S, E);
                asm volatile("s_waitcnt vmcnt(0)" ::: "memory"); __syncthreads();
                __builtin_amdgcn_fence(__ATOMIC_ACQUIRE, "agent"); asm volatile("s_waitcnt vmcnt(0)" ::: "memory");
                const int r = pm * 256 + (tid >> 1), gg = r >> 9, n = r & 511;
                if (kv == 0) { float acc[48]; cmp_layer2<48>(H1, args.in[I_W2K] + l * 256 * 96, 96, pm, tid, acc);
                    if (n < 511) { bf16* KCH = (bf16*)(ws + WS_KCMP) + (size_t)(n * 2 + gg) * 96 + (tid & 1) * 48; bf16* KCL = (bf16*)(ws + WS_KCL) + (size_t)(n * 2 + gg) * 96 + (tid & 1) * 48;
#pragma unroll
                        for (int i = 0; i < 48; ++i) { const unsigned hi = f2bf(acc[i]); KCH[i] = (bf16)hi; KCL[i] = (bf16)f2bf(acc[i] - __uint_as_float(hi << 16)); } } }
                else { float acc[32]; cmp_layer2<32>(H1, args.in[I_W2V] + l * 256 * 64, 64, pm, tid, acc);
                    if (n < 511) { bf16* VCT = (bf16*)(ws + WS_VCT) + (size_t)(gg * 64 + (tid & 1) * 32) * 512 + n;
#pragma unroll
                        for (int i = 0; i < 32; ++i) VCT[(size_t)i * 512] = (bf16)f2bf(acc[i]); } }
                if (bx == 0) { if (tid < 192) { ((bf16*)(ws + WS_KCMP))[511 * 192 + tid] = 0; ((bf16*)(ws + WS_KCL))[511 * 192 + tid] = 0; } if (tid < 128) ((bf16*)(ws + WS_VCT))[tid * 512 + 511] = 0; }
            } else {
                const bf16* PA = (const bf16*)(ws + WS_A); const float* SM = (const float*)(ws + WS_SM);
                for (int it = bx - 8; it < NCHUNK * 4; it += G - 8)
                    gdn_prep_chunk(PA, SM, args.in[I_CONVW] + l * 4 * 1536, args.in[I_ALOG] + l * 4, args.in[I_DTB] + l * 4, ws + WS_QKV, it >> 2, it & 3, lds, tid);
            }
        } break;
        case K_M3: {
            const bf16* PA = (const bf16*)(ws + WS_A); bf16* OB3 = (bf16*)(ws + WS_O);
            float* wl = (float*)(lds + wave * 16384);
            if (bx < 4) gdn_scan_block(ws + WS_QKV, OB3, bx, lds, tid);
            else if (bx < 8) gla_scan_block(ws + ALPHA_OFF, ws + WS_WGU, OB3 + 2 * (size_t)SEQ * 512, bx - 4, lds, tid);
            else { const LAS int* btab = (const LAS int*)(ldsl + BTAB_OFF); const LAS float* relb = (const LAS float*)(ldsl + RELB_OFF);
                for (int it = (bx - 8) * NWAVES + wave; it < SEQ / 2; it += (G - 8) * NWAVES)
                    nsa_quad(PA, (const float*)(ws + WS_SM), (const bf16*)(ws + WS_KCMP), (const bf16*)(ws + WS_KCL), (const bf16*)(ws + WS_VCT), (const bf16*)(ws + WS_VTS), (const bf16*)(ws + WS_VTW),
                             relb, btab, OB3 + (size_t)SEQ * 512, (it >> 1) * 4, it & 1, wl, lane); }
        } break;
        case K_M4: {
            for (int it = gw; it < SEQ * 4; it += NGW) out_norm_item((bf16*)(ws + WS_O), (const bf16*)(ws + WS_A), PA_GZ, args.in[I_GDNNW] + l * 128, it >> 2, it & 3, lane);
            for (int it = gw; it < SEQ * 4; it += NGW) out_norm_item((bf16*)(ws + WS_O) + 2 * (size_t)SEQ * 512, (const bf16*)(ws + WS_A), PA_LR, args.in[I_GLANW] + l * 128, it >> 2, it & 3, lane);
        } break;
        case K_M5: {
#pragma unroll 1
            for (int br = 0; br < 3; ++br) {
                pg8::StaticOrder S; S.init(SEQ, DM, G, bx);
                pg8::Gemm g{(const bf16*)(ws + WS_O) + (size_t)br * SEQ * 512, (const bf16*)(ws + WS_WB) + (size_t)br * 512 * 1024, SEQ, DM, 512, 512};
                pg8::EpiMerge E{(const bf16*)(ws + WS_G) + br * 1024, (float*)(ws + WS_RMW), (bf16*)(ws + WS_MG), br};
                pg8::gemm_phase<pg8::EpiMerge, pg8::StaticOrder, true, true>(ldsl, g, S, E);
            }
        } break;
        default: break;
        }
#if MK_ONE_LAUNCH
        if (pc + 1 < args.ph_hi) xcd_barrier(bar);
#endif
    }
}

extern "C" void kernel_launch(void* const* d_in, const int* in_sizes, int n_in, void* d_out, int out_size, void* d_ws, size_t ws_size, hipStream_t stream) {
    static int grid = 0;
    if (grid == 0) {
        if (n_in != 30 || out_size != MTOK * DM || ws_size < 292 * MiB) { fprintf(stderr, "kernel_launch: unexpected shapes (n_in %d out %d ws %zu)\n", n_in, out_size, ws_size); grid = -1; return; }
        int dev = 0, cus = 0, per_cu = 0;
        if (hipGetDevice(&dev) != hipSuccess || hipDeviceGetAttribute(&cus, hipDeviceAttributeMultiprocessorCount, dev) != hipSuccess) { grid = -1; return; }
        if (hipFuncSetAttribute((const void*)mk_fwd, hipFuncAttributeMaxDynamicSharedMemorySize, LDS_BYTES) != hipSuccess) { fprintf(stderr, "kernel_launch: hipFuncSetAttribute failed\n"); grid = -1; return; }
        if (hipOccupancyMaxActiveBlocksPerMultiprocessor(&per_cu, (const void*)mk_fwd, NTHR, LDS_BYTES) != hipSuccess || per_cu < 1) { fprintf(stderr, "kernel_launch: occupancy query says %d blocks per CU\n", per_cu); grid = -1; (void)hipGetLastError(); return; }
        (void)hipGetLastError();
        grid = cus;
    }
    if (grid < 0) return;
    (void)hipMemsetAsync((char*)d_ws + WS_CTL, 0, CTL_ZERO_BYTES, stream);
    Args a{};
    for (int i = 0; i < 30; ++i) a.in[i] = (const float*)d_in[i];
    a.out = (float*)d_out; a.ws = (unsigned char*)d_ws;
    int np = 0;
#ifndef PROBE_KIND
#define PROBE_KIND -1
#endif
    auto push = [&](int kind, int sub, int b, int l, int mixer) { const int reps = (kind == PROBE_KIND) ? 2 : 1; for (int r = 0; r < reps; ++r) a.prog[np++] = (unsigned char)(kind | sub << 4 | b << 5 | l << 6 | mixer << 7); };
    for (int l = 0; l < DEPTH; ++l) {
        push(K_CONV, 0, 0, l, 0); push(K_F1, 0, 0, l, 0); push(K_GF32, 0, 0, l, 0); push(K_ROWS, 0, 0, l, 0);
        for (int b = 0; b < NBATCH; ++b) { push(K_M1, 0, b, l, 1); push(K_M2, 0, b, l, 1); push(K_M2B, 0, b, l, 1); push(K_M3, 0, b, l, 1); push(K_M4, 0, b, l, 1); push(K_M5, 0, b, l, 1); push(K_GF32, 0, b, l, 1); push(K_ROWS, 0, b, l, 1); }
        push(K_CONV, 1, 0, l, 0); push(K_F1, 1, 0, l, 0); push(K_GF32, 1, 0, l, 0); push(K_ROWS, 1, 0, l, 0);
    }
    const int NPH = np;
#if MK_ONE_LAUNCH
    a.ph_lo = 0; a.ph_hi = NPH;
    hipLaunchKernelGGL(mk_fwd, dim3(grid), dim3(NTHR), LDS_BYTES, stream, a);
#else
    for (int p = 0; p < NPH; ++p) { a.ph_lo = p; a.ph_hi = p + 1; hipLaunchKernelGGL(mk_fwd, dim3(grid), dim3(NTHR), LDS_BYTES, stream, a); }
#endif
}
```

```cpp
#include <hip/hip_runtime.h>
#include <cstdio>
#include <cstdint>
#ifndef MK_ONE_LAUNCH
#define MK_ONE_LAUNCH 1
#endif
namespace pg8 {
#define PG8_LAS __attribute__((address_space(3)))
typedef unsigned short bf16_t;
typedef short bf16x8 __attribute__((ext_vector_type(8)));
typedef float f32x4 __attribute__((ext_vector_type(4)));
typedef unsigned u32x4 __attribute__((ext_vector_type(4)));
typedef unsigned u32x2 __attribute__((ext_vector_type(2)));
constexpr int BM = 256, BK = 64, HALF = 128, HTB = HALF * BK * 2  , STAGE_BYTES = 8 * HTB, NXCD = 8, WGM = 8;

__host__ __device__ __forceinline__ int lds_byte(int r, int c) { const int st = (r >> 4) * 2 + (c >> 5), rr = r & 15, cc = c & 31, ob = rr * 64 + cc * 2; return st * 1024 + (ob ^ (((ob >> 9) & 1) << 5)); }
__host__ __device__ __forceinline__ void stage_rc(int b, int& R, int& C) { const int st = b / 1024, sb = b % 1024, swz = sb ^ (((sb >> 9) & 1) << 5); R = (st >> 1) * 16 + swz / 64; C = (st & 1) * 32 + (swz % 64) / 2; }
__host__ __device__ __forceinline__ int perm32(int rho) { const int n = rho >> 4, i = rho & 15; return 8 * (i >> 2) + 4 * n + (i & 3); }

struct Unit { int pm, pn; };
struct Gemm { const bf16_t* A; const bf16_t* Bt; int M, N, K, lda; };

struct StaticOrder {
    int nM, nN, nwg, G, c;
    __host__ __device__ void init(int M, int N, int G_, int c_) { nM = M / BM; nN = N / BM; nwg = nM * nN; G = G_; c = c_; }
    __host__ __device__ bool next(int i, Unit& u) const {
        const long L = (long)i * G + c; if (L >= nwg) return false;
        int wgid = (int)L; { const int q = nwg / NXCD, r = nwg % NXCD, xcd = wgid % NXCD, off = wgid / NXCD; wgid = (xcd < r ? xcd * (q + 1) : r * (q + 1) + (xcd - r) * q) + off; }
        const int nig = WGM * nN, gid = wgid / nig, fm = gid * WGM, gsz = (nM - fm) < WGM ? (nM - fm) : WGM;
        u.pm = fm + ((wgid % nig) % gsz); u.pn = (wgid % nig) / gsz; return true;
    }
    __device__ __forceinline__ void a_ready(const Unit&) const {}
    __device__ __forceinline__ void done(const Unit&) const {}
};

struct OneTile { int pm, pn; __device__ __forceinline__ bool next(int i, Unit& u) const { if (i) return false; u.pm = pm; u.pn = pn; return true; }
    __device__ __forceinline__ void a_ready(const Unit&) const {} __device__ __forceinline__ void done(const Unit&) const {} };
__device__ __forceinline__ unsigned cvt_pk_bf16(float lo, float hi) { unsigned r; asm volatile("v_cvt_pk_bf16_f32 %0, %1, %2" : "=v"(r) : "v"(lo), "v"(hi)); return r; }
__device__ __forceinline__ float bflo(unsigned w) { return __uint_as_float(w << 16); }
__device__ __forceinline__ float bfhi(unsigned w) { return __uint_as_float(w & 0xffff0000u); }
__device__ __forceinline__ float sigmoid_f(float x) { return __builtin_amdgcn_rcpf(1.f + __expf(-x)); }

struct EpiSwiglu {
    static constexpr bool PERM = true, AFTER_DRAIN = false;
    bf16_t* H; int ldh;
    __device__ __forceinline__ void operator()(const f32x4 (&acc)[2][2][4][2], const Unit& u, int wr, int wc, int fr, int fq) const {
        const int row0 = u.pm * BM + wr * 64 + fr, j0 = u.pn * HALF + wc * 32 + 8 * fq;
#pragma unroll
        for (int ai = 0; ai < 2; ++ai)
#pragma unroll
            for (int m = 0; m < 4; ++m) {
                bf16_t* p = H + (size_t)(row0 + ai * HALF + m * 16) * ldh + j0;
                float h[8];
#pragma unroll
                for (int n = 0; n < 2; ++n)
#pragma unroll
                    for (int i = 0; i < 4; ++i) { const float g = acc[ai][0][m][n][i], uu = acc[ai][1][m][n][i]; h[n * 4 + i] = g * sigmoid_f(g) * uu; }
                u32x4 w; w.x = cvt_pk_bf16(h[0], h[1]); w.y = cvt_pk_bf16(h[2], h[3]); w.z = cvt_pk_bf16(h[4], h[5]); w.w = cvt_pk_bf16(h[6], h[7]);
                *(u32x4*)p = w;
                asm volatile("" ::: "memory");
            }
    }
};
struct EpiGelu {
    static constexpr bool PERM = false, AFTER_DRAIN = false;
    bf16_t* Hd; const float* bias;
    __device__ __forceinline__ void operator()(const f32x4 (&acc)[2][2][4][2], const Unit& u, int wr, int wc, int fr, int fq) const {
        const int row0 = u.pm * BM + wr * 64 + fr, col0 = wc * 32 + 4 * fq;
#pragma unroll
        for (int bj = 0; bj < 2; ++bj)
#pragma unroll
            for (int n = 0; n < 2; ++n) { const int c = col0 + bj * HALF + n * 16; const f32x4 bv = *(const f32x4*)(bias + c);
#pragma unroll
                for (int ai = 0; ai < 2; ++ai)
#pragma unroll
                    for (int m = 0; m < 4; ++m) { f32x4 v = acc[ai][bj][m][n] + bv;
#pragma unroll
                        for (int i = 0; i < 4; ++i) { const float x = v[i]; const float u2 = 1.5957691216057308f * (x + 0.044715f * x * x * x); v[i] = x * (1.f - __builtin_amdgcn_rcpf(1.f + __expf(u2))); }
                        u32x2 w; w.x = cvt_pk_bf16(v[0], v[1]); w.y = cvt_pk_bf16(v[2], v[3]);
                        *(u32x2*)(Hd + (size_t)(row0 + ai * HALF + m * 16) * 256 + c) = w; asm volatile("" ::: "memory"); } }
    }
};
struct EpiF32 {
    static constexpr bool PERM = false, AFTER_DRAIN = false;
    float* Y; int ldc;
    __device__ __forceinline__ void operator()(const f32x4 (&acc)[2][2][4][2], const Unit& u, int wr, int wc, int fr, int fq) const {
        const int row0 = u.pm * BM + wr * 64 + fr, col0 = u.pn * BM + wc * 32 + 4 * fq;
#pragma unroll
        for (int ai = 0; ai < 2; ++ai)
#pragma unroll
            for (int m = 0; m < 4; ++m) { float* p = Y + (size_t)(row0 + ai * HALF + m * 16) * ldc + col0;
#pragma unroll
                for (int bj = 0; bj < 2; ++bj)
#pragma unroll
                    for (int n = 0; n < 2; ++n) *(f32x4*)(p + bj * HALF + n * 16) = acc[ai][bj][m][n]; }
    }
};
struct EpiWin {
    static constexpr bool PERM = true, AFTER_DRAIN = false;
    bf16_t* PA; float* SM; bf16_t* G;
    __device__ __forceinline__ void operator()(const f32x4 (&acc)[2][2][4][2], const Unit& u, int wr, int wc, int fr, int fq) const {
        const int row0 = u.pm * BM + wr * 64 + fr, cw = wc * 32 + 8 * fq;
        const bool gate = u.pn >= 21;
#pragma unroll
        for (int ai = 0; ai < 2; ++ai)
#pragma unroll
            for (int m = 0; m < 4; ++m) { const size_t row = (size_t)(row0 + ai * HALF + m * 16);
#pragma unroll
                for (int bj = 0; bj < 2; ++bj) {
                    f32x4 v0 = acc[ai][bj][m][0], v1 = acc[ai][bj][m][1];
                    if (gate) {
#pragma unroll
                        for (int i = 0; i < 4; ++i) { v0[i] = sigmoid_f(v0[i]); v1[i] = sigmoid_f(v1[i]); }
                    }
                    u32x4 w; w.x = cvt_pk_bf16(v0[0], v0[1]); w.y = cvt_pk_bf16(v0[2], v0[3]); w.z = cvt_pk_bf16(v1[0], v1[1]); w.w = cvt_pk_bf16(v1[2], v1[3]);
                    if (gate) *(u32x4*)(G + row * 3072 + (u.pn - 21) * BM + bj * HALF + cw) = w;
                    else {
                        const int col = u.pn * BM + bj * HALF + cw;
                        *(u32x4*)(PA + row * 5376 + col) = w;
                        if (col >= 5312) { float* s = SM + row * 64 + (col - 5312); *(f32x4*)s = v0; *(f32x4*)(s + 4) = v1; }
                    }
                    asm volatile("" ::: "memory");
                }
            }
    }
};
struct EpiMerge {
    static constexpr bool PERM = false, AFTER_DRAIN = false;
    const bf16_t* G; float* RMW; bf16_t* MG; int STEP;
    __device__ __forceinline__ void operator()(const f32x4 (&acc)[2][2][4][2], const Unit& u, int wr, int wc, int fr, int fq) const {
        const int row0 = u.pm * BM + wr * 64 + fr, col0 = u.pn * BM + wc * 32 + 4 * fq;
#pragma unroll
        for (int ai = 0; ai < 2; ++ai)
#pragma unroll
            for (int m = 0; m < 4; ++m) { const size_t row = (size_t)(row0 + ai * HALF + m * 16);
#pragma unroll
                for (int bj = 0; bj < 2; ++bj)
#pragma unroll
                    for (int n = 0; n < 2; ++n) { const int c = col0 + bj * HALF + n * 16;
                        const u32x2 gw = *(const u32x2*)(G + row * 3072 + c);
                        f32x4 v = acc[ai][bj][m][n]; v[0] *= bflo(gw.x); v[1] *= bfhi(gw.x); v[2] *= bflo(gw.y); v[3] *= bfhi(gw.y);
                        float* r = RMW + row * 1024 + c;
                        if (STEP == 0) *(f32x4*)r = v;
                        else if (STEP == 1) *(f32x4*)r = *(const f32x4*)r + v;
                        else { v = *(const f32x4*)r + v; u32x2 w; w.x = cvt_pk_bf16(v[0], v[1]); w.y = cvt_pk_bf16(v[2], v[3]); *(u32x2*)(MG + row * 1024 + c) = w; }
                    }
            }
    }
};

template <class Epi, class Sched, bool ALIGN_EPI = false, bool SP2 = false>
__device__ __forceinline__ void gemm_phase(PG8_LAS unsigned char* lds, const Gemm g, const Sched& S, const Epi& E) {
    int tid_ = threadIdx.x; asm volatile("" : "+v"(tid_));
    const int tid = tid_, wid = __builtin_amdgcn_readfirstlane(tid >> 6), lane = tid & 63, wr = wid >> 2, wc = wid & 3, fr = lane & 15, fq = lane >> 4;
    const int K = g.K, nt = K / BK, lda = g.lda;
    unsigned voffA[2], voffB[2];
#pragma unroll
    for (int i = 0; i < 2; ++i) { int R, C; stage_rc(tid * 16 + i * 8192, R, C); const int Rb = Epi::PERM ? ((R & ~31) + perm32(R & 31)) : R;
        voffA[i] = (unsigned)(R * lda + C) * 2u; voffB[i] = (unsigned)(Rb * K + C) * 2u; }
    const size_t kstep = (size_t)(BK * 2);
    const size_t hstepA = (size_t)HALF * lda * 2, tstepA = 2 * hstepA;
    const size_t hstep = (size_t)HALF * K * 2;
    const size_t tstep = 2 * hstep;
    const unsigned ldsw = (unsigned)wid * 1024u;
    const int aoff = lds_byte(wr * 64 + fr, fq * 8), boff = lds_byte(wc * 32 + fr, fq * 8);
#define PG8_SA(b, h) (((b) * 2 + (h)) * HTB)
#define PG8_SB(b, h) ((4 + (b) * 2 + (h)) * HTB)
#define PG8_STAGE(bufoff, gbase, voff) do { _Pragma("unroll") for (int _i = 0; _i < 2; ++_i) \
        __builtin_amdgcn_global_load_lds((const unsigned*)((const char*)(gbase) + (voff)[_i]), (PG8_LAS unsigned*)(lds + (bufoff) + ldsw + _i * 8192), 16, 0, 0); } while (0)
#define PG8_LDA(dst, b, h) do { _Pragma("unroll") for (int m = 0; m < 4; ++m) _Pragma("unroll") for (int k = 0; k < 2; ++k) dst[m][k] = *(const PG8_LAS bf16x8*)(lds + PG8_SA(b, h) + aoff + m * 2048 + k * 1024); } while (0)
#define PG8_LDB(dst, b, h) do { _Pragma("unroll") for (int n = 0; n < 2; ++n) _Pragma("unroll") for (int k = 0; k < 2; ++k) dst[n][k] = *(const PG8_LAS bf16x8*)(lds + PG8_SB(b, h) + boff + n * 2048 + k * 1024); } while (0)
#define PG8_MMA(ai, bj, At, Bt) do { __builtin_amdgcn_s_setprio(1); _Pragma("unroll") for (int m = 0; m < 4; ++m) _Pragma("unroll") for (int n = 0; n < 2; ++n) _Pragma("unroll") for (int k = 0; k < 2; ++k) \
        acc[ai][bj][m][n] = __builtin_amdgcn_mfma_f32_16x16x32_bf16(Bt[n][k], At[m][k], acc[ai][bj][m][n], 0, 0, 0); __builtin_amdgcn_s_setprio(0); } while (0)
#define PG8_WAIT_V(n) asm volatile("s_waitcnt vmcnt(" #n ")" ::: "memory")
#define PG8_WAIT_L(n) asm volatile("s_waitcnt lgkmcnt(" #n ")" ::: "memory")
#define PG8_BAR __builtin_amdgcn_s_barrier()
#define PG8_SCHED __builtin_amdgcn_sched_barrier(0)
    Unit cur, nxt; int ui = 0;
    if (!S.next(0, cur)) return;
    f32x4 acc[2][2][4][2];
#pragma unroll
    for (int a = 0; a < 2; ++a)
#pragma unroll
        for (int b = 0; b < 2; ++b)
#pragma unroll
            for (int m = 0; m < 4; ++m)
#pragma unroll
                for (int n = 0; n < 2; ++n) acc[a][b][m][n] = (f32x4){0.f, 0.f, 0.f, 0.f};
    bf16x8 At[4][2], B0[2][2], B1[2][2];
    const char* cA = (const char*)g.A + (size_t)cur.pm * tstepA; const char* cB = (const char*)g.Bt + (size_t)cur.pn * tstep;
    S.a_ready(cur);
    if constexpr (SP2) {
        PG8_STAGE(PG8_SB(0, 0), cB, voffB); PG8_STAGE(PG8_SB(0, 1), cB + hstep, voffB); PG8_STAGE(PG8_SA(0, 0), cA, voffA); PG8_STAGE(PG8_SA(0, 1), cA + hstepA, voffA);
        if (wr == 1) PG8_BAR;
        PG8_WAIT_V(2); PG8_BAR;
        PG8_STAGE(PG8_SB(1, 0), cB + kstep, voffB); PG8_STAGE(PG8_SA(1, 0), cA + kstep, voffA); PG8_STAGE(PG8_SB(1, 1), cB + hstep + kstep, voffB);
        PG8_WAIT_V(6); PG8_BAR;
    } else {
        PG8_STAGE(PG8_SB(0, 0), cB, voffB); PG8_STAGE(PG8_SA(0, 0), cA, voffA); PG8_STAGE(PG8_SB(0, 1), cB + hstep, voffB); PG8_STAGE(PG8_SA(0, 1), cA + hstepA, voffA);
        if (wr == 1) PG8_BAR;
        PG8_WAIT_V(4); PG8_BAR;
        PG8_STAGE(PG8_SB(1, 0), cB + kstep, voffB); PG8_STAGE(PG8_SA(1, 0), cA + kstep, voffA); PG8_STAGE(PG8_SB(1, 1), cB + hstep + kstep, voffB);
        PG8_WAIT_V(6); PG8_BAR;
    }
    for (;;) {
        const bool has_next = S.next(ui + 1, nxt);
        const char* nA = has_next ? (const char*)g.A + (size_t)nxt.pm * tstepA : cA; const char* nB = has_next ? (const char*)g.Bt + (size_t)nxt.pn * tstep : cB;
        for (int t = 0; t < nt; t += 2) {
            const bool last = (t == nt - 2);
            const char* a1 = cA + (size_t)(t + 1) * kstep;
            const char* a2 = last ? nA : cA + (size_t)(t + 2) * kstep; const char* b2 = last ? nB : cB + (size_t)(t + 2) * kstep;
            const char* a3 = a2 + kstep; const char* b3 = b2 + kstep;
            if (last && has_next) S.a_ready(nxt);
            if constexpr (SP2) {
            PG8_LDB(B0, 0, 0); PG8_LDB(B1, 0, 1); PG8_SCHED; PG8_LDA(At, 0, 0); PG8_STAGE(PG8_SA(1, 1), a1 + hstepA, voffA);
            PG8_WAIT_V(8); PG8_WAIT_L(0); PG8_BAR; PG8_MMA(0, 0, At, B0); PG8_MMA(0, 1, At, B1); PG8_BAR; PG8_SCHED;
            PG8_LDA(At, 0, 1); PG8_STAGE(PG8_SB(0, 0), b2, voffB); PG8_STAGE(PG8_SB(0, 1), b2 + hstep, voffB); PG8_STAGE(PG8_SA(0, 0), a2, voffA);
            PG8_WAIT_V(8); PG8_WAIT_L(0); PG8_BAR; PG8_MMA(1, 0, At, B0); PG8_MMA(1, 1, At, B1); PG8_BAR; PG8_SCHED;
            PG8_LDB(B0, 1, 0); PG8_LDB(B1, 1, 1); PG8_SCHED; PG8_LDA(At, 1, 0); PG8_STAGE(PG8_SA(0, 1), a2 + hstepA, voffA);
            PG8_WAIT_V(8); PG8_WAIT_L(0); PG8_BAR; PG8_MMA(0, 0, At, B0); PG8_MMA(0, 1, At, B1); PG8_BAR; PG8_SCHED;
            PG8_LDA(At, 1, 1); PG8_STAGE(PG8_SB(1, 0), b3, voffB); PG8_STAGE(PG8_SB(1, 1), b3 + hstep, voffB); PG8_STAGE(PG8_SA(1, 0), a3, voffA);
            PG8_WAIT_V(8); PG8_WAIT_L(0); PG8_BAR; PG8_MMA(1, 0, At, B0); PG8_MMA(1, 1, At, B1); PG8_BAR; PG8_SCHED;
            } else {
            PG8_LDB(B0, 0, 0); PG8_SCHED; PG8_LDA(At, 0, 0); PG8_STAGE(PG8_SA(1, 1), a1 + hstepA, voffA);
            PG8_WAIT_L(8); PG8_BAR; PG8_WAIT_L(0); PG8_MMA(0, 0, At, B0); PG8_BAR; PG8_SCHED;
            PG8_LDB(B1, 0, 1); PG8_STAGE(PG8_SB(0, 0), b2, voffB);
            PG8_BAR; PG8_WAIT_L(0); PG8_MMA(0, 1, At, B1); PG8_BAR;
            PG8_LDA(At, 0, 1); PG8_STAGE(PG8_SA(0, 0), a2, voffA);
            PG8_BAR; PG8_WAIT_L(0); PG8_MMA(1, 0, At, B0); PG8_BAR; PG8_SCHED;
            PG8_STAGE(PG8_SB(0, 1), b2 + hstep, voffB);
            PG8_WAIT_V(6); PG8_BAR; PG8_MMA(1, 1, At, B1); PG8_BAR;
            PG8_LDB(B0, 1, 0); PG8_SCHED; PG8_LDA(At, 1, 0); PG8_STAGE(PG8_SA(0, 1), a2 + hstepA, voffA);
            PG8_WAIT_L(8); PG8_BAR; PG8_WAIT_L(0); PG8_MMA(0, 0, At, B0); PG8_BAR; PG8_SCHED;
            PG8_LDB(B1, 1, 1); PG8_STAGE(PG8_SB(1, 0), b3, voffB);
            PG8_BAR; PG8_WAIT_L(0); PG8_MMA(0, 1, At, B1); PG8_BAR;
            PG8_LDA(At, 1, 1); PG8_STAGE(PG8_SA(1, 0), a3, voffA);
            PG8_BAR; PG8_WAIT_L(0); PG8_MMA(1, 0, At, B0); PG8_BAR; PG8_SCHED;
            PG8_STAGE(PG8_SB(1, 1), b3 + hstep, voffB);
            PG8_WAIT_V(6); PG8_BAR; PG8_MMA(1, 1, At, B1); PG8_BAR;
            }
        }
        if constexpr (ALIGN_EPI) { if (wr == 0) PG8_BAR; }
        if constexpr (!Epi::AFTER_DRAIN) { E(acc, cur, wr, wc, fr, fq); S.done(cur); }
        if (!has_next) break;
#pragma unroll
        for (int a = 0; a < 2; ++a)
#pragma unroll
            for (int b = 0; b < 2; ++b)
#pragma unroll
                for (int m = 0; m < 4; ++m)
#pragma unroll
                    for (int n = 0; n < 2; ++n) acc[a][b][m][n] = (f32x4){0.f, 0.f, 0.f, 0.f};
        cur = nxt; cA = nA; cB = nB; ++ui;
        if constexpr (ALIGN_EPI) { if (wr == 1) PG8_BAR; }
    }
    PG8_WAIT_V(0);
    if constexpr (!ALIGN_EPI) { if (wr == 0) PG8_BAR; }
    PG8_BAR;
    if constexpr (Epi::AFTER_DRAIN) { E.fused(acc, cur, wr, wc, fr, fq, lds, wid, lane); S.done(cur); }
#undef PG8_SA
#undef PG8_SB
#undef PG8_STAGE
#undef PG8_LDA
#undef PG8_LDB
#undef PG8_MMA
#undef PG8_WAIT_V
#undef PG8_WAIT_L
#undef PG8_BAR
#undef PG8_SCHED
}
}

constexpr int NWAVES = 8, NTHR = 512;
constexpr int NBATCH = 2, SEQ = 8192, MTOK = NBATCH * SEQ, DM = 1024, DFF = 2816, DIN_SRC = 8432, NIN = 8448, NPA = 5376, NMG = 3072, DEPTH = 2;
constexpr float NORM_EPS = 1e-6f;
constexpr int PA_GQ = 0, PA_GK = 512, PA_GV = 1024, PA_GZ = 1536, PA_NQ = 2048, PA_KC = 2816, PA_KS = 3136, PA_KW = 3456, PA_LQ = 3776, PA_LK = 4032, PA_LV = 4288, PA_LR = 4800, PA_SM = 5312;
constexpr size_t MiB = 1u << 20;
constexpr size_t WS_CTL = 0, CTL_ZERO_BYTES = 1 * MiB;
constexpr size_t WS_WGU = 1 * MiB, WS_WD = 12 * MiB, WS_WIN = WS_WD + 5632 * 1024, WS_WB = WS_WIN + (size_t)NIN * DM * 2, WS_WO = WS_WB + 3 * MiB;
constexpr size_t WS_XN = 40 * MiB, WS_A = 72 * MiB, WS_G = 160 * MiB, WS_O = 208 * MiB, WS_QKV = 232 * MiB, WS_SM = 290 * MiB, WS_GATES = 258 * MiB, WS_ORAW = 259 * MiB, WS_VTS = 270 * MiB, WS_VTW = 272 * MiB, WS_KCMP = 275 * MiB, WS_KCL = WS_KCMP + 256 * 1024, WS_VCT = WS_KCMP + 512 * 1024, WS_END = 276 * MiB;
constexpr size_t WS_H = WS_A, WS_Y = WS_G;
constexpr size_t WS_RMW = WS_A, WS_MG = WS_A + 32 * MiB, WS_YB = WS_A + 48 * MiB;
static_assert(WS_WO + 2 * MiB <= WS_XN && WS_Y + 64 * MiB <= WS_QKV && WS_YB + 32 * MiB <= WS_G, "ws map");
constexpr int CW_BAR = 4096, CW_Q = 8192;
constexpr int RING_BYTES = 131072, LDSCTL_OFF = RING_BYTES, MISC_OFF = LDSCTL_OFF + 320, BTAB_OFF = RING_BYTES + 1024, RELB_OFF = RING_BYTES + 1536, LDS_BYTES = 147456;

#define GAS __attribute__((address_space(1)))
#define LAS __attribute__((address_space(3)))
typedef unsigned short bf16;
typedef unsigned v4u __attribute__((ext_vector_type(4)));
typedef unsigned v2u __attribute__((ext_vector_type(2)));
typedef float f32x4 __attribute__((ext_vector_type(4)));
#define LDS_WAIT() asm volatile("s_waitcnt lgkmcnt(0)" ::: "memory")
__device__ __forceinline__ unsigned f2bf(float f) { unsigned u = __builtin_bit_cast(unsigned, f); return (u + 0x7fffu + ((u >> 16) & 1u)) >> 16; }
__device__ __forceinline__ unsigned pk2(float lo, float hi) { return f2bf(lo) | (f2bf(hi) << 16); }
__device__ __forceinline__ float bf2f(bf16 h) { return __uint_as_float((unsigned)h << 16); }
__device__ __forceinline__ float bflo(unsigned w) { return __uint_as_float(w << 16); }
__device__ __forceinline__ float bfhi(unsigned w) { return __uint_as_float(w & 0xffff0000u); }
__device__ __forceinline__ float wave_sum(float v) {
#pragma unroll
    for (int o = 1; o < 64; o <<= 1) v += __shfl_xor(v, o);
    return v;
}
__device__ __forceinline__ float wave_max(float v) {
#pragma unroll
    for (int o = 1; o < 64; o <<= 1) v = fmaxf(v, __shfl_xor(v, o));
    return v;
}
__device__ __forceinline__ float sigmoidf_(float x) { return 1.f / (1.f + expf(-x)); }
__device__ __forceinline__ float siluf_(float x) { return x / (1.f + expf(-x)); }
__device__ __forceinline__ float softplusf_(float x) { return x > 20.f ? x : log1pf(expf(x)); }
__device__ __forceinline__ float logsigmoidf_(float x) { return fminf(x, 0.f) - log1pf(expf(-fabsf(x))); }
__device__ __forceinline__ float gelu_tanhf_(float x) { return 0.5f * x * (1.f + tanhf(0.7978845608028654f * (x + 0.044715f * x * x * x))); }

#define XB_TMO      128
#define XB_XCNT(j)  (256  + 64 * (j))
#define XB_XSUB(j)  (1280 + 64 * (j))
#define XB_XGEN(j)  (2304 + 64 * (j))
#define XB_TOP      3328
#define XB_TOPGEN   3392
#define XCD_BAR_WORDS 3456
#define XB_SPIN_CAP (1u << 22)
__device__ __forceinline__ unsigned xb_ld(unsigned* p)              { return __hip_atomic_load(p, __ATOMIC_RELAXED, __HIP_MEMORY_SCOPE_AGENT); }
__device__ __forceinline__ unsigned xb_add(unsigned* p, unsigned v) { return __hip_atomic_fetch_add(p, v, __ATOMIC_RELAXED, __HIP_MEMORY_SCOPE_AGENT); }
__device__ __forceinline__ unsigned xb_xcc_id() { return (unsigned)__builtin_amdgcn_s_getreg((3 << 11) | 20) & 0xFu; }
#define XB_SPIN(cond, bar) do { unsigned _sp = 0; while (cond) { __builtin_amdgcn_s_sleep(1); \
    if ((++_sp & 255u) == 0u) { if (xb_ld(&(bar)[XB_TMO])) break; if (_sp > XB_SPIN_CAP) { atomicAdd(&(bar)[XB_TMO], 1u); break; } } } } while (0)
struct XcdBarrier { unsigned* bar; unsigned x; volatile LAS unsigned* st; };
__device__ __forceinline__ XcdBarrier xcd_barrier_post(unsigned* bar, volatile LAS unsigned* st) {
    XcdBarrier b; b.bar = bar; b.x = xb_xcc_id(); b.st = st;
    if (threadIdx.x == 0) (void)xb_add(&bar[XB_XCNT(b.x)], 1u);
    return b;
}
__device__ __forceinline__ void xcd_barrier_complete(unsigned* bar, unsigned x, unsigned& nloc, unsigned& nx) {
    const unsigned G = gridDim.x * gridDim.y * gridDim.z;
    unsigned sum, cnt, mine, sp = 0u;
    for (;;) {
        sum = 0u; cnt = 0u; mine = 0u;
#pragma unroll
        for (unsigned j = 0; j < 16; ++j) { const unsigned c = xb_ld(&bar[XB_XCNT(j)]); sum += c; cnt += (c > 0u) ? 1u : 0u; mine = (j == x) ? c : mine; }
        if (sum == G) break;
        __builtin_amdgcn_s_sleep(1);
        if ((++sp & 255u) == 0u) { if (xb_ld(&bar[XB_TMO])) break; if (sp > XB_SPIN_CAP) { atomicAdd(&bar[XB_TMO], 1u); break; } }
    }
    nloc = mine > 0u ? mine : 1u; nx = cnt > 0u ? cnt : 1u;
}
__device__ __forceinline__ void xcd_barrier(const XcdBarrier& b) {
    asm volatile("s_waitcnt vmcnt(0)" ::: "memory");
    __syncthreads();
    if (threadIdx.x == 0) {
        unsigned* bar = b.bar;
        __builtin_amdgcn_s_waitcnt(0);
        unsigned nloc = b.st[0], nx = b.st[1];
        if (nloc == 0u) { xcd_barrier_complete(bar, b.x, nloc, nx); b.st[0] = nloc; b.st[1] = nx; }
        const unsigned old = xb_add(&bar[XB_XSUB(b.x)], 1u);
        const unsigned gen = old / nloc;
        if (old + 1u == (gen + 1u) * nloc) {
            __builtin_amdgcn_fence(__ATOMIC_RELEASE, "agent");
            asm volatile("s_waitcnt vmcnt(0)" ::: "memory");
            const unsigned og = xb_add(&bar[XB_TOP], 1u);
            const unsigned tg = og / nx;
            if (og + 1u == (tg + 1u) * nx) xb_add(&bar[XB_TOPGEN], 1u);
            else XB_SPIN(xb_ld(&bar[XB_TOPGEN]) == tg, bar);
            __builtin_amdgcn_fence(__ATOMIC_ACQUIRE, "agent");
            xb_add(&bar[XB_XGEN(b.x)], 1u);
            asm volatile("s_waitcnt vmcnt(0)" ::: "memory");
        } else {
            XB_SPIN(xb_ld(&bar[XB_XGEN(b.x)]) == gen, bar);
            __builtin_amdgcn_fence(__ATOMIC_ACQUIRE, "agent");
            asm volatile("s_waitcnt vmcnt(0)" ::: "memory");
        }
    }
    __syncthreads();
}

constexpr int MAXPH = 128;
struct Args { const float* in[30]; float* out; unsigned char* ws; int ph_lo, ph_hi; unsigned char prog[MAXPH]; };
enum { I_X = 0, I_RELB, I_F1PRE, I_F1GU, I_F1D, I_F1POST, I_MPRE, I_WIN, I_CONVW, I_ALOG, I_DTB, I_GDNNW, I_PEK, I_W1K, I_W2K, I_PEV, I_W1V, I_W2V, I_GGW, I_GGB, I_GLANW, I_WBG, I_WBN, I_WBL, I_WOUT, I_MPOST, I_F2PRE, I_F2GU, I_F2D, I_F2POST };

template <class RowMap>
__device__ __forceinline__ void transpose_item(const float* W, int K, int N, bf16* WT, LAS float* scr, int item, int lane, const RowMap& rm) {
    const int nblk = (N + 31) / 32, kb = item / nblk, nb = item % nblk, k0 = 64 * kb, n0 = 32 * nb;
    const bool okc = (n0 + (lane & 31)) < N;
#pragma unroll 8
    for (int i = 0; i < 32; ++i) { const int kk = 2 * i + (lane >> 5); scr[kk * 33 + (lane & 31)] = okc ? W[(size_t)(k0 + kk) * N + n0 + (lane & 31)] : 0.f; }
    LDS_WAIT(); asm volatile("" ::: "memory");
    const int c = lane & 7;
#pragma unroll
    for (int j = 0; j < 4; ++j) { const int n = (lane >> 3) + 8 * j; const LAS float* s = scr + (8 * c) * 33 + n;
        v4u o; o.x = pk2(s[0 * 33], s[1 * 33]); o.y = pk2(s[2 * 33], s[3 * 33]); o.z = pk2(s[4 * 33], s[5 * 33]); o.w = pk2(s[6 * 33], s[7 * 33]);
        if (n0 + n < N) *(v4u*)(WT + (size_t)rm(n0 + n) * K + k0 + 8 * c) = o; }
    LDS_WAIT(); asm volatile("" ::: "memory");
}
struct MapId { __device__ __forceinline__ int operator()(int n) const { return n; } };
struct MapGU { __device__ __forceinline__ int operator()(int n) const { const int u = n >= DFF, j = u ? n - DFF : n; return 256 * (j >> 7) + 128 * u + (j & 127); } };
struct MapWin { __device__ __forceinline__ int operator()(int c) const {
    if (c < 2048) return c;
    if (c < 2056) return PA_SM + (c - 2048);
    if (c < 2824) return PA_NQ + (c - 2056);
    if (c < 3784) return PA_KC + (c - 2824);
    if (c < 3808) return PA_SM + 8 + (c - 3784);
    if (c < 5344) return PA_LQ + (c - 3808);
    if (c < 5360) return PA_SM + 32 + (c - 5344);
    return NPA + (c - 5360); } };

__device__ __forceinline__ void row_pass(const float* xin, const float* y, const float* wpost, float scale, float* xout, const float* wnext, bf16* xn, int lane) {
    f32x4 v[4];
#pragma unroll
    for (int j = 0; j < 4; ++j) v[j] = ((const f32x4*)xin)[lane + 64 * j];
    if (y) {
        f32x4 yv[4]; float s = 0.f;
#pragma unroll
        for (int j = 0; j < 4; ++j) { yv[j] = ((const f32x4*)y)[lane + 64 * j]; s += (yv[j].x * yv[j].x + yv[j].y * yv[j].y) + (yv[j].z * yv[j].z + yv[j].w * yv[j].w); }
        const float r = scale / sqrtf(wave_sum(s) * (1.f / DM) + NORM_EPS);
#pragma unroll
        for (int j = 0; j < 4; ++j) { const f32x4 w = ((const f32x4*)wpost)[lane + 64 * j]; v[j] = v[j] + yv[j] * w * r; }
    }
    if (xout) {
#pragma unroll
        for (int j = 0; j < 4; ++j) ((f32x4*)xout)[lane + 64 * j] = v[j];
    }
    if (xn) {
        float s = 0.f;
#pragma unroll
        for (int j = 0; j < 4; ++j) s += (v[j].x * v[j].x + v[j].y * v[j].y) + (v[j].z * v[j].z + v[j].w * v[j].w);
        const float r = 1.f / sqrtf(wave_sum(s) * (1.f / DM) + NORM_EPS);
#pragma unroll
        for (int j = 0; j < 4; ++j) { const f32x4 w = ((const f32x4*)wnext)[lane + 64 * j]; const f32x4 o = v[j] * w * r;
            v2u pk; pk.x = pk2(o.x, o.y); pk.y = pk2(o.z, o.w); ((v2u*)xn)[lane + 64 * j] = pk; }
    }
}

__device__ __forceinline__ void gdn_out_item(const float* ORAW, const bf16* PA, const float* nw, bf16* OA, int t, int h, int lane) {
    const float o0 = ORAW[(size_t)t * 512 + h * 128 + 2 * lane], o1 = ORAW[(size_t)t * 512 + h * 128 + 2 * lane + 1];
    const float rr = 1.f / sqrtf(wave_sum(o0 * o0 + o1 * o1) * (1.f / 128.f) + NORM_EPS);
    const unsigned z = *(const unsigned*)(PA + (size_t)t * NPA + PA_GZ + h * 128 + 2 * lane);
    *(unsigned*)(OA + (size_t)t * 512 + h * 128 + 2 * lane) = pk2(o0 * rr * nw[2 * lane] * siluf_(bflo(z)), o1 * rr * nw[2 * lane + 1] * siluf_(bfhi(z)));
}

typedef short bf16x8 __attribute__((ext_vector_type(8)));
#define MFMA16(a, b, c) __builtin_amdgcn_mfma_f32_16x16x32_bf16((a), (b), (c), 0, 0, 0)
__device__ __forceinline__ int kperm32(int p) { const int q = p >> 3, j = p & 7; return j < 4 ? 4 * q + j : 16 + 4 * q + (j - 4); }
__device__ __forceinline__ bf16x8 pack_ctiles(const f32x4& t0, const f32x4& t1) {
    v4u w; w.x = pk2(t0[0], t0[1]); w.y = pk2(t0[2], t0[3]); w.z = pk2(t1[0], t1[1]); w.w = pk2(t1[2], t1[3]); return __builtin_bit_cast(bf16x8, w);
}
constexpr int GLA_CH = 64, NCHUNK = SEQ / 64;
constexpr size_t GLA_QD = 0, GLA_KT = GLA_QD + (size_t)NCHUNK * 4 * 8192, GLA_AI = GLA_KT + (size_t)NCHUNK * 4 * 8192, GLA_CD = GLA_AI + (size_t)NCHUNK * 4 * 8192, GLA_BYTES = GLA_CD + (size_t)NCHUNK * 4 * 256, GLA_VBYTES = (size_t)NCHUNK * 4 * 16384;
__device__ __forceinline__ void gla_prep_item(const bf16* PA, const float* SM, const float* ggw, const float* ggb, unsigned char* img, unsigned char* imgv, int n, int h, float* sl, int tid) {
    float* Qs = sl; float* Ks = sl + 64 * 65; float* BC = sl + 2 * 64 * 65; bf16* Vs = (bf16*)(sl + 3 * 64 * 65);
    const int t0 = n * 64, ch = n * 4 + h, lane = tid & 63, wave = tid >> 6;
    __syncthreads();
    {
        const int c = tid >> 3, dg = tid & 7;
        const bf16* row = PA + (size_t)(t0 + c) * NPA;
        const v4u q8 = *(const v4u*)(row + PA_LQ + h * 64 + dg * 8), k8 = *(const v4u*)(row + PA_LK + h * 64 + dg * 8);
        const float qv[8] = {bflo(q8.x), bfhi(q8.x), bflo(q8.y), bfhi(q8.y), bflo(q8.z), bfhi(q8.z), bflo(q8.w), bfhi(q8.w)};
        const float kv[8] = {bflo(k8.x), bfhi(k8.x), bflo(k8.y), bfhi(k8.y), bflo(k8.z), bfhi(k8.z), bflo(k8.w), bfhi(k8.w)};
        const float* al = SM + (size_t)(t0 + c) * 64 + 32;
        float x[8];
#pragma unroll
        for (int j = 0; j < 8; ++j) x[j] = ggb[h * 64 + dg * 8 + j];
#pragma unroll
        for (int r = 0; r < 16; ++r) { const float a = al[r];
#pragma unroll
            for (int j = 0; j < 8; ++j) x[j] += a * ggw[r * 256 + h * 64 + dg * 8 + j]; }
#pragma unroll
        for (int j = 0; j < 8; ++j) { const int d = dg * 8 + j; Qs[c * 65 + d] = qv[j] * 0.125f; Ks[c * 65 + d] = kv[j]; BC[c * 65 + d] = logsigmoidf_(x[j]) * (1.f / 16.f); }
        const v4u va = *(const v4u*)(row + PA_LV + h * 128 + dg * 16), vb = *(const v4u*)(row + PA_LV + h * 128 + dg * 16 + 8);
        *(v4u*)(Vs + c * 136 + dg * 16) = va; *(v4u*)(Vs + c * 136 + dg * 16 + 8) = vb;
    }
    __syncthreads();
    if (tid < 64) { float run = 0.f; for (int c = 0; c < 64; ++c) { run += BC[c * 65 + tid]; BC[c * 65 + tid] = run; } }
    __syncthreads();
    {
        bf16* QD = (bf16*)(img + GLA_QD) + (size_t)ch * 4096; bf16* KT = (bf16*)(img + GLA_KT) + (size_t)ch * 4096; float* CD = (float*)(img + GLA_CD) + (size_t)ch * 64;
        const int r = tid >> 3, pg = tid & 7;
        float o[8];
#pragma unroll
        for (int j = 0; j < 8; ++j) { const int p = pg * 8 + j, d = (p & 32) + kperm32(p & 31); o[j] = Qs[r * 65 + d] * expf(BC[r * 65 + d]); }
        v4u w; w.x = pk2(o[0], o[1]); w.y = pk2(o[2], o[3]); w.z = pk2(o[4], o[5]); w.w = pk2(o[6], o[7]);
        *(v4u*)(QD + r * 64 + pg * 8) = w;
#pragma unroll
        for (int j = 0; j < 8; ++j) { const int c = pg * 8 + j; o[j] = Ks[c * 65 + r] * expf(BC[63 * 65 + r] - BC[c * 65 + r]); }
        w.x = pk2(o[0], o[1]); w.y = pk2(o[2], o[3]); w.z = pk2(o[4], o[5]); w.w = pk2(o[6], o[7]);
        *(v4u*)(KT + r * 64 + pg * 8) = w;
        if (tid < 64) CD[tid] = expf(BC[63 * 65 + tid]);
        bf16* VI = (bf16*)(imgv) + (size_t)ch * 8192;
#pragma unroll
        for (int i = 0; i < 2; ++i) { const int f = tid + 512 * i, ws = f >> 7, kk = (f >> 6) & 1, l = f & 63, q = l >> 4, col = l & 15;
            unsigned short e[8];
#pragma unroll
            for (int j = 0; j < 8; ++j) e[j] = Vs[(32 * kk + 8 * q + j) * 136 + 16 * ws + col];
            v4u vw; vw.x = e[0] | ((unsigned)e[1] << 16); vw.y = e[2] | ((unsigned)e[3] << 16); vw.z = e[4] | ((unsigned)e[5] << 16); vw.w = e[6] | ((unsigned)e[7] << 16);
            *(v4u*)(VI + (size_t)f * 8) = vw; }
    }
    {
        bf16* AI = (bf16*)(img + GLA_AI) + (size_t)ch * 4096;
        const int q = lane >> 4, fr = lane & 15;
#pragma unroll 1
        for (int i = 0; i < 2; ++i) { const int tl = wave + 8 * i, ib = tl >> 2, jb = tl & 3;
            f32x4 acc = {0.f, 0.f, 0.f, 0.f};
            if (jb <= ib) {
#pragma unroll
                for (int kk = 0; kk < 2; ++kk) { float a[8], b[8];
#pragma unroll
                    for (int j = 0; j < 8; ++j) { const int d = 32 * kk + 8 * q + j; const float ref = ib > 0 ? BC[(16 * ib - 1) * 65 + d] : 0.f;
                        a[j] = Qs[(16 * ib + fr) * 65 + d] * expf(BC[(16 * ib + fr) * 65 + d] - ref);
                        b[j] = Ks[(16 * jb + fr) * 65 + d] * expf(ref - BC[(16 * jb + fr) * 65 + d]); }
                    v4u aw, bw; aw.x = pk2(a[0], a[1]); aw.y = pk2(a[2], a[3]); aw.z = pk2(a[4], a[5]); aw.w = pk2(a[6], a[7]);
                    bw.x = pk2(b[0], b[1]); bw.y = pk2(b[2], b[3]); bw.z = pk2(b[4], b[5]); bw.w = pk2(b[6], b[7]);
                    acc = MFMA16(__builtin_bit_cast(bf16x8, aw), __builtin_bit_cast(bf16x8, bw), acc); }
            }
#pragma unroll
            for (int r = 0; r < 4; ++r) { const int row = 4 * q + r; float v = acc[r]; if (jb == ib && fr > row) v = 0.f; AI[(16 * ib + row) * 64 + 16 * jb + fr] = (bf16)f2bf(v); }
        }
    }
}
constexpr int GLA_BUF = 3 * 64 * 144 + 256;
__device__ __forceinline__ void gla_scan_block(const unsigned char* img, const unsigned char* imgv, bf16* OC, int h, unsigned char* lds, int tid) {
    const int lane = tid & 63, ws = __builtin_amdgcn_readfirstlane(tid >> 6), q = lane >> 4, fr = lane & 15;
    f32x4 S[4];
#pragma unroll
    for (int i = 0; i < 4; ++i) S[i] = (f32x4){0.f, 0.f, 0.f, 0.f};
    v4u st[3]; v4u stc = {0u, 0u, 0u, 0u}; v4u vB[2];
#define GLA_FETCH(N) do { const int ch_ = (N) * 4 + h; \
        st[0] = *(const v4u*)(img + GLA_QD + (size_t)ch_ * 8192 + tid * 16); st[1] = *(const v4u*)(img + GLA_AI + (size_t)ch_ * 8192 + tid * 16); st[2] = *(const v4u*)(img + GLA_KT + (size_t)ch_ * 8192 + tid * 16); \
        if (tid < 16) stc = *(const v4u*)(img + GLA_CD + (size_t)ch_ * 256 + tid * 16); \
        vB[0] = *(const v4u*)(imgv + (size_t)ch_ * 16384 + (ws * 2 + 0) * 1024 + lane * 16); vB[1] = *(const v4u*)(imgv + (size_t)ch_ * 16384 + (ws * 2 + 1) * 1024 + lane * 16); } while (0)
#define GLA_PUT(B) do { unsigned char* b_ = lds + (B) * GLA_BUF; const int r_ = tid >> 3, c_ = tid & 7; \
        *(v4u*)(b_ + r_ * 144 + c_ * 16) = st[0]; *(v4u*)(b_ + 64 * 144 + r_ * 144 + c_ * 16) = st[1]; *(v4u*)(b_ + 2 * 64 * 144 + r_ * 144 + c_ * 16) = st[2]; \
        if (tid < 16) *(v4u*)(b_ + 3 * 64 * 144 + tid * 16) = stc; } while (0)
    __syncthreads();
    GLA_FETCH(0); GLA_PUT(0);
    __syncthreads();
    for (int n = 0; n < NCHUNK; ++n) {
        const unsigned char* b = lds + (n & 1) * GLA_BUF;
        const v4u vb0 = vB[0], vb1 = vB[1];
        if (n + 1 < NCHUNK) GLA_FETCH(n + 1);
        const bf16x8 v0 = __builtin_bit_cast(bf16x8, vb0), v1 = __builtin_bit_cast(bf16x8, vb1);
        const bf16x8 s0 = pack_ctiles(S[0], S[1]), s1 = pack_ctiles(S[2], S[3]);
        f32x4 o[4];
#pragma unroll
        for (int m = 0; m < 4; ++m) {
            const unsigned char* ar = b + (16 * m + fr) * 144 + q * 16;
            const bf16x8 qa0 = *(const bf16x8*)(ar), qa1 = *(const bf16x8*)(ar + 64);
            const bf16x8 aa0 = *(const bf16x8*)(ar + 64 * 144);
            f32x4 acc = {0.f, 0.f, 0.f, 0.f};
            acc = MFMA16(qa0, s0, acc); acc = MFMA16(qa1, s1, acc); acc = MFMA16(aa0, v0, acc);
            if (m >= 2) { const bf16x8 aa1 = *(const bf16x8*)(ar + 64 * 144 + 64); acc = MFMA16(aa1, v1, acc); }
            o[m] = acc;
        }
#pragma unroll
        for (int dt = 0; dt < 4; ++dt) {
            const unsigned char* kr = b + 2 * 64 * 144 + (16 * dt + fr) * 144 + q * 16;
            const bf16x8 k0 = *(const bf16x8*)(kr), k1 = *(const bf16x8*)(kr + 64);
            const f32x4 cd = *(const f32x4*)(b + 3 * 64 * 144 + (16 * dt + 4 * q) * 4);
            f32x4 acc = S[dt] * cd;
            acc = MFMA16(k0, v0, acc); acc = MFMA16(k1, v1, acc);
            S[dt] = acc;
        }
#pragma unroll
        for (int m = 0; m < 4; ++m)
#pragma unroll
            for (int r = 0; r < 4; ++r) OC[(size_t)(64 * n + 16 * m + 4 * q + r) * 512 + h * 128 + 16 * ws + fr] = (bf16)f2bf(o[m][r]);
        if (n + 1 < NCHUNK) GLA_PUT((n + 1) & 1);
        __syncthreads();
    }
#undef GLA_FETCH
#undef GLA_PUT
}
__device__ __forceinline__ void out_norm_item(bf16* O, const bf16* PA, int gcol, const float* nw, int t, int h, int lane) {
    const unsigned ow = *(const unsigned*)(O + (size_t)t * 512 + h * 128 + 2 * lane);
    const float o0 = bflo(ow), o1 = bfhi(ow);
    const float rr = 1.f / sqrtf(wave_sum(o0 * o0 + o1 * o1) * (1.f / 128.f) + NORM_EPS);
    const unsigned z = *(const unsigned*)(PA + (size_t)t * NPA + gcol + h * 128 + 2 * lane);
    *(unsigned*)(O + (size_t)t * 512 + h * 128 + 2 * lane) = pk2(o0 * rr * nw[2 * lane] * siluf_(bflo(z)), o1 * rr * nw[2 * lane + 1] * siluf_(bfhi(z)));
}

constexpr size_t GDN_WI = 0, GDN_QI = GDN_WI + (size_t)NCHUNK * 4 * 16384, GDN_AT = GDN_QI + (size_t)NCHUNK * 4 * 16384, GDN_KT = GDN_AT + (size_t)NCHUNK * 4 * 8192,
                 GDN_UI = GDN_KT + (size_t)NCHUNK * 4 * 16384, GDN_DV = GDN_UI + (size_t)NCHUNK * 4 * 16384, GDN_BYTES = GDN_DV + (size_t)NCHUNK * 4 * 768;
__device__ __forceinline__ int pperm32(int k) { const int half = (k >> 4) & 1, fr = k & 15; return 8 * (fr >> 2) + 4 * half + (fr & 3); }
__device__ __forceinline__ void gdn_prep_chunk(const bf16* PA, const float* SM, const float* convw, const float* alog, const float* dtb, unsigned char* img, int n, int h, unsigned char* lds, int tid) {
    bf16* Qn = (bf16*)lds; bf16* Kn = (bf16*)(lds + 17408); bf16* Rt = (bf16*)(lds + 34816); bf16* Ts = (bf16*)(lds + 71680); float* Ls = (float*)(lds + 80896); float* gv = (float*)(lds + 98304);
    const int t0 = n * 64, ch = n * 4 + h, lane = tid & 63, wave = tid >> 6, q = lane >> 4, fr = lane & 15;
    __syncthreads();
    {
        const int c = tid >> 3, g8 = tid & 7, t = t0 + c;
        float val[3][16];
#pragma unroll
        for (int w = 0; w < 3; ++w) {
            const int c0 = w * 512 + h * 128 + g8 * 16;
#pragma unroll
            for (int i = 0; i < 16; ++i) val[w][i] = 0.f;
#pragma unroll
            for (int j = 0; j < 4; ++j) { const int tt = t - 3 + j;
                if (tt >= 0) {
                    const v4u xa = *(const v4u*)(PA + (size_t)tt * NPA + c0), xb = *(const v4u*)(PA + (size_t)tt * NPA + c0 + 8);
                    const float x[16] = {bflo(xa.x), bfhi(xa.x), bflo(xa.y), bfhi(xa.y), bflo(xa.z), bfhi(xa.z), bflo(xa.w), bfhi(xa.w), bflo(xb.x), bfhi(xb.x), bflo(xb.y), bfhi(xb.y), bflo(xb.z), bfhi(xb.z), bflo(xb.w), bfhi(xb.w)};
                    const f32x4* wp = (const f32x4*)(convw + j * 1536 + c0);
#pragma unroll
                    for (int i4 = 0; i4 < 4; ++i4) { const f32x4 wv = wp[i4]; val[w][4 * i4] += wv.x * x[4 * i4]; val[w][4 * i4 + 1] += wv.y * x[4 * i4 + 1]; val[w][4 * i4 + 2] += wv.z * x[4 * i4 + 2]; val[w][4 * i4 + 3] += wv.w * x[4 * i4 + 3]; }
                } }
#pragma unroll
            for (int i = 0; i < 16; ++i) val[w][i] = siluf_(val[w][i]);
        }
        float sq = 0.f, sk = 0.f;
#pragma unroll
        for (int i = 0; i < 16; ++i) { sq += val[0][i] * val[0][i]; sk += val[1][i] * val[1][i]; }
        sq += __shfl_xor(sq, 1); sq += __shfl_xor(sq, 2); sq += __shfl_xor(sq, 4);
        sk += __shfl_xor(sk, 1); sk += __shfl_xor(sk, 2); sk += __shfl_xor(sk, 4);
        const float rq = 0.08838834764831845f / sqrtf(sq + 1e-6f), rk = 1.f / sqrtf(sk + 1e-6f);
        const float beta = sigmoidf_(SM[(size_t)t * 64 + h]);
        v4u w0, w1;
        w0.x = pk2(val[0][0] * rq, val[0][1] * rq); w0.y = pk2(val[0][2] * rq, val[0][3] * rq); w0.z = pk2(val[0][4] * rq, val[0][5] * rq); w0.w = pk2(val[0][6] * rq, val[0][7] * rq);
        w1.x = pk2(val[0][8] * rq, val[0][9] * rq); w1.y = pk2(val[0][10] * rq, val[0][11] * rq); w1.z = pk2(val[0][12] * rq, val[0][13] * rq); w1.w = pk2(val[0][14] * rq, val[0][15] * rq);
        *(v4u*)(Qn + c * 136 + g8 * 16) = w0; *(v4u*)(Qn + c * 136 + g8 * 16 + 8) = w1;
        w0.x = pk2(val[1][0] * rk, val[1][1] * rk); w0.y = pk2(val[1][2] * rk, val[1][3] * rk); w0.z = pk2(val[1][4] * rk, val[1][5] * rk); w0.w = pk2(val[1][6] * rk, val[1][7] * rk);
        w1.x = pk2(val[1][8] * rk, val[1][9] * rk); w1.y = pk2(val[1][10] * rk, val[1][11] * rk); w1.z = pk2(val[1][12] * rk, val[1][13] * rk); w1.w = pk2(val[1][14] * rk, val[1][15] * rk);
        *(v4u*)(Kn + c * 136 + g8 * 16) = w0; *(v4u*)(Kn + c * 136 + g8 * 16 + 8) = w1;
#pragma unroll
        for (int i = 0; i < 16; ++i) Rt[(g8 * 16 + i) * 72 + c] = (bf16)f2bf(beta * val[2][i]);
        if (g8 == 0) { gv[c] = -expf(alog[h]) * softplusf_(SM[(size_t)t * 64 + 4 + h] + dtb[h]); gv[64 + c] = beta; }
    }
    __syncthreads();
    if (wave == 0) {
        float x = gv[lane];
#pragma unroll
        for (int off = 1; off < 64; off <<= 1) { const float y = __shfl_up(x, off); if (lane >= off) x += y; }
        gv[128 + lane] = x; gv[192 + lane] = expf(x);
    }
    __syncthreads();
    {
        const int c = tid >> 3, g8 = tid & 7; const float s = gv[64 + c] * gv[192 + c];
#pragma unroll
        for (int i = 0; i < 16; ++i) Rt[(128 + g8 * 16 + i) * 72 + c] = (bf16)f2bf(s * bf2f(Kn[c * 136 + g8 * 16 + i]));
    }
    {
        bf16* AT = (bf16*)(img + GDN_AT) + (size_t)ch * 4096;
#pragma unroll 1
        for (int job = wave; job < 26; job += 8) {
            int ib, jb; const bool isq = job >= 10;
            if (!isq) { int r = job; ib = 0; while (r > ib) { r -= ib + 1; ++ib; } jb = r; } else { ib = (job - 10) >> 2; jb = (job - 10) & 3; }
            f32x4 acc = {0.f, 0.f, 0.f, 0.f};
            if (jb <= ib) {
                const bf16* ap = (isq ? Qn : Kn) + (16 * ib + fr) * 136 + q * 8; const bf16* bp = Kn + (16 * jb + fr) * 136 + q * 8;
#pragma unroll
                for (int kk = 0; kk < 4; ++kk) acc = MFMA16(*(const bf16x8*)(ap + 32 * kk), *(const bf16x8*)(bp + 32 * kk), acc);
            }
            const int j = 16 * jb + fr; const float gj = gv[128 + j];
#pragma unroll
            for (int r = 0; r < 4; ++r) { const int i = 16 * ib + 4 * q + r; const float dec = expf(fminf(gv[128 + i] - gj, 0.f));
                if (!isq) Ls[i * 68 + j] = (j < i) ? gv[64 + i] * acc[r] * dec : 0.f;
                else AT[i * 64 + 32 * (jb >> 1) + 8 * (fr >> 2) + 4 * (jb & 1) + (fr & 3)] = (bf16)f2bf(j <= i ? acc[r] * dec : 0.f); }
        }
    }
    __syncthreads();
    if (wave == 0) {
        float T[64];
        int vz = 0; asm volatile("" : "+v"(vz));
        const float* Lz = Ls + vz;
#pragma unroll
        for (int i = 0; i < 64; ++i) {
            float a0 = fmaxf(0.f, 1.f - fabsf((float)(lane - i))), a1 = 0.f, a2 = 0.f, a3 = 0.f;
#pragma unroll
            for (int m4 = 0; m4 < (i + 3) / 4; ++m4) { const f32x4 lv = *(const f32x4*)(Lz + i * 68 + 4 * m4);
                if (4 * m4 < i) a0 -= lv.x * T[4 * m4]; if (4 * m4 + 1 < i) a1 -= lv.y * T[4 * m4 + 1]; if (4 * m4 + 2 < i) a2 -= lv.z * T[4 * m4 + 2]; if (4 * m4 + 3 < i) a3 -= lv.w * T[4 * m4 + 3]; }
            T[i] = (a0 + a1) + (a2 + a3);
            Ts[i * 72 + lane] = (bf16)f2bf(T[i]);
        }
    } else {
        const int t2 = tid - 64;
        bf16* QI = (bf16*)(img + GDN_QI) + (size_t)ch * 8192; bf16* KT = (bf16*)(img + GDN_KT) + (size_t)ch * 8192; float* DV = (float*)(img + GDN_DV) + (size_t)ch * 192;
        for (int it = t2; it < 64 * 16; it += 448) { const int c = it >> 4, pg = it & 15;
            unsigned short e[8];
#pragma unroll
            for (int j = 0; j < 8; ++j) { const int p = pg * 8 + j; e[j] = Qn[c * 136 + (p & ~31) + kperm32(p & 31)]; }
            v4u w; w.x = e[0] | ((unsigned)e[1] << 16); w.y = e[2] | ((unsigned)e[3] << 16); w.z = e[4] | ((unsigned)e[5] << 16); w.w = e[6] | ((unsigned)e[7] << 16);
            *(v4u*)(QI + c * 128 + pg * 8) = w; }
        for (int it = t2; it < 128 * 8; it += 448) { const int d = it >> 3, pg = it & 7;
            unsigned short e[8];
#pragma unroll
            for (int j = 0; j < 8; ++j) { const int p = pg * 8 + j; e[j] = Kn[((p & ~31) + kperm32(p & 31)) * 136 + d]; }
            v4u w; w.x = e[0] | ((unsigned)e[1] << 16); w.y = e[2] | ((unsigned)e[3] << 16); w.z = e[4] | ((unsigned)e[5] << 16); w.w = e[6] | ((unsigned)e[7] << 16);
            *(v4u*)(KT + d * 64 + pg * 8) = w; }
        if (t2 < 64) { DV[t2] = gv[192 + t2]; DV[64 + t2] = expf(gv[128 + 63] - gv[128 + t2]); if (t2 == 0) DV[128] = gv[192 + 63]; }
    }
    __syncthreads();
    {
        bf16x8 tf[4][2];
#pragma unroll
        for (int m = 0; m < 4; ++m)
#pragma unroll
            for (int kk = 0; kk < 2; ++kk) tf[m][kk] = *(const bf16x8*)(Ts + (16 * m + fr) * 72 + 32 * kk + q * 8);
#pragma unroll
        for (int cc = 0; cc < 2; ++cc) { const int ct = 2 * wave + cc;
            const bf16x8 r0 = *(const bf16x8*)(Rt + (16 * ct + fr) * 72 + q * 8), r1 = *(const bf16x8*)(Rt + (16 * ct + fr) * 72 + 32 + q * 8);
#pragma unroll
            for (int m = 0; m < 4; ++m) { f32x4 acc = {0.f, 0.f, 0.f, 0.f}; acc = MFMA16(tf[m][0], r0, acc); acc = MFMA16(tf[m][1], r1, acc);
                if (ct < 8) { v2u w; w.x = pk2(acc[0], acc[1]); w.y = pk2(acc[2], acc[3]); *(v2u*)(img + GDN_UI + (size_t)ch * 16384 + ((ct * 4 + m) * 64 + lane) * 8) = w; }
                else { const int dt = ct - 8; bf16* WI = (bf16*)(img + GDN_WI) + (size_t)ch * 8192;
#pragma unroll
                    for (int r = 0; r < 4; ++r) WI[(16 * m + 4 * q + r) * 128 + 32 * (dt >> 1) + 8 * (fr >> 2) + 4 * (dt & 1) + (fr & 3)] = (bf16)f2bf(-acc[r]); }
            } }
    }
}
constexpr int GDN_BUF = 2 * 17408 + 9216 + 18432 + 768;
__device__ __forceinline__ void gdn_scan_block(const unsigned char* img, bf16* OA, int h, unsigned char* lds, int tid) {
    const int lane = tid & 63, ws = __builtin_amdgcn_readfirstlane(tid >> 6), q = lane >> 4, fr = lane & 15;
    f32x4 S[8];
#pragma unroll
    for (int i = 0; i < 8; ++i) S[i] = (f32x4){0.f, 0.f, 0.f, 0.f};
    v4u st[7]; v4u stc = {0u, 0u, 0u, 0u}; v2u ub[4];
#define GDN_FETCH(N) do { const int ch_ = (N) * 4 + h; \
        st[0] = *(const v4u*)(img + GDN_WI + (size_t)ch_ * 16384 + tid * 16); st[1] = *(const v4u*)(img + GDN_WI + (size_t)ch_ * 16384 + 8192 + tid * 16); \
        st[2] = *(const v4u*)(img + GDN_QI + (size_t)ch_ * 16384 + tid * 16); st[3] = *(const v4u*)(img + GDN_QI + (size_t)ch_ * 16384 + 8192 + tid * 16); \
        st[4] = *(const v4u*)(img + GDN_AT + (size_t)ch_ * 8192 + tid * 16); \
        st[5] = *(const v4u*)(img + GDN_KT + (size_t)ch_ * 16384 + tid * 16); st[6] = *(const v4u*)(img + GDN_KT + (size_t)ch_ * 16384 + 8192 + tid * 16); \
        if (tid < 48) stc = *(const v4u*)(img + GDN_DV + (size_t)ch_ * 768 + tid * 16); \
        _Pragma("unroll") for (int m_ = 0; m_ < 4; ++m_) ub[m_] = *(const v2u*)(img + GDN_UI + (size_t)ch_ * 16384 + ((ws * 4 + m_) * 64 + lane) * 8); } while (0)
#define GDN_PUT(B) do { unsigned char* b_ = lds + (B) * GDN_BUF; const int r16 = tid >> 4, c16 = tid & 15, r8 = tid >> 3, c8 = tid & 7; \
        *(v4u*)(b_ + r16 * 272 + c16 * 16) = st[0]; *(v4u*)(b_ + (32 + r16) * 272 + c16 * 16) = st[1]; \
        *(v4u*)(b_ + 17408 + r16 * 272 + c16 * 16) = st[2]; *(v4u*)(b_ + 17408 + (32 + r16) * 272 + c16 * 16) = st[3]; \
        *(v4u*)(b_ + 34816 + r8 * 144 + c8 * 16) = st[4]; \
        *(v4u*)(b_ + 44032 + r8 * 144 + c8 * 16) = st[5]; *(v4u*)(b_ + 44032 + (64 + r8) * 144 + c8 * 16) = st[6]; \
        if (tid < 48) *(v4u*)(b_ + 62464 + tid * 16) = stc; } while (0)
    __syncthreads();
    GDN_FETCH(0); GDN_PUT(0);
    __syncthreads();
    for (int n = 0; n < NCHUNK; ++n) {
        const unsigned char* b = lds + (n & 1) * GDN_BUF;
        const float* DV = (const float*)(b + 62464);
        f32x4 vn[4], o[4];
#pragma unroll
        for (int m = 0; m < 4; ++m) vn[m] = (f32x4){bflo(ub[m].x), bfhi(ub[m].x), bflo(ub[m].y), bfhi(ub[m].y)};
        if (n + 1 < NCHUNK) GDN_FETCH(n + 1);
        bf16x8 sB[4];
#pragma unroll
        for (int kk = 0; kk < 4; ++kk) sB[kk] = pack_ctiles(S[2 * kk], S[2 * kk + 1]);
#pragma unroll
        for (int m = 0; m < 4; ++m) {
            const unsigned char* wr_ = b + (16 * m + fr) * 272 + q * 16;
            f32x4 oi = {0.f, 0.f, 0.f, 0.f};
#pragma unroll
            for (int kk = 0; kk < 4; ++kk) { vn[m] = MFMA16(*(const bf16x8*)(wr_ + 64 * kk), sB[kk], vn[m]); oi = MFMA16(*(const bf16x8*)(wr_ + 17408 + 64 * kk), sB[kk], oi); }
            o[m] = oi * *(const f32x4*)(DV + 16 * m + 4 * q);
        }
        const bf16x8 vb0 = pack_ctiles(vn[0], vn[1]), vb1 = pack_ctiles(vn[2], vn[3]);
#pragma unroll
        for (int m = 0; m < 4; ++m) {
            const unsigned char* ar = b + 34816 + (16 * m + fr) * 144 + q * 16;
            o[m] = MFMA16(*(const bf16x8*)(ar), vb0, o[m]);
            if (m >= 2) o[m] = MFMA16(*(const bf16x8*)(ar + 64), vb1, o[m]);
        }
#pragma unroll
        for (int m = 0; m < 4; ++m) vn[m] = vn[m] * *(const f32x4*)(DV + 64 + 16 * m + 4 * q);
        const bf16x8 xs0 = pack_ctiles(vn[0], vn[1]), xs1 = pack_ctiles(vn[2], vn[3]);
        const float cdec = DV[128];
#pragma unroll
        for (int dt = 0; dt < 8; ++dt) {
            const unsigned char* kr = b + 44032 + (16 * dt + fr) * 144 + q * 16;
            f32x4 acc = S[dt] * cdec;
            acc = MFMA16(*(const bf16x8*)(kr), xs0, acc); acc = MFMA16(*(const bf16x8*)(kr + 64), xs1, acc);
            S[dt] = acc;
        }
#pragma unroll
        for (int m = 0; m < 4; ++m)
#pragma unroll
            for (int r = 0; r < 4; ++r) OA[(size_t)(64 * n + 16 * m + 4 * q + r) * 512 + h * 128 + 16 * ws + fr] = (bf16)f2bf(o[m][r]);
        if (n + 1 < NCHUNK) GDN_PUT((n + 1) & 1);
        __syncthreads();
    }
#undef GDN_FETCH
#undef GDN_PUT
}

constexpr int NSA_BUF = 64 * 208 + 64 * 144, NSA_WOFF = 2 * NSA_BUF, NSA_UOFF = NSA_WOFF + 8 * 2048;
__device__ __forceinline__ float col_max4(const f32x4 (&s)[4]) {
    float a = fmaxf(fmaxf(s[0][0], s[0][1]), fmaxf(s[0][2], s[0][3]));
#pragma unroll
    for (int i = 1; i < 4; ++i) a = fmaxf(a, fmaxf(fmaxf(s[i][0], s[i][1]), fmaxf(s[i][2], s[i][3])));
    a = fmaxf(a, __shfl_xor(a, 16)); a = fmaxf(a, __shfl_xor(a, 32)); return a;
}
template <bool WINDOW>
__device__ __forceinline__ void nsa_lds_block(const unsigned char* kb, int pos0, int t, bool colsel, int head, const bf16x8 (&qf)[3],
                                              const LAS float* relb, const LAS int* btab, float& m, float& l, f32x4 (&o)[4], int lane) {
    const int q = lane >> 4, fr = lane & 15;
    const float scale = 0.10206207261596577f;
    f32x4 s[4];
#pragma unroll
    for (int rt = 0; rt < 4; ++rt) {
        const unsigned char* kp = kb + (16 * rt + fr) * 208 + q * 16;
        f32x4 acc = {0.f, 0.f, 0.f, 0.f};
#pragma unroll
        for (int kk = 0; kk < 3; ++kk) acc = MFMA16(*(const bf16x8*)(kp + 64 * kk), qf[kk], acc);
        s[rt] = acc;
    }
    const bool far = !WINDOW && (pos0 + 63 + 128 <= t);
    const float bfar = relb[31 * 8 + head];
#pragma unroll
    for (int rt = 0; rt < 4; ++rt)
#pragma unroll
        for (int r = 0; r < 4; ++r) { const int pos = pos0 + 16 * rt + 4 * q + r, dist = t - pos;
            bool ok = colsel && dist >= 0; if (WINDOW) ok = ok && dist < 512;
            float bias = bfar; if (!far) { const int dd = dist < 0 ? 0 : dist; bias = relb[(dd < 128 ? btab[dd] : 31) * 8 + head]; }
            s[rt][r] = ok ? s[rt][r] * scale + bias : -INFINITY; }
    const float bm = col_max4(s);
    const float mn = fmaxf(m, bm);
    const float corr = (mn == -INFINITY) ? 1.f : __expf(m - mn);
    float ps = 0.f;
#pragma unroll
    for (int rt = 0; rt < 4; ++rt)
#pragma unroll
        for (int r = 0; r < 4; ++r) { const float p = (s[rt][r] == -INFINITY) ? 0.f : __expf(s[rt][r] - mn); s[rt][r] = p; ps += p; }
    ps += __shfl_xor(ps, 16); ps += __shfl_xor(ps, 32);
    l = l * corr + ps; m = mn;
    const bf16x8 pb0 = pack_ctiles(s[0], s[1]), pb1 = pack_ctiles(s[2], s[3]);
#pragma unroll
    for (int dt = 0; dt < 4; ++dt) {
        const unsigned char* vp = kb + 64 * 208 + (16 * dt + fr) * 144 + q * 8;
        const v2u a0 = *(const v2u*)(vp), a1 = *(const v2u*)(vp + 32), a2 = *(const v2u*)(vp + 64), a3 = *(const v2u*)(vp + 96);
        v4u w0; w0.x = a0.x; w0.y = a0.y; w0.z = a1.x; w0.w = a1.y;
        v4u w1; w1.x = a2.x; w1.y = a2.y; w1.z = a3.x; w1.w = a3.y;
        f32x4 acc = o[dt] * corr;
        acc = MFMA16(__builtin_bit_cast(bf16x8, w0), pb0, acc); acc = MFMA16(__builtin_bit_cast(bf16x8, w1), pb1, acc);
        o[dt] = acc;
    }
}
#define NSA_FETCH_KV(KCOL, VT, POS0) do { \
        { const int c_ = tid, r_ = c_ / 12, x_ = c_ % 12; sg[0] = *(const v4u*)(PA + (size_t)((POS0) + r_) * NPA + (KCOL) + g * 160 + x_ * 8); } \
        { const int c_ = tid + 512; if (c_ < 768) { const int r_ = c_ / 12, x_ = c_ % 12; sg[1] = *(const v4u*)(PA + (size_t)((POS0) + r_) * NPA + (KCOL) + g * 160 + x_ * 8); } \
          else { const int v_ = c_ - 768, r_ = v_ >> 3, x_ = v_ & 7; sg[1] = *(const v4u*)((VT) + (size_t)(g * 64 + r_) * SEQ + (POS0) + x_ * 8); } } \
        if (tid < 256) { const int v_ = tid + 256, r_ = v_ >> 3, x_ = v_ & 7; sg[2] = *(const v4u*)((VT) + (size_t)(g * 64 + r_) * SEQ + (POS0) + x_ * 8); } } while (0)
#define NSA_PUT_KV(B) do { unsigned char* b_ = lds + (B) * NSA_BUF; \
        { const int c_ = tid, r_ = c_ / 12, x_ = c_ % 12; *(v4u*)(b_ + r_ * 208 + x_ * 16) = sg[0]; } \
        { const int c_ = tid + 512; if (c_ < 768) { const int r_ = c_ / 12, x_ = c_ % 12; *(v4u*)(b_ + r_ * 208 + x_ * 16) = sg[1]; } \
          else { const int v_ = c_ - 768, r_ = v_ >> 3, x_ = v_ & 7; *(v4u*)(b_ + 64 * 208 + r_ * 144 + x_ * 16) = sg[1]; } } \
        if (tid < 256) { const int v_ = tid + 256, r_ = v_ >> 3, x_ = v_ & 7; *(v4u*)(b_ + 64 * 208 + r_ * 144 + x_ * 16) = sg[2]; } } while (0)
#define NSA_FETCH_C(PR) do { \
        { const int c_ = tid, hl_ = c_ / 384, r_ = (c_ % 384) / 12, x_ = c_ % 12; sg[0] = *(const v4u*)((hl_ ? KCL : KCH) + (size_t)((32 * (PR) + r_) * 2 + g) * 96 + x_ * 8); } \
        { const int c_ = tid + 512; if (c_ < 768) { const int hl_ = c_ / 384, r_ = (c_ % 384) / 12, x_ = c_ % 12; sg[1] = *(const v4u*)((hl_ ? KCL : KCH) + (size_t)((32 * (PR) + r_) * 2 + g) * 96 + x_ * 8); } \
          else { const int v_ = c_ - 768, r_ = v_ >> 2, x_ = v_ & 3; sg[1] = *(const v4u*)(VCT + (size_t)(g * 64 + r_) * 512 + 32 * (PR) + x_ * 8); } } } while (0)
#define NSA_PUT_C(B) do { unsigned char* b_ = lds + (B) * NSA_BUF; \
        { const int c_ = tid, hl_ = c_ / 384, r_ = (c_ % 384) / 12, x_ = c_ % 12; *(v4u*)(b_ + (hl_ * 32 + r_) * 208 + x_ * 16) = sg[0]; } \
        { const int c_ = tid + 512; if (c_ < 768) { const int hl_ = c_ / 384, r_ = (c_ % 384) / 12, x_ = c_ % 12; *(v4u*)(b_ + (hl_ * 32 + r_) * 208 + x_ * 16) = sg[1]; } \
          else { const int v_ = c_ - 768, r_ = v_ >> 2, x_ = v_ & 3; *(v4u*)(b_ + 64 * 208 + r_ * 80 + x_ * 16) = sg[1]; } } } while (0)
__device__ __forceinline__ void nsa_unit(const bf16* PA, const float* SM, const bf16* KCH, const bf16* KCL, const bf16* VCT, const bf16* VTS, const bf16* VTW,
                                         const LAS float* relb, const LAS int* btab, bf16* OB, int T0, int g, unsigned char* lds, int tid) {
    const int lane = tid & 63, wave = __builtin_amdgcn_readfirstlane(tid >> 6), q = lane >> 4, fr = lane & 15, tl = fr >> 2, hh = fr & 3;
    const int t0 = T0 + 4 * wave, t = t0 + tl, head = g * 4 + hh;
    const float scale = 0.10206207261596577f;
    v4u sg[3];
    bf16x8 qf[3];
#pragma unroll
    for (int kk = 0; kk < 3; ++kk) qf[kk] = *(const bf16x8*)(PA + (size_t)t * NPA + PA_NQ + head * 96 + 32 * kk + q * 8);
    float* imp = (float*)(lds + NSA_WOFF + wave * 2048);
    __syncthreads();
#pragma unroll
    for (int i = 0; i < 8; ++i) imp[lane + 64 * i] = 0.f;
    const int ncv = t >= 31 ? (t - 31) / 16 + 1 : 0;
    const int ncvw = (t0 + 3) >= 31 ? (t0 + 3 - 31) / 16 + 1 : 0;
    const int ncvu = (T0 + 31) >= 31 ? (T0 + 31 - 31) / 16 + 1 : 0;
    const int ntile = (ncvw + 15) >> 4, npair = (ncvu + 31) >> 5;
    f32x4 oc[4];
#pragma unroll
    for (int dt = 0; dt < 4; ++dt) oc[dt] = (f32x4){0.f, 0.f, 0.f, 0.f};
    if (npair > 0) {
        float m = -INFINITY, l = 0.f;
        NSA_FETCH_C(0); NSA_PUT_C(0); __syncthreads();
#pragma unroll 1
        for (int pr = 0; pr < npair; ++pr) {
            const unsigned char* kb = lds + (pr & 1) * NSA_BUF;
            if (pr + 1 < npair) NSA_FETCH_C(pr + 1);
#pragma unroll
            for (int u = 0; u < 2; ++u) { const int T = 2 * pr + u;
                if (T < ntile) {
                    const unsigned char* kp = kb + (16 * u + fr) * 208 + q * 16;
                    f32x4 acc = {0.f, 0.f, 0.f, 0.f};
#pragma unroll
                    for (int kk = 0; kk < 3; ++kk) { acc = MFMA16(*(const bf16x8*)(kp + 64 * kk), qf[kk], acc); acc = MFMA16(*(const bf16x8*)(kp + 32 * 208 + 64 * kk), qf[kk], acc); }
                    float sv[4]; float bm = -INFINITY;
#pragma unroll
                    for (int r = 0; r < 4; ++r) { const int n = 16 * T + 4 * q + r; const int dist = t - (16 * n + 31); const int dd = dist < 0 ? 0 : dist;
                        sv[r] = (n < ncv) ? acc[r] * scale + relb[(dd < 128 ? btab[dd] : 31) * 8 + head] : -INFINITY; bm = fmaxf(bm, sv[r]); }
                    const float mn = fmaxf(m, bm);
                    if (mn != -INFINITY) { float ps = 0.f;
#pragma unroll
                        for (int r = 0; r < 4; ++r) ps += (sv[r] == -INFINITY) ? 0.f : __expf(sv[r] - mn);
                        l = l * __expf(m - mn) + ps; m = mn; }
                } }
            if (pr + 1 < npair) NSA_PUT_C((pr + 1) & 1);
            __syncthreads();
        }
        float M = fmaxf(m, __shfl_xor(m, 16)); M = fmaxf(M, __shfl_xor(M, 32));
        float lt = (m == -INFINITY) ? 0.f : l * __expf(m - M);
        lt += __shfl_xor(lt, 16); lt += __shfl_xor(lt, 32);
        const float inv = lt > 0.f ? 1.f / lt : 0.f;
        float carry = 0.f;
        NSA_FETCH_C(0); NSA_PUT_C(0); __syncthreads();
#pragma unroll 1
        for (int pr = 0; pr < npair; ++pr) {
            const unsigned char* kb = lds + (pr & 1) * NSA_BUF;
            if (pr + 1 < npair) NSA_FETCH_C(pr + 1);
            if (2 * pr < ntile) {
                f32x4 pt[2];
#pragma unroll
                for (int u = 0; u < 2; ++u) { const int T = 2 * pr + u;
                    f32x4 acc = {0.f, 0.f, 0.f, 0.f};
                    if (T < ntile) {
                        const unsigned char* kp = kb + (16 * u + fr) * 208 + q * 16;
#pragma unroll
                        for (int kk = 0; kk < 3; ++kk) { acc = MFMA16(*(const bf16x8*)(kp + 64 * kk), qf[kk], acc); acc = MFMA16(*(const bf16x8*)(kp + 32 * 208 + 64 * kk), qf[kk], acc); }
                    }
#pragma unroll
                    for (int r = 0; r < 4; ++r) { const int n = 16 * T + 4 * q + r; const int dist = t - (16 * n + 31); const int dd = dist < 0 ? 0 : dist;
                        const bool ok = (T < ntile) && (n < ncv);
                        pt[u][r] = ok ? __expf(acc[r] * scale + relb[(dd < 128 ? btab[dd] : 31) * 8 + head] - M) * inv : 0.f; }
                    const float x3 = pt[u][3];
                    float prev = __shfl(x3, (lane + 48) & 63);
                    const float nxt = __shfl(x3, 48 + fr);
                    if (q == 0) prev = carry;
                    carry = nxt;
                    float v = ((pt[u][0] + pt[u][1]) + (pt[u][2] + pt[u][3])) + prev;
                    v += __shfl_xor(v, 1); v += __shfl_xor(v, 2);
                    if (hh == 0 && T < ntile) imp[tl * 128 + 4 * T + q] = v;
                }
                const bf16x8 pb = pack_ctiles(pt[0], pt[1]);
#pragma unroll
                for (int dt = 0; dt < 4; ++dt) {
                    const unsigned char* vp = kb + 64 * 208 + (16 * dt + fr) * 80 + q * 8;
                    const v2u a0 = *(const v2u*)(vp), a1 = *(const v2u*)(vp + 32);
                    v4u w0; w0.x = a0.x; w0.y = a0.y; w0.z = a1.x; w0.w = a1.y;
                    oc[dt] = MFMA16(__builtin_bit_cast(bf16x8, w0), pb, oc[dt]);
                }
            }
            if (pr + 1 < npair) NSA_PUT_C((pr + 1) & 1);
            __syncthreads();
        }
    }
    LDS_WAIT(); asm volatile("" ::: "memory");
    const int blk_t = T0 >> 6; const int nsel = blk_t + 1 < 16 ? blk_t + 1 : 16;
    unsigned long long msk_lo[4], msk_hi[4];
#pragma unroll
    for (int tk = 0; tk < 4; ++tk) {
        float v0, v1; { const int s0 = lane, s1 = lane + 64;
            v0 = (s0 == 0 || s0 == blk_t || s0 == blk_t - 1) ? INFINITY : (s0 > blk_t ? -INFINITY : imp[tk * 128 + s0]);
            v1 = (s1 == blk_t || s1 == blk_t - 1) ? INFINITY : (s1 > blk_t ? -INFINITY : imp[tk * 128 + s1]); }
        unsigned long long lo = 0ull, hi = 0ull;
#pragma unroll 1
        for (int r = 0; r < nsel; ++r) {
            float bv; int bi;
            if (v0 >= v1) { bv = v0; bi = lane; } else { bv = v1; bi = lane + 64; }
#pragma unroll
            for (int off = 32; off >= 1; off >>= 1) { const float ov = __shfl_xor(bv, off); const int oi = __shfl_xor(bi, off); if (ov > bv || (ov == bv && oi < bi)) { bv = ov; bi = oi; } }
            bi = __builtin_amdgcn_readfirstlane(bi);
            if (bi < 64) lo |= 1ull << bi; else hi |= 1ull << (bi - 64);
            if (bi == lane) v0 = -INFINITY; else if (bi == lane + 64) v1 = -INFINITY;
        }
        msk_lo[tk] = lo; msk_hi[tk] = hi;
    }
    const unsigned long long wlo = (msk_lo[0] | msk_lo[1]) | (msk_lo[2] | msk_lo[3]), whi = (msk_hi[0] | msk_hi[1]) | (msk_hi[2] | msk_hi[3]);
    unsigned long long* um = (unsigned long long*)(lds + NSA_UOFF);
    if (lane == 0) { um[wave * 2] = wlo; um[wave * 2 + 1] = whi; }
    __syncthreads();
    unsigned long long ulo = 0ull, uhi = 0ull;
#pragma unroll
    for (int w = 0; w < 8; ++w) { ulo |= um[w * 2]; uhi |= um[w * 2 + 1]; }
    ulo = ((unsigned long long)__builtin_amdgcn_readfirstlane((unsigned)(ulo >> 32)) << 32) | (unsigned)__builtin_amdgcn_readfirstlane((unsigned)ulo);
    uhi = ((unsigned long long)__builtin_amdgcn_readfirstlane((unsigned)(uhi >> 32)) << 32) | (unsigned)__builtin_amdgcn_readfirstlane((unsigned)uhi);
    f32x4 os[4]; float ms = -INFINITY, ls = 0.f;
#pragma unroll
    for (int dt = 0; dt < 4; ++dt) os[dt] = (f32x4){0.f, 0.f, 0.f, 0.f};
    const unsigned long long mylo = tl == 0 ? msk_lo[0] : tl == 1 ? msk_lo[1] : tl == 2 ? msk_lo[2] : msk_lo[3];
    const unsigned long long myhi = tl == 0 ? msk_hi[0] : tl == 1 ? msk_hi[1] : tl == 2 ? msk_hi[2] : msk_hi[3];
    {
        int cur; { if (ulo) { cur = __builtin_ctzll(ulo); ulo &= ulo - 1; } else { cur = 64 + __builtin_ctzll(uhi); uhi &= uhi - 1; } }
        NSA_FETCH_KV(PA_KS, VTS, 64 * cur); NSA_PUT_KV(0); __syncthreads();
        int par = 0;
#pragma unroll 1
        for (;;) {
            int nxt = -1;
            if (ulo) { nxt = __builtin_ctzll(ulo); ulo &= ulo - 1; } else if (uhi) { nxt = 64 + __builtin_ctzll(uhi); uhi &= uhi - 1; }
            if (nxt >= 0) NSA_FETCH_KV(PA_KS, VTS, 64 * nxt);
            const bool wsel = cur < 64 ? ((wlo >> cur) & 1ull) : ((whi >> (cur - 64)) & 1ull);
            if (wsel) { const bool csel = cur < 64 ? ((mylo >> cur) & 1ull) : ((myhi >> (cur - 64)) & 1ull);
                nsa_lds_block<false>(lds + par * NSA_BUF, 64 * cur, t, csel, head, qf, relb, btab, ms, ls, os, lane); }
            if (nxt >= 0) NSA_PUT_KV(par ^ 1);
            __syncthreads();
            if (nxt < 0) break;
            cur = nxt; par ^= 1;
        }
    }
    f32x4 ow[4]; float mw = -INFINITY, lw = 0.f;
#pragma unroll
    for (int dt = 0; dt < 4; ++dt) ow[dt] = (f32x4){0.f, 0.f, 0.f, 0.f};
    {
        const int b0 = (T0 - 511) < 0 ? 0 : (T0 - 511) >> 6, b1 = (T0 + 31) >> 6;
        NSA_FETCH_KV(PA_KW, VTW, 64 * b0); NSA_PUT_KV(0); __syncthreads();
#pragma unroll 1
        for (int bi = b0; bi <= b1; ++bi) {
            if (bi < b1) NSA_FETCH_KV(PA_KW, VTW, 64 * (bi + 1));
            if (64 * bi + 63 >= t0 - 511 && 64 * bi <= t0 + 3)
                nsa_lds_block<true>(lds + ((bi - b0) & 1) * NSA_BUF, 64 * bi, t, true, head, qf, relb, btab, mw, lw, ow, lane);
            if (bi < b1) NSA_PUT_KV((bi - b0 + 1) & 1);
            __syncthreads();
        }
    }
    const float* gl = SM + (size_t)t * 64 + 8 + head * 3;
    const float gc = sigmoidf_(gl[0]), gs = sigmoidf_(gl[1]) / ls, gw = sigmoidf_(gl[2]) / lw;
#pragma unroll
    for (int dt = 0; dt < 4; ++dt) { const f32x4 o = oc[dt] * gc + os[dt] * gs + ow[dt] * gw;
        v2u w; w.x = pk2(o[0], o[1]); w.y = pk2(o[2], o[3]);
        *(v2u*)(OB + (size_t)t * 512 + head * 64 + 16 * dt + 4 * q) = w; }
    asm volatile("" ::: "memory");
}
__device__ __forceinline__ void nsa_vt_item(const bf16* PA, bf16* VTS, bf16* VTW, int item, unsigned short* wl, int lane) {
    const int chunk = item >> 2, g = (item >> 1) & 1, which = item & 1;
    const int kcol = which ? PA_KW : PA_KS; bf16* VT = which ? VTW : VTS;
    for (int i = 0; i < 8; ++i) { const int tt = i * 8 + (lane >> 3), c8 = lane & 7;
        const v4u x = *(const v4u*)(PA + (size_t)(chunk * 64 + tt) * NPA + kcol + g * 160 + 96 + c8 * 8);
        unsigned* d = (unsigned*)(wl + tt * 66 + c8 * 8); d[0] = x.x; d[1] = x.y; d[2] = x.z; d[3] = x.w; }
    LDS_WAIT(); asm volatile("" ::: "memory");
    for (int i = 0; i < 8; ++i) { const int dv = i * 8 + (lane >> 3), c8 = lane & 7;
        unsigned short e[8];
#pragma unroll
        for (int j = 0; j < 8; ++j) e[j] = wl[(c8 * 8 + j) * 66 + dv];
        v4u w; w.x = e[0] | ((unsigned)e[1] << 16); w.y = e[2] | ((unsigned)e[3] << 16); w.z = e[4] | ((unsigned)e[5] << 16); w.w = e[6] | ((unsigned)e[7] << 16);
        *(v4u*)(VT + (size_t)(g * 64 + dv) * SEQ + chunk * 64 + c8 * 8) = w; }
    LDS_WAIT(); asm volatile("" ::: "memory");
}

constexpr size_t CMP_KCF = 0, CMP_VCF = 3328 * 1024, CMP_H1K = 5632 * 1024, CMP_H1V = 6144 * 1024;
constexpr size_t CW_W1K = 0, CW_W1V = 1536 * 1024, CW_BPART = 2560 * 1024, CW_BIAS = CW_BPART + 2 * 16 * 256 * 4;
template <int ND>
__device__ __forceinline__ void cmp_layer2(const bf16* H1, const float* w2, int nd_total, int pm, int tid, float (&acc)[ND]) {
    const int r = pm * 256 + (tid >> 1), d0 = (tid & 1) * ND;
#pragma unroll
    for (int i = 0; i < ND; ++i) acc[i] = 0.f;
#pragma unroll 1
    for (int j = 0; j < 256; ++j) {
        const float hv = bf2f(H1[(size_t)r * 256 + j]);
        const f32x4* wp = (const f32x4*)(w2 + (size_t)j * nd_total + d0);
#pragma unroll
        for (int i4 = 0; i4 < ND / 4; ++i4) { const f32x4 wv = wp[i4]; acc[4 * i4] += hv * wv.x; acc[4 * i4 + 1] += hv * wv.y; acc[4 * i4 + 2] += hv * wv.z; acc[4 * i4 + 3] += hv * wv.w; }
    }
}

constexpr int PH_PER_LAYER = 22, NPHASES = DEPTH * PH_PER_LAYER;
enum { K_CONV = 0, K_F1, K_GF32, K_ROWS, K_M1, K_M2, K_M3, K_M4, K_M5, K_M2B };
constexpr size_t ALPHA_OFF = 276 * MiB;
static_assert(ALPHA_OFF + GLA_BYTES <= 290 * MiB && WS_WGU + GLA_VBYTES <= WS_WD && WS_QKV + GDN_BYTES <= WS_KCMP, "gla/gdn images");
__global__ void __launch_bounds__(NTHR, 2) mk_fwd(Args args) {
    extern __shared__ __attribute__((aligned(16))) unsigned char lds[];
    LAS unsigned char* ldsl = (LAS unsigned char*)lds;
    {
        const int tid = threadIdx.x;
        for (int u = tid; u < (LDS_BYTES - LDSCTL_OFF) / 4; u += NTHR) ((LAS unsigned*)(ldsl + LDSCTL_OFF))[u] = 0u;
        __syncthreads();
        LAS int* btab = (LAS int*)(ldsl + BTAB_OFF);
        if (tid < 128) { int b = tid; if (tid >= 16) { const float v = logf((float)tid / 16.f) / 2.0794415416798357f * 16.f; b = 16 + (int)v; if (b > 31) b = 31; } btab[tid] = b; }
        if (tid < 256) ((LAS float*)(ldsl + RELB_OFF))[tid] = args.in[I_RELB][tid];
        __syncthreads();
    }
#if MK_ONE_LAUNCH
    XcdBarrier bar = xcd_barrier_post((unsigned*)(args.ws + WS_CTL) + CW_BAR, (volatile LAS unsigned*)(ldsl + MISC_OFF) + 8);
#endif
#pragma unroll 1
    for (int pc = args.ph_lo; pc < args.ph_hi; ++pc) {
        const unsigned pe = args.prog[pc];
        const int kind = pe & 15, sub = (pe >> 4) & 1, b = (pe >> 5) & 1, l = (pe >> 6) & 1; const bool mixer = (pe >> 7) & 1;
        unsigned char* ws = args.ws;
        int tid_ = threadIdx.x; asm volatile("" : "+v"(tid_));
        const int tid = tid_, lane = tid & 63, wave = __builtin_amdgcn_readfirstlane(tid >> 6);
        const int G = gridDim.x, bx = blockIdx.x;
        const int vcu = (G % 8 == 0) ? (bx % 8) * (G / 8) + bx / 8 : bx;
        const int gw = vcu * NWAVES + wave, NGW = G * NWAVES;
        switch (kind) {
        case K_CONV: {
            bf16* WGU = (bf16*)(ws + WS_WGU); bf16* WD = (bf16*)(ws + WS_WD); bf16* WIN = (bf16*)(ws + WS_WIN); bf16* WB = (bf16*)(ws + WS_WB); bf16* WO = (bf16*)(ws + WS_WO);
            LAS float* scr = (LAS float*)(ldsl + wave * 16384);
            const float* w_gu = args.in[sub ? I_F2GU : I_F1GU] + (size_t)l * DM * 2 * DFF;
            const float* w_dn = args.in[sub ? I_F2D : I_F1D] + (size_t)l * DFF * DM;
            constexpr int I_GU = (DM / 64) * (2 * DFF / 32), I_DN = (DFF / 64) * (DM / 32), I_IN = (DM / 64) * ((DIN_SRC + 31) / 32), I_BR = (512 / 64) * (DM / 32), I_OUT = (DM / 64) * (DM / 32);
            const int nitems = I_GU + I_DN + (sub == 0 ? I_IN + 3 * I_BR + I_OUT : 0);
            for (int it = gw; it < nitems; it += NGW) {
                int r = it;
                if (r < I_GU) { transpose_item(w_gu, DM, 2 * DFF, WGU, scr, r, lane, MapGU()); continue; } r -= I_GU;
                if (r < I_DN) { transpose_item(w_dn, DFF, DM, WD, scr, r, lane, MapId()); continue; } r -= I_DN;
                if (r < I_IN) { transpose_item(args.in[I_WIN] + (size_t)l * DM * DIN_SRC, DM, DIN_SRC, WIN, scr, r, lane, MapWin()); continue; } r -= I_IN;
                if (r < 3 * I_BR) { const int br = r / I_BR; transpose_item(args.in[I_WBG + br] + (size_t)l * 512 * DM, 512, DM, WB + (size_t)br * 512 * 1024, scr, r % I_BR, lane, MapId()); continue; } r -= 3 * I_BR;
                transpose_item(args.in[I_WOUT] + (size_t)l * DM * DM, DM, DM, WO, scr, r, lane, MapId());
            }
            if (sub == 0) { for (int i = gw * 64 + lane; i < 16 * DM / 2; i += NGW * 64) ((unsigned*)(WIN + (size_t)(PA_SM + 48) * DM))[i] = 0u; }
            if (l == 0 && sub == 0) { const float* n_pre = args.in[I_F1PRE]; bf16* XN = (bf16*)(ws + WS_XN);
                for (int m = gw; m < MTOK; m += NGW) row_pass(args.in[I_X] + (size_t)m * DM, nullptr, nullptr, 0.f, nullptr, n_pre, XN + (size_t)m * DM, lane); }
        } break;
        case K_F1: {
            pg8::Gemm g{(const bf16*)(ws + WS_XN), (const bf16*)(ws + WS_WGU), MTOK, 2 * DFF, DM, DM}; pg8::StaticOrder S; S.init(MTOK, 2 * DFF, G, bx); pg8::EpiSwiglu E{(bf16*)(ws + WS_H), DFF};
            pg8::gemm_phase<pg8::EpiSwiglu, pg8::StaticOrder, true, true>(ldsl, g, S, E);
        } break;
        case K_GF32: {
            pg8::Gemm g; pg8::EpiF32 E; pg8::StaticOrder S;
            if (mixer) { g = pg8::Gemm{(const bf16*)(ws + WS_MG), (const bf16*)(ws + WS_WO), SEQ, DM, DM, DM}; E = pg8::EpiF32{(float*)(ws + WS_YB), DM}; S.init(SEQ, DM, G, bx); }
            else { g = pg8::Gemm{(const bf16*)(ws + WS_H), (const bf16*)(ws + WS_WD), MTOK, DM, DFF, DFF}; E = pg8::EpiF32{(float*)(ws + WS_Y), DM}; S.init(MTOK, DM, G, bx); }
            pg8::gemm_phase<pg8::EpiF32, pg8::StaticOrder, true, true>(ldsl, g, S, E);
        } break;
        case K_ROWS: {
            float* xres = args.out; bf16* XN = (bf16*)(ws + WS_XN);
            if (mixer) {
                const float* YB = (const float*)(ws + WS_YB);
                for (int m = gw; m < SEQ; m += NGW) { const size_t r = (size_t)b * SEQ + m;
                    row_pass(xres + r * DM, YB + (size_t)m * DM, args.in[I_MPOST] + l * DM, 1.0f, xres + r * DM, args.in[I_F2PRE] + l * DM, XN + r * DM, lane); }
            } else {
                const float* Y = (const float*)(ws + WS_Y);
                const float* n_post = args.in[sub ? I_F2POST : I_F1POST] + l * DM;
                const float* xin = (l == 0 && sub == 0) ? args.in[I_X] : xres;
                const float* wnext = sub == 0 ? args.in[I_MPRE] + l * DM : (l + 1 < DEPTH ? args.in[I_F1PRE] + (l + 1) * DM : nullptr);
                for (int m = gw; m < MTOK; m += NGW) row_pass(xin + (size_t)m * DM, Y + (size_t)m * DM, n_post, 0.5f, xres + (size_t)m * DM, wnext, wnext ? XN + (size_t)m * DM : nullptr, lane);
                if (sub == 0) {
                    LAS float* scr = (LAS float*)(ldsl + wave * 16384);
                    const float* w1k = args.in[I_W1K] + (size_t)l * 3072 * 256; const float* w1v = args.in[I_W1V] + (size_t)l * 2048 * 256;
                    for (int it = gw; it < 48 * 8 + 32 * 8; it += NGW) {
                        if (it < 384) transpose_item(w1k, 3072, 256, (bf16*)(ws + WS_WD + CW_W1K), scr, it, lane, MapId());
                        else transpose_item(w1v, 2048, 256, (bf16*)(ws + WS_WD + CW_W1V), scr, it - 384, lane, MapId()); }
                    if (bx < 32) { const int which = bx >> 4, part = bx & 15, j = tid & 255, hf = tid >> 8;
                        const int per = which ? 128 : 192, i0 = part * per + hf * (per / 2);
                        const float* pe = which ? args.in[I_PEV] + l * 32 * 64 : args.in[I_PEK] + l * 32 * 96; const float* w1 = which ? w1v : w1k;
                        float a = 0.f;
                        for (int i = i0; i < i0 + per / 2; ++i) a += pe[i] * w1[(size_t)i * 256 + j];
                        float* red = (float*)lds; __syncthreads(); red[tid] = a; __syncthreads();
                        if (tid < 256) ((float*)(ws + WS_WD + CW_BPART))[(which * 16 + part) * 256 + tid] = red[tid] + red[tid + 256];
                    }
                }
            }
        } break;
        case K_M1: {
            pg8::Gemm g{(const bf16*)(ws + WS_XN) + (size_t)b * SEQ * DM, (const bf16*)(ws + WS_WIN), SEQ, NIN, DM, DM}; pg8::StaticOrder S; S.init(SEQ, NIN, G, bx);
            pg8::EpiWin E{(bf16*)(ws + WS_A), (float*)(ws + WS_SM), (bf16*)(ws + WS_G)};
            pg8::gemm_phase<pg8::EpiWin, pg8::StaticOrder, true, true>(ldsl, g, S, E);
        } break;
        case K_M2: {
            const bf16* PA = (const bf16*)(ws + WS_A); const float* SM = (const float*)(ws + WS_SM);
            if (bx == 0) { const int which = tid >> 8, j = tid & 255; float a = 0.f; const float* bp = (const float*)(ws + WS_WD + CW_BPART) + which * 16 * 256 + j;
                for (int p = 0; p < 16; ++p) a += bp[p * 256];
                ((float*)(ws + WS_WD + CW_BIAS))[which * 256 + j] = a; }
            {
                bf16* KCF = (bf16*)(ws + WS_O + CMP_KCF); bf16* VCF = (bf16*)(ws + WS_O + CMP_VCF);
                for (int it = vcu * NTHR + tid; it < SEQ * 2 * 20; it += G * NTHR) { const int c = it % 20, tg = it / 20, g = tg & 1, t = tg >> 1;
                    const v4u x = *(const v4u*)(PA + (size_t)t * NPA + PA_KC + g * 160 + c * 8);
                    if (c < 12) *(v4u*)(KCF + ((size_t)g * SEQ + t) * 96 + c * 8) = x; else *(v4u*)(VCF + ((size_t)g * SEQ + t) * 64 + (c - 12) * 8) = x; }
                if (bx == 1) { const v4u z = {0u, 0u, 0u, 0u}; if (tid < 192) *(v4u*)(KCF + (size_t)2 * SEQ * 96 + tid * 8) = z; else if (tid < 320) *(v4u*)(VCF + (size_t)2 * SEQ * 64 + (tid - 192) * 8) = z; }
            }
            for (int it = gw; it < NCHUNK * 4; it += NGW) nsa_vt_item(PA, (bf16*)(ws + WS_VTS), (bf16*)(ws + WS_VTW), it, (unsigned short*)(lds + wave * 16384), lane);
            for (int it = bx; it < NCHUNK * 4; it += G)
                gla_prep_item(PA, SM, args.in[I_GGW] + l * 16 * 256, args.in[I_GGB] + l * 256, ws + ALPHA_OFF, ws + WS_WGU, it >> 2, it & 3, (float*)lds, tid);
        } break;
        case K_M2B: {
            if (bx < 8) {
                const int kv = bx >> 2, pm = bx & 3;
                bf16* H1 = (bf16*)(ws + WS_O + (kv ? CMP_H1V : CMP_H1K));
                pg8::Gemm g = kv ? pg8::Gemm{(const bf16*)(ws + WS_O + CMP_VCF), (const bf16*)(ws + WS_WD + CW_W1V), 1024, 256, 2048, 1024}
                                 : pg8::Gemm{(const bf16*)(ws + WS_O + CMP_KCF), (const bf16*)(ws + WS_WD + CW_W1K), 1024, 256, 3072, 1536};
                pg8::OneTile S{pm, 0}; pg8::EpiGelu E{H1, (const float*)(ws + WS_WD + CW_BIAS) + kv * 256};
                pg8::gemm_phase<pg8::EpiGelu, pg8::OneTile, false, true>(ldsl, g, S, E);
                asm volatile("s_waitcnt vmcnt(0)" ::: "memory"); __syncthreads();
                __builtin_amdgcn_fence(__ATOMIC_ACQUIRE, "agent"); asm volatile("s_waitcnt vmcnt(0)" ::: "memory");
                const int r = pm * 256 + (tid >> 1), gg = r >> 9, n = r & 511;
                if (kv == 0) { float acc[48]; cmp_layer2<48>(H1, args.in[I_W2K] + l * 256 * 96, 96, pm, tid, acc);
                    if (n < 511) { bf16* KCH = (bf16*)(ws + WS_KCMP) + (size_t)(n * 2 + gg) * 96 + (tid & 1) * 48; bf16* KCL = (bf16*)(ws + WS_KCL) + (size_t)(n * 2 + gg) * 96 + (tid & 1) * 48;
#pragma unroll
                        for (int i = 0; i < 48; ++i) { const unsigned hi = f2bf(acc[i]); KCH[i] = (bf16)hi; KCL[i] = (bf16)f2bf(acc[i] - __uint_as_float(hi << 16)); } } }
                else { float acc[32]; cmp_layer2<32>(H1, args.in[I_W2V] + l * 256 * 64, 64, pm, tid, acc);
                    if (n < 511) { bf16* VCT = (bf16*)(ws + WS_VCT) + (size_t)(gg * 64 + (tid & 1) * 32) * 512 + n;
#pragma unroll
                        for (int i = 0; i < 32; ++i) VCT[(size_t)i * 512] = (bf16)f2bf(acc[i]); } }
                if (bx == 0) { if (tid < 192) { ((bf16*)(ws + WS_KCMP))[511 * 192 + tid] = 0; ((bf16*)(ws + WS_KCL))[511 * 192 + tid] = 0; } if (tid < 128) ((bf16*)(ws + WS_VCT))[tid * 512 + 511] = 0; }
            } else {
                const bf16* PA = (const bf16*)(ws + WS_A); const float* SM = (const float*)(ws + WS_SM);
                for (int it = bx - 8; it < NCHUNK * 4; it += G - 8)
                    gdn_prep_chunk(PA, SM, args.in[I_CONVW] + l * 4 * 1536, args.in[I_ALOG] + l * 4, args.in[I_DTB] + l * 4, ws + WS_QKV, it >> 2, it & 3, lds, tid);
            }
        } break;
        case K_M3: {
            const bf16* PA = (const bf16*)(ws + WS_A); bf16* OB3 = (bf16*)(ws + WS_O);
            float* wl = (float*)(lds + wave * 16384);
            if (bx < 4) gdn_scan_block(ws + WS_QKV, OB3, bx, lds, tid);
            else if (bx < 8) gla_scan_block(ws + ALPHA_OFF, ws + WS_WGU, OB3 + 2 * (size_t)SEQ * 512, bx - 4, lds, tid);
            else { const LAS int* btab = (const LAS int*)(ldsl + BTAB_OFF); const LAS float* relb = (const LAS float*)(ldsl + RELB_OFF);
                unsigned* qctr = (unsigned*)(ws + WS_CTL) + CW_Q + 64 * (l * 2 + b);
                volatile unsigned* qw = (volatile unsigned*)(lds + NSA_UOFF + 256);
                for (;;) {
                    __syncthreads();
                    if (tid == 0) *qw = __hip_atomic_fetch_add(qctr, 1u, __ATOMIC_RELAXED, __HIP_MEMORY_SCOPE_AGENT);
                    __syncthreads();
                    const unsigned u = *qw;
                    if (u >= (unsigned)(SEQ / 32 * 2)) break;
                    nsa_unit(PA, (const float*)(ws + WS_SM), (const bf16*)(ws + WS_KCMP), (const bf16*)(ws + WS_KCL), (const bf16*)(ws + WS_VCT), (const bf16*)(ws + WS_VTS), (const bf16*)(ws + WS_VTW),
                             relb, btab, OB3 + (size_t)SEQ * 512, SEQ - 32 - 32 * (int)(u >> 1), (int)(u & 1), lds, tid);
                } }
        } break;
        case K_M4: {
            for (int it = gw; it < SEQ * 4; it += NGW) out_norm_item((bf16*)(ws + WS_O), (const bf16*)(ws + WS_A), PA_GZ, args.in[I_GDNNW] + l * 128, it >> 2, it & 3, lane);
            for (int it = gw; it < SEQ * 4; it += NGW) out_norm_item((bf16*)(ws + WS_O) + 2 * (size_t)SEQ * 512, (const bf16*)(ws + WS_A), PA_LR, args.in[I_GLANW] + l * 128, it >> 2, it & 3, lane);
        } break;
        case K_M5: {
#pragma unroll 1
            for (int br = 0; br < 3; ++br) {
                pg8::StaticOrder S; S.init(SEQ, DM, G, bx);
                pg8::Gemm g{(const bf16*)(ws + WS_O) + (size_t)br * SEQ * 512, (const bf16*)(ws + WS_WB) + (size_t)br * 512 * 1024, SEQ, DM, 512, 512};
                pg8::EpiMerge E{(const bf16*)(ws + WS_G) + br * 1024, (float*)(ws + WS_RMW), (bf16*)(ws + WS_MG), br};
                pg8::gemm_phase<pg8::EpiMerge, pg8::StaticOrder, true, true>(ldsl, g, S, E);
            }
        } break;
        default: break;
        }
#if MK_ONE_LAUNCH
        if (pc + 1 < args.ph_hi) xcd_barrier(bar);
#endif
    }
}

extern "C" void kernel_launch(void* const* d_in, const int* in_sizes, int n_in, void* d_out, int out_size, void* d_ws, size_t ws_size, hipStream_t stream) {
    static int grid = 0;
    if (grid == 0) {
        if (n_in != 30 || out_size != MTOK * DM || ws_size < 292 * MiB) { fprintf(stderr, "kernel_launch: unexpected shapes (n_in %d out %d ws %zu)\n", n_in, out_size, ws_size); grid = -1; return; }
        int dev = 0, cus = 0, per_cu = 0;
        if (hipGetDevice(&dev) != hipSuccess || hipDeviceGetAttribute(&cus, hipDeviceAttributeMultiprocessorCount, dev) != hipSuccess) { grid = -1; return; }
        if (hipFuncSetAttribute((const void*)mk_fwd, hipFuncAttributeMaxDynamicSharedMemorySize, LDS_BYTES) != hipSuccess) { fprintf(stderr, "kernel_launch: hipFuncSetAttribute failed\n"); grid = -1; return; }
        if (hipOccupancyMaxActiveBlocksPerMultiprocessor(&per_cu, (const void*)mk_fwd, NTHR, LDS_BYTES) != hipSuccess || per_cu < 1) { fprintf(stderr, "kernel_launch: occupancy query says %d blocks per CU\n", per_cu); grid = -1; (void)hipGetLastError(); return; }
        (void)hipGetLastError();
        grid = cus;
    }
    if (grid < 0) return;
    (void)hipMemsetAsync((char*)d_ws + WS_CTL, 0, CTL_ZERO_BYTES, stream);
    Args a{};
    for (int i = 0; i < 30; ++i) a.in[i] = (const float*)d_in[i];
    a.out = (float*)d_out; a.ws = (unsigned char*)d_ws;
    int np = 0;
#ifndef PROBE_KIND
#define PROBE_KIND -1
#endif
    auto push = [&](int kind, int sub, int b, int l, int mixer) { const int reps = (kind == PROBE_KIND) ? 2 : 1; for (int r = 0; r < reps; ++r) a.prog[np++] = (unsigned char)(kind | sub << 4 | b << 5 | l << 6 | mixer << 7); };
    for (int l = 0; l < DEPTH; ++l) {
        push(K_CONV, 0, 0, l, 0); push(K_F1, 0, 0, l, 0); push(K_GF32, 0, 0, l, 0); push(K_ROWS, 0, 0, l, 0);
        for (int b = 0; b < NBATCH; ++b) { push(K_M1, 0, b, l, 1); push(K_M2, 0, b, l, 1); push(K_M2B, 0, b, l, 1); push(K_M3, 0, b, l, 1); push(K_M4, 0, b, l, 1); push(K_M5, 0, b, l, 1); push(K_GF32, 0, b, l, 1); push(K_ROWS, 0, b, l, 1); }
        push(K_CONV, 1, 0, l, 0); push(K_F1, 1, 0, l, 0); push(K_GF32, 1, 0, l, 0); push(K_ROWS, 1, 0, l, 0);
    }
    const int NPH = np;
#if MK_ONE_LAUNCH
    a.ph_lo = 0; a.ph_hi = NPH;
    hipLaunchKernelGGL(mk_fwd, dim3(grid), dim3(NTHR), LDS_BYTES, stream, a);
#else
    for (int p = 0; p < NPH; ++p) { a.ph_lo = p; a.ph_hi = p + 1; hipLaunchKernelGGL(mk_fwd, dim3(grid), dim3(NTHR), LDS_BYTES, stream, a); }
#endif
}
```

```cpp
#include <hip/hip_runtime.h>
#include <cstdio>
#include <cstdint>
#ifndef MK_ONE_LAUNCH
#define MK_ONE_LAUNCH 1
#endif
namespace pg8 {
#define PG8_LAS __attribute__((address_space(3)))
typedef unsigned short bf16_t;
typedef short bf16x8 __attribute__((ext_vector_type(8)));
typedef float f32x4 __attribute__((ext_vector_type(4)));
typedef unsigned u32x4 __attribute__((ext_vector_type(4)));
typedef unsigned u32x2 __attribute__((ext_vector_type(2)));
constexpr int BM = 256, BK = 64, HALF = 128, HTB = HALF * BK * 2  , STAGE_BYTES = 8 * HTB, NXCD = 8, WGM = 8;

__host__ __device__ __forceinline__ int lds_byte(int r, int c) { const int st = (r >> 4) * 2 + (c >> 5), rr = r & 15, cc = c & 31, ob = rr * 64 + cc * 2; return st * 1024 + (ob ^ (((ob >> 9) & 1) << 5)); }
__host__ __device__ __forceinline__ void stage_rc(int b, int& R, int& C) { const int st = b / 1024, sb = b % 1024, swz = sb ^ (((sb >> 9) & 1) << 5); R = (st >> 1) * 16 + swz / 64; C = (st & 1) * 32 + (swz % 64) / 2; }
__host__ __device__ __forceinline__ int perm32(int rho) { const int n = rho >> 4, i = rho & 15; return 8 * (i >> 2) + 4 * n + (i & 3); }

struct Unit { int pm, pn; };
struct Gemm { const bf16_t* A; const bf16_t* Bt; int M, N, K, lda, ldb; };

struct StaticOrder {
    int nM, nN, nwg, G, c;
    __host__ __device__ void init(int M, int N, int G_, int c_) { nM = M / BM; nN = N / BM; nwg = nM * nN; G = G_; c = c_; }
    __host__ __device__ bool next(int i, Unit& u) const {
        const long L = (long)i * G + c; if (L >= nwg) return false;
        int wgid = (int)L; { const int q = nwg / NXCD, r = nwg % NXCD, xcd = wgid % NXCD, off = wgid / NXCD; wgid = (xcd < r ? xcd * (q + 1) : r * (q + 1) + (xcd - r) * q) + off; }
        const int nig = WGM * nN, gid = wgid / nig, fm = gid * WGM, gsz = (nM - fm) < WGM ? (nM - fm) : WGM;
        u.pm = fm + ((wgid % nig) % gsz); u.pn = (wgid % nig) / gsz; return true;
    }
    __device__ __forceinline__ void a_ready(const Unit&) const {}
    __device__ __forceinline__ void done(const Unit&) const {}
};

struct OneTile { int pm, pn; __device__ __forceinline__ bool next(int i, Unit& u) const { if (i) return false; u.pm = pm; u.pn = pn; return true; }
    __device__ __forceinline__ void a_ready(const Unit&) const {} __device__ __forceinline__ void done(const Unit&) const {} };
__device__ __forceinline__ unsigned cvt_pk_bf16(float lo, float hi) { unsigned r; asm volatile("v_cvt_pk_bf16_f32 %0, %1, %2" : "=v"(r) : "v"(lo), "v"(hi)); return r; }
__device__ __forceinline__ float bflo(unsigned w) { return __uint_as_float(w << 16); }
__device__ __forceinline__ float bfhi(unsigned w) { return __uint_as_float(w & 0xffff0000u); }
__device__ __forceinline__ float sigmoid_f(float x) { return __builtin_amdgcn_rcpf(1.f + __expf(-x)); }

struct EpiSwiglu {
    static constexpr bool PERM = true, AFTER_DRAIN = false;
    bf16_t* H; int ldh;
    __device__ __forceinline__ void operator()(const f32x4 (&acc)[2][2][4][2], const Unit& u, int wr, int wc, int fr, int fq) const {
        const int row0 = u.pm * BM + wr * 64 + fr, j0 = u.pn * HALF + wc * 32 + 8 * fq;
#pragma unroll
        for (int ai = 0; ai < 2; ++ai)
#pragma unroll
            for (int m = 0; m < 4; ++m) {
                bf16_t* p = H + (size_t)(row0 + ai * HALF + m * 16) * ldh + j0;
                float h[8];
#pragma unroll
                for (int n = 0; n < 2; ++n)
#pragma unroll
                    for (int i = 0; i < 4; ++i) { const float g = acc[ai][0][m][n][i], uu = acc[ai][1][m][n][i]; h[n * 4 + i] = g * sigmoid_f(g) * uu; }
                u32x4 w; w.x = cvt_pk_bf16(h[0], h[1]); w.y = cvt_pk_bf16(h[2], h[3]); w.z = cvt_pk_bf16(h[4], h[5]); w.w = cvt_pk_bf16(h[6], h[7]);
                *(u32x4*)p = w;
                asm volatile("" ::: "memory");
            }
    }
};
struct EpiGelu {
    static constexpr bool PERM = false, AFTER_DRAIN = false;
    bf16_t* Hd; const float* bias;
    __device__ __forceinline__ void operator()(const f32x4 (&acc)[2][2][4][2], const Unit& u, int wr, int wc, int fr, int fq) const {
        const int row0 = u.pm * BM + wr * 64 + fr, col0 = wc * 32 + 4 * fq;
#pragma unroll
        for (int bj = 0; bj < 2; ++bj)
#pragma unroll
            for (int n = 0; n < 2; ++n) { const int c = col0 + bj * HALF + n * 16; const f32x4 bv = *(const f32x4*)(bias + c);
#pragma unroll
                for (int ai = 0; ai < 2; ++ai)
#pragma unroll
                    for (int m = 0; m < 4; ++m) { f32x4 v = acc[ai][bj][m][n] + bv;
#pragma unroll
                        for (int i = 0; i < 4; ++i) { const float x = v[i]; const float u2 = 1.5957691216057308f * (x + 0.044715f * x * x * x); v[i] = x * (1.f - __builtin_amdgcn_rcpf(1.f + __expf(u2))); }
                        u32x2 w; w.x = cvt_pk_bf16(v[0], v[1]); w.y = cvt_pk_bf16(v[2], v[3]);
                        *(u32x2*)(Hd + (size_t)(row0 + ai * HALF + m * 16) * 256 + c) = w; asm volatile("" ::: "memory"); } }
    }
};
struct EpiF32 {
    static constexpr bool PERM = false, AFTER_DRAIN = false;
    float* Y; int ldc;
    __device__ __forceinline__ void operator()(const f32x4 (&acc)[2][2][4][2], const Unit& u, int wr, int wc, int fr, int fq) const {
        const int row0 = u.pm * BM + wr * 64 + fr, col0 = u.pn * BM + wc * 32 + 4 * fq;
#pragma unroll
        for (int ai = 0; ai < 2; ++ai)
#pragma unroll
            for (int m = 0; m < 4; ++m) { float* p = Y + (size_t)(row0 + ai * HALF + m * 16) * ldc + col0;
#pragma unroll
                for (int bj = 0; bj < 2; ++bj)
#pragma unroll
                    for (int n = 0; n < 2; ++n) *(f32x4*)(p + bj * HALF + n * 16) = acc[ai][bj][m][n]; }
    }
};
struct EpiWin {
    static constexpr bool PERM = true, AFTER_DRAIN = false;
    bf16_t* PA; float* SM; bf16_t* G; bf16_t* KCF; bf16_t* VCF;
    __device__ __forceinline__ void operator()(const f32x4 (&acc)[2][2][4][2], const Unit& u, int wr, int wc, int fr, int fq) const {
        const int row0 = u.pm * BM + wr * 64 + fr, cw = wc * 32 + 8 * fq;
        const bool gate = u.pn >= 21;
#pragma unroll
        for (int ai = 0; ai < 2; ++ai)
#pragma unroll
            for (int m = 0; m < 4; ++m) { const size_t row = (size_t)(row0 + ai * HALF + m * 16);
#pragma unroll
                for (int bj = 0; bj < 2; ++bj) {
                    f32x4 v0 = acc[ai][bj][m][0], v1 = acc[ai][bj][m][1];
                    if (gate) {
#pragma unroll
                        for (int i = 0; i < 4; ++i) { v0[i] = sigmoid_f(v0[i]); v1[i] = sigmoid_f(v1[i]); }
                    }
                    u32x4 w; w.x = cvt_pk_bf16(v0[0], v0[1]); w.y = cvt_pk_bf16(v0[2], v0[3]); w.z = cvt_pk_bf16(v1[0], v1[1]); w.w = cvt_pk_bf16(v1[2], v1[3]);
                    if (gate) *(u32x4*)(G + row * 3072 + (u.pn - 21) * BM + bj * HALF + cw) = w;
                    else {
                        const int col = u.pn * BM + bj * HALF + cw;
                        *(u32x4*)(PA + row * 5376 + col) = w;
                        if (col >= 5312) { float* s = SM + row * 64 + (col - 5312); *(f32x4*)s = v0; *(f32x4*)(s + 4) = v1; }
                        if (col >= 2816 && col < 3136) { const int off = col - 2816, gg = off >= 160, c = off - gg * 160;
                            if (c < 96) *(u32x4*)(KCF + ((size_t)gg * 8192 + row) * 96 + c) = w; else *(u32x4*)(VCF + ((size_t)gg * 8192 + row) * 64 + (c - 96)) = w; }
                    }
                    asm volatile("" ::: "memory");
                }
            }
    }
};
struct EpiMerge {
    static constexpr bool PERM = false, AFTER_DRAIN = false;
    const bf16_t* G; float* RMW; bf16_t* MG; int STEP;
    __device__ __forceinline__ void operator()(const f32x4 (&acc)[2][2][4][2], const Unit& u, int wr, int wc, int fr, int fq) const {
        const int row0 = u.pm * BM + wr * 64 + fr, col0 = u.pn * BM + wc * 32 + 4 * fq;
#pragma unroll
        for (int ai = 0; ai < 2; ++ai)
#pragma unroll
            for (int m = 0; m < 4; ++m) { const size_t row = (size_t)(row0 + ai * HALF + m * 16);
#pragma unroll
                for (int bj = 0; bj < 2; ++bj)
#pragma unroll
                    for (int n = 0; n < 2; ++n) { const int c = col0 + bj * HALF + n * 16;
                        const u32x2 gw = *(const u32x2*)(G + row * 3072 + c);
                        f32x4 v = acc[ai][bj][m][n]; v[0] *= bflo(gw.x); v[1] *= bfhi(gw.x); v[2] *= bflo(gw.y); v[3] *= bfhi(gw.y);
                        float* r = RMW + row * 1024 + c;
                        if (STEP == 0) *(f32x4*)r = v;
                        else if (STEP == 1) *(f32x4*)r = *(const f32x4*)r + v;
                        else { v = *(const f32x4*)r + v; u32x2 w; w.x = cvt_pk_bf16(v[0], v[1]); w.y = cvt_pk_bf16(v[2], v[3]); *(u32x2*)(MG + row * 1024 + c) = w; }
                    }
            }
    }
};

template <class Epi, class Sched, bool ALIGN_EPI = false, bool SP2 = false>
__device__ __forceinline__ void gemm_phase(PG8_LAS unsigned char* lds, const Gemm g, const Sched& S, const Epi& E) {
    int tid_ = threadIdx.x; asm volatile("" : "+v"(tid_));
    const int tid = tid_, wid = __builtin_amdgcn_readfirstlane(tid >> 6), lane = tid & 63, wr = wid >> 2, wc = wid & 3, fr = lane & 15, fq = lane >> 4;
    const int K = g.K, nt = K / BK, lda = g.lda, ldb = g.ldb;
    unsigned voffA[2], voffB[2];
#pragma unroll
    for (int i = 0; i < 2; ++i) { int R, C; stage_rc(tid * 16 + i * 8192, R, C); const int Rb = Epi::PERM ? ((R & ~31) + perm32(R & 31)) : R;
        voffA[i] = (unsigned)(R * lda + C) * 2u; voffB[i] = (unsigned)(Rb * ldb + C) * 2u; }
    const size_t kstep = (size_t)(BK * 2);
    const size_t hstepA = (size_t)HALF * lda * 2, tstepA = 2 * hstepA;
    const size_t hstep = (size_t)HALF * ldb * 2;
    const size_t tstep = 2 * hstep;
    const unsigned ldsw = (unsigned)wid * 1024u;
    const int aoff = lds_byte(wr * 64 + fr, fq * 8), boff = lds_byte(wc * 32 + fr, fq * 8);
#define PG8_SA(b, h) (((b) * 2 + (h)) * HTB)
#define PG8_SB(b, h) ((4 + (b) * 2 + (h)) * HTB)
#define PG8_STAGE(bufoff, gbase, voff) do { _Pragma("unroll") for (int _i = 0; _i < 2; ++_i) \
        __builtin_amdgcn_global_load_lds((const unsigned*)((const char*)(gbase) + (voff)[_i]), (PG8_LAS unsigned*)(lds + (bufoff) + ldsw + _i * 8192), 16, 0, 0); } while (0)
#define PG8_LDA(dst, b, h) do { _Pragma("unroll") for (int m = 0; m < 4; ++m) _Pragma("unroll") for (int k = 0; k < 2; ++k) dst[m][k] = *(const PG8_LAS bf16x8*)(lds + PG8_SA(b, h) + aoff + m * 2048 + k * 1024); } while (0)
#define PG8_LDB(dst, b, h) do { _Pragma("unroll") for (int n = 0; n < 2; ++n) _Pragma("unroll") for (int k = 0; k < 2; ++k) dst[n][k] = *(const PG8_LAS bf16x8*)(lds + PG8_SB(b, h) + boff + n * 2048 + k * 1024); } while (0)
#define PG8_MMA(ai, bj, At, Bt) do { __builtin_amdgcn_s_setprio(1); _Pragma("unroll") for (int m = 0; m < 4; ++m) _Pragma("unroll") for (int n = 0; n < 2; ++n) _Pragma("unroll") for (int k = 0; k < 2; ++k) \
        acc[ai][bj][m][n] = __builtin_amdgcn_mfma_f32_16x16x32_bf16(Bt[n][k], At[m][k], acc[ai][bj][m][n], 0, 0, 0); __builtin_amdgcn_s_setprio(0); } while (0)
#define PG8_WAIT_V(n) asm volatile("s_waitcnt vmcnt(" #n ")" ::: "memory")
#define PG8_WAIT_L(n) asm volatile("s_waitcnt lgkmcnt(" #n ")" ::: "memory")
#define PG8_BAR __builtin_amdgcn_s_barrier()
#define PG8_SCHED __builtin_amdgcn_sched_barrier(0)
    Unit cur, nxt; int ui = 0;
    if (!S.next(0, cur)) return;
    f32x4 acc[2][2][4][2];
#pragma unroll
    for (int a = 0; a < 2; ++a)
#pragma unroll
        for (int b = 0; b < 2; ++b)
#pragma unroll
            for (int m = 0; m < 4; ++m)
#pragma unroll
                for (int n = 0; n < 2; ++n) acc[a][b][m][n] = (f32x4){0.f, 0.f, 0.f, 0.f};
    bf16x8 At[4][2], B0[2][2], B1[2][2];
    const char* cA = (const char*)g.A + (size_t)cur.pm * tstepA; const char* cB = (const char*)g.Bt + (size_t)cur.pn * tstep;
    S.a_ready(cur);
    if constexpr (SP2) {
        PG8_STAGE(PG8_SB(0, 0), cB, voffB); PG8_STAGE(PG8_SB(0, 1), cB + hstep, voffB); PG8_STAGE(PG8_SA(0, 0), cA, voffA); PG8_STAGE(PG8_SA(0, 1), cA + hstepA, voffA);
        if (wr == 1) PG8_BAR;
        PG8_WAIT_V(2); PG8_BAR;
        PG8_STAGE(PG8_SB(1, 0), cB + kstep, voffB); PG8_STAGE(PG8_SA(1, 0), cA + kstep, voffA); PG8_STAGE(PG8_SB(1, 1), cB + hstep + kstep, voffB);
        PG8_WAIT_V(6); PG8_BAR;
    } else {
        PG8_STAGE(PG8_SB(0, 0), cB, voffB); PG8_STAGE(PG8_SA(0, 0), cA, voffA); PG8_STAGE(PG8_SB(0, 1), cB + hstep, voffB); PG8_STAGE(PG8_SA(0, 1), cA + hstepA, voffA);
        if (wr == 1) PG8_BAR;
        PG8_WAIT_V(4); PG8_BAR;
        PG8_STAGE(PG8_SB(1, 0), cB + kstep, voffB); PG8_STAGE(PG8_SA(1, 0), cA + kstep, voffA); PG8_STAGE(PG8_SB(1, 1), cB + hstep + kstep, voffB);
        PG8_WAIT_V(6); PG8_BAR;
    }
    for (;;) {
        const bool has_next = S.next(ui + 1, nxt);
        const char* nA = has_next ? (const char*)g.A + (size_t)nxt.pm * tstepA : cA; const char* nB = has_next ? (const char*)g.Bt + (size_t)nxt.pn * tstep : cB;
        for (int t = 0; t < nt; t += 2) {
            const bool last = (t == nt - 2);
            const char* a1 = cA + (size_t)(t + 1) * kstep;
            const char* a2 = last ? nA : cA + (size_t)(t + 2) * kstep; const char* b2 = last ? nB : cB + (size_t)(t + 2) * kstep;
            const char* a3 = a2 + kstep; const char* b3 = b2 + kstep;
            if (last && has_next) S.a_ready(nxt);
            if constexpr (SP2) {
            PG8_LDB(B0, 0, 0); PG8_LDB(B1, 0, 1); PG8_SCHED; PG8_LDA(At, 0, 0); PG8_STAGE(PG8_SA(1, 1), a1 + hstepA, voffA);
            PG8_WAIT_V(8); PG8_WAIT_L(0); PG8_BAR; PG8_MMA(0, 0, At, B0); PG8_MMA(0, 1, At, B1); PG8_BAR; PG8_SCHED;
            PG8_LDA(At, 0, 1); PG8_STAGE(PG8_SB(0, 0), b2, voffB); PG8_STAGE(PG8_SB(0, 1), b2 + hstep, voffB); PG8_STAGE(PG8_SA(0, 0), a2, voffA);
            PG8_WAIT_V(8); PG8_WAIT_L(0); PG8_BAR; PG8_MMA(1, 0, At, B0); PG8_MMA(1, 1, At, B1); PG8_BAR; PG8_SCHED;
            PG8_LDB(B0, 1, 0); PG8_LDB(B1, 1, 1); PG8_SCHED; PG8_LDA(At, 1, 0); PG8_STAGE(PG8_SA(0, 1), a2 + hstepA, voffA);
            PG8_WAIT_V(8); PG8_WAIT_L(0); PG8_BAR; PG8_MMA(0, 0, At, B0); PG8_MMA(0, 1, At, B1); PG8_BAR; PG8_SCHED;
            PG8_LDA(At, 1, 1); PG8_STAGE(PG8_SB(1, 0), b3, voffB); PG8_STAGE(PG8_SB(1, 1), b3 + hstep, voffB); PG8_STAGE(PG8_SA(1, 0), a3, voffA);
            PG8_WAIT_V(8); PG8_WAIT_L(0); PG8_BAR; PG8_MMA(1, 0, At, B0); PG8_MMA(1, 1, At, B1); PG8_BAR; PG8_SCHED;
            } else {
            PG8_LDB(B0, 0, 0); PG8_SCHED; PG8_LDA(At, 0, 0); PG8_STAGE(PG8_SA(1, 1), a1 + hstepA, voffA);
            PG8_WAIT_L(8); PG8_BAR; PG8_WAIT_L(0); PG8_MMA(0, 0, At, B0); PG8_BAR; PG8_SCHED;
            PG8_LDB(B1, 0, 1); PG8_STAGE(PG8_SB(0, 0), b2, voffB);
            PG8_BAR; PG8_WAIT_L(0); PG8_MMA(0, 1, At, B1); PG8_BAR;
            PG8_LDA(At, 0, 1); PG8_STAGE(PG8_SA(0, 0), a2, voffA);
            PG8_BAR; PG8_WAIT_L(0); PG8_MMA(1, 0, At, B0); PG8_BAR; PG8_SCHED;
            PG8_STAGE(PG8_SB(0, 1), b2 + hstep, voffB);
            PG8_WAIT_V(6); PG8_BAR; PG8_MMA(1, 1, At, B1); PG8_BAR;
            PG8_LDB(B0, 1, 0); PG8_SCHED; PG8_LDA(At, 1, 0); PG8_STAGE(PG8_SA(0, 1), a2 + hstepA, voffA);
            PG8_WAIT_L(8); PG8_BAR; PG8_WAIT_L(0); PG8_MMA(0, 0, At, B0); PG8_BAR; PG8_SCHED;
            PG8_LDB(B1, 1, 1); PG8_STAGE(PG8_SB(1, 0), b3, voffB);
            PG8_BAR; PG8_WAIT_L(0); PG8_MMA(0, 1, At, B1); PG8_BAR;
            PG8_LDA(At, 1, 1); PG8_STAGE(PG8_SA(1, 0), a3, voffA);
            PG8_BAR; PG8_WAIT_L(0); PG8_MMA(1, 0, At, B0); PG8_BAR; PG8_SCHED;
            PG8_STAGE(PG8_SB(1, 1), b3 + hstep, voffB);
            PG8_WAIT_V(6); PG8_BAR; PG8_MMA(1, 1, At, B1); PG8_BAR;
            }
        }
        if constexpr (ALIGN_EPI) { if (wr == 0) PG8_BAR; }
        if constexpr (!Epi::AFTER_DRAIN) { E(acc, cur, wr, wc, fr, fq); S.done(cur); }
        if (!has_next) break;
#pragma unroll
        for (int a = 0; a < 2; ++a)
#pragma unroll
            for (int b = 0; b < 2; ++b)
#pragma unroll
                for (int m = 0; m < 4; ++m)
#pragma unroll
                    for (int n = 0; n < 2; ++n) acc[a][b][m][n] = (f32x4){0.f, 0.f, 0.f, 0.f};
        cur = nxt; cA = nA; cB = nB; ++ui;
        if constexpr (ALIGN_EPI) { if (wr == 1) PG8_BAR; }
    }
    PG8_WAIT_V(0);
    if constexpr (!ALIGN_EPI) { if (wr == 0) PG8_BAR; }
    PG8_BAR;
    if constexpr (Epi::AFTER_DRAIN) { E.fused(acc, cur, wr, wc, fr, fq, lds, wid, lane); S.done(cur); }
#undef PG8_SA
#undef PG8_SB
#undef PG8_STAGE
#undef PG8_LDA
#undef PG8_LDB
#undef PG8_MMA
#undef PG8_WAIT_V
#undef PG8_WAIT_L
#undef PG8_BAR
#undef PG8_SCHED
}
}

constexpr int NWAVES = 8, NTHR = 512;
constexpr int NBATCH = 2, SEQ = 8192, MTOK = NBATCH * SEQ, DM = 1024, DFF = 2816, DIN_SRC = 8432, NIN = 8448, NPA = 5376, NMG = 3072, DEPTH = 2;
constexpr float NORM_EPS = 1e-6f;
constexpr int PA_GQ = 0, PA_GK = 512, PA_GV = 1024, PA_GZ = 1536, PA_NQ = 2048, PA_KC = 2816, PA_KS = 3136, PA_KW = 3456, PA_LQ = 3776, PA_LK = 4032, PA_LV = 4288, PA_LR = 4800, PA_SM = 5312;
constexpr size_t MiB = 1u << 20;
constexpr size_t WS_CTL = 0, CTL_ZERO_BYTES = 1 * MiB;
constexpr size_t WS_WGU = 1 * MiB, WS_WD = 12 * MiB, WS_WIN = WS_WD + 5632 * 1024, WS_WB = WS_WIN + (size_t)NIN * DM * 2, WS_WO = WS_WB + 3 * MiB;
constexpr size_t WS_XN = 40 * MiB, WS_A = 72 * MiB, WS_G = 160 * MiB, WS_O = 208 * MiB, WS_QKV = 232 * MiB, WS_SM = 290 * MiB, WS_GATES = 258 * MiB, WS_ORAW = 259 * MiB, WS_VTS = 270 * MiB, WS_VTW = 272 * MiB, WS_KCMP = 275 * MiB, WS_KCL = WS_KCMP + 256 * 1024, WS_VCT = WS_KCMP + 512 * 1024, WS_END = 276 * MiB;
constexpr size_t WS_H = WS_A, WS_Y = WS_G;
constexpr size_t WS_RMW = WS_A, WS_MG = WS_A + 32 * MiB, WS_YB = WS_A + 48 * MiB;
static_assert(WS_WO + 2 * MiB <= WS_XN && WS_Y + 64 * MiB <= WS_QKV && WS_YB + 32 * MiB <= WS_G, "ws map");
constexpr int CW_BAR = 4096, CW_Q = 8192;
constexpr int RING_BYTES = 131072, LDSCTL_OFF = RING_BYTES, MISC_OFF = LDSCTL_OFF + 320, BTAB_OFF = RING_BYTES + 1024, RELB_OFF = RING_BYTES + 1536, LDS_BYTES = 147456;

#define GAS __attribute__((address_space(1)))
#define LAS __attribute__((address_space(3)))
typedef unsigned short bf16;
typedef unsigned v4u __attribute__((ext_vector_type(4)));
typedef unsigned v2u __attribute__((ext_vector_type(2)));
typedef float f32x4 __attribute__((ext_vector_type(4)));
#define LDS_WAIT() asm volatile("s_waitcnt lgkmcnt(0)" ::: "memory")
typedef float f32x2_t __attribute__((ext_vector_type(2))); typedef __bf16 bf16x2_t __attribute__((ext_vector_type(2)));
__device__ __forceinline__ unsigned pk2(float lo, float hi) { f32x2_t v = {lo, hi}; bf16x2_t r = __builtin_convertvector(v, bf16x2_t); return __builtin_bit_cast(unsigned, r); }
__device__ __forceinline__ unsigned f2bf(float f) { return pk2(f, 0.f) & 0xffffu; }
__device__ __forceinline__ float bf2f(bf16 h) { return __uint_as_float((unsigned)h << 16); }
__device__ __forceinline__ float bflo(unsigned w) { return __uint_as_float(w << 16); }
__device__ __forceinline__ float bfhi(unsigned w) { return __uint_as_float(w & 0xffff0000u); }
__device__ __forceinline__ float wave_sum(float v) {
#pragma unroll
    for (int o = 1; o < 64; o <<= 1) v += __shfl_xor(v, o);
    return v;
}
__device__ __forceinline__ float wave_max(float v) {
#pragma unroll
    for (int o = 1; o < 64; o <<= 1) v = fmaxf(v, __shfl_xor(v, o));
    return v;
}
__device__ __forceinline__ float sigmoidf_(float x) { return 1.f / (1.f + expf(-x)); }
__device__ __forceinline__ float siluf_(float x) { return x / (1.f + expf(-x)); }
__device__ __forceinline__ float softplusf_(float x) { return x > 20.f ? x : log1pf(expf(x)); }
__device__ __forceinline__ float logsigmoidf_(float x) { return fminf(x, 0.f) - log1pf(expf(-fabsf(x))); }
__device__ __forceinline__ float gelu_tanhf_(float x) { return 0.5f * x * (1.f + tanhf(0.7978845608028654f * (x + 0.044715f * x * x * x))); }

#define XB_TMO      128
#define XB_XCNT(j)  (256  + 64 * (j))
#define XB_XSUB(j)  (1280 + 64 * (j))
#define XB_XGEN(j)  (2304 + 64 * (j))
#define XB_TOP      3328
#define XB_TOPGEN   3392
#define XCD_BAR_WORDS 3456
#define XB_SPIN_CAP (1u << 22)
__device__ __forceinline__ unsigned xb_ld(unsigned* p)              { return __hip_atomic_load(p, __ATOMIC_RELAXED, __HIP_MEMORY_SCOPE_AGENT); }
__device__ __forceinline__ unsigned xb_add(unsigned* p, unsigned v) { return __hip_atomic_fetch_add(p, v, __ATOMIC_RELAXED, __HIP_MEMORY_SCOPE_AGENT); }
__device__ __forceinline__ unsigned xb_xcc_id() { return (unsigned)__builtin_amdgcn_s_getreg((3 << 11) | 20) & 0xFu; }
#define XB_SPIN(cond, bar) do { unsigned _sp = 0; while (cond) { __builtin_amdgcn_s_sleep(1); \
    if ((++_sp & 255u) == 0u) { if (xb_ld(&(bar)[XB_TMO])) break; if (_sp > XB_SPIN_CAP) { atomicAdd(&(bar)[XB_TMO], 1u); break; } } } } while (0)
struct XcdBarrier { unsigned* bar; unsigned x; volatile LAS unsigned* st; };
__device__ __forceinline__ XcdBarrier xcd_barrier_post(unsigned* bar, volatile LAS unsigned* st) {
    XcdBarrier b; b.bar = bar; b.x = xb_xcc_id(); b.st = st;
    if (threadIdx.x == 0) (void)xb_add(&bar[XB_XCNT(b.x)], 1u);
    return b;
}
__device__ __forceinline__ void xcd_barrier_complete(unsigned* bar, unsigned x, unsigned& nloc, unsigned& nx) {
    const unsigned G = gridDim.x * gridDim.y * gridDim.z;
    unsigned sum, cnt, mine, sp = 0u;
    for (;;) {
        sum = 0u; cnt = 0u; mine = 0u;
#pragma unroll
        for (unsigned j = 0; j < 16; ++j) { const unsigned c = xb_ld(&bar[XB_XCNT(j)]); sum += c; cnt += (c > 0u) ? 1u : 0u; mine = (j == x) ? c : mine; }
        if (sum == G) break;
        __builtin_amdgcn_s_sleep(1);
        if ((++sp & 255u) == 0u) { if (xb_ld(&bar[XB_TMO])) break; if (sp > XB_SPIN_CAP) { atomicAdd(&bar[XB_TMO], 1u); break; } }
    }
    nloc = mine > 0u ? mine : 1u; nx = cnt > 0u ? cnt : 1u;
}
__device__ __forceinline__ void xcd_barrier(const XcdBarrier& b) {
    asm volatile("s_waitcnt vmcnt(0)" ::: "memory");
    __syncthreads();
    if (threadIdx.x == 0) {
        unsigned* bar = b.bar;
        __builtin_amdgcn_s_waitcnt(0);
        unsigned nloc = b.st[0], nx = b.st[1];
        if (nloc == 0u) { xcd_barrier_complete(bar, b.x, nloc, nx); b.st[0] = nloc; b.st[1] = nx; }
        const unsigned old = xb_add(&bar[XB_XSUB(b.x)], 1u);
        const unsigned gen = old / nloc;
        if (old + 1u == (gen + 1u) * nloc) {
            __builtin_amdgcn_fence(__ATOMIC_RELEASE, "agent");
            asm volatile("s_waitcnt vmcnt(0)" ::: "memory");
            const unsigned og = xb_add(&bar[XB_TOP], 1u);
            const unsigned tg = og / nx;
            if (og + 1u == (tg + 1u) * nx) xb_add(&bar[XB_TOPGEN], 1u);
            else XB_SPIN(xb_ld(&bar[XB_TOPGEN]) == tg, bar);
            __builtin_amdgcn_fence(__ATOMIC_ACQUIRE, "agent");
            xb_add(&bar[XB_XGEN(b.x)], 1u);
            asm volatile("s_waitcnt vmcnt(0)" ::: "memory");
        } else {
            XB_SPIN(xb_ld(&bar[XB_XGEN(b.x)]) == gen, bar);
            __builtin_amdgcn_fence(__ATOMIC_ACQUIRE, "agent");
            asm volatile("s_waitcnt vmcnt(0)" ::: "memory");
        }
    }
    __syncthreads();
}

constexpr int MAXPH = 128;
struct Args { const float* in[30]; float* out; unsigned char* ws; int ph_lo, ph_hi; unsigned short prog[MAXPH]; };
enum { I_X = 0, I_RELB, I_F1PRE, I_F1GU, I_F1D, I_F1POST, I_MPRE, I_WIN, I_CONVW, I_ALOG, I_DTB, I_GDNNW, I_PEK, I_W1K, I_W2K, I_PEV, I_W1V, I_W2V, I_GGW, I_GGB, I_GLANW, I_WBG, I_WBN, I_WBL, I_WOUT, I_MPOST, I_F2PRE, I_F2GU, I_F2D, I_F2POST };

template <class RowMap>
__device__ __forceinline__ void transpose_item(const float* W, int K, int N, bf16* WT, LAS float* scr, int item, int lane, const RowMap& rm) {
    const int nblk = (N + 31) / 32, kb = item / nblk, nb = item % nblk, k0 = 64 * kb, n0 = 32 * nb;
    const bool okc = (n0 + (lane & 31)) < N;
#pragma unroll 8
    for (int i = 0; i < 32; ++i) { const int kk = 2 * i + (lane >> 5); scr[kk * 33 + (lane & 31)] = okc ? W[(size_t)(k0 + kk) * N + n0 + (lane & 31)] : 0.f; }
    LDS_WAIT(); asm volatile("" ::: "memory");
    const int c = lane & 7;
#pragma unroll
    for (int j = 0; j < 4; ++j) { const int n = (lane >> 3) + 8 * j; const LAS float* s = scr + (8 * c) * 33 + n;
        v4u o; o.x = pk2(s[0 * 33], s[1 * 33]); o.y = pk2(s[2 * 33], s[3 * 33]); o.z = pk2(s[4 * 33], s[5 * 33]); o.w = pk2(s[6 * 33], s[7 * 33]);
        if (n0 + n < N) *(v4u*)(WT + (size_t)rm(n0 + n) * K + k0 + 8 * c) = o; }
    LDS_WAIT(); asm volatile("" ::: "memory");
}
struct MapId { __device__ __forceinline__ int operator()(int n) const { return n; } };
struct MapGU { __device__ __forceinline__ int operator()(int n) const { const int u = n >= DFF, j = u ? n - DFF : n; return 256 * (j >> 7) + 128 * u + (j & 127); } };
struct MapWin { __device__ __forceinline__ int operator()(int c) const {
    if (c < 2048) return c;
    if (c < 2056) return PA_SM + (c - 2048);
    if (c < 2824) return PA_NQ + (c - 2056);
    if (c < 3784) return PA_KC + (c - 2824);
    if (c < 3808) return PA_SM + 8 + (c - 3784);
    if (c < 5344) return PA_LQ + (c - 3808);
    if (c < 5360) return PA_SM + 32 + (c - 5344);
    return NPA + (c - 5360); } };

__device__ __forceinline__ void row_pass(const float* xin, const float* y, const float* wpost, float scale, float* xout, const float* wnext, bf16* xn, int lane) {
    f32x4 v[4];
#pragma unroll
    for (int j = 0; j < 4; ++j) v[j] = ((const f32x4*)xin)[lane + 64 * j];
    if (y) {
        f32x4 yv[4]; float s = 0.f;
#pragma unroll
        for (int j = 0; j < 4; ++j) { yv[j] = ((const f32x4*)y)[lane + 64 * j]; s += (yv[j].x * yv[j].x + yv[j].y * yv[j].y) + (yv[j].z * yv[j].z + yv[j].w * yv[j].w); }
        const float r = scale / sqrtf(wave_sum(s) * (1.f / DM) + NORM_EPS);
#pragma unroll
        for (int j = 0; j < 4; ++j) { const f32x4 w = ((const f32x4*)wpost)[lane + 64 * j]; v[j] = v[j] + yv[j] * w * r; }
    }
    if (xout) {
#pragma unroll
        for (int j = 0; j < 4; ++j) ((f32x4*)xout)[lane + 64 * j] = v[j];
    }
    if (xn) {
        float s = 0.f;
#pragma unroll
        for (int j = 0; j < 4; ++j) s += (v[j].x * v[j].x + v[j].y * v[j].y) + (v[j].z * v[j].z + v[j].w * v[j].w);
        const float r = 1.f / sqrtf(wave_sum(s) * (1.f / DM) + NORM_EPS);
#pragma unroll
        for (int j = 0; j < 4; ++j) { const f32x4 w = ((const f32x4*)wnext)[lane + 64 * j]; const f32x4 o = v[j] * w * r;
            v2u pk; pk.x = pk2(o.x, o.y); pk.y = pk2(o.z, o.w); ((v2u*)xn)[lane + 64 * j] = pk; }
    }
}

__device__ __forceinline__ void gdn_out_item(const float* ORAW, const bf16* PA, const float* nw, bf16* OA, int t, int h, int lane) {
    const float o0 = ORAW[(size_t)t * 512 + h * 128 + 2 * lane], o1 = ORAW[(size_t)t * 512 + h * 128 + 2 * lane + 1];
    const float rr = 1.f / sqrtf(wave_sum(o0 * o0 + o1 * o1) * (1.f / 128.f) + NORM_EPS);
    const unsigned z = *(const unsigned*)(PA + (size_t)t * NPA + PA_GZ + h * 128 + 2 * lane);
    *(unsigned*)(OA + (size_t)t * 512 + h * 128 + 2 * lane) = pk2(o0 * rr * nw[2 * lane] * siluf_(bflo(z)), o1 * rr * nw[2 * lane + 1] * siluf_(bfhi(z)));
}

typedef short bf16x8 __attribute__((ext_vector_type(8)));
#define MFMA16(a, b, c) __builtin_amdgcn_mfma_f32_16x16x32_bf16((a), (b), (c), 0, 0, 0)
__device__ __forceinline__ int kperm32(int p) { const int q = p >> 3, j = p & 7; return j < 4 ? 4 * q + j : 16 + 4 * q + (j - 4); }
__device__ __forceinline__ bf16x8 pack_ctiles(const f32x4& t0, const f32x4& t1) {
    v4u w; w.x = pk2(t0[0], t0[1]); w.y = pk2(t0[2], t0[3]); w.z = pk2(t1[0], t1[1]); w.w = pk2(t1[2], t1[3]); return __builtin_bit_cast(bf16x8, w);
}
constexpr int GLA_CH = 64, NCHUNK = SEQ / 64;
constexpr size_t GLA_QD = 0, GLA_KT = GLA_QD + (size_t)NCHUNK * 4 * 8192, GLA_AI = GLA_KT + (size_t)NCHUNK * 4 * 8192, GLA_CD = GLA_AI + (size_t)NCHUNK * 4 * 8192, GLA_BYTES = GLA_CD + (size_t)NCHUNK * 4 * 256, GLA_VBYTES = (size_t)NCHUNK * 4 * 16384;
__device__ __forceinline__ void gla_prep_item(const bf16* PA, const float* SM, const float* ggw, const float* ggb, unsigned char* img, unsigned char* imgv, int n, int h, float* sl, int tid) {
    float* Qs = sl; float* Ks = sl + 64 * 65; float* BC = sl + 2 * 64 * 65; bf16* Vs = (bf16*)(sl + 3 * 64 * 65);
    const int t0 = n * 64, ch = n * 4 + h, lane = tid & 63, wave = tid >> 6;
    __syncthreads();
    {
        const int c = tid >> 3, dg = tid & 7;
        const bf16* row = PA + (size_t)(t0 + c) * NPA;
        const v4u q8 = *(const v4u*)(row + PA_LQ + h * 64 + dg * 8), k8 = *(const v4u*)(row + PA_LK + h * 64 + dg * 8);
        const float qv[8] = {bflo(q8.x), bfhi(q8.x), bflo(q8.y), bfhi(q8.y), bflo(q8.z), bfhi(q8.z), bflo(q8.w), bfhi(q8.w)};
        const float kv[8] = {bflo(k8.x), bfhi(k8.x), bflo(k8.y), bfhi(k8.y), bflo(k8.z), bfhi(k8.z), bflo(k8.w), bfhi(k8.w)};
        const float* al = SM + (size_t)(t0 + c) * 64 + 32;
        float x[8];
#pragma unroll
        for (int j = 0; j < 8; ++j) x[j] = ggb[h * 64 + dg * 8 + j];
#pragma unroll
        for (int r = 0; r < 16; ++r) { const float a = al[r];
#pragma unroll
            for (int j = 0; j < 8; ++j) x[j] += a * ggw[r * 256 + h * 64 + dg * 8 + j]; }
#pragma unroll
        for (int j = 0; j < 8; ++j) { const int d = dg * 8 + j; Qs[c * 65 + d] = qv[j] * 0.125f; Ks[c * 65 + d] = kv[j]; BC[c * 65 + d] = logsigmoidf_(x[j]) * (1.f / 16.f); }
        const v4u va = *(const v4u*)(row + PA_LV + h * 128 + dg * 16), vb = *(const v4u*)(row + PA_LV + h * 128 + dg * 16 + 8);
        *(v4u*)(Vs + c * 136 + dg * 16) = va; *(v4u*)(Vs + c * 136 + dg * 16 + 8) = vb;
    }
    __syncthreads();
    if (tid < 64) { float run = 0.f; for (int c = 0; c < 64; ++c) { run += BC[c * 65 + tid]; BC[c * 65 + tid] = run; } }
    __syncthreads();
    {
        bf16* QD = (bf16*)(img + GLA_QD) + (size_t)ch * 4096; bf16* KT = (bf16*)(img + GLA_KT) + (size_t)ch * 4096; float* CD = (float*)(img + GLA_CD) + (size_t)ch * 64;
        const int r = tid >> 3, pg = tid & 7;
        float o[8];
#pragma unroll
        for (int j = 0; j < 8; ++j) { const int p = pg * 8 + j, d = (p & 32) + kperm32(p & 31); o[j] = Qs[r * 65 + d] * expf(BC[r * 65 + d]); }
        v4u w; w.x = pk2(o[0], o[1]); w.y = pk2(o[2], o[3]); w.z = pk2(o[4], o[5]); w.w = pk2(o[6], o[7]);
        *(v4u*)(QD + r * 64 + pg * 8) = w;
#pragma unroll
        for (int j = 0; j < 8; ++j) { const int c = pg * 8 + j; o[j] = Ks[c * 65 + r] * expf(BC[63 * 65 + r] - BC[c * 65 + r]); }
        w.x = pk2(o[0], o[1]); w.y = pk2(o[2], o[3]); w.z = pk2(o[4], o[5]); w.w = pk2(o[6], o[7]);
        *(v4u*)(KT + r * 64 + pg * 8) = w;
        if (tid < 64) CD[tid] = expf(BC[63 * 65 + tid]);
        bf16* VI = (bf16*)(imgv) + (size_t)ch * 8192;
#pragma unroll
        for (int i = 0; i < 2; ++i) { const int f = tid + 512 * i, ws = f >> 7, kk = (f >> 6) & 1, l = f & 63, q = l >> 4, col = l & 15;
            unsigned short e[8];
#pragma unroll
            for (int j = 0; j < 8; ++j) e[j] = Vs[(32 * kk + 8 * q + j) * 136 + 16 * ws + col];
            v4u vw; vw.x = e[0] | ((unsigned)e[1] << 16); vw.y = e[2] | ((unsigned)e[3] << 16); vw.z = e[4] | ((unsigned)e[5] << 16); vw.w = e[6] | ((unsigned)e[7] << 16);
            *(v4u*)(VI + (size_t)f * 8) = vw; }
    }
    {
        bf16* AI = (bf16*)(img + GLA_AI) + (size_t)ch * 4096;
        const int q = lane >> 4, fr = lane & 15;
#pragma unroll 1
        for (int i = 0; i < 2; ++i) { const int tl = wave + 8 * i, ib = tl >> 2, jb = tl & 3;
            f32x4 acc = {0.f, 0.f, 0.f, 0.f};
            if (jb <= ib) {
#pragma unroll
                for (int kk = 0; kk < 2; ++kk) { float a[8], b[8];
#pragma unroll
                    for (int j = 0; j < 8; ++j) { const int d = 32 * kk + 8 * q + j; const float ref = ib > 0 ? BC[(16 * ib - 1) * 65 + d] : 0.f;
                        a[j] = Qs[(16 * ib + fr) * 65 + d] * expf(BC[(16 * ib + fr) * 65 + d] - ref);
                        b[j] = Ks[(16 * jb + fr) * 65 + d] * expf(ref - BC[(16 * jb + fr) * 65 + d]); }
                    v4u aw, bw; aw.x = pk2(a[0], a[1]); aw.y = pk2(a[2], a[3]); aw.z = pk2(a[4], a[5]); aw.w = pk2(a[6], a[7]);
                    bw.x = pk2(b[0], b[1]); bw.y = pk2(b[2], b[3]); bw.z = pk2(b[4], b[5]); bw.w = pk2(b[6], b[7]);
                    acc = MFMA16(__builtin_bit_cast(bf16x8, aw), __builtin_bit_cast(bf16x8, bw), acc); }
            }
#pragma unroll
            for (int r = 0; r < 4; ++r) { const int row = 4 * q + r; float v = acc[r]; if (jb == ib && fr > row) v = 0.f; AI[(16 * ib + row) * 64 + 16 * jb + fr] = (bf16)f2bf(v); }
        }
    }
}
constexpr int GLA_BUF = 3 * 64 * 144 + 256;
__device__ __forceinline__ void gla_scan_block(const unsigned char* img, const unsigned char* imgv, bf16* OC, int h, unsigned char* lds, int tid) {
    const int lane = tid & 63, ws = __builtin_amdgcn_readfirstlane(tid >> 6), q = lane >> 4, fr = lane & 15;
    f32x4 S[4];
#pragma unroll
    for (int i = 0; i < 4; ++i) S[i] = (f32x4){0.f, 0.f, 0.f, 0.f};
    v4u st[3]; v4u stc = {0u, 0u, 0u, 0u}; v4u vB[2];
#define GLA_FETCH(N) do { const int ch_ = (N) * 4 + h; \
        st[0] = *(const v4u*)(img + GLA_QD + (size_t)ch_ * 8192 + tid * 16); st[1] = *(const v4u*)(img + GLA_AI + (size_t)ch_ * 8192 + tid * 16); st[2] = *(const v4u*)(img + GLA_KT + (size_t)ch_ * 8192 + tid * 16); \
        if (tid < 16) stc = *(const v4u*)(img + GLA_CD + (size_t)ch_ * 256 + tid * 16); \
        vB[0] = *(const v4u*)(imgv + (size_t)ch_ * 16384 + (ws * 2 + 0) * 1024 + lane * 16); vB[1] = *(const v4u*)(imgv + (size_t)ch_ * 16384 + (ws * 2 + 1) * 1024 + lane * 16); } while (0)
#define GLA_PUT(B) do { unsigned char* b_ = lds + (B) * GLA_BUF; const int r_ = tid >> 3, c_ = tid & 7; \
        *(v4u*)(b_ + r_ * 144 + c_ * 16) = st[0]; *(v4u*)(b_ + 64 * 144 + r_ * 144 + c_ * 16) = st[1]; *(v4u*)(b_ + 2 * 64 * 144 + r_ * 144 + c_ * 16) = st[2]; \
        if (tid < 16) *(v4u*)(b_ + 3 * 64 * 144 + tid * 16) = stc; } while (0)
    __syncthreads();
    GLA_FETCH(0); GLA_PUT(0);
    __syncthreads();
    for (int n = 0; n < NCHUNK; ++n) {
        const unsigned char* b = lds + (n & 1) * GLA_BUF;
        const v4u vb0 = vB[0], vb1 = vB[1];
        if (n + 1 < NCHUNK) GLA_FETCH(n + 1);
        const bf16x8 v0 = __builtin_bit_cast(bf16x8, vb0), v1 = __builtin_bit_cast(bf16x8, vb1);
        const bf16x8 s0 = pack_ctiles(S[0], S[1]), s1 = pack_ctiles(S[2], S[3]);
        f32x4 o[4];
        bf16x8 qa[4][2], aa[6];
#pragma unroll
        for (int m = 0; m < 4; ++m) { const unsigned char* ar = b + (16 * m + fr) * 144 + q * 16;
            qa[m][0] = *(const bf16x8*)(ar); qa[m][1] = *(const bf16x8*)(ar + 64); aa[m] = *(const bf16x8*)(ar + 64 * 144); if (m >= 2) aa[2 + m] = *(const bf16x8*)(ar + 64 * 144 + 64); }
        __builtin_amdgcn_sched_barrier(0);
#pragma unroll
        for (int m = 0; m < 4; ++m) {
            f32x4 acc = {0.f, 0.f, 0.f, 0.f};
            acc = MFMA16(qa[m][0], s0, acc); acc = MFMA16(qa[m][1], s1, acc); acc = MFMA16(aa[m], v0, acc);
            if (m >= 2) acc = MFMA16(aa[2 + m], v1, acc);
            o[m] = acc;
        }
        bf16x8 kf[4][2]; f32x4 cdv[4];
#pragma unroll
        for (int dt = 0; dt < 4; ++dt) { const unsigned char* kr = b + 2 * 64 * 144 + (16 * dt + fr) * 144 + q * 16; kf[dt][0] = *(const bf16x8*)(kr); kf[dt][1] = *(const bf16x8*)(kr + 64);
            cdv[dt] = *(const f32x4*)(b + 3 * 64 * 144 + (16 * dt + 4 * q) * 4); }
        __builtin_amdgcn_sched_barrier(0);
#pragma unroll
        for (int dt = 0; dt < 4; ++dt) { f32x4 acc = S[dt] * cdv[dt]; acc = MFMA16(kf[dt][0], v0, acc); acc = MFMA16(kf[dt][1], v1, acc); S[dt] = acc; }
#pragma unroll
        for (int m = 0; m < 4; ++m)
#pragma unroll
            for (int r = 0; r < 4; ++r) OC[(size_t)(64 * n + 16 * m + 4 * q + r) * 512 + h * 128 + 16 * ws + fr] = (bf16)f2bf(o[m][r]);
        if (n + 1 < NCHUNK) GLA_PUT((n + 1) & 1);
        asm volatile("s_waitcnt lgkmcnt(0)" ::: "memory"); __builtin_amdgcn_s_barrier(); asm volatile("" ::: "memory");
    }
#undef GLA_FETCH
#undef GLA_PUT
}
__device__ __forceinline__ void out_norm_item(bf16* O, const bf16* PA, int gcol, const float* nw, int t, int h, int lane) {
    const unsigned ow = *(const unsigned*)(O + (size_t)t * 512 + h * 128 + 2 * lane);
    const float o0 = bflo(ow), o1 = bfhi(ow);
    const float rr = 1.f / sqrtf(wave_sum(o0 * o0 + o1 * o1) * (1.f / 128.f) + NORM_EPS);
    const unsigned z = *(const unsigned*)(PA + (size_t)t * NPA + gcol + h * 128 + 2 * lane);
    *(unsigned*)(O + (size_t)t * 512 + h * 128 + 2 * lane) = pk2(o0 * rr * nw[2 * lane] * siluf_(bflo(z)), o1 * rr * nw[2 * lane + 1] * siluf_(bfhi(z)));
}

constexpr size_t GDN_WI = 0, GDN_QI = GDN_WI + (size_t)NCHUNK * 4 * 16384, GDN_AT = GDN_QI + (size_t)NCHUNK * 4 * 16384, GDN_KT = GDN_AT + (size_t)NCHUNK * 4 * 8192,
                 GDN_UI = GDN_KT + (size_t)NCHUNK * 4 * 16384, GDN_DV = GDN_UI + (size_t)NCHUNK * 4 * 16384, GDN_BYTES = GDN_DV + (size_t)NCHUNK * 4 * 768;
__device__ __forceinline__ int pperm32(int k) { const int half = (k >> 4) & 1, fr = k & 15; return 8 * (fr >> 2) + 4 * half + (fr & 3); }
__device__ __forceinline__ void gdn_prep_chunk(const bf16* PA, const float* SM, const float* convw, const float* alog, const float* dtb, unsigned char* img, int n, int h, unsigned char* lds, int tid) {
    bf16* Qn = (bf16*)lds; bf16* Kn = (bf16*)(lds + 17408); bf16* Rt = (bf16*)(lds + 34816); bf16* Ts = (bf16*)(lds + 71680); float* Ls = (float*)(lds + 80896); float* gv = (float*)(lds + 98304);
    const int t0 = n * 64, ch = n * 4 + h, lane = tid & 63, wave = tid >> 6, q = lane >> 4, fr = lane & 15;
    __syncthreads();
    {
        const int c = tid >> 3, g8 = tid & 7, t = t0 + c;
        float val[3][16];
#pragma unroll
        for (int w = 0; w < 3; ++w) {
            const int c0 = w * 512 + h * 128 + g8 * 16;
#pragma unroll
            for (int i = 0; i < 16; ++i) val[w][i] = 0.f;
#pragma unroll
            for (int j = 0; j < 4; ++j) { const int tt = t - 3 + j;
                if (tt >= 0) {
                    const v4u xa = *(const v4u*)(PA + (size_t)tt * NPA + c0), xb = *(const v4u*)(PA + (size_t)tt * NPA + c0 + 8);
                    const float x[16] = {bflo(xa.x), bfhi(xa.x), bflo(xa.y), bfhi(xa.y), bflo(xa.z), bfhi(xa.z), bflo(xa.w), bfhi(xa.w), bflo(xb.x), bfhi(xb.x), bflo(xb.y), bfhi(xb.y), bflo(xb.z), bfhi(xb.z), bflo(xb.w), bfhi(xb.w)};
                    const f32x4* wp = (const f32x4*)(convw + j * 1536 + c0);
#pragma unroll
                    for (int i4 = 0; i4 < 4; ++i4) { const f32x4 wv = wp[i4]; val[w][4 * i4] += wv.x * x[4 * i4]; val[w][4 * i4 + 1] += wv.y * x[4 * i4 + 1]; val[w][4 * i4 + 2] += wv.z * x[4 * i4 + 2]; val[w][4 * i4 + 3] += wv.w * x[4 * i4 + 3]; }
                } }
#pragma unroll
            for (int i = 0; i < 16; ++i) val[w][i] = siluf_(val[w][i]);
        }
        float sq = 0.f, sk = 0.f;
#pragma unroll
        for (int i = 0; i < 16; ++i) { sq += val[0][i] * val[0][i]; sk += val[1][i] * val[1][i]; }
        sq += __shfl_xor(sq, 1); sq += __shfl_xor(sq, 2); sq += __shfl_xor(sq, 4);
        sk += __shfl_xor(sk, 1); sk += __shfl_xor(sk, 2); sk += __shfl_xor(sk, 4);
        const float rq = 0.08838834764831845f / sqrtf(sq + 1e-6f), rk = 1.f / sqrtf(sk + 1e-6f);
        const float beta = sigmoidf_(SM[(size_t)t * 64 + h]);
        v4u w0, w1;
        w0.x = pk2(val[0][0] * rq, val[0][1] * rq); w0.y = pk2(val[0][2] * rq, val[0][3] * rq); w0.z = pk2(val[0][4] * rq, val[0][5] * rq); w0.w = pk2(val[0][6] * rq, val[0][7] * rq);
        w1.x = pk2(val[0][8] * rq, val[0][9] * rq); w1.y = pk2(val[0][10] * rq, val[0][11] * rq); w1.z = pk2(val[0][12] * rq, val[0][13] * rq); w1.w = pk2(val[0][14] * rq, val[0][15] * rq);
        *(v4u*)(Qn + c * 136 + g8 * 16) = w0; *(v4u*)(Qn + c * 136 + g8 * 16 + 8) = w1;
        w0.x = pk2(val[1][0] * rk, val[1][1] * rk); w0.y = pk2(val[1][2] * rk, val[1][3] * rk); w0.z = pk2(val[1][4] * rk, val[1][5] * rk); w0.w = pk2(val[1][6] * rk, val[1][7] * rk);
        w1.x = pk2(val[1][8] * rk, val[1][9] * rk); w1.y = pk2(val[1][10] * rk, val[1][11] * rk); w1.z = pk2(val[1][12] * rk, val[1][13] * rk); w1.w = pk2(val[1][14] * rk, val[1][15] * rk);
        *(v4u*)(Kn + c * 136 + g8 * 16) = w0; *(v4u*)(Kn + c * 136 + g8 * 16 + 8) = w1;
#pragma unroll
        for (int i = 0; i < 16; ++i) Rt[(g8 * 16 + i) * 72 + c] = (bf16)f2bf(beta * val[2][i]);
        if (g8 == 0) { gv[c] = -expf(alog[h]) * softplusf_(SM[(size_t)t * 64 + 4 + h] + dtb[h]); gv[64 + c] = beta; }
    }
    __syncthreads();
    if (wave == 0) {
        float x = gv[lane];
#pragma unroll
        for (int off = 1; off < 64; off <<= 1) { const float y = __shfl_up(x, off); if (lane >= off) x += y; }
        gv[128 + lane] = x; gv[192 + lane] = expf(x);
    }
    __syncthreads();
    {
        const int c = tid >> 3, g8 = tid & 7; const float s = gv[64 + c] * gv[192 + c];
#pragma unroll
        for (int i = 0; i < 16; ++i) Rt[(128 + g8 * 16 + i) * 72 + c] = (bf16)f2bf(s * bf2f(Kn[c * 136 + g8 * 16 + i]));
    }
    {
        bf16* AT = (bf16*)(img + GDN_AT) + (size_t)ch * 4096;
#pragma unroll 1
        for (int job = wave; job < 26; job += 8) {
            int ib, jb; const bool isq = job >= 10;
            if (!isq) { int r = job; ib = 0; while (r > ib) { r -= ib + 1; ++ib; } jb = r; } else { ib = (job - 10) >> 2; jb = (job - 10) & 3; }
            f32x4 acc = {0.f, 0.f, 0.f, 0.f};
            if (jb <= ib) {
                const bf16* ap = (isq ? Qn : Kn) + (16 * ib + fr) * 136 + q * 8; const bf16* bp = Kn + (16 * jb + fr) * 136 + q * 8;
#pragma unroll
                for (int kk = 0; kk < 4; ++kk) acc = MFMA16(*(const bf16x8*)(ap + 32 * kk), *(const bf16x8*)(bp + 32 * kk), acc);
            }
            const int j = 16 * jb + fr; const float gj = gv[128 + j];
#pragma unroll
            for (int r = 0; r < 4; ++r) { const int i = 16 * ib + 4 * q + r; const float dec = expf(fminf(gv[128 + i] - gj, 0.f));
                if (!isq) Ls[i * 68 + j] = (j < i) ? gv[64 + i] * acc[r] * dec : 0.f;
                else AT[i * 64 + 32 * (jb >> 1) + 8 * (fr >> 2) + 4 * (jb & 1) + (fr & 3)] = (bf16)f2bf(j <= i ? acc[r] * dec : 0.f); }
        }
    }
    __syncthreads();
    if (wave == 0) {
        float T[64];
        int vz = 0; asm volatile("" : "+v"(vz));
        const float* Lz = Ls + vz;
#pragma unroll
        for (int i = 0; i < 64; ++i) {
            float a0 = fmaxf(0.f, 1.f - fabsf((float)(lane - i))), a1 = 0.f, a2 = 0.f, a3 = 0.f;
#pragma unroll
            for (int m4 = 0; m4 < (i + 3) / 4; ++m4) { const f32x4 lv = *(const f32x4*)(Lz + i * 68 + 4 * m4);
                if (4 * m4 < i) a0 -= lv.x * T[4 * m4]; if (4 * m4 + 1 < i) a1 -= lv.y * T[4 * m4 + 1]; if (4 * m4 + 2 < i) a2 -= lv.z * T[4 * m4 + 2]; if (4 * m4 + 3 < i) a3 -= lv.w * T[4 * m4 + 3]; }
            T[i] = (a0 + a1) + (a2 + a3);
            Ts[i * 72 + lane] = (bf16)f2bf(T[i]);
        }
    } else {
        const int t2 = tid - 64;
        bf16* QI = (bf16*)(img + GDN_QI) + (size_t)ch * 8192; bf16* KT = (bf16*)(img + GDN_KT) + (size_t)ch * 8192; float* DV = (float*)(img + GDN_DV) + (size_t)ch * 192;
        for (int it = t2; it < 64 * 16; it += 448) { const int c = it >> 4, pg = it & 15;
            unsigned short e[8];
#pragma unroll
            for (int j = 0; j < 8; ++j) { const int p = pg * 8 + j; e[j] = Qn[c * 136 + (p & ~31) + kperm32(p & 31)]; }
            v4u w; w.x = e[0] | ((unsigned)e[1] << 16); w.y = e[2] | ((unsigned)e[3] << 16); w.z = e[4] | ((unsigned)e[5] << 16); w.w = e[6] | ((unsigned)e[7] << 16);
            *(v4u*)(QI + c * 128 + pg * 8) = w; }
        for (int it = t2; it < 128 * 8; it += 448) { const int d = it >> 3, pg = it & 7;
            unsigned short e[8];
#pragma unroll
            for (int j = 0; j < 8; ++j) { const int p = pg * 8 + j; e[j] = Kn[((p & ~31) + kperm32(p & 31)) * 136 + d]; }
            v4u w; w.x = e[0] | ((unsigned)e[1] << 16); w.y = e[2] | ((unsigned)e[3] << 16); w.z = e[4] | ((unsigned)e[5] << 16); w.w = e[6] | ((unsigned)e[7] << 16);
            *(v4u*)(KT + d * 64 + pg * 8) = w; }
        if (t2 < 64) { DV[t2] = gv[192 + t2]; DV[64 + t2] = expf(gv[128 + 63] - gv[128 + t2]); if (t2 == 0) DV[128] = gv[192 + 63]; }
    }
    __syncthreads();
    {
        bf16x8 tf[4][2];
#pragma unroll
        for (int m = 0; m < 4; ++m)
#pragma unroll
            for (int kk = 0; kk < 2; ++kk) tf[m][kk] = *(const bf16x8*)(Ts + (16 * m + fr) * 72 + 32 * kk + q * 8);
#pragma unroll
        for (int cc = 0; cc < 2; ++cc) { const int ct = 2 * wave + cc;
            const bf16x8 r0 = *(const bf16x8*)(Rt + (16 * ct + fr) * 72 + q * 8), r1 = *(const bf16x8*)(Rt + (16 * ct + fr) * 72 + 32 + q * 8);
#pragma unroll
            for (int m = 0; m < 4; ++m) { f32x4 acc = {0.f, 0.f, 0.f, 0.f}; acc = MFMA16(tf[m][0], r0, acc); acc = MFMA16(tf[m][1], r1, acc);
                if (ct < 8) { v2u w; w.x = pk2(acc[0], acc[1]); w.y = pk2(acc[2], acc[3]); *(v2u*)(img + GDN_UI + (size_t)ch * 16384 + ((ct * 4 + m) * 64 + lane) * 8) = w; }
                else { const int dt = ct - 8; bf16* WI = (bf16*)(img + GDN_WI) + (size_t)ch * 8192;
#pragma unroll
                    for (int r = 0; r < 4; ++r) WI[(16 * m + 4 * q + r) * 128 + 32 * (dt >> 1) + 8 * (fr >> 2) + 4 * (dt & 1) + (fr & 3)] = (bf16)f2bf(-acc[r]); }
            } }
    }
}
__device__ __forceinline__ void gdn_step_math(const unsigned char* b, const float* DV, f32x4 (&S)[8], f32x4 (&vn)[4], f32x4 (&o)[4], int q, int fr) {
        bf16x8 sB[4];
#pragma unroll
        for (int kk = 0; kk < 4; ++kk) sB[kk] = pack_ctiles(S[2 * kk], S[2 * kk + 1]);
#pragma unroll
        for (int m = 0; m < 4; ++m) {
            bf16x8 wf[4], qq[4];
            const unsigned char* wr_ = b + (16 * m + fr) * 272 + q * 16;
#pragma unroll
            for (int kk = 0; kk < 4; ++kk) { wf[kk] = *(const bf16x8*)(wr_ + 64 * kk); qq[kk] = *(const bf16x8*)(wr_ + 17408 + 64 * kk); }
            __builtin_amdgcn_sched_barrier(0);
            f32x4 oi = {0.f, 0.f, 0.f, 0.f};
#pragma unroll
            for (int kk = 0; kk < 4; ++kk) { vn[m] = MFMA16(wf[kk], sB[kk], vn[m]); oi = MFMA16(qq[kk], sB[kk], oi); }
            o[m] = oi * *(const f32x4*)(DV + 16 * m + 4 * q);
        }
        bf16x8 af[6];
#pragma unroll
        for (int m = 0; m < 4; ++m) { const unsigned char* ar = b + 34816 + (16 * m + fr) * 144 + q * 16; af[m] = *(const bf16x8*)(ar); if (m >= 2) af[2 + m] = *(const bf16x8*)(ar + 64); }
        f32x4 ek[4];
#pragma unroll
        for (int m = 0; m < 4; ++m) ek[m] = *(const f32x4*)(DV + 64 + 16 * m + 4 * q);
        const float cdec = DV[128];
        const bf16x8 vb0 = pack_ctiles(vn[0], vn[1]), vb1 = pack_ctiles(vn[2], vn[3]);
        __builtin_amdgcn_sched_barrier(0);
#pragma unroll
        for (int m = 0; m < 4; ++m) { o[m] = MFMA16(af[m], vb0, o[m]); if (m >= 2) o[m] = MFMA16(af[2 + m], vb1, o[m]); }
#pragma unroll
        for (int m = 0; m < 4; ++m) vn[m] = vn[m] * ek[m];
        const bf16x8 xs0 = pack_ctiles(vn[0], vn[1]), xs1 = pack_ctiles(vn[2], vn[3]);
#pragma unroll
        for (int dh = 0; dh < 4; ++dh) {
            bf16x8 kf[2][2];
#pragma unroll
            for (int di = 0; di < 2; ++di) { const unsigned char* kr = b + 44032 + (16 * (2 * dh + di) + fr) * 144 + q * 16; kf[di][0] = *(const bf16x8*)(kr); kf[di][1] = *(const bf16x8*)(kr + 64); }
            __builtin_amdgcn_sched_barrier(0);
#pragma unroll
            for (int di = 0; di < 2; ++di) { const int dt = 2 * dh + di; f32x4 acc = S[dt] * cdec; acc = MFMA16(kf[di][0], xs0, acc); acc = MFMA16(kf[di][1], xs1, acc); S[dt] = acc; }
        }
}
constexpr int GDN_BUF = 2 * 17408 + 9216 + 18432 + 768;
__device__ __forceinline__ void gdn_scan_block(const unsigned char* img, bf16* OA, int h, unsigned char* lds, int tid) {
    const int lane = tid & 63, ws = __builtin_amdgcn_readfirstlane(tid >> 6), q = lane >> 4, fr = lane & 15;
    f32x4 S[8];
#pragma unroll
    for (int i = 0; i < 8; ++i) S[i] = (f32x4){0.f, 0.f, 0.f, 0.f};
    v4u stA[7], stB[7]; v4u scA = {0u, 0u, 0u, 0u}, scB = {0u, 0u, 0u, 0u}; v2u ubA[4], ubB[4];
#define GDN_FETCH(N, st, stc, ub) do { const int ch_ = (N) * 4 + h; \
        st[0] = *(const v4u*)(img + GDN_WI + (size_t)ch_ * 16384 + tid * 16); st[1] = *(const v4u*)(img + GDN_WI + (size_t)ch_ * 16384 + 8192 + tid * 16); \
        st[2] = *(const v4u*)(img + GDN_QI + (size_t)ch_ * 16384 + tid * 16); st[3] = *(const v4u*)(img + GDN_QI + (size_t)ch_ * 16384 + 8192 + tid * 16); \
        st[4] = *(const v4u*)(img + GDN_AT + (size_t)ch_ * 8192 + tid * 16); \
        st[5] = *(const v4u*)(img + GDN_KT + (size_t)ch_ * 16384 + tid * 16); st[6] = *(const v4u*)(img + GDN_KT + (size_t)ch_ * 16384 + 8192 + tid * 16); \
        if (tid < 48) stc = *(const v4u*)(img + GDN_DV + (size_t)ch_ * 768 + tid * 16); \
        _Pragma("unroll") for (int m_ = 0; m_ < 4; ++m_) ub[m_] = *(const v2u*)(img + GDN_UI + (size_t)ch_ * 16384 + ((ws * 4 + m_) * 64 + lane) * 8); } while (0)
#define GDN_PUT(B, st, stc) do { unsigned char* b_ = lds + (B) * GDN_BUF; const int r16 = tid >> 4, c16 = tid & 15, r8 = tid >> 3, c8 = tid & 7; \
        *(v4u*)(b_ + r16 * 272 + c16 * 16) = st[0]; *(v4u*)(b_ + (32 + r16) * 272 + c16 * 16) = st[1]; \
        *(v4u*)(b_ + 17408 + r16 * 272 + c16 * 16) = st[2]; *(v4u*)(b_ + 17408 + (32 + r16) * 272 + c16 * 16) = st[3]; \
        *(v4u*)(b_ + 34816 + r8 * 144 + c8 * 16) = st[4]; \
        *(v4u*)(b_ + 44032 + r8 * 144 + c8 * 16) = st[5]; *(v4u*)(b_ + 44032 + (64 + r8) * 144 + c8 * 16) = st[6]; \
        if (tid < 48) *(v4u*)(b_ + 62464 + tid * 16) = stc; } while (0)
    __syncthreads();
    GDN_FETCH(0, stA, scA, ubA); GDN_FETCH(1, stB, scB, ubB); GDN_PUT(0, stA, scA);
    __syncthreads();
#define GDN_STEP(n, ubc, stf, scf, ubf, stp, scp) do { \
        const unsigned char* b = lds + ((n) & 1) * GDN_BUF; const float* DV = (const float*)(b + 62464); \
        f32x4 vn[4], o[4]; \
        _Pragma("unroll") for (int m = 0; m < 4; ++m) vn[m] = (f32x4){bflo(ubc[m].x), bfhi(ubc[m].x), bflo(ubc[m].y), bfhi(ubc[m].y)}; \
        if ((n) + 2 < NCHUNK) GDN_FETCH((n) + 2, stf, scf, ubf); \
        gdn_step_math(b, DV, S, vn, o, q, fr); \
        _Pragma("unroll") for (int m = 0; m < 4; ++m) _Pragma("unroll") for (int r = 0; r < 4; ++r) OA[(size_t)(64 * (n) + 16 * m + 4 * q + r) * 512 + h * 128 + 16 * ws + fr] = (bf16)f2bf(o[m][r]); \
        if ((n) + 1 < NCHUNK) GDN_PUT(((n) + 1) & 1, stp, scp); \
        asm volatile("s_waitcnt lgkmcnt(0)" ::: "memory"); __builtin_amdgcn_s_barrier(); asm volatile("" ::: "memory"); } while (0)
#pragma unroll 1
    for (int n = 0; n < NCHUNK; n += 2) {
        GDN_STEP(n, ubA, stA, scA, ubA, stB, scB);
        GDN_STEP(n + 1, ubB, stB, scB, ubB, stA, scA);
    }
#undef GDN_STEP
#undef GDN_FETCH
#undef GDN_PUT
}

constexpr int NSA_BUF = 64 * 208 + 64 * 144, NSA_WOFF = 2 * NSA_BUF, NSA_UOFF = NSA_WOFF + 8 * 2048;
__device__ __forceinline__ float col_max4(const f32x4 (&s)[4]) {
    float a = fmaxf(fmaxf(s[0][0], s[0][1]), fmaxf(s[0][2], s[0][3]));
#pragma unroll
    for (int i = 1; i < 4; ++i) a = fmaxf(a, fmaxf(fmaxf(s[i][0], s[i][1]), fmaxf(s[i][2], s[i][3])));
    a = fmaxf(a, __shfl_xor(a, 16)); a = fmaxf(a, __shfl_xor(a, 32)); return a;
}
template <bool WINDOW>
__device__ __forceinline__ void nsa_lds_block(const unsigned char* kb, int pos0, int t, bool colsel, int head, const bf16x8 (&qf)[3],
                                              const LAS float* relb, const LAS int* btab, float& m, float& l, f32x4 (&o)[4], int lane) {
    const int q = lane >> 4, fr = lane & 15;
    const float scale = 0.10206207261596577f;
    f32x4 s[4];
#pragma unroll
    for (int rp = 0; rp < 2; ++rp) {
        bf16x8 kfr[2][3];
#pragma unroll
        for (int ri = 0; ri < 2; ++ri) { const unsigned char* kp = kb + (16 * (2 * rp + ri) + fr) * 208 + q * 16;
#pragma unroll
            for (int kk = 0; kk < 3; ++kk) kfr[ri][kk] = *(const bf16x8*)(kp + 64 * kk); }
        __builtin_amdgcn_sched_barrier(0);
#pragma unroll
        for (int ri = 0; ri < 2; ++ri) { f32x4 acc = {0.f, 0.f, 0.f, 0.f};
#pragma unroll
            for (int kk = 0; kk < 3; ++kk) acc = MFMA16(kfr[ri][kk], qf[kk], acc);
            s[2 * rp + ri] = acc; }
    }
    v2u va[2][4];
#pragma unroll
    for (int dt = 0; dt < 2; ++dt) { const unsigned char* vp = kb + 64 * 208 + (16 * dt + fr) * 144 + q * 8;
        va[dt][0] = *(const v2u*)(vp); va[dt][1] = *(const v2u*)(vp + 32); va[dt][2] = *(const v2u*)(vp + 64); va[dt][3] = *(const v2u*)(vp + 96); }
    __builtin_amdgcn_sched_barrier(0);
    const bool far = !WINDOW && (pos0 + 63 + 128 <= t);
    const float bfar = relb[31 * 8 + head];
#pragma unroll
    for (int rt = 0; rt < 4; ++rt)
#pragma unroll
        for (int r = 0; r < 4; ++r) { const int pos = pos0 + 16 * rt + 4 * q + r, dist = t - pos;
            bool ok = colsel && dist >= 0; if (WINDOW) ok = ok && dist < 512;
            float bias = bfar; if (!far) { const int dd = dist < 0 ? 0 : dist; bias = relb[(dd < 128 ? btab[dd] : 31) * 8 + head]; }
            s[rt][r] = ok ? s[rt][r] * scale + bias : -INFINITY; }
    const float bm = col_max4(s);
    const float mn = fmaxf(m, bm);
    const float corr = (mn == -INFINITY) ? 1.f : __expf(m - mn);
    float ps = 0.f;
#pragma unroll
    for (int rt = 0; rt < 4; ++rt)
#pragma unroll
        for (int r = 0; r < 4; ++r) { const float p = (s[rt][r] == -INFINITY) ? 0.f : __expf(s[rt][r] - mn); s[rt][r] = p; ps += p; }
    ps += __shfl_xor(ps, 16); ps += __shfl_xor(ps, 32);
    l = l * corr + ps; m = mn;
    const bf16x8 pb0 = pack_ctiles(s[0], s[1]), pb1 = pack_ctiles(s[2], s[3]);
    v2u vb[2][4];
#pragma unroll
    for (int dt = 0; dt < 2; ++dt) { const unsigned char* vp = kb + 64 * 208 + (16 * (2 + dt) + fr) * 144 + q * 8;
        vb[dt][0] = *(const v2u*)(vp); vb[dt][1] = *(const v2u*)(vp + 32); vb[dt][2] = *(const v2u*)(vp + 64); vb[dt][3] = *(const v2u*)(vp + 96); }
#pragma unroll
    for (int dt = 0; dt < 2; ++dt) {
        v4u w0; w0.x = va[dt][0].x; w0.y = va[dt][0].y; w0.z = va[dt][1].x; w0.w = va[dt][1].y;
        v4u w1; w1.x = va[dt][2].x; w1.y = va[dt][2].y; w1.z = va[dt][3].x; w1.w = va[dt][3].y;
        f32x4 acc = o[dt] * corr;
        acc = MFMA16(__builtin_bit_cast(bf16x8, w0), pb0, acc); acc = MFMA16(__builtin_bit_cast(bf16x8, w1), pb1, acc);
        o[dt] = acc;
    }
#pragma unroll
    for (int dt = 0; dt < 2; ++dt) {
        v4u w0; w0.x = vb[dt][0].x; w0.y = vb[dt][0].y; w0.z = vb[dt][1].x; w0.w = vb[dt][1].y;
        v4u w1; w1.x = vb[dt][2].x; w1.y = vb[dt][2].y; w1.z = vb[dt][3].x; w1.w = vb[dt][3].y;
        f32x4 acc = o[2 + dt] * corr;
        acc = MFMA16(__builtin_bit_cast(bf16x8, w0), pb0, acc); acc = MFMA16(__builtin_bit_cast(bf16x8, w1), pb1, acc);
        o[2 + dt] = acc;
    }
}
#define NSA_FETCH_KV(KCOL, VT, POS0, sg) do { \
        { const int c_ = tid, r_ = c_ / 12, x_ = c_ % 12; sg[0] = *(const v4u*)(PA + (size_t)((POS0) + r_) * NPA + (KCOL) + g * 160 + x_ * 8); } \
        { const int c_ = tid + 512; if (c_ < 768) { const int r_ = c_ / 12, x_ = c_ % 12; sg[1] = *(const v4u*)(PA + (size_t)((POS0) + r_) * NPA + (KCOL) + g * 160 + x_ * 8); } \
          else { const int v_ = c_ - 768, r_ = v_ >> 3, x_ = v_ & 7; sg[1] = *(const v4u*)((VT) + (size_t)(g * 64 + r_) * SEQ + (POS0) + x_ * 8); } } \
        if (tid < 256) { const int v_ = tid + 256, r_ = v_ >> 3, x_ = v_ & 7; sg[2] = *(const v4u*)((VT) + (size_t)(g * 64 + r_) * SEQ + (POS0) + x_ * 8); } } while (0)
#define NSA_PUT_KV(B, sg) do { unsigned char* b_ = lds + (B) * NSA_BUF; \
        { const int c_ = tid, r_ = c_ / 12, x_ = c_ % 12; *(v4u*)(b_ + r_ * 208 + x_ * 16) = sg[0]; } \
        { const int c_ = tid + 512; if (c_ < 768) { const int r_ = c_ / 12, x_ = c_ % 12; *(v4u*)(b_ + r_ * 208 + x_ * 16) = sg[1]; } \
          else { const int v_ = c_ - 768, r_ = v_ >> 3, x_ = v_ & 7; *(v4u*)(b_ + 64 * 208 + r_ * 144 + x_ * 16) = sg[1]; } } \
        if (tid < 256) { const int v_ = tid + 256, r_ = v_ >> 3, x_ = v_ & 7; *(v4u*)(b_ + 64 * 208 + r_ * 144 + x_ * 16) = sg[2]; } } while (0)
#define NSA_FETCH_C(PR, sg) do { \
        { const int c_ = tid, hl_ = c_ / 384, r_ = (c_ % 384) / 12, x_ = c_ % 12; sg[0] = *(const v4u*)((hl_ ? KCL : KCH) + (size_t)((32 * (PR) + r_) * 2 + g) * 96 + x_ * 8); } \
        { const int c_ = tid + 512; if (c_ < 768) { const int hl_ = c_ / 384, r_ = (c_ % 384) / 12, x_ = c_ % 12; sg[1] = *(const v4u*)((hl_ ? KCL : KCH) + (size_t)((32 * (PR) + r_) * 2 + g) * 96 + x_ * 8); } \
          else { const int v_ = c_ - 768, r_ = v_ >> 2, x_ = v_ & 3; sg[1] = *(const v4u*)(VCT + (size_t)(g * 64 + r_) * 512 + 32 * (PR) + x_ * 8); } } } while (0)
#define NSA_PUT_C(B, sg) do { unsigned char* b_ = lds + (B) * NSA_BUF; \
        { const int c_ = tid, hl_ = c_ / 384, r_ = (c_ % 384) / 12, x_ = c_ % 12; *(v4u*)(b_ + (hl_ * 32 + r_) * 208 + x_ * 16) = sg[0]; } \
        { const int c_ = tid + 512; if (c_ < 768) { const int hl_ = c_ / 384, r_ = (c_ % 384) / 12, x_ = c_ % 12; *(v4u*)(b_ + (hl_ * 32 + r_) * 208 + x_ * 16) = sg[1]; } \
          else { const int v_ = c_ - 768, r_ = v_ >> 2, x_ = v_ & 3; *(v4u*)(b_ + 64 * 208 + r_ * 80 + x_ * 16) = sg[1]; } } } while (0)
#define NSA_PIPELINE(NS, FETCH, PUT, COMPUTE) do { const int ns_ = (NS); \
        FETCH(0, sgA); if (ns_ > 1) FETCH(1, sgB); PUT(0, sgA); __syncthreads(); \
        _Pragma("unroll 1") for (int i_ = 0; i_ < ns_; i_ += 2) { \
            if (i_ + 2 < ns_) FETCH(i_ + 2, sgA); COMPUTE(i_, 0); if (i_ + 1 < ns_) PUT(1, sgB); __syncthreads(); \
            if (i_ + 1 < ns_) { if (i_ + 3 < ns_) FETCH(i_ + 3, sgB); COMPUTE(i_ + 1, 1); if (i_ + 2 < ns_) PUT(0, sgA); } __syncthreads(); \
        } } while (0)
struct NsaCmp { float m, l, M, inv, carry; };
__device__ __forceinline__ void nsa_cmp_pass1(const unsigned char* kb, int pr, int ntile, int ncv, int t, int head, const bf16x8 (&qf)[3], const LAS float* relb, const LAS int* btab, NsaCmp& c, int lane) {
    const int q = lane >> 4, fr = lane & 15; const float scale = 0.10206207261596577f;
#pragma unroll
    for (int u = 0; u < 2; ++u) { const int T = 2 * pr + u;
        if (T < ntile) {
            const unsigned char* kp = kb + (16 * u + fr) * 208 + q * 16;
            bf16x8 kh[3], kl[3];
#pragma unroll
            for (int kk = 0; kk < 3; ++kk) { kh[kk] = *(const bf16x8*)(kp + 64 * kk); kl[kk] = *(const bf16x8*)(kp + 32 * 208 + 64 * kk); }
            __builtin_amdgcn_sched_barrier(0);
            f32x4 acc = {0.f, 0.f, 0.f, 0.f};
#pragma unroll
            for (int kk = 0; kk < 3; ++kk) { acc = MFMA16(kh[kk], qf[kk], acc); acc = MFMA16(kl[kk], qf[kk], acc); }
            float sv[4]; float bm = -INFINITY;
#pragma unroll
            for (int r = 0; r < 4; ++r) { const int n = 16 * T + 4 * q + r; const int dist = t - (16 * n + 31); const int dd = dist < 0 ? 0 : dist;
                sv[r] = (n < ncv) ? acc[r] * scale + relb[(dd < 128 ? btab[dd] : 31) * 8 + head] : -INFINITY; bm = fmaxf(bm, sv[r]); }
            const float mn = fmaxf(c.m, bm);
            if (mn != -INFINITY) { float ps = 0.f;
#pragma unroll
                for (int r = 0; r < 4; ++r) ps += (sv[r] == -INFINITY) ? 0.f : __expf(sv[r] - mn);
                c.l = c.l * __expf(c.m - mn) + ps; c.m = mn; }
        } }
}
__device__ __forceinline__ void nsa_cmp_pass2(const unsigned char* kb, int pr, int ntile, int ncv, int t, int head, const bf16x8 (&qf)[3], const LAS float* relb, const LAS int* btab, NsaCmp& c, f32x4 (&oc)[4], float* imp, int lane) {
    const int q = lane >> 4, fr = lane & 15, tl = fr >> 2, hh = fr & 3; const float scale = 0.10206207261596577f;
    if (2 * pr >= ntile) return;
    f32x4 pt[2];
#pragma unroll
    for (int u = 0; u < 2; ++u) { const int T = 2 * pr + u;
        f32x4 acc = {0.f, 0.f, 0.f, 0.f};
        if (T < ntile) {
            const unsigned char* kp = kb + (16 * u + fr) * 208 + q * 16;
            bf16x8 kh[3], kl[3];
#pragma unroll
            for (int kk = 0; kk < 3; ++kk) { kh[kk] = *(const bf16x8*)(kp + 64 * kk); kl[kk] = *(const bf16x8*)(kp + 32 * 208 + 64 * kk); }
            __builtin_amdgcn_sched_barrier(0);
#pragma unroll
            for (int kk = 0; kk < 3; ++kk) { acc = MFMA16(kh[kk], qf[kk], acc); acc = MFMA16(kl[kk], qf[kk], acc); }
        }
#pragma unroll
        for (int r = 0; r < 4; ++r) { const int n = 16 * T + 4 * q + r; const int dist = t - (16 * n + 31); const int dd = dist < 0 ? 0 : dist;
            const bool ok = (T < ntile) && (n < ncv);
            pt[u][r] = ok ? __expf(acc[r] * scale + relb[(dd < 128 ? btab[dd] : 31) * 8 + head] - c.M) * c.inv : 0.f; }
        const float x3 = pt[u][3];
        float prev = __shfl(x3, (lane + 48) & 63);
        const float nxt = __shfl(x3, 48 + fr);
        if (q == 0) prev = c.carry;
        c.carry = nxt;
        float v = ((pt[u][0] + pt[u][1]) + (pt[u][2] + pt[u][3])) + prev;
        v += __shfl_xor(v, 1); v += __shfl_xor(v, 2);
        if (hh == 0 && T < ntile) imp[tl * 128 + 4 * T + q] = v;
    }
    const bf16x8 pb = pack_ctiles(pt[0], pt[1]);
    v2u va[4][2];
#pragma unroll
    for (int dt = 0; dt < 4; ++dt) { const unsigned char* vp = kb + 64 * 208 + (16 * dt + fr) * 80 + q * 8; va[dt][0] = *(const v2u*)(vp); va[dt][1] = *(const v2u*)(vp + 32); }
    __builtin_amdgcn_sched_barrier(0);
#pragma unroll
    for (int dt = 0; dt < 4; ++dt) { v4u w0; w0.x = va[dt][0].x; w0.y = va[dt][0].y; w0.z = va[dt][1].x; w0.w = va[dt][1].y;
        oc[dt] = MFMA16(__builtin_bit_cast(bf16x8, w0), pb, oc[dt]); }
}
__device__ __forceinline__ void nsa_unit(const bf16* PA, const float* SM, const bf16* KCH, const bf16* KCL, const bf16* VCT, const bf16* VTS, const bf16* VTW,
                                         const LAS float* relb, const LAS int* btab, bf16* OB, int T0, int g, unsigned char* lds, int tid, int abl) {
    const int lane = tid & 63, wave = __builtin_amdgcn_readfirstlane(tid >> 6), q = lane >> 4, fr = lane & 15, tl = fr >> 2, hh = fr & 3;
    const int t0 = T0 + 4 * wave, t = t0 + tl, head = g * 4 + hh;
    v4u sgA[3] = {}, sgB[3] = {};
    bf16x8 qf[3];
#pragma unroll
    for (int kk = 0; kk < 3; ++kk) qf[kk] = *(const bf16x8*)(PA + (size_t)t * NPA + PA_NQ + head * 96 + 32 * kk + q * 8);
    float* imp = (float*)(lds + NSA_WOFF + wave * 2048);
    __syncthreads();
#pragma unroll
    for (int i = 0; i < 8; ++i) imp[lane + 64 * i] = 0.f;
    const int ncv = t >= 31 ? (t - 31) / 16 + 1 : 0;
    const int ncvw = (t0 + 3) >= 31 ? (t0 + 3 - 31) / 16 + 1 : 0;
    const int ncvu = (T0 + 31) >= 31 ? (T0 + 31 - 31) / 16 + 1 : 0;
    const int ntile = (ncvw + 15) >> 4, npair = (ncvu + 31) >> 5;
    f32x4 oc[4];
#pragma unroll
    for (int dt = 0; dt < 4; ++dt) oc[dt] = (f32x4){0.f, 0.f, 0.f, 0.f};
    if (npair > 0) {
        NsaCmp c; c.m = -INFINITY; c.l = 0.f; c.M = 0.f; c.inv = 0.f; c.carry = 0.f;
#define F_C(i, sg) NSA_FETCH_C((i), sg)
#define P_C(b, sg) NSA_PUT_C((b), sg)
#define C_P1(i, b) if (!(abl & 4)) nsa_cmp_pass1(lds + (b) * NSA_BUF, (i), ntile, ncv, t, head, qf, relb, btab, c, lane)
        NSA_PIPELINE(npair, F_C, P_C, C_P1);
        c.M = fmaxf(c.m, __shfl_xor(c.m, 16)); c.M = fmaxf(c.M, __shfl_xor(c.M, 32));
        float lt = (c.m == -INFINITY) ? 0.f : c.l * __expf(c.m - c.M);
        lt += __shfl_xor(lt, 16); lt += __shfl_xor(lt, 32);
        c.inv = lt > 0.f ? 1.f / lt : 0.f;
#define C_P2(i, b) if (!(abl & 4)) nsa_cmp_pass2(lds + (b) * NSA_BUF, (i), ntile, ncv, t, head, qf, relb, btab, c, oc, imp, lane)
        NSA_PIPELINE(npair, F_C, P_C, C_P2);
#undef F_C
#undef P_C
#undef C_P1
#undef C_P2
    }
    LDS_WAIT(); asm volatile("" ::: "memory");
    const int blk_t = T0 >> 6; const int nsel = blk_t + 1 < 16 ? blk_t + 1 : 16;
    unsigned long long msk_lo[4], msk_hi[4];
#pragma unroll
    for (int tk = 0; tk < 4; ++tk) {
        float v0, v1; { const int s0 = lane, s1 = lane + 64;
            v0 = (s0 == 0 || s0 == blk_t || s0 == blk_t - 1) ? INFINITY : (s0 > blk_t ? -INFINITY : imp[tk * 128 + s0]);
            v1 = (s1 == blk_t || s1 == blk_t - 1) ? INFINITY : (s1 > blk_t ? -INFINITY : imp[tk * 128 + s1]); }
        unsigned long long lo = 0ull, hi = 0ull;
#pragma unroll 1
        for (int r = 0; r < nsel; ++r) {
            float bv; int bi;
            if (v0 >= v1) { bv = v0; bi = lane; } else { bv = v1; bi = lane + 64; }
#pragma unroll
            for (int off = 32; off >= 1; off >>= 1) { const float ov = __shfl_xor(bv, off); const int oi = __shfl_xor(bi, off); if (ov > bv || (ov == bv && oi < bi)) { bv = ov; bi = oi; } }
            bi = __builtin_amdgcn_readfirstlane(bi);
            if (bi < 64) lo |= 1ull << bi; else hi |= 1ull << (bi - 64);
            if (bi == lane) v0 = -INFINITY; else if (bi == lane + 64) v1 = -INFINITY;
        }
        msk_lo[tk] = lo; msk_hi[tk] = hi;
    }
    const unsigned long long wlo = (msk_lo[0] | msk_lo[1]) | (msk_lo[2] | msk_lo[3]), whi = (msk_hi[0] | msk_hi[1]) | (msk_hi[2] | msk_hi[3]);
    unsigned char* sel4 = lds + NSA_UOFF + 1024 + wave * 128;
    { const unsigned n0 = (unsigned)(((msk_lo[0] >> lane) & 1ull) | (((msk_lo[1] >> lane) & 1ull) << 1) | (((msk_lo[2] >> lane) & 1ull) << 2) | (((msk_lo[3] >> lane) & 1ull) << 3));
      const unsigned n1 = (unsigned)(((msk_hi[0] >> lane) & 1ull) | (((msk_hi[1] >> lane) & 1ull) << 1) | (((msk_hi[2] >> lane) & 1ull) << 2) | (((msk_hi[3] >> lane) & 1ull) << 3));
      sel4[lane] = (unsigned char)n0; sel4[lane + 64] = (unsigned char)n1; }
    unsigned long long* um = (unsigned long long*)(lds + NSA_UOFF);
    unsigned char* blist = lds + NSA_UOFF + 512;
    if (lane == 0) { um[wave * 2] = wlo; um[wave * 2 + 1] = whi; }
    __syncthreads();
    int nblk;
    {
        unsigned long long ulo = 0ull, uhi = 0ull;
#pragma unroll
        for (int w = 0; w < 8; ++w) { ulo |= um[w * 2]; uhi |= um[w * 2 + 1]; }
        nblk = __builtin_popcountll(ulo) + __builtin_popcountll(uhi);
        if (tid < 128) { const bool in = tid < 64 ? ((ulo >> tid) & 1ull) : ((uhi >> (tid - 64)) & 1ull);
            if (in) { const int rank = tid < 64 ? __builtin_popcountll(ulo & ((1ull << tid) - 1ull)) : __builtin_popcountll(ulo) + __builtin_popcountll(uhi & ((1ull << (tid - 64)) - 1ull));
                blist[rank] = (unsigned char)tid; } }
        nblk = __builtin_amdgcn_readfirstlane(nblk);
    }
    __syncthreads();
    f32x4 os[4]; float ms = -INFINITY, ls = 0.f;
#pragma unroll
    for (int dt = 0; dt < 4; ++dt) os[dt] = (f32x4){0.f, 0.f, 0.f, 0.f};
#define F_S(i, sg) do { if (!(abl & 8)) { const int sb_ = blist[(i)]; NSA_FETCH_KV(PA_KS, VTS, 64 * sb_, sg); } } while (0)
#define P_S(b, sg) NSA_PUT_KV((b), sg)
#define C_S(i, b) do { const int cur_ = __builtin_amdgcn_readfirstlane((int)blist[(i)]); const unsigned s4_ = __builtin_amdgcn_readfirstlane((unsigned)sel4[cur_]); \
        if (s4_ && !(abl & 1)) nsa_lds_block<false>(lds + (b) * NSA_BUF, 64 * cur_, t, (s4_ >> tl) & 1u, head, qf, relb, btab, ms, ls, os, lane); } while (0)
    NSA_PIPELINE(nblk, F_S, P_S, C_S);
#undef F_S
#undef P_S
#undef C_S
    f32x4 ow[4]; float mw = -INFINITY, lw = 0.f;
#pragma unroll
    for (int dt = 0; dt < 4; ++dt) ow[dt] = (f32x4){0.f, 0.f, 0.f, 0.f};
    const int wb0 = (T0 - 511) < 0 ? 0 : (T0 - 511) >> 6, wb1 = (T0 + 31) >> 6;
#define F_W(i, sg) NSA_FETCH_KV(PA_KW, VTW, 64 * (wb0 + (i)), sg)
#define P_W(b, sg) NSA_PUT_KV((b), sg)
#define C_W(i, b) do { const int bi_ = wb0 + (i); if (64 * bi_ + 63 >= t0 - 511 && 64 * bi_ <= t0 + 3 && !(abl & 2)) \
        nsa_lds_block<true>(lds + (b) * NSA_BUF, 64 * bi_, t, true, head, qf, relb, btab, mw, lw, ow, lane); } while (0)
    NSA_PIPELINE(wb1 - wb0 + 1, F_W, P_W, C_W);
#undef F_W
#undef P_W
#undef C_W
    const float* gl = SM + (size_t)t * 64 + 8 + head * 3;
    const float gc = sigmoidf_(gl[0]), gs = sigmoidf_(gl[1]) / ls, gw = sigmoidf_(gl[2]) / lw;
#pragma unroll
    for (int dt = 0; dt < 4; ++dt) { const f32x4 o = oc[dt] * gc + os[dt] * gs + ow[dt] * gw;
        v2u w; w.x = pk2(o[0], o[1]); w.y = pk2(o[2], o[3]);
        *(v2u*)(OB + (size_t)t * 512 + head * 64 + 16 * dt + 4 * q) = w; }
    asm volatile("" ::: "memory");
}
__device__ __forceinline__ void nsa_vt_item(const bf16* PA, bf16* VTS, bf16* VTW, int item, unsigned short* wl, int lane) {
    const int chunk = item >> 2, g = (item >> 1) & 1, which = item & 1;
    const int kcol = which ? PA_KW : PA_KS; bf16* VT = which ? VTW : VTS;
    for (int i = 0; i < 8; ++i) { const int tt = i * 8 + (lane >> 3), c8 = lane & 7;
        const v4u x = *(const v4u*)(PA + (size_t)(chunk * 64 + tt) * NPA + kcol + g * 160 + 96 + c8 * 8);
        unsigned* d = (unsigned*)(wl + tt * 66 + c8 * 8); d[0] = x.x; d[1] = x.y; d[2] = x.z; d[3] = x.w; }
    LDS_WAIT(); asm volatile("" ::: "memory");
    for (int i = 0; i < 8; ++i) { const int dv = i * 8 + (lane >> 3), c8 = lane & 7;
        unsigned short e[8];
#pragma unroll
        for (int j = 0; j < 8; ++j) e[j] = wl[(c8 * 8 + j) * 66 + dv];
        v4u w; w.x = e[0] | ((unsigned)e[1] << 16); w.y = e[2] | ((unsigned)e[3] << 16); w.z = e[4] | ((unsigned)e[5] << 16); w.w = e[6] | ((unsigned)e[7] << 16);
        *(v4u*)(VT + (size_t)(g * 64 + dv) * SEQ + chunk * 64 + c8 * 8) = w; }
    LDS_WAIT(); asm volatile("" ::: "memory");
}

constexpr size_t CMP_KCF = 0, CMP_VCF = 3328 * 1024, CMP_H1K = 5632 * 1024, CMP_H1V = 6144 * 1024;
constexpr size_t CW_W1K = 0, CW_W1V = 1536 * 1024, CW_BPART = 2560 * 1024, CW_BIAS = CW_BPART + 2 * 16 * 256 * 4;
constexpr size_t CMP_PART = 8 * 1024 * 1024;
template <int ND>
__device__ __forceinline__ void cmp_layer2(const float* hrow, const float* w2, int nd_total, float (&acc)[ND]) {
#pragma unroll
    for (int i = 0; i < ND; ++i) acc[i] = 0.f;
#pragma unroll 4
    for (int j = 0; j < 256; ++j) {
        const float hv = hrow[j];
        const f32x4* wp = (const f32x4*)(w2 + (size_t)j * nd_total);
#pragma unroll
        for (int i4 = 0; i4 < ND / 4; ++i4) { const f32x4 wv = wp[i4]; acc[4 * i4] += hv * wv.x; acc[4 * i4 + 1] += hv * wv.y; acc[4 * i4 + 2] += hv * wv.z; acc[4 * i4 + 3] += hv * wv.w; }
    }
}

constexpr int PH_PER_LAYER = 22, NPHASES = DEPTH * PH_PER_LAYER;
#ifndef PROBE_ABL
#define PROBE_ABL 0
#endif
enum { K_CONV = 0, K_F1, K_GF32, K_ROWS, K_M1, K_M2, K_M3, K_M4, K_M5, K_M2B };
constexpr size_t ALPHA_OFF = 276 * MiB;
static_assert(ALPHA_OFF + GLA_BYTES <= 290 * MiB && WS_WGU + GLA_VBYTES <= WS_WD && WS_QKV + GDN_BYTES <= WS_KCMP, "gla/gdn images");
__global__ void __launch_bounds__(NTHR, 2) mk_fwd(Args args) {
    extern __shared__ __attribute__((aligned(16))) unsigned char lds[];
    LAS unsigned char* ldsl = (LAS unsigned char*)lds;
    {
        const int tid = threadIdx.x;
        for (int u = tid; u < (LDS_BYTES - LDSCTL_OFF) / 4; u += NTHR) ((LAS unsigned*)(ldsl + LDSCTL_OFF))[u] = 0u;
        __syncthreads();
        LAS int* btab = (LAS int*)(ldsl + BTAB_OFF);
        if (tid < 128) { int b = tid; if (tid >= 16) { const float v = logf((float)tid / 16.f) / 2.0794415416798357f * 16.f; b = 16 + (int)v; if (b > 31) b = 31; } btab[tid] = b; }
        if (tid < 256) ((LAS float*)(ldsl + RELB_OFF))[tid] = args.in[I_RELB][tid];
        __syncthreads();
    }
#if MK_ONE_LAUNCH
    XcdBarrier bar = xcd_barrier_post((unsigned*)(args.ws + WS_CTL) + CW_BAR, (volatile LAS unsigned*)(ldsl + MISC_OFF) + 8);
#endif
#pragma unroll 1
    for (int pc = args.ph_lo; pc < args.ph_hi; ++pc) {
        const unsigned pe = args.prog[pc];
        const int kind = pe & 15, sub = (pe >> 4) & 1, b = (pe >> 5) & 1, l = (pe >> 6) & 1, pmode = (pe >> 8) & 3; const bool mixer = (pe >> 7) & 1;
        unsigned char* ws = args.ws;
        int tid_ = threadIdx.x; asm volatile("" : "+v"(tid_));
        const int tid = tid_, lane = tid & 63, wave = __builtin_amdgcn_readfirstlane(tid >> 6);
        const int G = gridDim.x, bx = blockIdx.x;
        const int vcu = (G % 8 == 0) ? (bx % 8) * (G / 8) + bx / 8 : bx;
        const int gw = vcu * NWAVES + wave, NGW = G * NWAVES;
        switch (kind) {
        case K_CONV: {
            bf16* WGU = (bf16*)(ws + WS_WGU); bf16* WD = (bf16*)(ws + WS_WD); bf16* WIN = (bf16*)(ws + WS_WIN); bf16* WB = (bf16*)(ws + WS_WB); bf16* WO = (bf16*)(ws + WS_WO);
            LAS float* scr = (LAS float*)(ldsl + wave * 16384);
            const float* w_gu = args.in[sub ? I_F2GU : I_F1GU] + (size_t)l * DM * 2 * DFF;
            const float* w_dn = args.in[sub ? I_F2D : I_F1D] + (size_t)l * DFF * DM;
            constexpr int I_GU = (DM / 64) * (2 * DFF / 32), I_DN = (DFF / 64) * (DM / 32), I_IN = (DM / 64) * ((DIN_SRC + 31) / 32), I_BR = (512 / 64) * (DM / 32), I_OUT = (DM / 64) * (DM / 32);
            const int nitems = I_GU + I_DN + (sub == 0 ? I_IN + 3 * I_BR + I_OUT : 0);
            for (int it = gw; it < nitems; it += NGW) {
                int r = it;
                if (r < I_GU) { transpose_item(w_gu, DM, 2 * DFF, WGU, scr, r, lane, MapGU()); continue; } r -= I_GU;
                if (r < I_DN) { transpose_item(w_dn, DFF, DM, WD, scr, r, lane, MapId()); continue; } r -= I_DN;
                if (r < I_IN) { transpose_item(args.in[I_WIN] + (size_t)l * DM * DIN_SRC, DM, DIN_SRC, WIN, scr, r, lane, MapWin()); continue; } r -= I_IN;
                if (r < 3 * I_BR) { const int br = r / I_BR; transpose_item(args.in[I_WBG + br] + (size_t)l * 512 * DM, 512, DM, WB + (size_t)br * 512 * 1024, scr, r % I_BR, lane, MapId()); continue; } r -= 3 * I_BR;
                transpose_item(args.in[I_WOUT] + (size_t)l * DM * DM, DM, DM, WO, scr, r, lane, MapId());
            }
            if (sub == 0) { for (int i = gw * 64 + lane; i < 16 * DM / 2; i += NGW * 64) ((unsigned*)(WIN + (size_t)(PA_SM + 48) * DM))[i] = 0u; }
            if (l == 0 && sub == 0) { const float* n_pre = args.in[I_F1PRE]; bf16* XN = (bf16*)(ws + WS_XN);
                for (int m = gw; m < MTOK; m += NGW) row_pass(args.in[I_X] + (size_t)m * DM, nullptr, nullptr, 0.f, nullptr, n_pre, XN + (size_t)m * DM, lane); }
        } break;
        case K_F1: {
            pg8::Gemm g{(const bf16*)(ws + WS_XN), (const bf16*)(ws + WS_WGU), MTOK, 2 * DFF, DM, DM, DM}; pg8::StaticOrder S; S.init(MTOK, 2 * DFF, G, bx); pg8::EpiSwiglu E{(bf16*)(ws + WS_H), DFF};
            pg8::gemm_phase<pg8::EpiSwiglu, pg8::StaticOrder, true, true>(ldsl, g, S, E);
        } break;
        case K_GF32: {
            pg8::Gemm g; pg8::EpiF32 E; pg8::StaticOrder S;
            if (mixer) { g = pg8::Gemm{(const bf16*)(ws + WS_MG), (const bf16*)(ws + WS_WO), SEQ, DM, DM, DM, DM}; E = pg8::EpiF32{(float*)(ws + WS_YB), DM}; S.init(SEQ, DM, G, bx); }
            else { g = pg8::Gemm{(const bf16*)(ws + WS_H), (const bf16*)(ws + WS_WD), MTOK, DM, DFF, DFF, DFF}; E = pg8::EpiF32{(float*)(ws + WS_Y), DM}; S.init(MTOK, DM, G, bx); }
            pg8::gemm_phase<pg8::EpiF32, pg8::StaticOrder, true, true>(ldsl, g, S, E);
        } break;
        case K_ROWS: {
            float* xres = args.out; bf16* XN = (bf16*)(ws + WS_XN);
            if (mixer) {
                const float* YB = (const float*)(ws + WS_YB);
                for (int m = gw; m < SEQ; m += NGW) { const size_t r = (size_t)b * SEQ + m;
                    row_pass(xres + r * DM, YB + (size_t)m * DM, args.in[I_MPOST] + l * DM, 1.0f, xres + r * DM, args.in[I_F2PRE] + l * DM, XN + r * DM, lane); }
            } else {
                const float* Y = (const float*)(ws + WS_Y);
                const float* n_post = args.in[sub ? I_F2POST : I_F1POST] + l * DM;
                const float* xin = (l == 0 && sub == 0) ? args.in[I_X] : xres;
                const float* wnext = sub == 0 ? args.in[I_MPRE] + l * DM : (l + 1 < DEPTH ? args.in[I_F1PRE] + (l + 1) * DM : nullptr);
                for (int m = gw; m < MTOK; m += NGW) row_pass(xin + (size_t)m * DM, Y + (size_t)m * DM, n_post, 0.5f, xres + (size_t)m * DM, wnext, wnext ? XN + (size_t)m * DM : nullptr, lane);
                if (sub == 0) {
                    LAS float* scr = (LAS float*)(ldsl + wave * 16384);
                    const float* w1k = args.in[I_W1K] + (size_t)l * 3072 * 256; const float* w1v = args.in[I_W1V] + (size_t)l * 2048 * 256;
                    for (int it = gw; it < 48 * 8 + 32 * 8; it += NGW) {
                        if (it < 384) transpose_item(w1k, 3072, 256, (bf16*)(ws + WS_WD + CW_W1K), scr, it, lane, MapId());
                        else transpose_item(w1v, 2048, 256, (bf16*)(ws + WS_WD + CW_W1V), scr, it - 384, lane, MapId()); }
                    if (bx < 32) { const int which = bx >> 4, part = bx & 15, j = tid & 255, hf = tid >> 8;
                        const int per = which ? 128 : 192, i0 = part * per + hf * (per / 2);
                        const float* pe = which ? args.in[I_PEV] + l * 32 * 64 : args.in[I_PEK] + l * 32 * 96; const float* w1 = which ? w1v : w1k;
                        float a = 0.f;
                        for (int i = i0; i < i0 + per / 2; ++i) a += pe[i] * w1[(size_t)i * 256 + j];
                        float* red = (float*)lds; __syncthreads(); red[tid] = a; __syncthreads();
                        if (tid < 256) ((float*)(ws + WS_WD + CW_BPART))[(which * 16 + part) * 256 + tid] = red[tid] + red[tid + 256];
                    }
                }
            }
        } break;
        case K_M1: {
            pg8::Gemm g{(const bf16*)(ws + WS_XN) + (size_t)b * SEQ * DM, (const bf16*)(ws + WS_WIN), SEQ, NIN, DM, DM, DM}; pg8::StaticOrder S; S.init(SEQ, NIN, G, bx);
            pg8::EpiWin E{(bf16*)(ws + WS_A), (float*)(ws + WS_SM), (bf16*)(ws + WS_G), (bf16*)(ws + WS_O + CMP_KCF), (bf16*)(ws + WS_O + CMP_VCF)};
            if (bx == 1) { bf16* KCF = (bf16*)(ws + WS_O + CMP_KCF); bf16* VCF = (bf16*)(ws + WS_O + CMP_VCF);
                for (int i = tid; i < 768; i += NTHR) ((unsigned*)(KCF + (size_t)2 * SEQ * 96))[i] = 0u; for (int i = tid; i < 512; i += NTHR) ((unsigned*)(VCF + (size_t)2 * SEQ * 64))[i] = 0u; }
            pg8::gemm_phase<pg8::EpiWin, pg8::StaticOrder, true, true>(ldsl, g, S, E);
        } break;
        case K_M2: {
            const bf16* PA = (const bf16*)(ws + WS_A); const float* SM = (const float*)(ws + WS_SM);
            if (bx == 0) { const int which = tid >> 8, j = tid & 255; float a = 0.f; const float* bp = (const float*)(ws + WS_WD + CW_BPART) + which * 16 * 256 + j;
                for (int p = 0; p < 16; ++p) a += bp[p * 256];
                ((float*)(ws + WS_WD + CW_BIAS))[which * 256 + j] = a; }
            if (bx < 32) {
                const int kv = bx >> 4, pm = (bx >> 2) & 3, ks = bx & 3;
                pg8::Gemm g = kv ? pg8::Gemm{(const bf16*)(ws + WS_O + CMP_VCF) + ks * 512, (const bf16*)(ws + WS_WD + CW_W1V) + ks * 512, 1024, 256, 512, 1024, 2048}
                                 : pg8::Gemm{(const bf16*)(ws + WS_O + CMP_KCF) + ks * 768, (const bf16*)(ws + WS_WD + CW_W1K) + ks * 768, 1024, 256, 768, 1536, 3072};
                pg8::OneTile S{pm, 0}; pg8::EpiF32 E{(float*)(ws + WS_O + CMP_PART) + ((size_t)kv * 4 + ks) * 1024 * 256, 256};
                pg8::gemm_phase<pg8::EpiF32, pg8::OneTile, false, true>(ldsl, g, S, E);
                __syncthreads();
            }
            for (int it = gw; it < NCHUNK * 4; it += NGW) nsa_vt_item(PA, (bf16*)(ws + WS_VTS), (bf16*)(ws + WS_VTW), it, (unsigned short*)(lds + wave * 16384), lane);
            for (int it = bx; it < NCHUNK * 4; it += G)
                gla_prep_item(PA, SM, args.in[I_GGW] + l * 16 * 256, args.in[I_GGB] + l * 256, ws + ALPHA_OFF, ws + WS_WGU, it >> 2, it & 3, (float*)lds, tid);
        } break;
        case K_M2B: {
            if (bx < 32) {
                const int kv = bx >> 4, rg = bx & 15;
                float* Hs = (float*)lds;
                const float* part = (const float*)(ws + WS_O + CMP_PART) + (size_t)kv * 4 * 1024 * 256; const float* bias = (const float*)(ws + WS_WD + CW_BIAS) + kv * 256;
                __syncthreads();
                for (int i = tid; i < 64 * 64; i += NTHR) { const int r = i >> 6, c4 = (i & 63) * 4; const size_t o = (size_t)(rg * 64 + r) * 256 + c4;
                    f32x4 v = *(const f32x4*)(part + o) + *(const f32x4*)(part + 262144 + o) + *(const f32x4*)(part + 2 * 262144 + o) + *(const f32x4*)(part + 3 * 262144 + o) + *(const f32x4*)(bias + c4);
#pragma unroll
                    for (int e = 0; e < 4; ++e) v[e] = gelu_tanhf_(v[e]);
                    *(f32x4*)(Hs + r * 260 + c4) = v; }
                __syncthreads();
                const int r = tid >> 3, dg = tid & 7, row = rg * 64 + r, gg = row >> 9, n = row & 511;
                if (kv == 0) { float acc[12]; cmp_layer2<12>(Hs + r * 260, args.in[I_W2K] + l * 256 * 96 + dg * 12, 96, acc);
                    if (n < 511) { bf16* KCH = (bf16*)(ws + WS_KCMP) + (size_t)(n * 2 + gg) * 96 + dg * 12; bf16* KCL = (bf16*)(ws + WS_KCL) + (size_t)(n * 2 + gg) * 96 + dg * 12;
#pragma unroll
                        for (int i = 0; i < 12; ++i) { const unsigned hi = f2bf(acc[i]); KCH[i] = (bf16)hi; KCL[i] = (bf16)f2bf(acc[i] - __uint_as_float(hi << 16)); } } }
                else { float acc[8]; cmp_layer2<8>(Hs + r * 260, args.in[I_W2V] + l * 256 * 64 + dg * 8, 64, acc);
                    if (n < 511) { bf16* VCT = (bf16*)(ws + WS_VCT) + (size_t)(gg * 64 + dg * 8) * 512 + n;
#pragma unroll
                        for (int i = 0; i < 8; ++i) VCT[(size_t)i * 512] = (bf16)f2bf(acc[i]); } }
                if (bx == 0) { if (tid < 192) { ((bf16*)(ws + WS_KCMP))[511 * 192 + tid] = 0; ((bf16*)(ws + WS_KCL))[511 * 192 + tid] = 0; } if (tid < 128) ((bf16*)(ws + WS_VCT))[tid * 512 + 511] = 0; }
            } else {
                const bf16* PA = (const bf16*)(ws + WS_A); const float* SM = (const float*)(ws + WS_SM);
                for (int it = bx - 32; it < NCHUNK * 4; it += G - 32)
                    gdn_prep_chunk(PA, SM, args.in[I_CONVW] + l * 4 * 1536, args.in[I_ALOG] + l * 4, args.in[I_DTB] + l * 4, ws + WS_QKV, it >> 2, it & 3, lds, tid);
            }
        } break;
        case K_M3: {
            const bf16* PA = (const bf16*)(ws + WS_A); bf16* OB3 = (bf16*)(ws + WS_O);
            float* wl = (float*)(lds + wave * 16384);
            if (bx < 4) { if (pmode == 0 || pmode == 1) gdn_scan_block(ws + WS_QKV, OB3, bx, lds, tid); }
            else if (bx < 8) { if (pmode == 0 || pmode == 2) gla_scan_block(ws + ALPHA_OFF, ws + WS_WGU, OB3 + 2 * (size_t)SEQ * 512, bx - 4, lds, tid); }
            else if (pmode == 0 || pmode == 3) { const LAS int* btab = (const LAS int*)(ldsl + BTAB_OFF); const LAS float* relb = (const LAS float*)(ldsl + RELB_OFF);
                unsigned* qctr = (unsigned*)(ws + WS_CTL) + CW_Q + 64 * (l * 2 + b + 4 * pmode);
                volatile unsigned* qw = (volatile unsigned*)(lds + NSA_UOFF + 256);
                for (;;) {
                    __syncthreads();
                    if (tid == 0) *qw = __hip_atomic_fetch_add(qctr, 1u, __ATOMIC_RELAXED, __HIP_MEMORY_SCOPE_AGENT);
                    __syncthreads();
                    const unsigned u = *qw;
                    if (u >= (unsigned)(SEQ / 32 * 2)) break;
                    nsa_unit(PA, (const float*)(ws + WS_SM), (const bf16*)(ws + WS_KCMP), (const bf16*)(ws + WS_KCL), (const bf16*)(ws + WS_VCT), (const bf16*)(ws + WS_VTS), (const bf16*)(ws + WS_VTW),
                             relb, btab, pmode == 3 ? (bf16*)(ws + WS_QKV) : OB3 + (size_t)SEQ * 512, SEQ - 32 - 32 * (int)(u >> 1), (int)(u & 1), lds, tid, pmode == 3 ? PROBE_ABL : 0);
                } }
        } break;
        case K_M4: {
            for (int it = gw; it < SEQ * 4; it += NGW) out_norm_item((bf16*)(ws + WS_O), (const bf16*)(ws + WS_A), PA_GZ, args.in[I_GDNNW] + l * 128, it >> 2, it & 3, lane);
            for (int it = gw; it < SEQ * 4; it += NGW) out_norm_item((bf16*)(ws + WS_O) + 2 * (size_t)SEQ * 512, (const bf16*)(ws + WS_A), PA_LR, args.in[I_GLANW] + l * 128, it >> 2, it & 3, lane);
        } break;
        case K_M5: {
#pragma unroll 1
            for (int br = 0; br < 3; ++br) {
                pg8::StaticOrder S; S.init(SEQ, DM, G, bx);
                pg8::Gemm g{(const bf16*)(ws + WS_O) + (size_t)br * SEQ * 512, (const bf16*)(ws + WS_WB) + (size_t)br * 512 * 1024, SEQ, DM, 512, 512, 512};
                pg8::EpiMerge E{(const bf16*)(ws + WS_G) + br * 1024, (float*)(ws + WS_RMW), (bf16*)(ws + WS_MG), br};
                pg8::gemm_phase<pg8::EpiMerge, pg8::StaticOrder, true, true>(ldsl, g, S, E);
            }
        } break;
        default: break;
        }
#if MK_ONE_LAUNCH
        if (pc + 1 < args.ph_hi) xcd_barrier(bar);
#endif
    }
}

extern "C" void kernel_launch(void* const* d_in, const int* in_sizes, int n_in, void* d_out, int out_size, void* d_ws, size_t ws_size, hipStream_t stream) {
    static int grid = 0;
    if (grid == 0) {
        if (n_in != 30 || out_size != MTOK * DM || ws_size < 292 * MiB) { fprintf(stderr, "kernel_launch: unexpected shapes (n_in %d out %d ws %zu)\n", n_in, out_size, ws_size); grid = -1; return; }
        int dev = 0, cus = 0, per_cu = 0;
        if (hipGetDevice(&dev) != hipSuccess || hipDeviceGetAttribute(&cus, hipDeviceAttributeMultiprocessorCount, dev) != hipSuccess) { grid = -1; return; }
        if (hipFuncSetAttribute((const void*)mk_fwd, hipFuncAttributeMaxDynamicSharedMemorySize, LDS_BYTES) != hipSuccess) { fprintf(stderr, "kernel_launch: hipFuncSetAttribute failed\n"); grid = -1; return; }
        if (hipOccupancyMaxActiveBlocksPerMultiprocessor(&per_cu, (const void*)mk_fwd, NTHR, LDS_BYTES) != hipSuccess || per_cu < 1) { fprintf(stderr, "kernel_launch: occupancy query says %d blocks per CU\n", per_cu); grid = -1; (void)hipGetLastError(); return; }
        (void)hipGetLastError();
        grid = cus;
    }
    if (grid < 0) return;
    (void)hipMemsetAsync((char*)d_ws + WS_CTL, 0, CTL_ZERO_BYTES, stream);
    Args a{};
    for (int i = 0; i < 30; ++i) a.in[i] = (const float*)d_in[i];
    a.out = (float*)d_out; a.ws = (unsigned char*)d_ws;
    int np = 0;
#ifndef PROBE_KIND
#define PROBE_KIND -1
#endif
    auto push = [&](int kind, int sub, int b, int l, int mixer) { const int reps = (kind == PROBE_KIND) ? 2 : 1; for (int r = 0; r < reps; ++r) a.prog[np++] = (unsigned short)(kind | sub << 4 | b << 5 | l << 6 | mixer << 7);
#ifdef PROBE_M3MODE
        if (kind == K_M3) a.prog[np++] = (unsigned short)(kind | sub << 4 | b << 5 | l << 6 | mixer << 7 | PROBE_M3MODE << 8);
#endif
    };
    for (int l = 0; l < DEPTH; ++l) {
        push(K_CONV, 0, 0, l, 0); push(K_F1, 0, 0, l, 0); push(K_GF32, 0, 0, l, 0); push(K_ROWS, 0, 0, l, 0);
        for (int b = 0; b < NBATCH; ++b) { push(K_M1, 0, b, l, 1); push(K_M2, 0, b, l, 1); push(K_M2B, 0, b, l, 1); push(K_M3, 0, b, l, 1); push(K_M4, 0, b, l, 1); push(K_M5, 0, b, l, 1); push(K_GF32, 0, b, l, 1); push(K_ROWS, 0, b, l, 1); }
        push(K_CONV, 1, 0, l, 0); push(K_F1, 1, 0, l, 0); push(K_GF32, 1, 0, l, 0); push(K_ROWS, 1, 0, l, 0);
    }
    const int NPH = np;
#if MK_ONE_LAUNCH
    a.ph_lo = 0; a.ph_hi = NPH;
    hipLaunchKernelGGL(mk_fwd, dim3(grid), dim3(NTHR), LDS_BYTES, stream, a);
#else
    for (int p = 0; p < NPH; ++p) { a.ph_lo = p; a.ph_hi = p + 1; hipLaunchKernelGGL(mk_fwd, dim3(grid), dim3(NTHR), LDS_BYTES, stream, a); }
#endif
}
```

```cpp
#include <hip/hip_runtime.h>
#include <cstdio>
#include <cstdint>
#ifndef MK_ONE_LAUNCH
#define MK_ONE_LAUNCH 1
#endif
namespace pg8 {
#define PG8_LAS __attribute__((address_space(3)))
typedef unsigned short bf16_t;
typedef short bf16x8 __attribute__((ext_vector_type(8)));
typedef float f32x4 __attribute__((ext_vector_type(4)));
typedef unsigned u32x4 __attribute__((ext_vector_type(4)));
typedef unsigned u32x2 __attribute__((ext_vector_type(2)));
constexpr int BM = 256, BK = 64, HALF = 128, HTB = HALF * BK * 2  , STAGE_BYTES = 8 * HTB, NXCD = 8, WGM = 8;

__host__ __device__ __forceinline__ int lds_byte(int r, int c) { const int st = (r >> 4) * 2 + (c >> 5), rr = r & 15, cc = c & 31, ob = rr * 64 + cc * 2; return st * 1024 + (ob ^ (((ob >> 9) & 1) << 5)); }
__host__ __device__ __forceinline__ void stage_rc(int b, int& R, int& C) { const int st = b / 1024, sb = b % 1024, swz = sb ^ (((sb >> 9) & 1) << 5); R = (st >> 1) * 16 + swz / 64; C = (st & 1) * 32 + (swz % 64) / 2; }
__host__ __device__ __forceinline__ int perm32(int rho) { const int n = rho >> 4, i = rho & 15; return 8 * (i >> 2) + 4 * n + (i & 3); }

struct Unit { int pm, pn; };
struct Gemm { const bf16_t* A; const bf16_t* Bt; int M, N, K, lda, ldb; };

struct StaticOrder {
    int nM, nN, nwg, G, c;
    __host__ __device__ void init(int M, int N, int G_, int c_) { nM = M / BM; nN = N / BM; nwg = nM * nN; G = G_; c = c_; }
    __host__ __device__ bool next(int i, Unit& u) const {
        const long L = (long)i * G + c; if (L >= nwg) return false;
        int wgid = (int)L; { const int q = nwg / NXCD, r = nwg % NXCD, xcd = wgid % NXCD, off = wgid / NXCD; wgid = (xcd < r ? xcd * (q + 1) : r * (q + 1) + (xcd - r) * q) + off; }
        const int nig = WGM * nN, gid = wgid / nig, fm = gid * WGM, gsz = (nM - fm) < WGM ? (nM - fm) : WGM;
        u.pm = fm + ((wgid % nig) % gsz); u.pn = (wgid % nig) / gsz; return true;
    }
    __device__ __forceinline__ void a_ready(const Unit&) const {}
    __device__ __forceinline__ void done(const Unit&) const {}
};

struct OneTile { int pm, pn; __device__ __forceinline__ bool next(int i, Unit& u) const { if (i) return false; u.pm = pm; u.pn = pn; return true; }
    __device__ __forceinline__ void a_ready(const Unit&) const {} __device__ __forceinline__ void done(const Unit&) const {} };
__device__ __forceinline__ unsigned cvt_pk_bf16(float lo, float hi) { unsigned r; asm volatile("v_cvt_pk_bf16_f32 %0, %1, %2" : "=v"(r) : "v"(lo), "v"(hi)); return r; }
__device__ __forceinline__ float bflo(unsigned w) { return __uint_as_float(w << 16); }
__device__ __forceinline__ float bfhi(unsigned w) { return __uint_as_float(w & 0xffff0000u); }
__device__ __forceinline__ float sigmoid_f(float x) { return __builtin_amdgcn_rcpf(1.f + __expf(-x)); }

struct EpiSwiglu {
    static constexpr bool PERM = true, AFTER_DRAIN = false;
    bf16_t* H; int ldh;
    __device__ __forceinline__ void operator()(const f32x4 (&acc)[2][2][4][2], const Unit& u, int wr, int wc, int fr, int fq) const {
        const int row0 = u.pm * BM + wr * 64 + fr, j0 = u.pn * HALF + wc * 32 + 8 * fq;
#pragma unroll
        for (int ai = 0; ai < 2; ++ai)
#pragma unroll
            for (int m = 0; m < 4; ++m) {
                bf16_t* p = H + (size_t)(row0 + ai * HALF + m * 16) * ldh + j0;
                float h[8];
#pragma unroll
                for (int n = 0; n < 2; ++n)
#pragma unroll
                    for (int i = 0; i < 4; ++i) { const float g = acc[ai][0][m][n][i], uu = acc[ai][1][m][n][i]; h[n * 4 + i] = g * sigmoid_f(g) * uu; }
                u32x4 w; w.x = cvt_pk_bf16(h[0], h[1]); w.y = cvt_pk_bf16(h[2], h[3]); w.z = cvt_pk_bf16(h[4], h[5]); w.w = cvt_pk_bf16(h[6], h[7]);
                *(u32x4*)p = w;
                asm volatile("" ::: "memory");
            }
    }
};
struct EpiGelu {
    static constexpr bool PERM = false, AFTER_DRAIN = false;
    bf16_t* Hd; const float* bias;
    __device__ __forceinline__ void operator()(const f32x4 (&acc)[2][2][4][2], const Unit& u, int wr, int wc, int fr, int fq) const {
        const int row0 = u.pm * BM + wr * 64 + fr, col0 = wc * 32 + 4 * fq;
#pragma unroll
        for (int bj = 0; bj < 2; ++bj)
#pragma unroll
            for (int n = 0; n < 2; ++n) { const int c = col0 + bj * HALF + n * 16; const f32x4 bv = *(const f32x4*)(bias + c);
#pragma unroll
                for (int ai = 0; ai < 2; ++ai)
#pragma unroll
                    for (int m = 0; m < 4; ++m) { f32x4 v = acc[ai][bj][m][n] + bv;
#pragma unroll
                        for (int i = 0; i < 4; ++i) { const float x = v[i]; const float u2 = 1.5957691216057308f * (x + 0.044715f * x * x * x); v[i] = x * (1.f - __builtin_amdgcn_rcpf(1.f + __expf(u2))); }
                        u32x2 w; w.x = cvt_pk_bf16(v[0], v[1]); w.y = cvt_pk_bf16(v[2], v[3]);
                        *(u32x2*)(Hd + (size_t)(row0 + ai * HALF + m * 16) * 256 + c) = w; asm volatile("" ::: "memory"); } }
    }
};
struct EpiF32 {
    static constexpr bool PERM = false, AFTER_DRAIN = false;
    float* Y; int ldc;
    __device__ __forceinline__ void operator()(const f32x4 (&acc)[2][2][4][2], const Unit& u, int wr, int wc, int fr, int fq) const {
        const int row0 = u.pm * BM + wr * 64 + fr, col0 = u.pn * BM + wc * 32 + 4 * fq;
#pragma unroll
        for (int ai = 0; ai < 2; ++ai)
#pragma unroll
            for (int m = 0; m < 4; ++m) { float* p = Y + (size_t)(row0 + ai * HALF + m * 16) * ldc + col0;
#pragma unroll
                for (int bj = 0; bj < 2; ++bj)
#pragma unroll
                    for (int n = 0; n < 2; ++n) *(f32x4*)(p + bj * HALF + n * 16) = acc[ai][bj][m][n]; }
    }
};
struct EpiWin {
    static constexpr bool PERM = true, AFTER_DRAIN = false;
    bf16_t* PA; float* SM; bf16_t* G; bf16_t* KCF; bf16_t* VCF;
    __device__ __forceinline__ void operator()(const f32x4 (&acc)[2][2][4][2], const Unit& u, int wr, int wc, int fr, int fq) const {
        const int row0 = u.pm * BM + wr * 64 + fr, cw = wc * 32 + 8 * fq;
        const bool gate = u.pn >= 21;
#pragma unroll
        for (int ai = 0; ai < 2; ++ai)
#pragma unroll
            for (int m = 0; m < 4; ++m) { const size_t row = (size_t)(row0 + ai * HALF + m * 16);
#pragma unroll
                for (int bj = 0; bj < 2; ++bj) {
                    f32x4 v0 = acc[ai][bj][m][0], v1 = acc[ai][bj][m][1];
                    if (gate) {
#pragma unroll
                        for (int i = 0; i < 4; ++i) { v0[i] = sigmoid_f(v0[i]); v1[i] = sigmoid_f(v1[i]); }
                    }
                    u32x4 w; w.x = cvt_pk_bf16(v0[0], v0[1]); w.y = cvt_pk_bf16(v0[2], v0[3]); w.z = cvt_pk_bf16(v1[0], v1[1]); w.w = cvt_pk_bf16(v1[2], v1[3]);
                    if (gate) *(u32x4*)(G + row * 3072 + (u.pn - 21) * BM + bj * HALF + cw) = w;
                    else {
                        const int col = u.pn * BM + bj * HALF + cw;
                        *(u32x4*)(PA + row * 5376 + col) = w;
                        if (col >= 5312) { float* s = SM + row * 64 + (col - 5312); *(f32x4*)s = v0; *(f32x4*)(s + 4) = v1; }
                        if (col >= 2816 && col < 3136) { const int off = col - 2816, gg = off >= 160, c = off - gg * 160;
                            if (c < 96) *(u32x4*)(KCF + ((size_t)gg * 8192 + row) * 96 + c) = w; else *(u32x4*)(VCF + ((size_t)gg * 8192 + row) * 64 + (c - 96)) = w; }
                    }
                    asm volatile("" ::: "memory");
                }
            }
    }
};
struct EpiMerge {
    static constexpr bool PERM = false, AFTER_DRAIN = false;
    const bf16_t* G; float* RMW; bf16_t* MG; int STEP;
    __device__ __forceinline__ void operator()(const f32x4 (&acc)[2][2][4][2], const Unit& u, int wr, int wc, int fr, int fq) const {
        const int row0 = u.pm * BM + wr * 64 + fr, col0 = u.pn * BM + wc * 32 + 4 * fq;
#pragma unroll
        for (int ai = 0; ai < 2; ++ai)
#pragma unroll
          for (int mp = 0; mp < 2; ++mp) {
            u32x2 gw[2][2][2]; f32x4 rv[2][2][2];
#pragma unroll
            for (int mi = 0; mi < 2; ++mi) { const size_t row = (size_t)(row0 + ai * HALF + (2 * mp + mi) * 16); const bf16_t* gp = G + row * 3072 + col0; const float* rp = RMW + row * 1024 + col0;
#pragma unroll
                for (int bj = 0; bj < 2; ++bj)
#pragma unroll
                    for (int n = 0; n < 2; ++n) { gw[mi][bj][n] = *(const u32x2*)(gp + bj * HALF + n * 16); if (STEP != 0) rv[mi][bj][n] = *(const f32x4*)(rp + bj * HALF + n * 16); } }
#pragma unroll
            for (int mi = 0; mi < 2; ++mi) { const int m = 2 * mp + mi; const size_t row = (size_t)(row0 + ai * HALF + m * 16);
#pragma unroll
                for (int bj = 0; bj < 2; ++bj)
#pragma unroll
                    for (int n = 0; n < 2; ++n) { const int c = col0 + bj * HALF + n * 16; const u32x2 g2 = gw[mi][bj][n];
                        f32x4 v = acc[ai][bj][m][n]; v[0] *= bflo(g2.x); v[1] *= bfhi(g2.x); v[2] *= bflo(g2.y); v[3] *= bfhi(g2.y);
                        if (STEP != 0) v = v + rv[mi][bj][n];
                        if (STEP != 2) *(f32x4*)(RMW + row * 1024 + c) = v;
                        else { u32x2 w; w.x = cvt_pk_bf16(v[0], v[1]); w.y = cvt_pk_bf16(v[2], v[3]); *(u32x2*)(MG + row * 1024 + c) = w; }
                    } }
            asm volatile("" ::: "memory");
        }
    }
};

template <class Epi, class Sched, bool ALIGN_EPI = false, bool SP2 = false>
__device__ __forceinline__ void gemm_phase(PG8_LAS unsigned char* lds, const Gemm g, const Sched& S, const Epi& E) {
    int tid_ = threadIdx.x; asm volatile("" : "+v"(tid_));
    const int tid = tid_, wid = __builtin_amdgcn_readfirstlane(tid >> 6), lane = tid & 63, wr = wid >> 2, wc = wid & 3, fr = lane & 15, fq = lane >> 4;
    const int K = g.K, nt = K / BK, lda = g.lda, ldb = g.ldb;
    unsigned voffA[2], voffB[2];
#pragma unroll
    for (int i = 0; i < 2; ++i) { int R, C; stage_rc(tid * 16 + i * 8192, R, C); const int Rb = Epi::PERM ? ((R & ~31) + perm32(R & 31)) : R;
        voffA[i] = (unsigned)(R * lda + C) * 2u; voffB[i] = (unsigned)(Rb * ldb + C) * 2u; }
    const size_t kstep = (size_t)(BK * 2);
    const size_t hstepA = (size_t)HALF * lda * 2, tstepA = 2 * hstepA;
    const size_t hstep = (size_t)HALF * ldb * 2;
    const size_t tstep = 2 * hstep;
    const unsigned ldsw = (unsigned)wid * 1024u;
    const int aoff = lds_byte(wr * 64 + fr, fq * 8), boff = lds_byte(wc * 32 + fr, fq * 8);
#define PG8_SA(b, h) (((b) * 2 + (h)) * HTB)
#define PG8_SB(b, h) ((4 + (b) * 2 + (h)) * HTB)
#define PG8_STAGE(bufoff, gbase, voff) do { _Pragma("unroll") for (int _i = 0; _i < 2; ++_i) \
        __builtin_amdgcn_global_load_lds((const unsigned*)((const char*)(gbase) + (voff)[_i]), (PG8_LAS unsigned*)(lds + (bufoff) + ldsw + _i * 8192), 16, 0, 0); } while (0)
#define PG8_LDA(dst, b, h) do { _Pragma("unroll") for (int m = 0; m < 4; ++m) _Pragma("unroll") for (int k = 0; k < 2; ++k) dst[m][k] = *(const PG8_LAS bf16x8*)(lds + PG8_SA(b, h) + aoff + m * 2048 + k * 1024); } while (0)
#define PG8_LDB(dst, b, h) do { _Pragma("unroll") for (int n = 0; n < 2; ++n) _Pragma("unroll") for (int k = 0; k < 2; ++k) dst[n][k] = *(const PG8_LAS bf16x8*)(lds + PG8_SB(b, h) + boff + n * 2048 + k * 1024); } while (0)
#define PG8_MMA(ai, bj, At, Bt) do { __builtin_amdgcn_s_setprio(1); _Pragma("unroll") for (int m = 0; m < 4; ++m) _Pragma("unroll") for (int n = 0; n < 2; ++n) _Pragma("unroll") for (int k = 0; k < 2; ++k) \
        acc[ai][bj][m][n] = __builtin_amdgcn_mfma_f32_16x16x32_bf16(Bt[n][k], At[m][k], acc[ai][bj][m][n], 0, 0, 0); __builtin_amdgcn_s_setprio(0); } while (0)
#define PG8_WAIT_V(n) asm volatile("s_waitcnt vmcnt(" #n ")" ::: "memory")
#define PG8_WAIT_L(n) asm volatile("s_waitcnt lgkmcnt(" #n ")" ::: "memory")
#define PG8_BAR __builtin_amdgcn_s_barrier()
#define PG8_SCHED __builtin_amdgcn_sched_barrier(0)
    Unit cur, nxt; int ui = 0;
    if (!S.next(0, cur)) return;
    f32x4 acc[2][2][4][2];
#pragma unroll
    for (int a = 0; a < 2; ++a)
#pragma unroll
        for (int b = 0; b < 2; ++b)
#pragma unroll
            for (int m = 0; m < 4; ++m)
#pragma unroll
                for (int n = 0; n < 2; ++n) acc[a][b][m][n] = (f32x4){0.f, 0.f, 0.f, 0.f};
    bf16x8 At[4][2], B0[2][2], B1[2][2];
    const char* cA = (const char*)g.A + (size_t)cur.pm * tstepA; const char* cB = (const char*)g.Bt + (size_t)cur.pn * tstep;
    S.a_ready(cur);
    if constexpr (SP2) {
        PG8_STAGE(PG8_SB(0, 0), cB, voffB); PG8_STAGE(PG8_SB(0, 1), cB + hstep, voffB); PG8_STAGE(PG8_SA(0, 0), cA, voffA); PG8_STAGE(PG8_SA(0, 1), cA + hstepA, voffA);
        if (wr == 1) PG8_BAR;
        PG8_WAIT_V(2); PG8_BAR;
        PG8_STAGE(PG8_SB(1, 0), cB + kstep, voffB); PG8_STAGE(PG8_SA(1, 0), cA + kstep, voffA); PG8_STAGE(PG8_SB(1, 1), cB + hstep + kstep, voffB);
        PG8_WAIT_V(6); PG8_BAR;
    } else {
        PG8_STAGE(PG8_SB(0, 0), cB, voffB); PG8_STAGE(PG8_SA(0, 0), cA, voffA); PG8_STAGE(PG8_SB(0, 1), cB + hstep, voffB); PG8_STAGE(PG8_SA(0, 1), cA + hstepA, voffA);
        if (wr == 1) PG8_BAR;
        PG8_WAIT_V(4); PG8_BAR;
        PG8_STAGE(PG8_SB(1, 0), cB + kstep, voffB); PG8_STAGE(PG8_SA(1, 0), cA + kstep, voffA); PG8_STAGE(PG8_SB(1, 1), cB + hstep + kstep, voffB);
        PG8_WAIT_V(6); PG8_BAR;
    }
    for (;;) {
        const bool has_next = S.next(ui + 1, nxt);
        const char* nA = has_next ? (const char*)g.A + (size_t)nxt.pm * tstepA : cA; const char* nB = has_next ? (const char*)g.Bt + (size_t)nxt.pn * tstep : cB;
        for (int t = 0; t < nt; t += 2) {
            const bool last = (t == nt - 2);
            const char* a1 = cA + (size_t)(t + 1) * kstep;
            const char* a2 = last ? nA : cA + (size_t)(t + 2) * kstep; const char* b2 = last ? nB : cB + (size_t)(t + 2) * kstep;
            const char* a3 = a2 + kstep; const char* b3 = b2 + kstep;
            if (last && has_next) S.a_ready(nxt);
            if constexpr (SP2) {
            PG8_LDB(B0, 0, 0); PG8_LDB(B1, 0, 1); PG8_SCHED; PG8_LDA(At, 0, 0); PG8_STAGE(PG8_SA(1, 1), a1 + hstepA, voffA);
            PG8_WAIT_V(8); PG8_WAIT_L(0); PG8_BAR; PG8_MMA(0, 0, At, B0); PG8_MMA(0, 1, At, B1); PG8_BAR; PG8_SCHED;
            PG8_LDA(At, 0, 1); PG8_STAGE(PG8_SB(0, 0), b2, voffB); PG8_STAGE(PG8_SB(0, 1), b2 + hstep, voffB); PG8_STAGE(PG8_SA(0, 0), a2, voffA);
            PG8_WAIT_V(8); PG8_WAIT_L(0); PG8_BAR; PG8_MMA(1, 0, At, B0); PG8_MMA(1, 1, At, B1); PG8_BAR; PG8_SCHED;
            PG8_LDB(B0, 1, 0); PG8_LDB(B1, 1, 1); PG8_SCHED; PG8_LDA(At, 1, 0); PG8_STAGE(PG8_SA(0, 1), a2 + hstepA, voffA);
            PG8_WAIT_V(8); PG8_WAIT_L(0); PG8_BAR; PG8_MMA(0, 0, At, B0); PG8_MMA(0, 1, At, B1); PG8_BAR; PG8_SCHED;
            PG8_LDA(At, 1, 1); PG8_STAGE(PG8_SB(1, 0), b3, voffB); PG8_STAGE(PG8_SB(1, 1), b3 + hstep, voffB); PG8_STAGE(PG8_SA(1, 0), a3, voffA);
            PG8_WAIT_V(8); PG8_WAIT_L(0); PG8_BAR; PG8_MMA(1, 0, At, B0); PG8_MMA(1, 1, At, B1); PG8_BAR; PG8_SCHED;
            } else {
            PG8_LDB(B0, 0, 0); PG8_SCHED; PG8_LDA(At, 0, 0); PG8_STAGE(PG8_SA(1, 1), a1 + hstepA, voffA);
            PG8_WAIT_L(8); PG8_BAR; PG8_WAIT_L(0); PG8_MMA(0, 0, At, B0); PG8_BAR; PG8_SCHED;
            PG8_LDB(B1, 0, 1); PG8_STAGE(PG8_SB(0, 0), b2, voffB);
            PG8_BAR; PG8_WAIT_L(0); PG8_MMA(0, 1, At, B1); PG8_BAR;
            PG8_LDA(At, 0, 1); PG8_STAGE(PG8_SA(0, 0), a2, voffA);
            PG8_BAR; PG8_WAIT_L(0); PG8_MMA(1, 0, At, B0); PG8_BAR; PG8_SCHED;
            PG8_STAGE(PG8_SB(0, 1), b2 + hstep, voffB);
            PG8_WAIT_V(6); PG8_BAR; PG8_MMA(1, 1, At, B1); PG8_BAR;
            PG8_LDB(B0, 1, 0); PG8_SCHED; PG8_LDA(At, 1, 0); PG8_STAGE(PG8_SA(0, 1), a2 + hstepA, voffA);
            PG8_WAIT_L(8); PG8_BAR; PG8_WAIT_L(0); PG8_MMA(0, 0, At, B0); PG8_BAR; PG8_SCHED;
            PG8_LDB(B1, 1, 1); PG8_STAGE(PG8_SB(1, 0), b3, voffB);
            PG8_BAR; PG8_WAIT_L(0); PG8_MMA(0, 1, At, B1); PG8_BAR;
            PG8_LDA(At, 1, 1); PG8_STAGE(PG8_SA(1, 0), a3, voffA);
            PG8_BAR; PG8_WAIT_L(0); PG8_MMA(1, 0, At, B0); PG8_BAR; PG8_SCHED;
            PG8_STAGE(PG8_SB(1, 1), b3 + hstep, voffB);
            PG8_WAIT_V(6); PG8_BAR; PG8_MMA(1, 1, At, B1); PG8_BAR;
            }
        }
        if constexpr (ALIGN_EPI) { if (wr == 0) PG8_BAR; }
        if constexpr (!Epi::AFTER_DRAIN) { E(acc, cur, wr, wc, fr, fq); S.done(cur); }
        if (!has_next) break;
#pragma unroll
        for (int a = 0; a < 2; ++a)
#pragma unroll
            for (int b = 0; b < 2; ++b)
#pragma unroll
                for (int m = 0; m < 4; ++m)
#pragma unroll
                    for (int n = 0; n < 2; ++n) acc[a][b][m][n] = (f32x4){0.f, 0.f, 0.f, 0.f};
        cur = nxt; cA = nA; cB = nB; ++ui;
        if constexpr (ALIGN_EPI) { if (wr == 1) PG8_BAR; }
    }
    PG8_WAIT_V(0);
    if constexpr (!ALIGN_EPI) { if (wr == 0) PG8_BAR; }
    PG8_BAR;
    if constexpr (Epi::AFTER_DRAIN) { E.fused(acc, cur, wr, wc, fr, fq, lds, wid, lane); S.done(cur); }
#undef PG8_SA
#undef PG8_SB
#undef PG8_STAGE
#undef PG8_LDA
#undef PG8_LDB
#undef PG8_MMA
#undef PG8_WAIT_V
#undef PG8_WAIT_L
#undef PG8_BAR
#undef PG8_SCHED
}
}

constexpr int NWAVES = 8, NTHR = 512;
constexpr int NBATCH = 2, SEQ = 8192, MTOK = NBATCH * SEQ, DM = 1024, DFF = 2816, DIN_SRC = 8432, NIN = 8448, NPA = 5376, NMG = 3072, DEPTH = 2;
constexpr float NORM_EPS = 1e-6f;
constexpr int PA_GQ = 0, PA_GK = 512, PA_GV = 1024, PA_GZ = 1536, PA_NQ = 2048, PA_KC = 2816, PA_KS = 3136, PA_KW = 3456, PA_LQ = 3776, PA_LK = 4032, PA_LV = 4288, PA_LR = 4800, PA_SM = 5312;
constexpr size_t MiB = 1u << 20;
constexpr size_t WS_CTL = 0, CTL_ZERO_BYTES = 1 * MiB;
constexpr size_t WS_WGU = 1 * MiB, WS_WD = 12 * MiB, WS_WIN = WS_WD + 5632 * 1024, WS_WB = WS_WIN + (size_t)NIN * DM * 2, WS_WO = WS_WB + 3 * MiB;
constexpr size_t WS_XN = 40 * MiB, WS_A = 72 * MiB, WS_G = 160 * MiB, WS_O = 208 * MiB, WS_QKV = 232 * MiB, WS_SM = 290 * MiB, WS_GATES = 258 * MiB, WS_ORAW = 259 * MiB, WS_VTS = 270 * MiB, WS_VTW = 272 * MiB, WS_KCMP = 275 * MiB, WS_KCL = WS_KCMP + 256 * 1024, WS_VCT = WS_KCMP + 512 * 1024, WS_END = 276 * MiB;
constexpr size_t WS_H = WS_A, WS_Y = WS_G;
constexpr size_t WS_RMW = WS_A, WS_MG = WS_A + 32 * MiB, WS_YB = WS_A + 48 * MiB;
static_assert(WS_WO + 2 * MiB <= WS_XN && WS_Y + 64 * MiB <= WS_QKV && WS_YB + 32 * MiB <= WS_G, "ws map");
constexpr int CW_BAR = 4096, CW_Q = 8192;
constexpr int RING_BYTES = 131072, LDSCTL_OFF = RING_BYTES, MISC_OFF = LDSCTL_OFF + 320, BTAB_OFF = RING_BYTES + 1024, RELB_OFF = RING_BYTES + 1536, LDS_BYTES = 147456;

#define GAS __attribute__((address_space(1)))
#define LAS __attribute__((address_space(3)))
typedef unsigned short bf16;
typedef unsigned v4u __attribute__((ext_vector_type(4)));
typedef unsigned v2u __attribute__((ext_vector_type(2)));
typedef float f32x4 __attribute__((ext_vector_type(4)));
#define LDS_WAIT() asm volatile("s_waitcnt lgkmcnt(0)" ::: "memory")
typedef float f32x2_t __attribute__((ext_vector_type(2))); typedef __bf16 bf16x2_t __attribute__((ext_vector_type(2)));
__device__ __forceinline__ unsigned pk2(float lo, float hi) { f32x2_t v = {lo, hi}; bf16x2_t r = __builtin_convertvector(v, bf16x2_t); return __builtin_bit_cast(unsigned, r); }
__device__ __forceinline__ unsigned f2bf(float f) { return pk2(f, 0.f) & 0xffffu; }
__device__ __forceinline__ float bf2f(bf16 h) { return __uint_as_float((unsigned)h << 16); }
__device__ __forceinline__ float bflo(unsigned w) { return __uint_as_float(w << 16); }
__device__ __forceinline__ float bfhi(unsigned w) { return __uint_as_float(w & 0xffff0000u); }
__device__ __forceinline__ float wave_sum(float v) {
#pragma unroll
    for (int o = 1; o < 64; o <<= 1) v += __shfl_xor(v, o);
    return v;
}
__device__ __forceinline__ float wave_max(float v) {
#pragma unroll
    for (int o = 1; o < 64; o <<= 1) v = fmaxf(v, __shfl_xor(v, o));
    return v;
}
__device__ __forceinline__ float sigmoidf_(float x) { return 1.f / (1.f + expf(-x)); }
__device__ __forceinline__ float siluf_(float x) { return x / (1.f + expf(-x)); }
__device__ __forceinline__ float softplusf_(float x) { return x > 20.f ? x : log1pf(expf(x)); }
__device__ __forceinline__ float logsigmoidf_(float x) { return fminf(x, 0.f) - log1pf(expf(-fabsf(x))); }
__device__ __forceinline__ float gelu_tanhf_(float x) { return 0.5f * x * (1.f + tanhf(0.7978845608028654f * (x + 0.044715f * x * x * x))); }

#define XB_TMO      128
#define XB_XCNT(j)  (256  + 64 * (j))
#define XB_XSUB(j)  (1280 + 64 * (j))
#define XB_XGEN(j)  (2304 + 64 * (j))
#define XB_TOP      3328
#define XB_TOPGEN   3392
#define XCD_BAR_WORDS 3456
#define XB_SPIN_CAP (1u << 22)
__device__ __forceinline__ unsigned xb_ld(unsigned* p)              { return __hip_atomic_load(p, __ATOMIC_RELAXED, __HIP_MEMORY_SCOPE_AGENT); }
__device__ __forceinline__ unsigned xb_add(unsigned* p, unsigned v) { return __hip_atomic_fetch_add(p, v, __ATOMIC_RELAXED, __HIP_MEMORY_SCOPE_AGENT); }
__device__ __forceinline__ unsigned xb_xcc_id() { return (unsigned)__builtin_amdgcn_s_getreg((3 << 11) | 20) & 0xFu; }
#define XB_SPIN(cond, bar) do { unsigned _sp = 0; while (cond) { __builtin_amdgcn_s_sleep(1); \
    if ((++_sp & 255u) == 0u) { if (xb_ld(&(bar)[XB_TMO])) break; if (_sp > XB_SPIN_CAP) { atomicAdd(&(bar)[XB_TMO], 1u); break; } } } } while (0)
struct XcdBarrier { unsigned* bar; unsigned x; volatile LAS unsigned* st; };
__device__ __forceinline__ XcdBarrier xcd_barrier_post(unsigned* bar, volatile LAS unsigned* st) {
    XcdBarrier b; b.bar = bar; b.x = xb_xcc_id(); b.st = st;
    if (threadIdx.x == 0) (void)xb_add(&bar[XB_XCNT(b.x)], 1u);
    return b;
}
__device__ __forceinline__ void xcd_barrier_complete(unsigned* bar, unsigned x, unsigned& nloc, unsigned& nx) {
    const unsigned G = gridDim.x * gridDim.y * gridDim.z;
    unsigned sum, cnt, mine, sp = 0u;
    for (;;) {
        sum = 0u; cnt = 0u; mine = 0u;
#pragma unroll
        for (unsigned j = 0; j < 16; ++j) { const unsigned c = xb_ld(&bar[XB_XCNT(j)]); sum += c; cnt += (c > 0u) ? 1u : 0u; mine = (j == x) ? c : mine; }
        if (sum == G) break;
        __builtin_amdgcn_s_sleep(1);
        if ((++sp & 255u) == 0u) { if (xb_ld(&bar[XB_TMO])) break; if (sp > XB_SPIN_CAP) { atomicAdd(&bar[XB_TMO], 1u); break; } }
    }
    nloc = mine > 0u ? mine : 1u; nx = cnt > 0u ? cnt : 1u;
}
__device__ __forceinline__ void xcd_barrier(const XcdBarrier& b) {
    asm volatile("s_waitcnt vmcnt(0)" ::: "memory");
    __syncthreads();
    if (threadIdx.x == 0) {
        unsigned* bar = b.bar;
        __builtin_amdgcn_s_waitcnt(0);
        unsigned nloc = b.st[0], nx = b.st[1];
        if (nloc == 0u) { xcd_barrier_complete(bar, b.x, nloc, nx); b.st[0] = nloc; b.st[1] = nx; }
        const unsigned old = xb_add(&bar[XB_XSUB(b.x)], 1u);
        const unsigned gen = old / nloc;
        if (old + 1u == (gen + 1u) * nloc) {
            __builtin_amdgcn_fence(__ATOMIC_RELEASE, "agent");
            asm volatile("s_waitcnt vmcnt(0)" ::: "memory");
            const unsigned og = xb_add(&bar[XB_TOP], 1u);
            const unsigned tg = og / nx;
            if (og + 1u == (tg + 1u) * nx) xb_add(&bar[XB_TOPGEN], 1u);
            else XB_SPIN(xb_ld(&bar[XB_TOPGEN]) == tg, bar);
            __builtin_amdgcn_fence(__ATOMIC_ACQUIRE, "agent");
            xb_add(&bar[XB_XGEN(b.x)], 1u);
            asm volatile("s_waitcnt vmcnt(0)" ::: "memory");
        } else {
            XB_SPIN(xb_ld(&bar[XB_XGEN(b.x)]) == gen, bar);
            __builtin_amdgcn_fence(__ATOMIC_ACQUIRE, "agent");
            asm volatile("s_waitcnt vmcnt(0)" ::: "memory");
        }
    }
    __syncthreads();
}

constexpr int MAXPH = 128;
struct Args { const float* in[30]; float* out; unsigned char* ws; int ph_lo, ph_hi; unsigned short prog[MAXPH]; };
enum { I_X = 0, I_RELB, I_F1PRE, I_F1GU, I_F1D, I_F1POST, I_MPRE, I_WIN, I_CONVW, I_ALOG, I_DTB, I_GDNNW, I_PEK, I_W1K, I_W2K, I_PEV, I_W1V, I_W2V, I_GGW, I_GGB, I_GLANW, I_WBG, I_WBN, I_WBL, I_WOUT, I_MPOST, I_F2PRE, I_F2GU, I_F2D, I_F2POST };

template <class RowMap>
__device__ __forceinline__ void transpose_item(const float* W, int K, int N, bf16* WT, LAS float* scr, int item, int lane, const RowMap& rm) {
    const int nblk = (N + 31) / 32, kb = item / nblk, nb = item % nblk, k0 = 64 * kb, n0 = 32 * nb;
    const bool okc = (n0 + (lane & 31)) < N;
#pragma unroll 8
    for (int i = 0; i < 32; ++i) { const int kk = 2 * i + (lane >> 5); scr[kk * 33 + (lane & 31)] = okc ? W[(size_t)(k0 + kk) * N + n0 + (lane & 31)] : 0.f; }
    LDS_WAIT(); asm volatile("" ::: "memory");
    const int c = lane & 7;
#pragma unroll
    for (int j = 0; j < 4; ++j) { const int n = (lane >> 3) + 8 * j; const LAS float* s = scr + (8 * c) * 33 + n;
        v4u o; o.x = pk2(s[0 * 33], s[1 * 33]); o.y = pk2(s[2 * 33], s[3 * 33]); o.z = pk2(s[4 * 33], s[5 * 33]); o.w = pk2(s[6 * 33], s[7 * 33]);
        if (n0 + n < N) *(v4u*)(WT + (size_t)rm(n0 + n) * K + k0 + 8 * c) = o; }
    LDS_WAIT(); asm volatile("" ::: "memory");
}
struct MapId { __device__ __forceinline__ int operator()(int n) const { return n; } };
struct MapGU { __device__ __forceinline__ int operator()(int n) const { const int u = n >= DFF, j = u ? n - DFF : n; return 256 * (j >> 7) + 128 * u + (j & 127); } };
struct MapWin { __device__ __forceinline__ int operator()(int c) const {
    if (c < 2048) return c;
    if (c < 2056) return PA_SM + (c - 2048);
    if (c < 2824) return PA_NQ + (c - 2056);
    if (c < 3784) return PA_KC + (c - 2824);
    if (c < 3808) return PA_SM + 8 + (c - 3784);
    if (c < 5344) return PA_LQ + (c - 3808);
    if (c < 5360) return PA_SM + 32 + (c - 5344);
    return NPA + (c - 5360); } };

__device__ __forceinline__ void row_pass(const float* xin, const float* y, const float* wpost, float scale, float* xout, const float* wnext, bf16* xn, int lane) {
    f32x4 v[4];
#pragma unroll
    for (int j = 0; j < 4; ++j) v[j] = ((const f32x4*)xin)[lane + 64 * j];
    if (y) {
        f32x4 yv[4]; float s = 0.f;
#pragma unroll
        for (int j = 0; j < 4; ++j) { yv[j] = ((const f32x4*)y)[lane + 64 * j]; s += (yv[j].x * yv[j].x + yv[j].y * yv[j].y) + (yv[j].z * yv[j].z + yv[j].w * yv[j].w); }
        const float r = scale / sqrtf(wave_sum(s) * (1.f / DM) + NORM_EPS);
#pragma unroll
        for (int j = 0; j < 4; ++j) { const f32x4 w = ((const f32x4*)wpost)[lane + 64 * j]; v[j] = v[j] + yv[j] * w * r; }
    }
    if (xout) {
#pragma unroll
        for (int j = 0; j < 4; ++j) ((f32x4*)xout)[lane + 64 * j] = v[j];
    }
    if (xn) {
        float s = 0.f;
#pragma unroll
        for (int j = 0; j < 4; ++j) s += (v[j].x * v[j].x + v[j].y * v[j].y) + (v[j].z * v[j].z + v[j].w * v[j].w);
        const float r = 1.f / sqrtf(wave_sum(s) * (1.f / DM) + NORM_EPS);
#pragma unroll
        for (int j = 0; j < 4; ++j) { const f32x4 w = ((const f32x4*)wnext)[lane + 64 * j]; const f32x4 o = v[j] * w * r;
            v2u pk; pk.x = pk2(o.x, o.y); pk.y = pk2(o.z, o.w); ((v2u*)xn)[lane + 64 * j] = pk; }
    }
}

__device__ __forceinline__ void gdn_out_item(const float* ORAW, const bf16* PA, const float* nw, bf16* OA, int t, int h, int lane) {
    const float o0 = ORAW[(size_t)t * 512 + h * 128 + 2 * lane], o1 = ORAW[(size_t)t * 512 + h * 128 + 2 * lane + 1];
    const float rr = 1.f / sqrtf(wave_sum(o0 * o0 + o1 * o1) * (1.f / 128.f) + NORM_EPS);
    const unsigned z = *(const unsigned*)(PA + (size_t)t * NPA + PA_GZ + h * 128 + 2 * lane);
    *(unsigned*)(OA + (size_t)t * 512 + h * 128 + 2 * lane) = pk2(o0 * rr * nw[2 * lane] * siluf_(bflo(z)), o1 * rr * nw[2 * lane + 1] * siluf_(bfhi(z)));
}

typedef short bf16x8 __attribute__((ext_vector_type(8)));
#define MFMA16(a, b, c) __builtin_amdgcn_mfma_f32_16x16x32_bf16((a), (b), (c), 0, 0, 0)
__device__ __forceinline__ int kperm32(int p) { const int q = p >> 3, j = p & 7; return j < 4 ? 4 * q + j : 16 + 4 * q + (j - 4); }
__device__ __forceinline__ bf16x8 pack_ctiles(const f32x4& t0, const f32x4& t1) {
    v4u w; w.x = pk2(t0[0], t0[1]); w.y = pk2(t0[2], t0[3]); w.z = pk2(t1[0], t1[1]); w.w = pk2(t1[2], t1[3]); return __builtin_bit_cast(bf16x8, w);
}
constexpr int GLA_CH = 64, NCHUNK = SEQ / 64;
constexpr size_t GLA_QD = 0, GLA_KT = GLA_QD + (size_t)NCHUNK * 4 * 8192, GLA_AI = GLA_KT + (size_t)NCHUNK * 4 * 8192, GLA_CD = GLA_AI + (size_t)NCHUNK * 4 * 8192, GLA_BYTES = GLA_CD + (size_t)NCHUNK * 4 * 256, GLA_VBYTES = (size_t)NCHUNK * 4 * 16384;
__device__ __forceinline__ void gla_prep_item(const bf16* PA, const float* SM, const float* ggw, const float* ggb, unsigned char* img, unsigned char* imgv, int n, int h, float* sl, int tid) {
    float* Qs = sl; float* Ks = sl + 64 * 65; float* BC = sl + 2 * 64 * 65; bf16* Vs = (bf16*)(sl + 3 * 64 * 65);
    const int t0 = n * 64, ch = n * 4 + h, lane = tid & 63, wave = tid >> 6;
    __syncthreads();
    {
        const int c = tid >> 3, dg = tid & 7;
        const bf16* row = PA + (size_t)(t0 + c) * NPA;
        const v4u q8 = *(const v4u*)(row + PA_LQ + h * 64 + dg * 8), k8 = *(const v4u*)(row + PA_LK + h * 64 + dg * 8);
        const float qv[8] = {bflo(q8.x), bfhi(q8.x), bflo(q8.y), bfhi(q8.y), bflo(q8.z), bfhi(q8.z), bflo(q8.w), bfhi(q8.w)};
        const float kv[8] = {bflo(k8.x), bfhi(k8.x), bflo(k8.y), bfhi(k8.y), bflo(k8.z), bfhi(k8.z), bflo(k8.w), bfhi(k8.w)};
        const float* al = SM + (size_t)(t0 + c) * 64 + 32;
        float x[8];
#pragma unroll
        for (int j = 0; j < 8; ++j) x[j] = ggb[h * 64 + dg * 8 + j];
#pragma unroll
        for (int r = 0; r < 16; ++r) { const float a = al[r];
#pragma unroll
            for (int j = 0; j < 8; ++j) x[j] += a * ggw[r * 256 + h * 64 + dg * 8 + j]; }
#pragma unroll
        for (int j = 0; j < 8; ++j) { const int d = dg * 8 + j; Qs[c * 65 + d] = qv[j] * 0.125f; Ks[c * 65 + d] = kv[j]; BC[c * 65 + d] = logsigmoidf_(x[j]) * (1.f / 16.f); }
        const v4u va = *(const v4u*)(row + PA_LV + h * 128 + dg * 16), vb = *(const v4u*)(row + PA_LV + h * 128 + dg * 16 + 8);
        *(v4u*)(Vs + c * 136 + dg * 16) = va; *(v4u*)(Vs + c * 136 + dg * 16 + 8) = vb;
    }
    __syncthreads();
    if (tid < 64) { float run = 0.f; for (int c = 0; c < 64; ++c) { run += BC[c * 65 + tid]; BC[c * 65 + tid] = run; } }
    __syncthreads();
    {
        bf16* QD = (bf16*)(img + GLA_QD) + (size_t)ch * 4096; bf16* KT = (bf16*)(img + GLA_KT) + (size_t)ch * 4096; float* CD = (float*)(img + GLA_CD) + (size_t)ch * 64;
        const int r = tid >> 3, pg = tid & 7;
        float o[8];
#pragma unroll
        for (int j = 0; j < 8; ++j) { const int p = pg * 8 + j, d = (p & 32) + kperm32(p & 31); o[j] = Qs[r * 65 + d] * expf(BC[r * 65 + d]); }
        v4u w; w.x = pk2(o[0], o[1]); w.y = pk2(o[2], o[3]); w.z = pk2(o[4], o[5]); w.w = pk2(o[6], o[7]);
        *(v4u*)(QD + r * 64 + pg * 8) = w;
#pragma unroll
        for (int j = 0; j < 8; ++j) { const int c = pg * 8 + j; o[j] = Ks[c * 65 + r] * expf(BC[63 * 65 + r] - BC[c * 65 + r]); }
        w.x = pk2(o[0], o[1]); w.y = pk2(o[2], o[3]); w.z = pk2(o[4], o[5]); w.w = pk2(o[6], o[7]);
        *(v4u*)(KT + r * 64 + pg * 8) = w;
        if (tid < 64) CD[tid] = expf(BC[63 * 65 + tid]);
        bf16* VI = (bf16*)(imgv) + (size_t)ch * 8192;
#pragma unroll
        for (int i = 0; i < 2; ++i) { const int f = tid + 512 * i, ws = f >> 7, kk = (f >> 6) & 1, l = f & 63, q = l >> 4, col = l & 15;
            unsigned short e[8];
#pragma unroll
            for (int j = 0; j < 8; ++j) e[j] = Vs[(32 * kk + 8 * q + j) * 136 + 16 * ws + col];
            v4u vw; vw.x = e[0] | ((unsigned)e[1] << 16); vw.y = e[2] | ((unsigned)e[3] << 16); vw.z = e[4] | ((unsigned)e[5] << 16); vw.w = e[6] | ((unsigned)e[7] << 16);
            *(v4u*)(VI + (size_t)f * 8) = vw; }
    }
    {
        bf16* AI = (bf16*)(img + GLA_AI) + (size_t)ch * 4096;
        const int q = lane >> 4, fr = lane & 15;
#pragma unroll 1
        for (int i = 0; i < 2; ++i) { const int tl = wave + 8 * i, ib = tl >> 2, jb = tl & 3;
            f32x4 acc = {0.f, 0.f, 0.f, 0.f};
            if (jb <= ib) {
#pragma unroll
                for (int kk = 0; kk < 2; ++kk) { float a[8], b[8];
#pragma unroll
                    for (int j = 0; j < 8; ++j) { const int d = 32 * kk + 8 * q + j; const float ref = ib > 0 ? BC[(16 * ib - 1) * 65 + d] : 0.f;
                        a[j] = Qs[(16 * ib + fr) * 65 + d] * expf(BC[(16 * ib + fr) * 65 + d] - ref);
                        b[j] = Ks[(16 * jb + fr) * 65 + d] * expf(ref - BC[(16 * jb + fr) * 65 + d]); }
                    v4u aw, bw; aw.x = pk2(a[0], a[1]); aw.y = pk2(a[2], a[3]); aw.z = pk2(a[4], a[5]); aw.w = pk2(a[6], a[7]);
                    bw.x = pk2(b[0], b[1]); bw.y = pk2(b[2], b[3]); bw.z = pk2(b[4], b[5]); bw.w = pk2(b[6], b[7]);
                    acc = MFMA16(__builtin_bit_cast(bf16x8, aw), __builtin_bit_cast(bf16x8, bw), acc); }
            }
#pragma unroll
            for (int r = 0; r < 4; ++r) { const int row = 4 * q + r; float v = acc[r]; if (jb == ib && fr > row) v = 0.f; AI[(16 * ib + row) * 64 + 16 * jb + fr] = (bf16)f2bf(v); }
        }
    }
}
constexpr int GLA_BUF = 3 * 64 * 144 + 256;
__device__ __forceinline__ void gla_scan_block(const unsigned char* img, const unsigned char* imgv, bf16* OC, int h, unsigned char* lds, int tid) {
    const int lane = tid & 63, ws = __builtin_amdgcn_readfirstlane(tid >> 6), q = lane >> 4, fr = lane & 15;
    f32x4 S[4];
#pragma unroll
    for (int i = 0; i < 4; ++i) S[i] = (f32x4){0.f, 0.f, 0.f, 0.f};
    v4u st[3]; v4u stc = {0u, 0u, 0u, 0u}; v4u vB[2];
#define GLA_FETCH(N) do { const int ch_ = (N) * 4 + h; \
        st[0] = *(const v4u*)(img + GLA_QD + (size_t)ch_ * 8192 + tid * 16); st[1] = *(const v4u*)(img + GLA_AI + (size_t)ch_ * 8192 + tid * 16); st[2] = *(const v4u*)(img + GLA_KT + (size_t)ch_ * 8192 + tid * 16); \
        if (tid < 16) stc = *(const v4u*)(img + GLA_CD + (size_t)ch_ * 256 + tid * 16); \
        vB[0] = *(const v4u*)(imgv + (size_t)ch_ * 16384 + (ws * 2 + 0) * 1024 + lane * 16); vB[1] = *(const v4u*)(imgv + (size_t)ch_ * 16384 + (ws * 2 + 1) * 1024 + lane * 16); } while (0)
#define GLA_PUT(B) do { unsigned char* b_ = lds + (B) * GLA_BUF; const int r_ = tid >> 3, c_ = tid & 7; \
        *(v4u*)(b_ + r_ * 144 + c_ * 16) = st[0]; *(v4u*)(b_ + 64 * 144 + r_ * 144 + c_ * 16) = st[1]; *(v4u*)(b_ + 2 * 64 * 144 + r_ * 144 + c_ * 16) = st[2]; \
        if (tid < 16) *(v4u*)(b_ + 3 * 64 * 144 + tid * 16) = stc; } while (0)
    __syncthreads();
    GLA_FETCH(0); GLA_PUT(0);
    __syncthreads();
    for (int n = 0; n < NCHUNK; ++n) {
        const unsigned char* b = lds + (n & 1) * GLA_BUF;
        const v4u vb0 = vB[0], vb1 = vB[1];
        if (n + 1 < NCHUNK) GLA_FETCH(n + 1);
        const bf16x8 v0 = __builtin_bit_cast(bf16x8, vb0), v1 = __builtin_bit_cast(bf16x8, vb1);
        const bf16x8 s0 = pack_ctiles(S[0], S[1]), s1 = pack_ctiles(S[2], S[3]);
        f32x4 o[4];
        bf16x8 qa[4][2], aa[6];
#pragma unroll
        for (int m = 0; m < 4; ++m) { const unsigned char* ar = b + (16 * m + fr) * 144 + q * 16;
            qa[m][0] = *(const bf16x8*)(ar); qa[m][1] = *(const bf16x8*)(ar + 64); aa[m] = *(const bf16x8*)(ar + 64 * 144); if (m >= 2) aa[2 + m] = *(const bf16x8*)(ar + 64 * 144 + 64); }
        __builtin_amdgcn_sched_barrier(0);
#pragma unroll
        for (int m = 0; m < 4; ++m) {
            f32x4 acc = {0.f, 0.f, 0.f, 0.f};
            acc = MFMA16(qa[m][0], s0, acc); acc = MFMA16(qa[m][1], s1, acc); acc = MFMA16(aa[m], v0, acc);
            if (m >= 2) acc = MFMA16(aa[2 + m], v1, acc);
            o[m] = acc;
        }
        bf16x8 kf[4][2]; f32x4 cdv[4];
#pragma unroll
        for (int dt = 0; dt < 4; ++dt) { const unsigned char* kr = b + 2 * 64 * 144 + (16 * dt + fr) * 144 + q * 16; kf[dt][0] = *(const bf16x8*)(kr); kf[dt][1] = *(const bf16x8*)(kr + 64);
            cdv[dt] = *(const f32x4*)(b + 3 * 64 * 144 + (16 * dt + 4 * q) * 4); }
        __builtin_amdgcn_sched_barrier(0);
#pragma unroll
        for (int dt = 0; dt < 4; ++dt) { f32x4 acc = S[dt] * cdv[dt]; acc = MFMA16(kf[dt][0], v0, acc); acc = MFMA16(kf[dt][1], v1, acc); S[dt] = acc; }
#pragma unroll
        for (int m = 0; m < 4; ++m)
#pragma unroll
            for (int r = 0; r < 4; ++r) OC[(size_t)(64 * n + 16 * m + 4 * q + r) * 512 + h * 128 + 16 * ws + fr] = (bf16)f2bf(o[m][r]);
        if (n + 1 < NCHUNK) GLA_PUT((n + 1) & 1);
        asm volatile("s_waitcnt lgkmcnt(0)" ::: "memory"); __builtin_amdgcn_s_barrier(); asm volatile("" ::: "memory");
    }
#undef GLA_FETCH
#undef GLA_PUT
}
__device__ __forceinline__ void out_norm_item(bf16* O, const bf16* PA, int gcol, const float* nw, int t, int h, int lane) {
    const unsigned ow = *(const unsigned*)(O + (size_t)t * 512 + h * 128 + 2 * lane);
    const float o0 = bflo(ow), o1 = bfhi(ow);
    const float rr = 1.f / sqrtf(wave_sum(o0 * o0 + o1 * o1) * (1.f / 128.f) + NORM_EPS);
    const unsigned z = *(const unsigned*)(PA + (size_t)t * NPA + gcol + h * 128 + 2 * lane);
    *(unsigned*)(O + (size_t)t * 512 + h * 128 + 2 * lane) = pk2(o0 * rr * nw[2 * lane] * siluf_(bflo(z)), o1 * rr * nw[2 * lane + 1] * siluf_(bfhi(z)));
}

constexpr size_t GDN_WI = 0, GDN_QI = GDN_WI + (size_t)NCHUNK * 4 * 16384, GDN_AT = GDN_QI + (size_t)NCHUNK * 4 * 16384, GDN_KT = GDN_AT + (size_t)NCHUNK * 4 * 8192,
                 GDN_UI = GDN_KT + (size_t)NCHUNK * 4 * 16384, GDN_DV = GDN_UI + (size_t)NCHUNK * 4 * 16384, GDN_BYTES = GDN_DV + (size_t)NCHUNK * 4 * 768;
__device__ __forceinline__ int pperm32(int k) { const int half = (k >> 4) & 1, fr = k & 15; return 8 * (fr >> 2) + 4 * half + (fr & 3); }
__device__ __forceinline__ void gdn_prep_chunk(const bf16* PA, const float* SM, const float* convw, const float* alog, const float* dtb, unsigned char* img, int n, int h, unsigned char* lds, int tid) {
    bf16* Qn = (bf16*)lds; bf16* Kn = (bf16*)(lds + 17408); bf16* Rt = (bf16*)(lds + 34816); bf16* Ts = (bf16*)(lds + 71680); float* Ls = (float*)(lds + 80896); float* gv = (float*)(lds + 98304);
    const int t0 = n * 64, ch = n * 4 + h, lane = tid & 63, wave = tid >> 6, q = lane >> 4, fr = lane & 15;
    __syncthreads();
    {
        const int c = tid >> 3, g8 = tid & 7, t = t0 + c;
        float val[3][16];
#pragma unroll
        for (int w = 0; w < 3; ++w) {
            const int c0 = w * 512 + h * 128 + g8 * 16;
#pragma unroll
            for (int i = 0; i < 16; ++i) val[w][i] = 0.f;
#pragma unroll
            for (int j = 0; j < 4; ++j) { const int tt = t - 3 + j;
                if (tt >= 0) {
                    const v4u xa = *(const v4u*)(PA + (size_t)tt * NPA + c0), xb = *(const v4u*)(PA + (size_t)tt * NPA + c0 + 8);
                    const float x[16] = {bflo(xa.x), bfhi(xa.x), bflo(xa.y), bfhi(xa.y), bflo(xa.z), bfhi(xa.z), bflo(xa.w), bfhi(xa.w), bflo(xb.x), bfhi(xb.x), bflo(xb.y), bfhi(xb.y), bflo(xb.z), bfhi(xb.z), bflo(xb.w), bfhi(xb.w)};
                    const f32x4* wp = (const f32x4*)(convw + j * 1536 + c0);
#pragma unroll
                    for (int i4 = 0; i4 < 4; ++i4) { const f32x4 wv = wp[i4]; val[w][4 * i4] += wv.x * x[4 * i4]; val[w][4 * i4 + 1] += wv.y * x[4 * i4 + 1]; val[w][4 * i4 + 2] += wv.z * x[4 * i4 + 2]; val[w][4 * i4 + 3] += wv.w * x[4 * i4 + 3]; }
                } }
#pragma unroll
            for (int i = 0; i < 16; ++i) val[w][i] = siluf_(val[w][i]);
        }
        float sq = 0.f, sk = 0.f;
#pragma unroll
        for (int i = 0; i < 16; ++i) { sq += val[0][i] * val[0][i]; sk += val[1][i] * val[1][i]; }
        sq += __shfl_xor(sq, 1); sq += __shfl_xor(sq, 2); sq += __shfl_xor(sq, 4);
        sk += __shfl_xor(sk, 1); sk += __shfl_xor(sk, 2); sk += __shfl_xor(sk, 4);
        const float rq = 0.08838834764831845f / sqrtf(sq + 1e-6f), rk = 1.f / sqrtf(sk + 1e-6f);
        const float beta = sigmoidf_(SM[(size_t)t * 64 + h]);
        v4u w0, w1;
        w0.x = pk2(val[0][0] * rq, val[0][1] * rq); w0.y = pk2(val[0][2] * rq, val[0][3] * rq); w0.z = pk2(val[0][4] * rq, val[0][5] * rq); w0.w = pk2(val[0][6] * rq, val[0][7] * rq);
        w1.x = pk2(val[0][8] * rq, val[0][9] * rq); w1.y = pk2(val[0][10] * rq, val[0][11] * rq); w1.z = pk2(val[0][12] * rq, val[0][13] * rq); w1.w = pk2(val[0][14] * rq, val[0][15] * rq);
        *(v4u*)(Qn + c * 136 + g8 * 16) = w0; *(v4u*)(Qn + c * 136 + g8 * 16 + 8) = w1;
        w0.x = pk2(val[1][0] * rk, val[1][1] * rk); w0.y = pk2(val[1][2] * rk, val[1][3] * rk); w0.z = pk2(val[1][4] * rk, val[1][5] * rk); w0.w = pk2(val[1][6] * rk, val[1][7] * rk);
        w1.x = pk2(val[1][8] * rk, val[1][9] * rk); w1.y = pk2(val[1][10] * rk, val[1][11] * rk); w1.z = pk2(val[1][12] * rk, val[1][13] * rk); w1.w = pk2(val[1][14] * rk, val[1][15] * rk);
        *(v4u*)(Kn + c * 136 + g8 * 16) = w0; *(v4u*)(Kn + c * 136 + g8 * 16 + 8) = w1;
#pragma unroll
        for (int i = 0; i < 16; ++i) Rt[(g8 * 16 + i) * 72 + c] = (bf16)f2bf(beta * val[2][i]);
        if (g8 == 0) { gv[c] = -expf(alog[h]) * softplusf_(SM[(size_t)t * 64 + 4 + h] + dtb[h]); gv[64 + c] = beta; }
    }
    __syncthreads();
    if (wave == 0) {
        float x = gv[lane];
#pragma unroll
        for (int off = 1; off < 64; off <<= 1) { const float y = __shfl_up(x, off); if (lane >= off) x += y; }
        gv[128 + lane] = x; gv[192 + lane] = expf(x);
    }
    __syncthreads();
    {
        const int c = tid >> 3, g8 = tid & 7; const float s = gv[64 + c] * gv[192 + c];
#pragma unroll
        for (int i = 0; i < 16; ++i) Rt[(128 + g8 * 16 + i) * 72 + c] = (bf16)f2bf(s * bf2f(Kn[c * 136 + g8 * 16 + i]));
    }
    {
        bf16* AT = (bf16*)(img + GDN_AT) + (size_t)ch * 4096;
#pragma unroll 1
        for (int job = wave; job < 26; job += 8) {
            int ib, jb; const bool isq = job >= 10;
            if (!isq) { int r = job; ib = 0; while (r > ib) { r -= ib + 1; ++ib; } jb = r; } else { ib = (job - 10) >> 2; jb = (job - 10) & 3; }
            f32x4 acc = {0.f, 0.f, 0.f, 0.f};
            if (jb <= ib) {
                const bf16* ap = (isq ? Qn : Kn) + (16 * ib + fr) * 136 + q * 8; const bf16* bp = Kn + (16 * jb + fr) * 136 + q * 8;
#pragma unroll
                for (int kk = 0; kk < 4; ++kk) acc = MFMA16(*(const bf16x8*)(ap + 32 * kk), *(const bf16x8*)(bp + 32 * kk), acc);
            }
            const int j = 16 * jb + fr; const float gj = gv[128 + j];
#pragma unroll
            for (int r = 0; r < 4; ++r) { const int i = 16 * ib + 4 * q + r; const float dec = expf(fminf(gv[128 + i] - gj, 0.f));
                if (!isq) Ls[i * 68 + j] = (j < i) ? gv[64 + i] * acc[r] * dec : 0.f;
                else AT[i * 64 + 32 * (jb >> 1) + 8 * (fr >> 2) + 4 * (jb & 1) + (fr & 3)] = (bf16)f2bf(j <= i ? acc[r] * dec : 0.f); }
        }
    }
    __syncthreads();
    if (wave == 0) {
        float T[64];
        int vz = 0; asm volatile("" : "+v"(vz));
        const float* Lz = Ls + vz;
#pragma unroll
        for (int i = 0; i < 64; ++i) {
            float a0 = fmaxf(0.f, 1.f - fabsf((float)(lane - i))), a1 = 0.f, a2 = 0.f, a3 = 0.f;
#pragma unroll
            for (int m4 = 0; m4 < (i + 3) / 4; ++m4) { const f32x4 lv = *(const f32x4*)(Lz + i * 68 + 4 * m4);
                if (4 * m4 < i) a0 -= lv.x * T[4 * m4]; if (4 * m4 + 1 < i) a1 -= lv.y * T[4 * m4 + 1]; if (4 * m4 + 2 < i) a2 -= lv.z * T[4 * m4 + 2]; if (4 * m4 + 3 < i) a3 -= lv.w * T[4 * m4 + 3]; }
            T[i] = (a0 + a1) + (a2 + a3);
            Ts[i * 72 + lane] = (bf16)f2bf(T[i]);
        }
    } else {
        const int t2 = tid - 64;
        bf16* QI = (bf16*)(img + GDN_QI) + (size_t)ch * 8192; bf16* KT = (bf16*)(img + GDN_KT) + (size_t)ch * 8192; float* DV = (float*)(img + GDN_DV) + (size_t)ch * 192;
        for (int it = t2; it < 64 * 16; it += 448) { const int c = it >> 4, pg = it & 15;
            unsigned short e[8];
#pragma unroll
            for (int j = 0; j < 8; ++j) { const int p = pg * 8 + j; e[j] = Qn[c * 136 + (p & ~31) + kperm32(p & 31)]; }
            v4u w; w.x = e[0] | ((unsigned)e[1] << 16); w.y = e[2] | ((unsigned)e[3] << 16); w.z = e[4] | ((unsigned)e[5] << 16); w.w = e[6] | ((unsigned)e[7] << 16);
            *(v4u*)(QI + c * 128 + pg * 8) = w; }
        for (int it = t2; it < 128 * 8; it += 448) { const int d = it >> 3, pg = it & 7;
            unsigned short e[8];
#pragma unroll
            for (int j = 0; j < 8; ++j) { const int p = pg * 8 + j; e[j] = Kn[((p & ~31) + kperm32(p & 31)) * 136 + d]; }
            v4u w; w.x = e[0] | ((unsigned)e[1] << 16); w.y = e[2] | ((unsigned)e[3] << 16); w.z = e[4] | ((unsigned)e[5] << 16); w.w = e[6] | ((unsigned)e[7] << 16);
            *(v4u*)(KT + d * 64 + pg * 8) = w; }
        if (t2 < 64) { DV[t2] = gv[192 + t2]; DV[64 + t2] = expf(gv[128 + 63] - gv[128 + t2]); if (t2 == 0) DV[128] = gv[192 + 63]; }
    }
    __syncthreads();
    {
        bf16x8 tf[4][2];
#pragma unroll
        for (int m = 0; m < 4; ++m)
#pragma unroll
            for (int kk = 0; kk < 2; ++kk) tf[m][kk] = *(const bf16x8*)(Ts + (16 * m + fr) * 72 + 32 * kk + q * 8);
#pragma unroll
        for (int cc = 0; cc < 2; ++cc) { const int ct = 2 * wave + cc;
            const bf16x8 r0 = *(const bf16x8*)(Rt + (16 * ct + fr) * 72 + q * 8), r1 = *(const bf16x8*)(Rt + (16 * ct + fr) * 72 + 32 + q * 8);
#pragma unroll
            for (int m = 0; m < 4; ++m) { f32x4 acc = {0.f, 0.f, 0.f, 0.f}; acc = MFMA16(tf[m][0], r0, acc); acc = MFMA16(tf[m][1], r1, acc);
                if (ct < 8) { v2u w; w.x = pk2(acc[0], acc[1]); w.y = pk2(acc[2], acc[3]); *(v2u*)(img + GDN_UI + (size_t)ch * 16384 + ((ct * 4 + m) * 64 + lane) * 8) = w; }
                else { const int dt = ct - 8; bf16* WI = (bf16*)(img + GDN_WI) + (size_t)ch * 8192;
#pragma unroll
                    for (int r = 0; r < 4; ++r) WI[(16 * m + 4 * q + r) * 128 + 32 * (dt >> 1) + 8 * (fr >> 2) + 4 * (dt & 1) + (fr & 3)] = (bf16)f2bf(-acc[r]); }
            } }
    }
}
__device__ __forceinline__ void gdn_step_math2(const unsigned char* b, const float* DV, f32x4 (&S)[2][8], f32x4 (&vn)[2][4], bf16* Orow, int wv, int q, int fr) {
    bf16x8 sB[2][4];
#pragma unroll
    for (int c = 0; c < 2; ++c)
#pragma unroll
        for (int kk = 0; kk < 4; ++kk) sB[c][kk] = pack_ctiles(S[c][2 * kk], S[c][2 * kk + 1]);
#pragma unroll
    for (int m = 0; m < 4; ++m) {
        bf16x8 wf[4];
        const unsigned char* wr_ = b + (16 * m + fr) * 272 + q * 16;
#pragma unroll
        for (int kk = 0; kk < 4; ++kk) wf[kk] = *(const bf16x8*)(wr_ + 64 * kk);
        __builtin_amdgcn_sched_barrier(0);
#pragma unroll
        for (int kk = 0; kk < 4; ++kk) { vn[0][m] = MFMA16(wf[kk], sB[0][kk], vn[0][m]); vn[1][m] = MFMA16(wf[kk], sB[1][kk], vn[1][m]); }
    }
    bf16x8 vb[2][2];
#pragma unroll
    for (int c = 0; c < 2; ++c) { vb[c][0] = pack_ctiles(vn[c][0], vn[c][1]); vb[c][1] = pack_ctiles(vn[c][2], vn[c][3]); }
#pragma unroll
    for (int m = 0; m < 4; ++m) {
        bf16x8 qq[4], af[2];
        const unsigned char* wr_ = b + 17408 + (16 * m + fr) * 272 + q * 16; const unsigned char* ar = b + 34816 + (16 * m + fr) * 144 + q * 16;
#pragma unroll
        for (int kk = 0; kk < 4; ++kk) qq[kk] = *(const bf16x8*)(wr_ + 64 * kk);
        af[0] = *(const bf16x8*)(ar); if (m >= 2) af[1] = *(const bf16x8*)(ar + 64);
        const f32x4 eg = *(const f32x4*)(DV + 16 * m + 4 * q);
        __builtin_amdgcn_sched_barrier(0);
#pragma unroll
        for (int c = 0; c < 2; ++c) {
            f32x4 oi = {0.f, 0.f, 0.f, 0.f};
#pragma unroll
            for (int kk = 0; kk < 4; ++kk) oi = MFMA16(qq[kk], sB[c][kk], oi);
            oi = oi * eg;
            oi = MFMA16(af[0], vb[c][0], oi); if (m >= 2) oi = MFMA16(af[1], vb[c][1], oi);
#pragma unroll
            for (int r = 0; r < 4; ++r) Orow[(size_t)(16 * m + 4 * q + r) * 512 + 16 * (wv + 4 * c) + fr] = (bf16)f2bf(oi[r]);
        }
    }
    bf16x8 xs[2][2];
#pragma unroll
    for (int c = 0; c < 2; ++c) {
#pragma unroll
        for (int m = 0; m < 4; ++m) vn[c][m] = vn[c][m] * *(const f32x4*)(DV + 64 + 16 * m + 4 * q);
        xs[c][0] = pack_ctiles(vn[c][0], vn[c][1]); xs[c][1] = pack_ctiles(vn[c][2], vn[c][3]); }
    const float cdec = DV[128];
#pragma unroll
    for (int dh = 0; dh < 4; ++dh) {
        bf16x8 kf[2][2];
#pragma unroll
        for (int di = 0; di < 2; ++di) { const unsigned char* kr = b + 44032 + (16 * (2 * dh + di) + fr) * 144 + q * 16; kf[di][0] = *(const bf16x8*)(kr); kf[di][1] = *(const bf16x8*)(kr + 64); }
        __builtin_amdgcn_sched_barrier(0);
#pragma unroll
        for (int di = 0; di < 2; ++di) { const int dt = 2 * dh + di;
#pragma unroll
            for (int c = 0; c < 2; ++c) { f32x4 acc = S[c][dt] * cdec; acc = MFMA16(kf[di][0], xs[c][0], acc); acc = MFMA16(kf[di][1], xs[c][1], acc); S[c][dt] = acc; } }
    }
}
constexpr int GDN_BUF = 2 * 17408 + 9216 + 18432 + 768;
__device__ __forceinline__ void gdn_scan_block(const unsigned char* img, bf16* OA, int h, unsigned char* lds, int tid) {
    const int lane = tid & 63, wv = __builtin_amdgcn_readfirstlane(tid >> 6), q = lane >> 4, fr = lane & 15;
#define GDN_BAR() do { asm volatile("s_waitcnt lgkmcnt(0)" ::: "memory"); __builtin_amdgcn_s_barrier(); asm volatile("" ::: "memory"); } while (0)
    __syncthreads();
    if (wv >= 4) {
        const int lt = tid - 256;
        v4u stA[14], stB[14]; v4u scA = {0u, 0u, 0u, 0u}, scB = {0u, 0u, 0u, 0u};
#define GDN_LFETCH(N, st, stc) do { const int ch_ = (N) * 4 + h; \
        _Pragma("unroll") for (int i_ = 0; i_ < 4; ++i_) { st[i_] = *(const v4u*)(img + GDN_WI + (size_t)ch_ * 16384 + (lt + 256 * i_) * 16); st[4 + i_] = *(const v4u*)(img + GDN_QI + (size_t)ch_ * 16384 + (lt + 256 * i_) * 16); \
            st[10 + i_] = *(const v4u*)(img + GDN_KT + (size_t)ch_ * 16384 + (lt + 256 * i_) * 16); } \
        st[8] = *(const v4u*)(img + GDN_AT + (size_t)ch_ * 8192 + lt * 16); st[9] = *(const v4u*)(img + GDN_AT + (size_t)ch_ * 8192 + (lt + 256) * 16); \
        if (lt < 48) stc = *(const v4u*)(img + GDN_DV + (size_t)ch_ * 768 + lt * 16); } while (0)
#define GDN_LPUT(B, st, stc) do { unsigned char* b_ = lds + (B) * GDN_BUF; \
        _Pragma("unroll") for (int i_ = 0; i_ < 4; ++i_) { const int p16 = lt + 256 * i_; \
            *(v4u*)(b_ + (p16 >> 4) * 272 + (p16 & 15) * 16) = st[i_]; *(v4u*)(b_ + 17408 + (p16 >> 4) * 272 + (p16 & 15) * 16) = st[4 + i_]; \
            *(v4u*)(b_ + 44032 + (p16 >> 3) * 144 + (p16 & 7) * 16) = st[10 + i_]; } \
        *(v4u*)(b_ + 34816 + (lt >> 3) * 144 + (lt & 7) * 16) = st[8]; *(v4u*)(b_ + 34816 + ((lt + 256) >> 3) * 144 + (lt & 7) * 16) = st[9]; \
        if (lt < 48) *(v4u*)(b_ + 62464 + lt * 16) = stc; } while (0)
        GDN_LFETCH(0, stA, scA); GDN_LFETCH(1, stB, scB); GDN_LPUT(0, stA, scA);
        GDN_BAR();
#pragma unroll 1
        for (int n = 0; n < NCHUNK; n += 2) {
            if (n + 2 < NCHUNK) GDN_LFETCH(n + 2, stA, scA);
            GDN_LPUT(1, stB, scB);
            GDN_BAR();
            if (n + 3 < NCHUNK) GDN_LFETCH(n + 3, stB, scB);
            if (n + 2 < NCHUNK) GDN_LPUT(0, stA, scA);
            GDN_BAR();
        }
#undef GDN_LFETCH
#undef GDN_LPUT
    } else {
        f32x4 S[2][8];
#pragma unroll
        for (int c = 0; c < 2; ++c)
#pragma unroll
            for (int i = 0; i < 8; ++i) S[c][i] = (f32x4){0.f, 0.f, 0.f, 0.f};
        v2u ub[2][4];
        const GAS unsigned char* ubase = (const GAS unsigned char*)(img + GDN_UI + (size_t)h * 16384 + (wv * 256 + lane) * 8);
#define GDN_UFETCH(N) do { const GAS unsigned char* p_ = ubase + (size_t)(N) * 65536; asm volatile("" : "+v"(p_)); _Pragma("unroll") for (int c_ = 0; c_ < 2; ++c_) _Pragma("unroll") for (int m_ = 0; m_ < 4; ++m_) \
        ub[c_][m_] = *(const GAS v2u*)(p_ + c_ * 8192 + m_ * 512); } while (0)
        GDN_UFETCH(0);
        GDN_BAR();
#pragma unroll 1
        for (int n = 0; n < NCHUNK; ++n) {
            const unsigned char* b = lds + (n & 1) * GDN_BUF; const float* DV = (const float*)(b + 62464);
            f32x4 vn[2][4];
#pragma unroll
            for (int c = 0; c < 2; ++c)
#pragma unroll
                for (int m = 0; m < 4; ++m) vn[c][m] = (f32x4){bflo(ub[c][m].x), bfhi(ub[c][m].x), bflo(ub[c][m].y), bfhi(ub[c][m].y)};
            if (n + 1 < NCHUNK) GDN_UFETCH(n + 1);
            gdn_step_math2(b, DV, S, vn, OA + (size_t)(64 * n) * 512 + h * 128, wv, q, fr);
            GDN_BAR();
        }
#undef GDN_UFETCH
    }
#undef GDN_BAR
}

constexpr int NSA_BUF = 64 * 208 + 64 * 144, NSA_WOFF = 2 * NSA_BUF, NSA_UOFF = NSA_WOFF + 8 * 2048;
__device__ __forceinline__ float col_max4(const f32x4 (&s)[4]) {
    float a = fmaxf(fmaxf(s[0][0], s[0][1]), fmaxf(s[0][2], s[0][3]));
#pragma unroll
    for (int i = 1; i < 4; ++i) a = fmaxf(a, fmaxf(fmaxf(s[i][0], s[i][1]), fmaxf(s[i][2], s[i][3])));
    a = fmaxf(a, __shfl_xor(a, 16)); a = fmaxf(a, __shfl_xor(a, 32)); return a;
}
constexpr float NSA_SC2 = 0.10206207261596577f * 1.4426950408889634f, NSA_MASK = -1.0e30f;
template <bool WINDOW>
__device__ __forceinline__ void nsa_lds_block(const unsigned char* kb, int pos0, int t, int t0, bool colsel, int head, const bf16x8 (&qf)[3],
                                              const LAS float* relb, const LAS int* btab, float& m, float& l, f32x4 (&o)[4], int lane) {
    const int q = lane >> 4, fr = lane & 15;
    f32x4 s[4];
#pragma unroll
    for (int rp = 0; rp < 2; ++rp) {
        bf16x8 kfr[2][3];
#pragma unroll
        for (int ri = 0; ri < 2; ++ri) { const unsigned char* kp = kb + (16 * (2 * rp + ri) + fr) * 208 + q * 16;
#pragma unroll
            for (int kk = 0; kk < 3; ++kk) kfr[ri][kk] = *(const bf16x8*)(kp + 64 * kk); }
        __builtin_amdgcn_sched_barrier(0);
#pragma unroll
        for (int ri = 0; ri < 2; ++ri) { f32x4 acc = {0.f, 0.f, 0.f, 0.f};
#pragma unroll
            for (int kk = 0; kk < 3; ++kk) acc = MFMA16(kfr[ri][kk], qf[kk], acc);
            s[2 * rp + ri] = acc; }
    }
    v2u va[2][4];
#pragma unroll
    for (int dt = 0; dt < 2; ++dt) { const unsigned char* vp = kb + 64 * 208 + (16 * dt + fr) * 144 + q * 8;
        va[dt][0] = *(const v2u*)(vp); va[dt][1] = *(const v2u*)(vp + 32); va[dt][2] = *(const v2u*)(vp + 64); va[dt][3] = *(const v2u*)(vp + 96); }
    __builtin_amdgcn_sched_barrier(0);
    const float bfar = relb[31 * 8 + head];
    const bool fast = (pos0 + 63 + 128 <= t0) && (!WINDOW || pos0 >= t0 + 3 - 511);
    if (fast) {
        const float bc = colsel ? bfar : NSA_MASK;
#pragma unroll
        for (int rt = 0; rt < 4; ++rt)
#pragma unroll
            for (int r = 0; r < 4; ++r) s[rt][r] = colsel ? s[rt][r] * NSA_SC2 + bc : NSA_MASK;
    } else {
#pragma unroll
        for (int rt = 0; rt < 4; ++rt)
#pragma unroll
            for (int r = 0; r < 4; ++r) { const int pos = pos0 + 16 * rt + 4 * q + r, dist = t - pos;
                bool ok = colsel && dist >= 0; if (WINDOW) ok = ok && dist < 512;
                const int dd = dist < 0 ? 0 : dist; const float bias = relb[(dd < 128 ? btab[dd] : 31) * 8 + head];
                s[rt][r] = ok ? s[rt][r] * NSA_SC2 + bias : NSA_MASK; }
    }
    const float bm = col_max4(s);
    const float mn = fmaxf(m, bm);
    const float corr = __builtin_amdgcn_exp2f(m - mn);
    float ps = 0.f;
#pragma unroll
    for (int rt = 0; rt < 4; ++rt)
#pragma unroll
        for (int r = 0; r < 4; ++r) { const float p = __builtin_amdgcn_exp2f(s[rt][r] - mn); s[rt][r] = p; ps += p; }
    ps += __shfl_xor(ps, 16); ps += __shfl_xor(ps, 32);
    l = l * corr + ps; m = mn;
    const bf16x8 pb0 = pack_ctiles(s[0], s[1]), pb1 = pack_ctiles(s[2], s[3]);
    v2u vb[2][4];
#pragma unroll
    for (int dt = 0; dt < 2; ++dt) { const unsigned char* vp = kb + 64 * 208 + (16 * (2 + dt) + fr) * 144 + q * 8;
        vb[dt][0] = *(const v2u*)(vp); vb[dt][1] = *(const v2u*)(vp + 32); vb[dt][2] = *(const v2u*)(vp + 64); vb[dt][3] = *(const v2u*)(vp + 96); }
#pragma unroll
    for (int dt = 0; dt < 2; ++dt) {
        v4u w0; w0.x = va[dt][0].x; w0.y = va[dt][0].y; w0.z = va[dt][1].x; w0.w = va[dt][1].y;
        v4u w1; w1.x = va[dt][2].x; w1.y = va[dt][2].y; w1.z = va[dt][3].x; w1.w = va[dt][3].y;
        f32x4 acc = o[dt] * corr;
        acc = MFMA16(__builtin_bit_cast(bf16x8, w0), pb0, acc); acc = MFMA16(__builtin_bit_cast(bf16x8, w1), pb1, acc);
        o[dt] = acc;
    }
#pragma unroll
    for (int dt = 0; dt < 2; ++dt) {
        v4u w0; w0.x = vb[dt][0].x; w0.y = vb[dt][0].y; w0.z = vb[dt][1].x; w0.w = vb[dt][1].y;
        v4u w1; w1.x = vb[dt][2].x; w1.y = vb[dt][2].y; w1.z = vb[dt][3].x; w1.w = vb[dt][3].y;
        f32x4 acc = o[2 + dt] * corr;
        acc = MFMA16(__builtin_bit_cast(bf16x8, w0), pb0, acc); acc = MFMA16(__builtin_bit_cast(bf16x8, w1), pb1, acc);
        o[2 + dt] = acc;
    }
}
#define NSA_FETCH_KV(KCOL, VT, POS0, sg) do { \
        { const int c_ = tid, r_ = c_ / 12, x_ = c_ % 12; sg[0] = *(const v4u*)(PA + (size_t)((POS0) + r_) * NPA + (KCOL) + g * 160 + x_ * 8); } \
        { const int c_ = tid + 512; if (c_ < 768) { const int r_ = c_ / 12, x_ = c_ % 12; sg[1] = *(const v4u*)(PA + (size_t)((POS0) + r_) * NPA + (KCOL) + g * 160 + x_ * 8); } \
          else { const int v_ = c_ - 768, r_ = v_ >> 3, x_ = v_ & 7; sg[1] = *(const v4u*)((VT) + (size_t)(g * 64 + r_) * SEQ + (POS0) + x_ * 8); } } \
        if (tid < 256) { const int v_ = tid + 256, r_ = v_ >> 3, x_ = v_ & 7; sg[2] = *(const v4u*)((VT) + (size_t)(g * 64 + r_) * SEQ + (POS0) + x_ * 8); } } while (0)
#define NSA_PUT_KV(B, sg) do { unsigned char* b_ = lds + (B) * NSA_BUF; \
        { const int c_ = tid, r_ = c_ / 12, x_ = c_ % 12; *(v4u*)(b_ + r_ * 208 + x_ * 16) = sg[0]; } \
        { const int c_ = tid + 512; if (c_ < 768) { const int r_ = c_ / 12, x_ = c_ % 12; *(v4u*)(b_ + r_ * 208 + x_ * 16) = sg[1]; } \
          else { const int v_ = c_ - 768, r_ = v_ >> 3, x_ = v_ & 7; *(v4u*)(b_ + 64 * 208 + r_ * 144 + x_ * 16) = sg[1]; } } \
        if (tid < 256) { const int v_ = tid + 256, r_ = v_ >> 3, x_ = v_ & 7; *(v4u*)(b_ + 64 * 208 + r_ * 144 + x_ * 16) = sg[2]; } } while (0)
#define NSA_FETCH_C(PR, sg) do { \
        { const int c_ = tid, hl_ = c_ / 384, r_ = (c_ % 384) / 12, x_ = c_ % 12; sg[0] = *(const v4u*)((hl_ ? KCL : KCH) + (size_t)((32 * (PR) + r_) * 2 + g) * 96 + x_ * 8); } \
        { const int c_ = tid + 512; if (c_ < 768) { const int hl_ = c_ / 384, r_ = (c_ % 384) / 12, x_ = c_ % 12; sg[1] = *(const v4u*)((hl_ ? KCL : KCH) + (size_t)((32 * (PR) + r_) * 2 + g) * 96 + x_ * 8); } \
          else { const int v_ = c_ - 768, r_ = v_ >> 2, x_ = v_ & 3; sg[1] = *(const v4u*)(VCT + (size_t)(g * 64 + r_) * 512 + 32 * (PR) + x_ * 8); } } } while (0)
#define NSA_PUT_C(B, sg) do { unsigned char* b_ = lds + (B) * NSA_BUF; \
        { const int c_ = tid, hl_ = c_ / 384, r_ = (c_ % 384) / 12, x_ = c_ % 12; *(v4u*)(b_ + (hl_ * 32 + r_) * 208 + x_ * 16) = sg[0]; } \
        { const int c_ = tid + 512; if (c_ < 768) { const int hl_ = c_ / 384, r_ = (c_ % 384) / 12, x_ = c_ % 12; *(v4u*)(b_ + (hl_ * 32 + r_) * 208 + x_ * 16) = sg[1]; } \
          else { const int v_ = c_ - 768, r_ = v_ >> 2, x_ = v_ & 3; *(v4u*)(b_ + 64 * 208 + r_ * 80 + x_ * 16) = sg[1]; } } } while (0)
#define NSA_PIPELINE(NS, FETCH, PUT, COMPUTE) do { const int ns_ = (NS); \
        FETCH(0, sgA); if (ns_ > 1) FETCH(1, sgB); PUT(0, sgA); __syncthreads(); \
        _Pragma("unroll 1") for (int i_ = 0; i_ < ns_; i_ += 2) { \
            if (i_ + 2 < ns_) FETCH(i_ + 2, sgA); COMPUTE(i_, 0); if (i_ + 1 < ns_) PUT(1, sgB); __syncthreads(); \
            if (i_ + 1 < ns_) { if (i_ + 3 < ns_) FETCH(i_ + 3, sgB); COMPUTE(i_ + 1, 1); if (i_ + 2 < ns_) PUT(0, sgA); } __syncthreads(); \
        } } while (0)
struct NsaCmp { float m, l, M, inv, carry; };
__device__ __forceinline__ float nsa_cmp_score(float acc, int n, int ncv, int t, int head, const LAS float* relb, const LAS int* btab) {
    const int dist = t - (16 * n + 31); const int dd = dist < 0 ? 0 : dist;
    return (n < ncv) ? acc * NSA_SC2 + relb[(dd < 128 ? btab[dd] : 31) * 8 + head] : NSA_MASK;
}
__device__ __forceinline__ void nsa_cmp_tile(const unsigned char* kb, int u, int T, int ncv, int t, int t0, int head, const bf16x8 (&qf)[3], const LAS float* relb, const LAS int* btab, float (&sv)[4], int lane) {
    const int q = lane >> 4, fr = lane & 15;
    const unsigned char* kp = kb + (16 * u + fr) * 208 + q * 16;
    bf16x8 kh[3], kl[3];
#pragma unroll
    for (int kk = 0; kk < 3; ++kk) { kh[kk] = *(const bf16x8*)(kp + 64 * kk); kl[kk] = *(const bf16x8*)(kp + 32 * 208 + 64 * kk); }
    __builtin_amdgcn_sched_barrier(0);
    f32x4 acc = {0.f, 0.f, 0.f, 0.f};
#pragma unroll
    for (int kk = 0; kk < 3; ++kk) { acc = MFMA16(kh[kk], qf[kk], acc); acc = MFMA16(kl[kk], qf[kk], acc); }
    const int nlast = 16 * T + 15;
    if (16 * nlast + 31 + 128 <= t0) {
        const float bfar = relb[31 * 8 + head];
#pragma unroll
        for (int r = 0; r < 4; ++r) sv[r] = acc[r] * NSA_SC2 + bfar;
    } else {
#pragma unroll
        for (int r = 0; r < 4; ++r) sv[r] = nsa_cmp_score(acc[r], 16 * T + 4 * q + r, ncv, t, head, relb, btab);
    }
}
__device__ __forceinline__ void nsa_cmp_pass1(const unsigned char* kb, int pr, int ntile, int ncv, int t, int t0, int head, const bf16x8 (&qf)[3], const LAS float* relb, const LAS int* btab, NsaCmp& c, int lane) {
#pragma unroll
    for (int u = 0; u < 2; ++u) { const int T = 2 * pr + u;
        if (T < ntile) {
            float sv[4]; nsa_cmp_tile(kb, u, T, ncv, t, t0, head, qf, relb, btab, sv, lane);
            const float mn = fmaxf(c.m, fmaxf(fmaxf(sv[0], sv[1]), fmaxf(sv[2], sv[3])));
            const float ps = (__builtin_amdgcn_exp2f(sv[0] - mn) + __builtin_amdgcn_exp2f(sv[1] - mn)) + (__builtin_amdgcn_exp2f(sv[2] - mn) + __builtin_amdgcn_exp2f(sv[3] - mn));
            c.l = c.l * __builtin_amdgcn_exp2f(c.m - mn) + ps; c.m = mn;
        } }
}
__device__ __forceinline__ void nsa_cmp_pass2(const unsigned char* kb, int pr, int ntile, int ncv, int t, int t0, int head, const bf16x8 (&qf)[3], const LAS float* relb, const LAS int* btab, NsaCmp& c, f32x4 (&oc)[4], float* imp, int lane) {
    const int q = lane >> 4, fr = lane & 15, tl = fr >> 2, hh = fr & 3;
    if (2 * pr >= ntile) return;
    f32x4 pt[2];
#pragma unroll
    for (int u = 0; u < 2; ++u) { const int T = 2 * pr + u;
        float sv[4] = {NSA_MASK, NSA_MASK, NSA_MASK, NSA_MASK};
        if (T < ntile) nsa_cmp_tile(kb, u, T, ncv, t, t0, head, qf, relb, btab, sv, lane);
#pragma unroll
        for (int r = 0; r < 4; ++r) pt[u][r] = (sv[r] > -1.0e29f) ? __builtin_amdgcn_exp2f(sv[r] - c.M) * c.inv : 0.f;
        const float x3 = pt[u][3];
        float prev = __shfl(x3, (lane + 48) & 63);
        const float nxt = __shfl(x3, 48 + fr);
        if (q == 0) prev = c.carry;
        c.carry = nxt;
        float v = ((pt[u][0] + pt[u][1]) + (pt[u][2] + pt[u][3])) + prev;
        v += __shfl_xor(v, 1); v += __shfl_xor(v, 2);
        if (hh == 0 && T < ntile) imp[tl * 128 + 4 * T + q] = v;
    }
    const bf16x8 pb = pack_ctiles(pt[0], pt[1]);
    v2u va[4][2];
#pragma unroll
    for (int dt = 0; dt < 4; ++dt) { const unsigned char* vp = kb + 64 * 208 + (16 * dt + fr) * 80 + q * 8; va[dt][0] = *(const v2u*)(vp); va[dt][1] = *(const v2u*)(vp + 32); }
    __builtin_amdgcn_sched_barrier(0);
#pragma unroll
    for (int dt = 0; dt < 4; ++dt) { v4u w0; w0.x = va[dt][0].x; w0.y = va[dt][0].y; w0.z = va[dt][1].x; w0.w = va[dt][1].y;
        oc[dt] = MFMA16(__builtin_bit_cast(bf16x8, w0), pb, oc[dt]); }
}
__device__ __forceinline__ void nsa_unit(const bf16* PA, const float* SM, const bf16* KCH, const bf16* KCL, const bf16* VCT, const bf16* VTS, const bf16* VTW,
                                         const LAS float* relb, const LAS int* btab, bf16* OB, int T0, int g, unsigned char* lds, int tid, int abl) {
    const int lane = tid & 63, wave = __builtin_amdgcn_readfirstlane(tid >> 6), q = lane >> 4, fr = lane & 15, tl = fr >> 2, hh = fr & 3;
    const int t0 = T0 + 4 * wave, t = t0 + tl, head = g * 4 + hh;
    v4u sgA[3] = {}, sgB[3] = {};
    bf16x8 qf[3];
#pragma unroll
    for (int kk = 0; kk < 3; ++kk) qf[kk] = *(const bf16x8*)(PA + (size_t)t * NPA + PA_NQ + head * 96 + 32 * kk + q * 8);
    float* imp = (float*)(lds + NSA_WOFF + wave * 2048);
    __syncthreads();
#pragma unroll
    for (int i = 0; i < 8; ++i) imp[lane + 64 * i] = 0.f;
    const int ncv = t >= 31 ? (t - 31) / 16 + 1 : 0;
    const int ncvw = (t0 + 3) >= 31 ? (t0 + 3 - 31) / 16 + 1 : 0;
    const int ncvu = (T0 + 31) >= 31 ? (T0 + 31 - 31) / 16 + 1 : 0;
    const int ntile = (ncvw + 15) >> 4, npair = (ncvu + 31) >> 5;
    f32x4 oc[4];
#pragma unroll
    for (int dt = 0; dt < 4; ++dt) oc[dt] = (f32x4){0.f, 0.f, 0.f, 0.f};
    if (npair > 0) {
        NsaCmp c; c.m = NSA_MASK; c.l = 0.f; c.M = 0.f; c.inv = 0.f; c.carry = 0.f;
#define F_C(i, sg) NSA_FETCH_C((i), sg)
#define P_C(b, sg) NSA_PUT_C((b), sg)
#define C_P1(i, b) if (!(abl & 4)) nsa_cmp_pass1(lds + (b) * NSA_BUF, (i), ntile, ncv, t, t0, head, qf, relb, btab, c, lane)
        NSA_PIPELINE(npair, F_C, P_C, C_P1);
        c.M = fmaxf(c.m, __shfl_xor(c.m, 16)); c.M = fmaxf(c.M, __shfl_xor(c.M, 32));
        float lt = c.l * __builtin_amdgcn_exp2f(c.m - c.M);
        lt += __shfl_xor(lt, 16); lt += __shfl_xor(lt, 32);
        c.inv = lt > 0.f ? 1.f / lt : 0.f;
#define C_P2(i, b) if (!(abl & 4)) nsa_cmp_pass2(lds + (b) * NSA_BUF, (i), ntile, ncv, t, t0, head, qf, relb, btab, c, oc, imp, lane)
        NSA_PIPELINE(npair, F_C, P_C, C_P2);
#undef F_C
#undef P_C
#undef C_P1
#undef C_P2
    }
    LDS_WAIT(); asm volatile("" ::: "memory");
    const int blk_t = T0 >> 6; const int nsel = blk_t + 1 < 16 ? blk_t + 1 : 16;
    unsigned long long msk_lo[4], msk_hi[4];
#pragma unroll
    for (int tk = 0; tk < 4; ++tk) {
        unsigned k0, k1; { const int s0 = lane, s1 = lane + 64;
            k0 = (s0 == 0 || s0 == blk_t || s0 == blk_t - 1) ? 0xffffffffu : (s0 > blk_t ? 0u : __float_as_uint(imp[tk * 128 + s0]) + 1u);
            k1 = (s1 == blk_t || s1 == blk_t - 1) ? 0xffffffffu : (s1 > blk_t ? 0u : __float_as_uint(imp[tk * 128 + s1]) + 1u); }
        unsigned th = 0u;
#pragma unroll 1
        for (int bit = 31; bit >= 0; --bit) { const unsigned cand = th | (1u << bit);
            const int cnt = __builtin_popcountll(__ballot(k0 >= cand)) + __builtin_popcountll(__ballot(k1 >= cand));
            if (cnt >= nsel) th = cand; }
        const unsigned long long g0 = __ballot(k0 > th), g1 = __ballot(k1 > th), e0 = __ballot(k0 == th), e1 = __ballot(k1 == th);
        int need = nsel - (__builtin_popcountll(g0) + __builtin_popcountll(g1));
        unsigned long long t0m = 0ull, t1m = 0ull;
        { unsigned long long r = e0; while (need > 0 && r) { const unsigned long long low = r & (~r + 1ull); t0m |= low; r ^= low; --need; } }
        { unsigned long long r = e1; while (need > 0 && r) { const unsigned long long low = r & (~r + 1ull); t1m |= low; r ^= low; --need; } }
        msk_lo[tk] = g0 | t0m; msk_hi[tk] = g1 | t1m;
    }
    const unsigned long long wlo = (msk_lo[0] | msk_lo[1]) | (msk_lo[2] | msk_lo[3]), whi = (msk_hi[0] | msk_hi[1]) | (msk_hi[2] | msk_hi[3]);
    unsigned char* sel4 = lds + NSA_UOFF + 1024 + wave * 128;
    { const unsigned n0 = (unsigned)(((msk_lo[0] >> lane) & 1ull) | (((msk_lo[1] >> lane) & 1ull) << 1) | (((msk_lo[2] >> lane) & 1ull) << 2) | (((msk_lo[3] >> lane) & 1ull) << 3));
      const unsigned n1 = (unsigned)(((msk_hi[0] >> lane) & 1ull) | (((msk_hi[1] >> lane) & 1ull) << 1) | (((msk_hi[2] >> lane) & 1ull) << 2) | (((msk_hi[3] >> lane) & 1ull) << 3));
      sel4[lane] = (unsigned char)n0; sel4[lane + 64] = (unsigned char)n1; }
    unsigned long long* um = (unsigned long long*)(lds + NSA_UOFF);
    unsigned char* blist = lds + NSA_UOFF + 512;
    if (lane == 0) { um[wave * 2] = wlo; um[wave * 2 + 1] = whi; }
    __syncthreads();
    int nblk;
    {
        unsigned long long ulo = 0ull, uhi = 0ull;
#pragma unroll
        for (int w = 0; w < 8; ++w) { ulo |= um[w * 2]; uhi |= um[w * 2 + 1]; }
        nblk = __builtin_popcountll(ulo) + __builtin_popcountll(uhi);
        if (tid < 128) { const bool in = tid < 64 ? ((ulo >> tid) & 1ull) : ((uhi >> (tid - 64)) & 1ull);
            if (in) { const int rank = tid < 64 ? __builtin_popcountll(ulo & ((1ull << tid) - 1ull)) : __builtin_popcountll(ulo) + __builtin_popcountll(uhi & ((1ull << (tid - 64)) - 1ull));
                blist[rank] = (unsigned char)tid; } }
        nblk = __builtin_amdgcn_readfirstlane(nblk);
    }
    __syncthreads();
    f32x4 os[4]; float ms = NSA_MASK, ls = 0.f;
#pragma unroll
    for (int dt = 0; dt < 4; ++dt) os[dt] = (f32x4){0.f, 0.f, 0.f, 0.f};
#define F_S(i, sg) do { if (!(abl & 8)) { const int sb_ = blist[(i)]; NSA_FETCH_KV(PA_KS, VTS, 64 * sb_, sg); } } while (0)
#define P_S(b, sg) NSA_PUT_KV((b), sg)
#define C_S(i, b) do { const int cur_ = __builtin_amdgcn_readfirstlane((int)blist[(i)]); const unsigned s4_ = __builtin_amdgcn_readfirstlane((unsigned)sel4[cur_]); \
        if (s4_ && !(abl & 1)) nsa_lds_block<false>(lds + (b) * NSA_BUF, 64 * cur_, t, t0, (s4_ >> tl) & 1u, head, qf, relb, btab, ms, ls, os, lane); } while (0)
    NSA_PIPELINE(nblk, F_S, P_S, C_S);
#undef F_S
#undef P_S
#undef C_S
    f32x4 ow[4]; float mw = NSA_MASK, lw = 0.f;
#pragma unroll
    for (int dt = 0; dt < 4; ++dt) ow[dt] = (f32x4){0.f, 0.f, 0.f, 0.f};
    const int wb0 = (T0 - 511) < 0 ? 0 : (T0 - 511) >> 6, wb1 = (T0 + 31) >> 6;
#define F_W(i, sg) NSA_FETCH_KV(PA_KW, VTW, 64 * (wb0 + (i)), sg)
#define P_W(b, sg) NSA_PUT_KV((b), sg)
#define C_W(i, b) do { const int bi_ = wb0 + (i); if (64 * bi_ + 63 >= t0 - 511 && 64 * bi_ <= t0 + 3 && !(abl & 2)) \
        nsa_lds_block<true>(lds + (b) * NSA_BUF, 64 * bi_, t, t0, true, head, qf, relb, btab, mw, lw, ow, lane); } while (0)
    NSA_PIPELINE(wb1 - wb0 + 1, F_W, P_W, C_W);
#undef F_W
#undef P_W
#undef C_W
    const float* gl = SM + (size_t)t * 64 + 8 + head * 3;
    const float gc = sigmoidf_(gl[0]), gs = sigmoidf_(gl[1]) / ls, gw = sigmoidf_(gl[2]) / lw;
#pragma unroll
    for (int dt = 0; dt < 4; ++dt) { const f32x4 o = oc[dt] * gc + os[dt] * gs + ow[dt] * gw;
        v2u w; w.x = pk2(o[0], o[1]); w.y = pk2(o[2], o[3]);
        *(v2u*)(OB + (size_t)t * 512 + head * 64 + 16 * dt + 4 * q) = w; }
    asm volatile("" ::: "memory");
}
__device__ __forceinline__ void nsa_vt_item(const bf16* PA, bf16* VTS, bf16* VTW, int item, unsigned short* wl, int lane) {
    const int chunk = item >> 2, g = (item >> 1) & 1, which = item & 1;
    const int kcol = which ? PA_KW : PA_KS; bf16* VT = which ? VTW : VTS;
    for (int i = 0; i < 8; ++i) { const int tt = i * 8 + (lane >> 3), c8 = lane & 7;
        const v4u x = *(const v4u*)(PA + (size_t)(chunk * 64 + tt) * NPA + kcol + g * 160 + 96 + c8 * 8);
        unsigned* d = (unsigned*)(wl + tt * 66 + c8 * 8); d[0] = x.x; d[1] = x.y; d[2] = x.z; d[3] = x.w; }
    LDS_WAIT(); asm volatile("" ::: "memory");
    for (int i = 0; i < 8; ++i) { const int dv = i * 8 + (lane >> 3), c8 = lane & 7;
        unsigned short e[8];
#pragma unroll
        for (int j = 0; j < 8; ++j) e[j] = wl[(c8 * 8 + j) * 66 + dv];
        v4u w; w.x = e[0] | ((unsigned)e[1] << 16); w.y = e[2] | ((unsigned)e[3] << 16); w.z = e[4] | ((unsigned)e[5] << 16); w.w = e[6] | ((unsigned)e[7] << 16);
        *(v4u*)(VT + (size_t)(g * 64 + dv) * SEQ + chunk * 64 + c8 * 8) = w; }
    LDS_WAIT(); asm volatile("" ::: "memory");
}

constexpr size_t CMP_KCF = 0, CMP_VCF = 3328 * 1024, CMP_H1K = 5632 * 1024, CMP_H1V = 6144 * 1024;
constexpr size_t CW_W1K = 0, CW_W1V = 1536 * 1024, CW_BPART = 2560 * 1024, CW_BIAS = CW_BPART + 2 * 16 * 256 * 4;
constexpr size_t CMP_PART = 8 * 1024 * 1024;
template <int ND>
__device__ __forceinline__ void cmp_layer2(const float* hrow, const float* w2, int nd_total, float (&acc)[ND]) {
#pragma unroll
    for (int i = 0; i < ND; ++i) acc[i] = 0.f;
#pragma unroll 4
    for (int j = 0; j < 256; ++j) {
        const float hv = hrow[j];
        const f32x4* wp = (const f32x4*)(w2 + (size_t)j * nd_total);
#pragma unroll
        for (int i4 = 0; i4 < ND / 4; ++i4) { const f32x4 wv = wp[i4]; acc[4 * i4] += hv * wv.x; acc[4 * i4 + 1] += hv * wv.y; acc[4 * i4 + 2] += hv * wv.z; acc[4 * i4 + 3] += hv * wv.w; }
    }
}

constexpr int PH_PER_LAYER = 22, NPHASES = DEPTH * PH_PER_LAYER;
#ifndef PROBE_ABL
#define PROBE_ABL 0
#endif
enum { K_CONV = 0, K_F1, K_GF32, K_ROWS, K_M1, K_M2, K_M3, K_M4, K_M5, K_M2B };
constexpr size_t ALPHA_OFF = 276 * MiB;
static_assert(ALPHA_OFF + GLA_BYTES <= 290 * MiB && WS_WGU + GLA_VBYTES <= WS_WD && WS_QKV + GDN_BYTES <= WS_KCMP, "gla/gdn images");
__global__ void __launch_bounds__(NTHR, 2) mk_fwd(Args args) {
    extern __shared__ __attribute__((aligned(16))) unsigned char lds[];
    LAS unsigned char* ldsl = (LAS unsigned char*)lds;
    {
        const int tid = threadIdx.x;
        for (int u = tid; u < (LDS_BYTES - LDSCTL_OFF) / 4; u += NTHR) ((LAS unsigned*)(ldsl + LDSCTL_OFF))[u] = 0u;
        __syncthreads();
        LAS int* btab = (LAS int*)(ldsl + BTAB_OFF);
        if (tid < 128) { int b = tid; if (tid >= 16) { const float v = logf((float)tid / 16.f) / 2.0794415416798357f * 16.f; b = 16 + (int)v; if (b > 31) b = 31; } btab[tid] = b; }
        if (tid < 256) ((LAS float*)(ldsl + RELB_OFF))[tid] = args.in[I_RELB][tid] * 1.4426950408889634f;
        __syncthreads();
    }
#if MK_ONE_LAUNCH
    XcdBarrier bar = xcd_barrier_post((unsigned*)(args.ws + WS_CTL) + CW_BAR, (volatile LAS unsigned*)(ldsl + MISC_OFF) + 8);
#endif
#pragma unroll 1
    for (int pc = args.ph_lo; pc < args.ph_hi; ++pc) {
        const __attribute__((address_space(4))) Args* ap = (const __attribute__((address_space(4))) Args*)__builtin_amdgcn_kernarg_segment_ptr();
        asm volatile("" : "+s"(ap));
#define args (*ap)
        const unsigned pe = args.prog[pc];
        const int kind = pe & 15, sub = (pe >> 4) & 1, b = (pe >> 5) & 1, l = (pe >> 6) & 1, pmode = (pe >> 8) & 3; const bool mixer = (pe >> 7) & 1;
        unsigned char* ws = args.ws;
        int tid_ = threadIdx.x; asm volatile("" : "+v"(tid_));
        const int tid = tid_, lane = tid & 63, wave = __builtin_amdgcn_readfirstlane(tid >> 6);
        const int G = gridDim.x, bx = blockIdx.x;
        const int vcu = (G % 8 == 0) ? (bx % 8) * (G / 8) + bx / 8 : bx;
        const int gw = vcu * NWAVES + wave, NGW = G * NWAVES;
        switch (kind) {
        case K_CONV: {
            bf16* WGU = (bf16*)(ws + WS_WGU); bf16* WD = (bf16*)(ws + WS_WD); bf16* WIN = (bf16*)(ws + WS_WIN); bf16* WB = (bf16*)(ws + WS_WB); bf16* WO = (bf16*)(ws + WS_WO);
            LAS float* scr = (LAS float*)(ldsl + wave * 16384);
            const float* w_gu = args.in[sub ? I_F2GU : I_F1GU] + (size_t)l * DM * 2 * DFF;
            const float* w_dn = args.in[sub ? I_F2D : I_F1D] + (size_t)l * DFF * DM;
            constexpr int I_GU = (DM / 64) * (2 * DFF / 32), I_DN = (DFF / 64) * (DM / 32), I_IN = (DM / 64) * ((DIN_SRC + 31) / 32), I_BR = (512 / 64) * (DM / 32), I_OUT = (DM / 64) * (DM / 32);
            const int nitems = I_GU + I_DN + (sub == 0 ? I_IN + 3 * I_BR + I_OUT : 0);
            for (int it = gw; it < nitems; it += NGW) {
                int r = it;
                if (r < I_GU) { transpose_item(w_gu, DM, 2 * DFF, WGU, scr, r, lane, MapGU()); continue; } r -= I_GU;
                if (r < I_DN) { transpose_item(w_dn, DFF, DM, WD, scr, r, lane, MapId()); continue; } r -= I_DN;
                if (r < I_IN) { transpose_item(args.in[I_WIN] + (size_t)l * DM * DIN_SRC, DM, DIN_SRC, WIN, scr, r, lane, MapWin()); continue; } r -= I_IN;
                if (r < 3 * I_BR) { const int br = r / I_BR; transpose_item(args.in[I_WBG + br] + (size_t)l * 512 * DM, 512, DM, WB + (size_t)br * 512 * 1024, scr, r % I_BR, lane, MapId()); continue; } r -= 3 * I_BR;
                transpose_item(args.in[I_WOUT] + (size_t)l * DM * DM, DM, DM, WO, scr, r, lane, MapId());
            }
            if (sub == 0) { for (int i = gw * 64 + lane; i < 16 * DM / 2; i += NGW * 64) ((unsigned*)(WIN + (size_t)(PA_SM + 48) * DM))[i] = 0u; }
            if (l == 0 && sub == 0) { const float* n_pre = args.in[I_F1PRE]; bf16* XN = (bf16*)(ws + WS_XN);
                for (int m = gw; m < MTOK; m += NGW) row_pass(args.in[I_X] + (size_t)m * DM, nullptr, nullptr, 0.f, nullptr, n_pre, XN + (size_t)m * DM, lane); }
        } break;
        case K_F1: {
            pg8::Gemm g{(const bf16*)(ws + WS_XN), (const bf16*)(ws + WS_WGU), MTOK, 2 * DFF, DM, DM, DM}; pg8::StaticOrder S; S.init(MTOK, 2 * DFF, G, bx); pg8::EpiSwiglu E{(bf16*)(ws + WS_H), DFF};
            pg8::gemm_phase<pg8::EpiSwiglu, pg8::StaticOrder, true, true>(ldsl, g, S, E);
        } break;
        case K_GF32: {
            pg8::Gemm g; pg8::EpiF32 E; pg8::StaticOrder S;
            if (mixer) { g = pg8::Gemm{(const bf16*)(ws + WS_MG), (const bf16*)(ws + WS_WO), SEQ, DM, DM, DM, DM}; E = pg8::EpiF32{(float*)(ws + WS_YB), DM}; S.init(SEQ, DM, G, bx); }
            else { g = pg8::Gemm{(const bf16*)(ws + WS_H), (const bf16*)(ws + WS_WD), MTOK, DM, DFF, DFF, DFF}; E = pg8::EpiF32{(float*)(ws + WS_Y), DM}; S.init(MTOK, DM, G, bx); }
            pg8::gemm_phase<pg8::EpiF32, pg8::StaticOrder, true, true>(ldsl, g, S, E);
        } break;
        case K_ROWS: {
            float* xres = args.out; bf16* XN = (bf16*)(ws + WS_XN);
            if (mixer) {
                const float* YB = (const float*)(ws + WS_YB);
                for (int m = gw; m < SEQ; m += NGW) { const size_t r = (size_t)b * SEQ + m;
                    row_pass(xres + r * DM, YB + (size_t)m * DM, args.in[I_MPOST] + l * DM, 1.0f, xres + r * DM, args.in[I_F2PRE] + l * DM, XN + r * DM, lane); }
            } else {
                const float* Y = (const float*)(ws + WS_Y);
                const float* n_post = args.in[sub ? I_F2POST : I_F1POST] + l * DM;
                const float* xin = (l == 0 && sub == 0) ? args.in[I_X] : xres;
                const float* wnext = sub == 0 ? args.in[I_MPRE] + l * DM : (l + 1 < DEPTH ? args.in[I_F1PRE] + (l + 1) * DM : nullptr);
                for (int m = gw; m < MTOK; m += NGW) row_pass(xin + (size_t)m * DM, Y + (size_t)m * DM, n_post, 0.5f, xres + (size_t)m * DM, wnext, wnext ? XN + (size_t)m * DM : nullptr, lane);
                if (sub == 0) {
                    LAS float* scr = (LAS float*)(ldsl + wave * 16384);
                    const float* w1k = args.in[I_W1K] + (size_t)l * 3072 * 256; const float* w1v = args.in[I_W1V] + (size_t)l * 2048 * 256;
                    for (int it = gw; it < 48 * 8 + 32 * 8; it += NGW) {
                        if (it < 384) transpose_item(w1k, 3072, 256, (bf16*)(ws + WS_WD + CW_W1K), scr, it, lane, MapId());
                        else transpose_item(w1v, 2048, 256, (bf16*)(ws + WS_WD + CW_W1V), scr, it - 384, lane, MapId()); }
                    if (bx < 32) { const int which = bx >> 4, part = bx & 15, j = tid & 255, hf = tid >> 8;
                        const int per = which ? 128 : 192, i0 = part * per + hf * (per / 2);
                        const float* pe = which ? args.in[I_PEV] + l * 32 * 64 : args.in[I_PEK] + l * 32 * 96; const float* w1 = which ? w1v : w1k;
                        float a = 0.f;
                        for (int i = i0; i < i0 + per / 2; ++i) a += pe[i] * w1[(size_t)i * 256 + j];
                        float* red = (float*)lds; __syncthreads(); red[tid] = a; __syncthreads();
                        if (tid < 256) ((float*)(ws + WS_WD + CW_BPART))[(which * 16 + part) * 256 + tid] = red[tid] + red[tid + 256];
                    }
                }
            }
        } break;
        case K_M1: {
            pg8::Gemm g{(const bf16*)(ws + WS_XN) + (size_t)b * SEQ * DM, (const bf16*)(ws + WS_WIN), SEQ, NIN, DM, DM, DM}; pg8::StaticOrder S; S.init(SEQ, NIN, G, bx);
            pg8::EpiWin E{(bf16*)(ws + WS_A), (float*)(ws + WS_SM), (bf16*)(ws + WS_G), (bf16*)(ws + WS_O + CMP_KCF), (bf16*)(ws + WS_O + CMP_VCF)};
            if (bx == 1) { bf16* KCF = (bf16*)(ws + WS_O + CMP_KCF); bf16* VCF = (bf16*)(ws + WS_O + CMP_VCF);
                for (int i = tid; i < 768; i += NTHR) ((unsigned*)(KCF + (size_t)2 * SEQ * 96))[i] = 0u; for (int i = tid; i < 512; i += NTHR) ((unsigned*)(VCF + (size_t)2 * SEQ * 64))[i] = 0u; }
            pg8::gemm_phase<pg8::EpiWin, pg8::StaticOrder, true, true>(ldsl, g, S, E);
        } break;
        case K_M2: {
            const bf16* PA = (const bf16*)(ws + WS_A); const float* SM = (const float*)(ws + WS_SM);
            if (bx == 0) { const int which = tid >> 8, j = tid & 255; float a = 0.f; const float* bp = (const float*)(ws + WS_WD + CW_BPART) + which * 16 * 256 + j;
                for (int p = 0; p < 16; ++p) a += bp[p * 256];
                ((float*)(ws + WS_WD + CW_BIAS))[which * 256 + j] = a; }
            if (bx < 32) {
                const int kv = bx >> 4, pm = (bx >> 2) & 3, ks = bx & 3;
                pg8::Gemm g = kv ? pg8::Gemm{(const bf16*)(ws + WS_O + CMP_VCF) + ks * 512, (const bf16*)(ws + WS_WD + CW_W1V) + ks * 512, 1024, 256, 512, 1024, 2048}
                                 : pg8::Gemm{(const bf16*)(ws + WS_O + CMP_KCF) + ks * 768, (const bf16*)(ws + WS_WD + CW_W1K) + ks * 768, 1024, 256, 768, 1536, 3072};
                pg8::OneTile S{pm, 0}; pg8::EpiF32 E{(float*)(ws + WS_O + CMP_PART) + ((size_t)kv * 4 + ks) * 1024 * 256, 256};
                pg8::gemm_phase<pg8::EpiF32, pg8::OneTile, false, true>(ldsl, g, S, E);
                __syncthreads();
            }
            for (int it = gw; it < NCHUNK * 4; it += NGW) nsa_vt_item(PA, (bf16*)(ws + WS_VTS), (bf16*)(ws + WS_VTW), it, (unsigned short*)(lds + wave * 16384), lane);
            for (int it = bx; it < NCHUNK * 4; it += G)
                gla_prep_item(PA, SM, args.in[I_GGW] + l * 16 * 256, args.in[I_GGB] + l * 256, ws + ALPHA_OFF, ws + WS_WGU, it >> 2, it & 3, (float*)lds, tid);
        } break;
        case K_M2B: {
            if (bx < 32) {
                const int kv = bx >> 4, rg = bx & 15;
                float* Hs = (float*)lds;
                const float* part = (const float*)(ws + WS_O + CMP_PART) + (size_t)kv * 4 * 1024 * 256; const float* bias = (const float*)(ws + WS_WD + CW_BIAS) + kv * 256;
                __syncthreads();
                for (int i = tid; i < 64 * 64; i += NTHR) { const int r = i >> 6, c4 = (i & 63) * 4; const size_t o = (size_t)(rg * 64 + r) * 256 + c4;
                    f32x4 v = *(const f32x4*)(part + o) + *(const f32x4*)(part + 262144 + o) + *(const f32x4*)(part + 2 * 262144 + o) + *(const f32x4*)(part + 3 * 262144 + o) + *(const f32x4*)(bias + c4);
#pragma unroll
                    for (int e = 0; e < 4; ++e) v[e] = gelu_tanhf_(v[e]);
                    *(f32x4*)(Hs + r * 260 + c4) = v; }
                __syncthreads();
                const int r = tid >> 3, dg = tid & 7, row = rg * 64 + r, gg = row >> 9, n = row & 511;
                if (kv == 0) { float acc[12]; cmp_layer2<12>(Hs + r * 260, args.in[I_W2K] + l * 256 * 96 + dg * 12, 96, acc);
                    if (n < 511) { bf16* KCH = (bf16*)(ws + WS_KCMP) + (size_t)(n * 2 + gg) * 96 + dg * 12; bf16* KCL = (bf16*)(ws + WS_KCL) + (size_t)(n * 2 + gg) * 96 + dg * 12;
#pragma unroll
                        for (int i = 0; i < 12; ++i) { const unsigned hi = f2bf(acc[i]); KCH[i] = (bf16)hi; KCL[i] = (bf16)f2bf(acc[i] - __uint_as_float(hi << 16)); } } }
                else { float acc[8]; cmp_layer2<8>(Hs + r * 260, args.in[I_W2V] + l * 256 * 64 + dg * 8, 64, acc);
                    if (n < 511) { bf16* VCT = (bf16*)(ws + WS_VCT) + (size_t)(gg * 64 + dg * 8) * 512 + n;
#pragma unroll
                        for (int i = 0; i < 8; ++i) VCT[(size_t)i * 512] = (bf16)f2bf(acc[i]); } }
                if (bx == 0) { if (tid < 192) { ((bf16*)(ws + WS_KCMP))[511 * 192 + tid] = 0; ((bf16*)(ws + WS_KCL))[511 * 192 + tid] = 0; } if (tid < 128) ((bf16*)(ws + WS_VCT))[tid * 512 + 511] = 0; }
            } else {
                const bf16* PA = (const bf16*)(ws + WS_A); const float* SM = (const float*)(ws + WS_SM);
                for (int it = bx - 32; it < NCHUNK * 4; it += G - 32)
                    gdn_prep_chunk(PA, SM, args.in[I_CONVW] + l * 4 * 1536, args.in[I_ALOG] + l * 4, args.in[I_DTB] + l * 4, ws + WS_QKV, it >> 2, it & 3, lds, tid);
            }
        } break;
        case K_M3: {
            const bf16* PA = (const bf16*)(ws + WS_A); bf16* OB3 = (bf16*)(ws + WS_O);
            float* wl = (float*)(lds + wave * 16384);
            if (bx < 4) { if (pmode == 0 || pmode == 1) gdn_scan_block(ws + WS_QKV, OB3, bx, lds, tid); }
            else if (bx < 8) { if (pmode == 0 || pmode == 2) gla_scan_block(ws + ALPHA_OFF, ws + WS_WGU, OB3 + 2 * (size_t)SEQ * 512, bx - 4, lds, tid); }
            else if (pmode == 0 || pmode == 3) { const LAS int* btab = (const LAS int*)(ldsl + BTAB_OFF); const LAS float* relb = (const LAS float*)(ldsl + RELB_OFF);
                unsigned* qctr = (unsigned*)(ws + WS_CTL) + CW_Q + 64 * (l * 2 + b + 4 * pmode);
                volatile unsigned* qw = (volatile unsigned*)(lds + NSA_UOFF + 256);
                for (;;) {
                    __syncthreads();
                    if (tid == 0) *qw = __hip_atomic_fetch_add(qctr, 1u, __ATOMIC_RELAXED, __HIP_MEMORY_SCOPE_AGENT);
                    __syncthreads();
                    const unsigned u = *qw;
                    if (u >= (unsigned)(SEQ / 32 * 2)) break;
                    nsa_unit(PA, (const float*)(ws + WS_SM), (const bf16*)(ws + WS_KCMP), (const bf16*)(ws + WS_KCL), (const bf16*)(ws + WS_VCT), (const bf16*)(ws + WS_VTS), (const bf16*)(ws + WS_VTW),
                             relb, btab, pmode == 3 ? (bf16*)(ws + WS_QKV) : OB3 + (size_t)SEQ * 512, SEQ - 32 - 32 * (int)(u >> 1), (int)(u & 1), lds, tid, pmode == 3 ? PROBE_ABL : 0);
                } }
        } break;
        case K_M4: {
            for (int it = gw; it < SEQ * 4; it += NGW) out_norm_item((bf16*)(ws + WS_O), (const bf16*)(ws + WS_A), PA_GZ, args.in[I_GDNNW] + l * 128, it >> 2, it & 3, lane);
            for (int it = gw; it < SEQ * 4; it += NGW) out_norm_item((bf16*)(ws + WS_O) + 2 * (size_t)SEQ * 512, (const bf16*)(ws + WS_A), PA_LR, args.in[I_GLANW] + l * 128, it >> 2, it & 3, lane);
        } break;
        case K_M5: {
#pragma unroll 1
            for (int br = 0; br < 3; ++br) {
                pg8::StaticOrder S; S.init(SEQ, DM, G, bx);
                pg8::Gemm g{(const bf16*)(ws + WS_O) + (size_t)br * SEQ * 512, (const bf16*)(ws + WS_WB) + (size_t)br * 512 * 1024, SEQ, DM, 512, 512, 512};
                pg8::EpiMerge E{(const bf16*)(ws + WS_G) + br * 1024, (float*)(ws + WS_RMW), (bf16*)(ws + WS_MG), br};
                pg8::gemm_phase<pg8::EpiMerge, pg8::StaticOrder, true, true>(ldsl, g, S, E);
            }
        } break;
        default: break;
        }
#if MK_ONE_LAUNCH
        if (pc + 1 < args.ph_hi) xcd_barrier(bar);
#endif
#undef args
    }
}

extern "C" void kernel_launch(void* const* d_in, const int* in_sizes, int n_in, void* d_out, int out_size, void* d_ws, size_t ws_size, hipStream_t stream) {
    static int grid = 0;
    if (grid == 0) {
        if (n_in != 30 || out_size != MTOK * DM || ws_size < 292 * MiB) { fprintf(stderr, "kernel_launch: unexpected shapes (n_in %d out %d ws %zu)\n", n_in, out_size, ws_size); grid = -1; return; }
        int dev = 0, cus = 0, per_cu = 0;
        if (hipGetDevice(&dev) != hipSuccess || hipDeviceGetAttribute(&cus, hipDeviceAttributeMultiprocessorCount, dev) != hipSuccess) { grid = -1; return; }
        if (hipFuncSetAttribute((const void*)mk_fwd, hipFuncAttributeMaxDynamicSharedMemorySize, LDS_BYTES) != hipSuccess) { fprintf(stderr, "kernel_launch: hipFuncSetAttribute failed\n"); grid = -1; return; }
        if (hipOccupancyMaxActiveBlocksPerMultiprocessor(&per_cu, (const void*)mk_fwd, NTHR, LDS_BYTES) != hipSuccess || per_cu < 1) { fprintf(stderr, "kernel_launch: occupancy query says %d blocks per CU\n", per_cu); grid = -1; (void)hipGetLastError(); return; }
        (void)hipGetLastError();
        grid = cus;
    }
    if (grid < 0) return;
    (void)hipMemsetAsync((char*)d_ws + WS_CTL, 0, CTL_ZERO_BYTES, stream);
    Args a{};
    for (int i = 0; i < 30; ++i) a.in[i] = (const float*)d_in[i];
    a.out = (float*)d_out; a.ws = (unsigned char*)d_ws;
    int np = 0;
#ifndef PROBE_KIND
#define PROBE_KIND -1
#endif
    auto push = [&](int kind, int sub, int b, int l, int mixer) { const int reps = (kind == PROBE_KIND) ? 2 : 1; for (int r = 0; r < reps; ++r) a.prog[np++] = (unsigned short)(kind | sub << 4 | b << 5 | l << 6 | mixer << 7);
#ifdef PROBE_M3MODE
        if (kind == K_M3) a.prog[np++] = (unsigned short)(kind | sub << 4 | b << 5 | l << 6 | mixer << 7 | PROBE_M3MODE << 8);
#endif
    };
    for (int l = 0; l < DEPTH; ++l) {
        push(K_CONV, 0, 0, l, 0); push(K_F1, 0, 0, l, 0); push(K_GF32, 0, 0, l, 0); push(K_ROWS, 0, 0, l, 0);
        for (int b = 0; b < NBATCH; ++b) { push(K_M1, 0, b, l, 1); push(K_M2, 0, b, l, 1); push(K_M2B, 0, b, l, 1); push(K_M3, 0, b, l, 1); push(K_M4, 0, b, l, 1); push(K_M5, 0, b, l, 1); push(K_GF32, 0, b, l, 1); push(K_ROWS, 0, b, l, 1); }
        push(K_CONV, 1, 0, l, 0); push(K_F1, 1, 0, l, 0); push(K_GF32, 1, 0, l, 0); push(K_ROWS, 1, 0, l, 0);
    }
    const int NPH = np;
#if MK_ONE_LAUNCH
    a.ph_lo = 0; a.ph_hi = NPH;
    hipLaunchKernelGGL(mk_fwd, dim3(grid), dim3(NTHR), LDS_BYTES, stream, a);
#else
    for (int p = 0; p < NPH; ++p) { a.ph_lo = p; a.ph_hi = p + 1; hipLaunchKernelGGL(mk_fwd, dim3(grid), dim3(NTHR), LDS_BYTES, stream, a); }
#endif
}
```

```cpp
#include <hip/hip_runtime.h>
#include <cstdio>
#include <cstdint>
#ifndef MK_ONE_LAUNCH
#define MK_ONE_LAUNCH 1
#endif
namespace pg8 {
#define PG8_LAS __attribute__((address_space(3)))
typedef unsigned short bf16_t;
typedef short bf16x8 __attribute__((ext_vector_type(8)));
typedef float f32x4 __attribute__((ext_vector_type(4)));
typedef unsigned u32x4 __attribute__((ext_vector_type(4)));
typedef unsigned u32x2 __attribute__((ext_vector_type(2)));
constexpr int BM = 256, BK = 64, HALF = 128, HTB = HALF * BK * 2  , STAGE_BYTES = 8 * HTB, NXCD = 8, WGM = 8;

__host__ __device__ __forceinline__ int lds_byte(int r, int c) { const int st = (r >> 4) * 2 + (c >> 5), rr = r & 15, cc = c & 31, ob = rr * 64 + cc * 2; return st * 1024 + (ob ^ (((ob >> 9) & 1) << 5)); }
__host__ __device__ __forceinline__ void stage_rc(int b, int& R, int& C) { const int st = b / 1024, sb = b % 1024, swz = sb ^ (((sb >> 9) & 1) << 5); R = (st >> 1) * 16 + swz / 64; C = (st & 1) * 32 + (swz % 64) / 2; }
__host__ __device__ __forceinline__ int perm32(int rho) { const int n = rho >> 4, i = rho & 15; return 8 * (i >> 2) + 4 * n + (i & 3); }

struct Unit { int pm, pn; };
struct Gemm { const bf16_t* A; const bf16_t* Bt; int M, N, K, lda, ldb; };

struct StaticOrder {
    int nM, nN, nwg, G, c;
    __host__ __device__ void init(int M, int N, int G_, int c_) { nM = M / BM; nN = N / BM; nwg = nM * nN; G = G_; c = c_; }
    __host__ __device__ bool next(int i, Unit& u) const {
        const long L = (long)i * G + c; if (L >= nwg) return false;
        int wgid = (int)L; { const int q = nwg / NXCD, r = nwg % NXCD, xcd = wgid % NXCD, off = wgid / NXCD; wgid = (xcd < r ? xcd * (q + 1) : r * (q + 1) + (xcd - r) * q) + off; }
        const int nig = WGM * nN, gid = wgid / nig, fm = gid * WGM, gsz = (nM - fm) < WGM ? (nM - fm) : WGM;
        u.pm = fm + ((wgid % nig) % gsz); u.pn = (wgid % nig) / gsz; return true;
    }
    __device__ __forceinline__ void a_ready(const Unit&) const {}
    __device__ __forceinline__ void done(const Unit&) const {}
};

struct OneTile { int pm, pn; __device__ __forceinline__ bool next(int i, Unit& u) const { if (i) return false; u.pm = pm; u.pn = pn; return true; }
    __device__ __forceinline__ void a_ready(const Unit&) const {} __device__ __forceinline__ void done(const Unit&) const {} };
__device__ __forceinline__ unsigned cvt_pk_bf16(float lo, float hi) { unsigned r; asm volatile("v_cvt_pk_bf16_f32 %0, %1, %2" : "=v"(r) : "v"(lo), "v"(hi)); return r; }
__device__ __forceinline__ float bflo(unsigned w) { return __uint_as_float(w << 16); }
__device__ __forceinline__ float bfhi(unsigned w) { return __uint_as_float(w & 0xffff0000u); }
__device__ __forceinline__ float sigmoid_f(float x) { return __builtin_amdgcn_rcpf(1.f + __expf(-x)); }

struct EpiSwiglu {
    static constexpr bool PERM = true, AFTER_DRAIN = false;
    bf16_t* H; int ldh;
    __device__ __forceinline__ void operator()(const f32x4 (&acc)[2][2][4][2], const Unit& u, int wr, int wc, int fr, int fq) const {
        const int row0 = u.pm * BM + wr * 64 + fr, j0 = u.pn * HALF + wc * 32 + 8 * fq;
#pragma unroll
        for (int ai = 0; ai < 2; ++ai)
#pragma unroll
            for (int m = 0; m < 4; ++m) {
                bf16_t* p = H + (size_t)(row0 + ai * HALF + m * 16) * ldh + j0;
                float h[8];
#pragma unroll
                for (int n = 0; n < 2; ++n)
#pragma unroll
                    for (int i = 0; i < 4; ++i) { const float g = acc[ai][0][m][n][i], uu = acc[ai][1][m][n][i]; h[n * 4 + i] = g * sigmoid_f(g) * uu; }
                u32x4 w; w.x = cvt_pk_bf16(h[0], h[1]); w.y = cvt_pk_bf16(h[2], h[3]); w.z = cvt_pk_bf16(h[4], h[5]); w.w = cvt_pk_bf16(h[6], h[7]);
                *(u32x4*)p = w;
                asm volatile("" ::: "memory");
            }
    }
};
struct EpiGelu {
    static constexpr bool PERM = false, AFTER_DRAIN = false;
    bf16_t* Hd; const float* bias;
    __device__ __forceinline__ void operator()(const f32x4 (&acc)[2][2][4][2], const Unit& u, int wr, int wc, int fr, int fq) const {
        const int row0 = u.pm * BM + wr * 64 + fr, col0 = wc * 32 + 4 * fq;
#pragma unroll
        for (int bj = 0; bj < 2; ++bj)
#pragma unroll
            for (int n = 0; n < 2; ++n) { const int c = col0 + bj * HALF + n * 16; const f32x4 bv = *(const f32x4*)(bias + c);
#pragma unroll
                for (int ai = 0; ai < 2; ++ai)
#pragma unroll
                    for (int m = 0; m < 4; ++m) { f32x4 v = acc[ai][bj][m][n] + bv;
#pragma unroll
                        for (int i = 0; i < 4; ++i) { const float x = v[i]; const float u2 = 1.5957691216057308f * (x + 0.044715f * x * x * x); v[i] = x * (1.f - __builtin_amdgcn_rcpf(1.f + __expf(u2))); }
                        u32x2 w; w.x = cvt_pk_bf16(v[0], v[1]); w.y = cvt_pk_bf16(v[2], v[3]);
                        *(u32x2*)(Hd + (size_t)(row0 + ai * HALF + m * 16) * 256 + c) = w; asm volatile("" ::: "memory"); } }
    }
};
struct EpiY16 {
    static constexpr bool PERM = true, AFTER_DRAIN = false;
    bf16_t* Y; int ldc;
    __device__ __forceinline__ void operator()(const f32x4 (&acc)[2][2][4][2], const Unit& u, int wr, int wc, int fr, int fq) const {
        const int row0 = u.pm * BM + wr * 64 + fr, col0 = u.pn * BM + wc * 32 + 8 * fq;
#pragma unroll
        for (int ai = 0; ai < 2; ++ai)
#pragma unroll
            for (int m = 0; m < 4; ++m) { bf16_t* p = Y + (size_t)(row0 + ai * HALF + m * 16) * ldc + col0;
#pragma unroll
                for (int bj = 0; bj < 2; ++bj) { const f32x4 v0 = acc[ai][bj][m][0], v1 = acc[ai][bj][m][1];
                    u32x4 w; w.x = cvt_pk_bf16(v0[0], v0[1]); w.y = cvt_pk_bf16(v0[2], v0[3]); w.z = cvt_pk_bf16(v1[0], v1[1]); w.w = cvt_pk_bf16(v1[2], v1[3]);
                    *(u32x4*)(p + bj * HALF) = w; } }
    }
};
struct EpiF32 {
    static constexpr bool PERM = false, AFTER_DRAIN = false;
    float* Y; int ldc;
    __device__ __forceinline__ void operator()(const f32x4 (&acc)[2][2][4][2], const Unit& u, int wr, int wc, int fr, int fq) const {
        const int row0 = u.pm * BM + wr * 64 + fr, col0 = u.pn * BM + wc * 32 + 4 * fq;
#pragma unroll
        for (int ai = 0; ai < 2; ++ai)
#pragma unroll
            for (int m = 0; m < 4; ++m) { float* p = Y + (size_t)(row0 + ai * HALF + m * 16) * ldc + col0;
#pragma unroll
                for (int bj = 0; bj < 2; ++bj)
#pragma unroll
                    for (int n = 0; n < 2; ++n) *(f32x4*)(p + bj * HALF + n * 16) = acc[ai][bj][m][n]; }
    }
};
struct EpiWin {
    static constexpr bool PERM = true, AFTER_DRAIN = false;
    bf16_t* PA; float* SM; bf16_t* G; bf16_t* KCF; bf16_t* VCF;
    __device__ __forceinline__ void operator()(const f32x4 (&acc)[2][2][4][2], const Unit& u, int wr, int wc, int fr, int fq) const {
        const int row0 = u.pm * BM + wr * 64 + fr, cw = wc * 32 + 8 * fq;
        const bool gate = u.pn >= 21;
#pragma unroll
        for (int ai = 0; ai < 2; ++ai)
#pragma unroll
            for (int m = 0; m < 4; ++m) { const size_t row = (size_t)(row0 + ai * HALF + m * 16);
#pragma unroll
                for (int bj = 0; bj < 2; ++bj) {
                    f32x4 v0 = acc[ai][bj][m][0], v1 = acc[ai][bj][m][1];
                    if (gate) {
#pragma unroll
                        for (int i = 0; i < 4; ++i) { v0[i] = sigmoid_f(v0[i]); v1[i] = sigmoid_f(v1[i]); }
                    }
                    u32x4 w; w.x = cvt_pk_bf16(v0[0], v0[1]); w.y = cvt_pk_bf16(v0[2], v0[3]); w.z = cvt_pk_bf16(v1[0], v1[1]); w.w = cvt_pk_bf16(v1[2], v1[3]);
                    if (gate) *(u32x4*)(G + row * 3072 + (u.pn - 21) * BM + bj * HALF + cw) = w;
                    else {
                        const int col = u.pn * BM + bj * HALF + cw;
                        *(u32x4*)(PA + row * 5376 + col) = w;
                        if (col >= 5312) { float* s = SM + row * 64 + (col - 5312); *(f32x4*)s = v0; *(f32x4*)(s + 4) = v1; }
                        if (col >= 2816 && col < 3136) { const int off = col - 2816, gg = off >= 160, c = off - gg * 160;
                            if (c < 96) *(u32x4*)(KCF + ((size_t)gg * 8192 + row) * 96 + c) = w; else *(u32x4*)(VCF + ((size_t)gg * 8192 + row) * 64 + (c - 96)) = w; }
                    }
                    asm volatile("" ::: "memory");
                }
            }
    }
};
struct EpiMerge {
    static constexpr bool PERM = false, AFTER_DRAIN = false;
    const bf16_t* G; bf16_t* RMW; bf16_t* MG; int STEP;
    __device__ __forceinline__ void operator()(const f32x4 (&acc)[2][2][4][2], const Unit& u, int wr, int wc, int fr, int fq) const {
        const int row0 = u.pm * BM + wr * 64 + fr, col0 = u.pn * BM + wc * 32 + 4 * fq;
        bf16_t* dst = STEP == 2 ? MG : RMW;
#pragma unroll
        for (int ai = 0; ai < 2; ++ai)
#pragma unroll
          for (int mp = 0; mp < 2; ++mp) {
            u32x2 gw[2][2][2], rv[2][2][2];
#pragma unroll
            for (int mi = 0; mi < 2; ++mi) { const size_t row = (size_t)(row0 + ai * HALF + (2 * mp + mi) * 16); const bf16_t* gp = G + row * 3072 + col0; const bf16_t* rp = RMW + row * 1024 + col0;
#pragma unroll
                for (int bj = 0; bj < 2; ++bj)
#pragma unroll
                    for (int n = 0; n < 2; ++n) { gw[mi][bj][n] = *(const u32x2*)(gp + bj * HALF + n * 16); if (STEP != 0) rv[mi][bj][n] = *(const u32x2*)(rp + bj * HALF + n * 16); } }
#pragma unroll
            for (int mi = 0; mi < 2; ++mi) { const size_t row = (size_t)(row0 + ai * HALF + (2 * mp + mi) * 16);
#pragma unroll
                for (int bj = 0; bj < 2; ++bj)
#pragma unroll
                    for (int n = 0; n < 2; ++n) { const int c = col0 + bj * HALF + n * 16; const u32x2 g2 = gw[mi][bj][n];
                        f32x4 v = acc[ai][bj][2 * mp + mi][n]; v[0] *= bflo(g2.x); v[1] *= bfhi(g2.x); v[2] *= bflo(g2.y); v[3] *= bfhi(g2.y);
                        if (STEP != 0) { const u32x2 r2 = rv[mi][bj][n]; v[0] += bflo(r2.x); v[1] += bfhi(r2.x); v[2] += bflo(r2.y); v[3] += bfhi(r2.y); }
                        u32x2 w; w.x = cvt_pk_bf16(v[0], v[1]); w.y = cvt_pk_bf16(v[2], v[3]); *(u32x2*)(dst + row * 1024 + c) = w;
                    } }
            asm volatile("" ::: "memory");
        }
    }
};

template <class Epi, class Sched, bool ALIGN_EPI = false, bool SP2 = false>
__device__ __forceinline__ void gemm_phase(PG8_LAS unsigned char* lds, const Gemm g, const Sched& S, const Epi& E) {
    int tid_ = threadIdx.x; asm volatile("" : "+v"(tid_));
    const int tid = tid_, wid = __builtin_amdgcn_readfirstlane(tid >> 6), lane = tid & 63, wr = wid >> 2, wc = wid & 3, fr = lane & 15, fq = lane >> 4;
    const int K = g.K, nt = K / BK, lda = g.lda, ldb = g.ldb;
    unsigned voffA[2], voffB[2];
#pragma unroll
    for (int i = 0; i < 2; ++i) { int R, C; stage_rc(tid * 16 + i * 8192, R, C); const int Rb = Epi::PERM ? ((R & ~31) + perm32(R & 31)) : R;
        voffA[i] = (unsigned)(R * lda + C) * 2u; voffB[i] = (unsigned)(Rb * ldb + C) * 2u; }
    const size_t kstep = (size_t)(BK * 2);
    const size_t hstepA = (size_t)HALF * lda * 2, tstepA = 2 * hstepA;
    const size_t hstep = (size_t)HALF * ldb * 2;
    const size_t tstep = 2 * hstep;
    const unsigned ldsw = (unsigned)wid * 1024u;
    const int aoff = lds_byte(wr * 64 + fr, fq * 8), boff = lds_byte(wc * 32 + fr, fq * 8);
#define PG8_SA(b, h) (((b) * 2 + (h)) * HTB)
#define PG8_SB(b, h) ((4 + (b) * 2 + (h)) * HTB)
#define PG8_STAGE(bufoff, gbase, voff) do { _Pragma("unroll") for (int _i = 0; _i < 2; ++_i) \
        __builtin_amdgcn_global_load_lds((const unsigned*)((const char*)(gbase) + (voff)[_i]), (PG8_LAS unsigned*)(lds + (bufoff) + ldsw + _i * 8192), 16, 0, 0); } while (0)
#define PG8_LDA(dst, b, h) do { _Pragma("unroll") for (int m = 0; m < 4; ++m) _Pragma("unroll") for (int k = 0; k < 2; ++k) dst[m][k] = *(const PG8_LAS bf16x8*)(lds + PG8_SA(b, h) + aoff + m * 2048 + k * 1024); } while (0)
#define PG8_LDB(dst, b, h) do { _Pragma("unroll") for (int n = 0; n < 2; ++n) _Pragma("unroll") for (int k = 0; k < 2; ++k) dst[n][k] = *(const PG8_LAS bf16x8*)(lds + PG8_SB(b, h) + boff + n * 2048 + k * 1024); } while (0)
#define PG8_MMA(ai, bj, At, Bt) do { __builtin_amdgcn_s_setprio(1); _Pragma("unroll") for (int m = 0; m < 4; ++m) _Pragma("unroll") for (int n = 0; n < 2; ++n) _Pragma("unroll") for (int k = 0; k < 2; ++k) \
        acc[ai][bj][m][n] = __builtin_amdgcn_mfma_f32_16x16x32_bf16(Bt[n][k], At[m][k], acc[ai][bj][m][n], 0, 0, 0); __builtin_amdgcn_s_setprio(0); } while (0)
#define PG8_WAIT_V(n) asm volatile("s_waitcnt vmcnt(" #n ")" ::: "memory")
#define PG8_WAIT_L(n) asm volatile("s_waitcnt lgkmcnt(" #n ")" ::: "memory")
#define PG8_BAR __builtin_amdgcn_s_barrier()
#define PG8_SCHED __builtin_amdgcn_sched_barrier(0)
    Unit cur, nxt; int ui = 0;
    if (!S.next(0, cur)) return;
    f32x4 acc[2][2][4][2];
#pragma unroll
    for (int a = 0; a < 2; ++a)
#pragma unroll
        for (int b = 0; b < 2; ++b)
#pragma unroll
            for (int m = 0; m < 4; ++m)
#pragma unroll
                for (int n = 0; n < 2; ++n) acc[a][b][m][n] = (f32x4){0.f, 0.f, 0.f, 0.f};
    bf16x8 At[4][2], B0[2][2], B1[2][2];
    const char* cA = (const char*)g.A + (size_t)cur.pm * tstepA; const char* cB = (const char*)g.Bt + (size_t)cur.pn * tstep;
    S.a_ready(cur);
    if constexpr (SP2) {
        PG8_STAGE(PG8_SB(0, 0), cB, voffB); PG8_STAGE(PG8_SB(0, 1), cB + hstep, voffB); PG8_STAGE(PG8_SA(0, 0), cA, voffA); PG8_STAGE(PG8_SA(0, 1), cA + hstepA, voffA);
        if (wr == 1) PG8_BAR;
        PG8_WAIT_V(2); PG8_BAR;
        PG8_STAGE(PG8_SB(1, 0), cB + kstep, voffB); PG8_STAGE(PG8_SA(1, 0), cA + kstep, voffA); PG8_STAGE(PG8_SB(1, 1), cB + hstep + kstep, voffB);
        PG8_WAIT_V(6); PG8_BAR;
    } else {
        PG8_STAGE(PG8_SB(0, 0), cB, voffB); PG8_STAGE(PG8_SA(0, 0), cA, voffA); PG8_STAGE(PG8_SB(0, 1), cB + hstep, voffB); PG8_STAGE(PG8_SA(0, 1), cA + hstepA, voffA);
        if (wr == 1) PG8_BAR;
        PG8_WAIT_V(4); PG8_BAR;
        PG8_STAGE(PG8_SB(1, 0), cB + kstep, voffB); PG8_STAGE(PG8_SA(1, 0), cA + kstep, voffA); PG8_STAGE(PG8_SB(1, 1), cB + hstep + kstep, voffB);
        PG8_WAIT_V(6); PG8_BAR;
    }
    for (;;) {
        const bool has_next = S.next(ui + 1, nxt);
        const char* nA = has_next ? (const char*)g.A + (size_t)nxt.pm * tstepA : cA; const char* nB = has_next ? (const char*)g.Bt + (size_t)nxt.pn * tstep : cB;
        for (int t = 0; t < nt; t += 2) {
            const bool last = (t == nt - 2);
            const char* a1 = cA + (size_t)(t + 1) * kstep;
            const char* a2 = last ? nA : cA + (size_t)(t + 2) * kstep; const char* b2 = last ? nB : cB + (size_t)(t + 2) * kstep;
            const char* a3 = a2 + kstep; const char* b3 = b2 + kstep;
            if (last && has_next) S.a_ready(nxt);
            if constexpr (SP2) {
            PG8_LDB(B0, 0, 0); PG8_LDB(B1, 0, 1); PG8_SCHED; PG8_LDA(At, 0, 0); PG8_STAGE(PG8_SA(1, 1), a1 + hstepA, voffA);
            PG8_WAIT_V(8); PG8_WAIT_L(0); PG8_BAR; PG8_MMA(0, 0, At, B0); PG8_MMA(0, 1, At, B1); PG8_BAR; PG8_SCHED;
            PG8_LDA(At, 0, 1); PG8_STAGE(PG8_SB(0, 0), b2, voffB); PG8_STAGE(PG8_SB(0, 1), b2 + hstep, voffB); PG8_STAGE(PG8_SA(0, 0), a2, voffA);
            PG8_WAIT_V(8); PG8_WAIT_L(0); PG8_BAR; PG8_MMA(1, 0, At, B0); PG8_MMA(1, 1, At, B1); PG8_BAR; PG8_SCHED;
            PG8_LDB(B0, 1, 0); PG8_LDB(B1, 1, 1); PG8_SCHED; PG8_LDA(At, 1, 0); PG8_STAGE(PG8_SA(0, 1), a2 + hstepA, voffA);
            PG8_WAIT_V(8); PG8_WAIT_L(0); PG8_BAR; PG8_MMA(0, 0, At, B0); PG8_MMA(0, 1, At, B1); PG8_BAR; PG8_SCHED;
            PG8_LDA(At, 1, 1); PG8_STAGE(PG8_SB(1, 0), b3, voffB); PG8_STAGE(PG8_SB(1, 1), b3 + hstep, voffB); PG8_STAGE(PG8_SA(1, 0), a3, voffA);
            PG8_WAIT_V(8); PG8_WAIT_L(0); PG8_BAR; PG8_MMA(1, 0, At, B0); PG8_MMA(1, 1, At, B1); PG8_BAR; PG8_SCHED;
            } else {
            PG8_LDB(B0, 0, 0); PG8_SCHED; PG8_LDA(At, 0, 0); PG8_STAGE(PG8_SA(1, 1), a1 + hstepA, voffA);
            PG8_WAIT_L(8); PG8_BAR; PG8_WAIT_L(0); PG8_MMA(0, 0, At, B0); PG8_BAR; PG8_SCHED;
            PG8_LDB(B1, 0, 1); PG8_STAGE(PG8_SB(0, 0), b2, voffB);
            PG8_BAR; PG8_WAIT_L(0); PG8_MMA(0, 1, At, B1); PG8_BAR;
            PG8_LDA(At, 0, 1); PG8_STAGE(PG8_SA(0, 0), a2, voffA);
            PG8_BAR; PG8_WAIT_L(0); PG8_MMA(1, 0, At, B0); PG8_BAR; PG8_SCHED;
            PG8_STAGE(PG8_SB(0, 1), b2 + hstep, voffB);
            PG8_WAIT_V(6); PG8_BAR; PG8_MMA(1, 1, At, B1); PG8_BAR;
            PG8_LDB(B0, 1, 0); PG8_SCHED; PG8_LDA(At, 1, 0); PG8_STAGE(PG8_SA(0, 1), a2 + hstepA, voffA);
            PG8_WAIT_L(8); PG8_BAR; PG8_WAIT_L(0); PG8_MMA(0, 0, At, B0); PG8_BAR; PG8_SCHED;
            PG8_LDB(B1, 1, 1); PG8_STAGE(PG8_SB(1, 0), b3, voffB);
            PG8_BAR; PG8_WAIT_L(0); PG8_MMA(0, 1, At, B1); PG8_BAR;
            PG8_LDA(At, 1, 1); PG8_STAGE(PG8_SA(1, 0), a3, voffA);
            PG8_BAR; PG8_WAIT_L(0); PG8_MMA(1, 0, At, B0); PG8_BAR; PG8_SCHED;
            PG8_STAGE(PG8_SB(1, 1), b3 + hstep, voffB);
            PG8_WAIT_V(6); PG8_BAR; PG8_MMA(1, 1, At, B1); PG8_BAR;
            }
        }
        if constexpr (ALIGN_EPI) { if (wr == 0) PG8_BAR; }
        if constexpr (!Epi::AFTER_DRAIN) { E(acc, cur, wr, wc, fr, fq); S.done(cur); }
        if (!has_next) break;
#pragma unroll
        for (int a = 0; a < 2; ++a)
#pragma unroll
            for (int b = 0; b < 2; ++b)
#pragma unroll
                for (int m = 0; m < 4; ++m)
#pragma unroll
                    for (int n = 0; n < 2; ++n) acc[a][b][m][n] = (f32x4){0.f, 0.f, 0.f, 0.f};
        cur = nxt; cA = nA; cB = nB; ++ui;
        if constexpr (ALIGN_EPI) { if (wr == 1) PG8_BAR; }
    }
    PG8_WAIT_V(0);
    if constexpr (!ALIGN_EPI) { if (wr == 0) PG8_BAR; }
    PG8_BAR;
    if constexpr (Epi::AFTER_DRAIN) { E.fused(acc, cur, wr, wc, fr, fq, lds, wid, lane); S.done(cur); }
#undef PG8_SA
#undef PG8_SB
#undef PG8_STAGE
#undef PG8_LDA
#undef PG8_LDB
#undef PG8_MMA
#undef PG8_WAIT_V
#undef PG8_WAIT_L
#undef PG8_BAR
#undef PG8_SCHED
}
}

constexpr int NWAVES = 8, NTHR = 512;
constexpr int NBATCH = 2, SEQ = 8192, MTOK = NBATCH * SEQ, DM = 1024, DFF = 2816, DIN_SRC = 8432, NIN = 8448, NPA = 5376, NMG = 3072, DEPTH = 2;
constexpr float NORM_EPS = 1e-6f;
constexpr int PA_GQ = 0, PA_GK = 512, PA_GV = 1024, PA_GZ = 1536, PA_NQ = 2048, PA_KC = 2816, PA_KS = 3136, PA_KW = 3456, PA_LQ = 3776, PA_LK = 4032, PA_LV = 4288, PA_LR = 4800, PA_SM = 5312;
constexpr size_t MiB = 1u << 20;
constexpr size_t WS_CTL = 0, CTL_ZERO_BYTES = 1 * MiB;
constexpr size_t WS_WGU = 1 * MiB, WS_WD = 12 * MiB, WS_WIN = WS_WD + 5632 * 1024, WS_WB = WS_WIN + (size_t)NIN * DM * 2, WS_WO = WS_WB + 3 * MiB;
constexpr size_t WS_XN = 40 * MiB, WS_A = 72 * MiB, WS_G = 160 * MiB, WS_O = 208 * MiB, WS_QKV = 232 * MiB, WS_SM = 290 * MiB, WS_GATES = 258 * MiB, WS_ORAW = 259 * MiB, WS_VTS = 270 * MiB, WS_VTW = 272 * MiB, WS_KCMP = 275 * MiB, WS_KCL = WS_KCMP + 256 * 1024, WS_VCT = WS_KCMP + 512 * 1024, WS_END = 276 * MiB;
constexpr size_t WS_H = WS_A, WS_Y = WS_G;
constexpr size_t WS_RMW = WS_A, WS_MG = WS_A + 32 * MiB, WS_YB = WS_A + 48 * MiB;
static_assert(WS_WO + 2 * MiB <= WS_XN && WS_Y + 64 * MiB <= WS_QKV && WS_YB + 32 * MiB <= WS_G, "ws map");
constexpr int CW_BAR = 4096, CW_Q = 8192;
constexpr int RING_BYTES = 131072, LDSCTL_OFF = RING_BYTES, MISC_OFF = LDSCTL_OFF + 320, BTAB_OFF = RING_BYTES + 1024, RELB_OFF = RING_BYTES + 1536, LDS_BYTES = 147456;

#define GAS __attribute__((address_space(1)))
#define LAS __attribute__((address_space(3)))
typedef unsigned short bf16;
typedef unsigned v4u __attribute__((ext_vector_type(4)));
typedef unsigned v2u __attribute__((ext_vector_type(2)));
typedef float f32x4 __attribute__((ext_vector_type(4)));
#define LDS_WAIT() asm volatile("s_waitcnt lgkmcnt(0)" ::: "memory")
typedef float f32x2_t __attribute__((ext_vector_type(2))); typedef __bf16 bf16x2_t __attribute__((ext_vector_type(2)));
__device__ __forceinline__ unsigned pk2(float lo, float hi) { f32x2_t v = {lo, hi}; bf16x2_t r = __builtin_convertvector(v, bf16x2_t); return __builtin_bit_cast(unsigned, r); }
__device__ __forceinline__ unsigned f2bf(float f) { return pk2(f, 0.f) & 0xffffu; }
__device__ __forceinline__ float bf2f(bf16 h) { return __uint_as_float((unsigned)h << 16); }
__device__ __forceinline__ float bflo(unsigned w) { return __uint_as_float(w << 16); }
__device__ __forceinline__ float bfhi(unsigned w) { return __uint_as_float(w & 0xffff0000u); }
__device__ __forceinline__ float wave_sum(float v) {
#pragma unroll
    for (int o = 1; o < 64; o <<= 1) v += __shfl_xor(v, o);
    return v;
}
__device__ __forceinline__ float wave_max(float v) {
#pragma unroll
    for (int o = 1; o < 64; o <<= 1) v = fmaxf(v, __shfl_xor(v, o));
    return v;
}
__device__ __forceinline__ float sigmoidf_(float x) { return 1.f / (1.f + expf(-x)); }
__device__ __forceinline__ float siluf_(float x) { return x / (1.f + expf(-x)); }
__device__ __forceinline__ float softplusf_(float x) { return x > 20.f ? x : log1pf(expf(x)); }
__device__ __forceinline__ float logsigmoidf_(float x) { return fminf(x, 0.f) - log1pf(expf(-fabsf(x))); }
__device__ __forceinline__ float gelu_tanhf_(float x) { return 0.5f * x * (1.f + tanhf(0.7978845608028654f * (x + 0.044715f * x * x * x))); }

#define XB_TMO      128
#define XB_XCNT(j)  (256  + 64 * (j))
#define XB_XSUB(j)  (1280 + 64 * (j))
#define XB_XGEN(j)  (2304 + 64 * (j))
#define XB_TOP      3328
#define XB_TOPGEN   3392
#define XCD_BAR_WORDS 3456
#define XB_SPIN_CAP (1u << 22)
__device__ __forceinline__ unsigned xb_ld(unsigned* p)              { return __hip_atomic_load(p, __ATOMIC_RELAXED, __HIP_MEMORY_SCOPE_AGENT); }
__device__ __forceinline__ unsigned xb_add(unsigned* p, unsigned v) { return __hip_atomic_fetch_add(p, v, __ATOMIC_RELAXED, __HIP_MEMORY_SCOPE_AGENT); }
__device__ __forceinline__ unsigned xb_xcc_id() { return (unsigned)__builtin_amdgcn_s_getreg((3 << 11) | 20) & 0xFu; }
#define XB_SPIN(cond, bar) do { unsigned _sp = 0; while (cond) { __builtin_amdgcn_s_sleep(1); \
    if ((++_sp & 255u) == 0u) { if (xb_ld(&(bar)[XB_TMO])) break; if (_sp > XB_SPIN_CAP) { atomicAdd(&(bar)[XB_TMO], 1u); break; } } } } while (0)
struct XcdBarrier { unsigned* bar; unsigned x; volatile LAS unsigned* st; };
__device__ __forceinline__ XcdBarrier xcd_barrier_post(unsigned* bar, volatile LAS unsigned* st) {
    XcdBarrier b; b.bar = bar; b.x = xb_xcc_id(); b.st = st;
    if (threadIdx.x == 0) (void)xb_add(&bar[XB_XCNT(b.x)], 1u);
    return b;
}
__device__ __forceinline__ void xcd_barrier_complete(unsigned* bar, unsigned x, unsigned& nloc, unsigned& nx) {
    const unsigned G = gridDim.x * gridDim.y * gridDim.z;
    unsigned sum, cnt, mine, sp = 0u;
    for (;;) {
        sum = 0u; cnt = 0u; mine = 0u;
#pragma unroll
        for (unsigned j = 0; j < 16; ++j) { const unsigned c = xb_ld(&bar[XB_XCNT(j)]); sum += c; cnt += (c > 0u) ? 1u : 0u; mine = (j == x) ? c : mine; }
        if (sum == G) break;
        __builtin_amdgcn_s_sleep(1);
        if ((++sp & 255u) == 0u) { if (xb_ld(&bar[XB_TMO])) break; if (sp > XB_SPIN_CAP) { atomicAdd(&bar[XB_TMO], 1u); break; } }
    }
    nloc = mine > 0u ? mine : 1u; nx = cnt > 0u ? cnt : 1u;
}
__device__ __forceinline__ void xcd_barrier(const XcdBarrier& b) {
    asm volatile("s_waitcnt vmcnt(0)" ::: "memory");
    __syncthreads();
    if (threadIdx.x == 0) {
        unsigned* bar = b.bar;
        __builtin_amdgcn_s_waitcnt(0);
        unsigned nloc = b.st[0], nx = b.st[1];
        if (nloc == 0u) { xcd_barrier_complete(bar, b.x, nloc, nx); b.st[0] = nloc; b.st[1] = nx; }
        const unsigned old = xb_add(&bar[XB_XSUB(b.x)], 1u);
        const unsigned gen = old / nloc;
        if (old + 1u == (gen + 1u) * nloc) {
            __builtin_amdgcn_fence(__ATOMIC_RELEASE, "agent");
            asm volatile("s_waitcnt vmcnt(0)" ::: "memory");
            const unsigned og = xb_add(&bar[XB_TOP], 1u);
            const unsigned tg = og / nx;
            if (og + 1u == (tg + 1u) * nx) xb_add(&bar[XB_TOPGEN], 1u);
            else XB_SPIN(xb_ld(&bar[XB_TOPGEN]) == tg, bar);
            __builtin_amdgcn_fence(__ATOMIC_ACQUIRE, "agent");
            xb_add(&bar[XB_XGEN(b.x)], 1u);
            asm volatile("s_waitcnt vmcnt(0)" ::: "memory");
        } else {
            XB_SPIN(xb_ld(&bar[XB_XGEN(b.x)]) == gen, bar);
            __builtin_amdgcn_fence(__ATOMIC_ACQUIRE, "agent");
            asm volatile("s_waitcnt vmcnt(0)" ::: "memory");
        }
    }
    __syncthreads();
}

constexpr int MAXPH = 128;
struct Args { const float* in[30]; float* out; unsigned char* ws; int ph_lo, ph_hi; unsigned short prog[MAXPH]; };
enum { I_X = 0, I_RELB, I_F1PRE, I_F1GU, I_F1D, I_F1POST, I_MPRE, I_WIN, I_CONVW, I_ALOG, I_DTB, I_GDNNW, I_PEK, I_W1K, I_W2K, I_PEV, I_W1V, I_W2V, I_GGW, I_GGB, I_GLANW, I_WBG, I_WBN, I_WBL, I_WOUT, I_MPOST, I_F2PRE, I_F2GU, I_F2D, I_F2POST };

template <class RowMap>
__device__ __forceinline__ void transpose_item(const float* W, int K, int N, bf16* WT, LAS float* scr, int item, int lane, const RowMap& rm) {
    const int nblk = (N + 31) / 32, kb = item / nblk, nb = item % nblk, k0 = 64 * kb, n0 = 32 * nb;
    const bool okc = (n0 + (lane & 31)) < N;
#pragma unroll 8
    for (int i = 0; i < 32; ++i) { const int kk = 2 * i + (lane >> 5); scr[kk * 33 + (lane & 31)] = okc ? W[(size_t)(k0 + kk) * N + n0 + (lane & 31)] : 0.f; }
    LDS_WAIT(); asm volatile("" ::: "memory");
    const int c = lane & 7;
#pragma unroll
    for (int j = 0; j < 4; ++j) { const int n = (lane >> 3) + 8 * j; const LAS float* s = scr + (8 * c) * 33 + n;
        v4u o; o.x = pk2(s[0 * 33], s[1 * 33]); o.y = pk2(s[2 * 33], s[3 * 33]); o.z = pk2(s[4 * 33], s[5 * 33]); o.w = pk2(s[6 * 33], s[7 * 33]);
        if (n0 + n < N) *(v4u*)(WT + (size_t)rm(n0 + n) * K + k0 + 8 * c) = o; }
    LDS_WAIT(); asm volatile("" ::: "memory");
}
struct MapId { __device__ __forceinline__ int operator()(int n) const { return n; } };
struct MapGU { __device__ __forceinline__ int operator()(int n) const { const int u = n >= DFF, j = u ? n - DFF : n; return 256 * (j >> 7) + 128 * u + (j & 127); } };
struct MapWin { __device__ __forceinline__ int operator()(int c) const {
    if (c < 2048) return c;
    if (c < 2056) return PA_SM + (c - 2048);
    if (c < 2824) return PA_NQ + (c - 2056);
    if (c < 3784) return PA_KC + (c - 2824);
    if (c < 3808) return PA_SM + 8 + (c - 3784);
    if (c < 5344) return PA_LQ + (c - 3808);
    if (c < 5360) return PA_SM + 32 + (c - 5344);
    return NPA + (c - 5360); } };

__device__ __forceinline__ void row_pass(const float* xin, const bf16* y, const float* wpost, float scale, float* xout, const float* wnext, bf16* xn, int lane) {
    f32x4 v[4];
#pragma unroll
    for (int j = 0; j < 4; ++j) v[j] = ((const f32x4*)xin)[lane + 64 * j];
    if (y) {
        f32x4 yv[4]; float s = 0.f;
#pragma unroll
        for (int j = 0; j < 4; ++j) { const v2u yw = ((const v2u*)y)[lane + 64 * j]; yv[j] = (f32x4){bflo(yw.x), bfhi(yw.x), bflo(yw.y), bfhi(yw.y)}; s += (yv[j].x * yv[j].x + yv[j].y * yv[j].y) + (yv[j].z * yv[j].z + yv[j].w * yv[j].w); }
        const float r = scale / sqrtf(wave_sum(s) * (1.f / DM) + NORM_EPS);
#pragma unroll
        for (int j = 0; j < 4; ++j) { const f32x4 w = ((const f32x4*)wpost)[lane + 64 * j]; v[j] = v[j] + yv[j] * w * r; }
    }
    if (xout) {
#pragma unroll
        for (int j = 0; j < 4; ++j) ((f32x4*)xout)[lane + 64 * j] = v[j];
    }
    if (xn) {
        float s = 0.f;
#pragma unroll
        for (int j = 0; j < 4; ++j) s += (v[j].x * v[j].x + v[j].y * v[j].y) + (v[j].z * v[j].z + v[j].w * v[j].w);
        const float r = 1.f / sqrtf(wave_sum(s) * (1.f / DM) + NORM_EPS);
#pragma unroll
        for (int j = 0; j < 4; ++j) { const f32x4 w = ((const f32x4*)wnext)[lane + 64 * j]; const f32x4 o = v[j] * w * r;
            v2u pk; pk.x = pk2(o.x, o.y); pk.y = pk2(o.z, o.w); ((v2u*)xn)[lane + 64 * j] = pk; }
    }
}

__device__ __forceinline__ void gdn_out_item(const float* ORAW, const bf16* PA, const float* nw, bf16* OA, int t, int h, int lane) {
    const float o0 = ORAW[(size_t)t * 512 + h * 128 + 2 * lane], o1 = ORAW[(size_t)t * 512 + h * 128 + 2 * lane + 1];
    const float rr = 1.f / sqrtf(wave_sum(o0 * o0 + o1 * o1) * (1.f / 128.f) + NORM_EPS);
    const unsigned z = *(const unsigned*)(PA + (size_t)t * NPA + PA_GZ + h * 128 + 2 * lane);
    *(unsigned*)(OA + (size_t)t * 512 + h * 128 + 2 * lane) = pk2(o0 * rr * nw[2 * lane] * siluf_(bflo(z)), o1 * rr * nw[2 * lane + 1] * siluf_(bfhi(z)));
}

typedef short bf16x8 __attribute__((ext_vector_type(8)));
#define MFMA16(a, b, c) __builtin_amdgcn_mfma_f32_16x16x32_bf16((a), (b), (c), 0, 0, 0)
__device__ __forceinline__ int kperm32(int p) { const int q = p >> 3, j = p & 7; return j < 4 ? 4 * q + j : 16 + 4 * q + (j - 4); }
__device__ __forceinline__ bf16x8 pack_ctiles(const f32x4& t0, const f32x4& t1) {
    v4u w; w.x = pk2(t0[0], t0[1]); w.y = pk2(t0[2], t0[3]); w.z = pk2(t1[0], t1[1]); w.w = pk2(t1[2], t1[3]); return __builtin_bit_cast(bf16x8, w);
}
constexpr int GLA_CH = 64, NCHUNK = SEQ / 64;
constexpr size_t GLA_QD = 0, GLA_KT = GLA_QD + (size_t)NCHUNK * 4 * 8192, GLA_AI = GLA_KT + (size_t)NCHUNK * 4 * 8192, GLA_CD = GLA_AI + (size_t)NCHUNK * 4 * 8192, GLA_BYTES = GLA_CD + (size_t)NCHUNK * 4 * 256, GLA_VBYTES = (size_t)NCHUNK * 4 * 16384;
__device__ __forceinline__ void gla_prep_item(const bf16* PA, const float* SM, const float* ggw, const float* ggb, unsigned char* img, unsigned char* imgv, int n, int h, float* sl, int tid) {
    float* Qs = sl; float* Ks = sl + 64 * 65; float* BC = sl + 2 * 64 * 65; bf16* Vs = (bf16*)(sl + 3 * 64 * 65);
    const int t0 = n * 64, ch = n * 4 + h, lane = tid & 63, wave = tid >> 6;
    __syncthreads();
    {
        const int c = tid >> 3, dg = tid & 7;
        const bf16* row = PA + (size_t)(t0 + c) * NPA;
        const v4u q8 = *(const v4u*)(row + PA_LQ + h * 64 + dg * 8), k8 = *(const v4u*)(row + PA_LK + h * 64 + dg * 8);
        const float qv[8] = {bflo(q8.x), bfhi(q8.x), bflo(q8.y), bfhi(q8.y), bflo(q8.z), bfhi(q8.z), bflo(q8.w), bfhi(q8.w)};
        const float kv[8] = {bflo(k8.x), bfhi(k8.x), bflo(k8.y), bfhi(k8.y), bflo(k8.z), bfhi(k8.z), bflo(k8.w), bfhi(k8.w)};
        const float* al = SM + (size_t)(t0 + c) * 64 + 32;
        float x[8];
#pragma unroll
        for (int j = 0; j < 8; ++j) x[j] = ggb[h * 64 + dg * 8 + j];
#pragma unroll
        for (int r = 0; r < 16; ++r) { const float a = al[r];
#pragma unroll
            for (int j = 0; j < 8; ++j) x[j] += a * ggw[r * 256 + h * 64 + dg * 8 + j]; }
#pragma unroll
        for (int j = 0; j < 8; ++j) { const int d = dg * 8 + j; Qs[c * 65 + d] = qv[j] * 0.125f; Ks[c * 65 + d] = kv[j]; BC[c * 65 + d] = logsigmoidf_(x[j]) * (1.f / 16.f); }
        const v4u va = *(const v4u*)(row + PA_LV + h * 128 + dg * 16), vb = *(const v4u*)(row + PA_LV + h * 128 + dg * 16 + 8);
        *(v4u*)(Vs + c * 136 + dg * 16) = va; *(v4u*)(Vs + c * 136 + dg * 16 + 8) = vb;
    }
    __syncthreads();
    if (tid < 64) { float run = 0.f; for (int c = 0; c < 64; ++c) { run += BC[c * 65 + tid]; BC[c * 65 + tid] = run; } }
    __syncthreads();
    {
        bf16* QD = (bf16*)(img + GLA_QD) + (size_t)ch * 4096; bf16* KT = (bf16*)(img + GLA_KT) + (size_t)ch * 4096; float* CD = (float*)(img + GLA_CD) + (size_t)ch * 64;
        const int r = tid >> 3, pg = tid & 7;
        float o[8];
#pragma unroll
        for (int j = 0; j < 8; ++j) { const int p = pg * 8 + j, d = (p & 32) + kperm32(p & 31); o[j] = Qs[r * 65 + d] * expf(BC[r * 65 + d]); }
        v4u w; w.x = pk2(o[0], o[1]); w.y = pk2(o[2], o[3]); w.z = pk2(o[4], o[5]); w.w = pk2(o[6], o[7]);
        *(v4u*)(QD + r * 64 + pg * 8) = w;
#pragma unroll
        for (int j = 0; j < 8; ++j) { const int c = pg * 8 + j; o[j] = Ks[c * 65 + r] * expf(BC[63 * 65 + r] - BC[c * 65 + r]); }
        w.x = pk2(o[0], o[1]); w.y = pk2(o[2], o[3]); w.z = pk2(o[4], o[5]); w.w = pk2(o[6], o[7]);
        *(v4u*)(KT + r * 64 + pg * 8) = w;
        if (tid < 64) CD[tid] = expf(BC[63 * 65 + tid]);
        bf16* VI = (bf16*)(imgv) + (size_t)ch * 8192;
#pragma unroll
        for (int i = 0; i < 2; ++i) { const int f = tid + 512 * i, ws = f >> 7, kk = (f >> 6) & 1, l = f & 63, q = l >> 4, col = l & 15;
            unsigned short e[8];
#pragma unroll
            for (int j = 0; j < 8; ++j) e[j] = Vs[(32 * kk + 8 * q + j) * 136 + 16 * ws + col];
            v4u vw; vw.x = e[0] | ((unsigned)e[1] << 16); vw.y = e[2] | ((unsigned)e[3] << 16); vw.z = e[4] | ((unsigned)e[5] << 16); vw.w = e[6] | ((unsigned)e[7] << 16);
            *(v4u*)(VI + (size_t)f * 8) = vw; }
    }
    {
        bf16* AI = (bf16*)(img + GLA_AI) + (size_t)ch * 4096;
        const int q = lane >> 4, fr = lane & 15;
#pragma unroll 1
        for (int i = 0; i < 2; ++i) { const int tl = wave + 8 * i, ib = tl >> 2, jb = tl & 3;
            f32x4 acc = {0.f, 0.f, 0.f, 0.f};
            if (jb <= ib) {
#pragma unroll
                for (int kk = 0; kk < 2; ++kk) { float a[8], b[8];
#pragma unroll
                    for (int j = 0; j < 8; ++j) { const int d = 32 * kk + 8 * q + j; const float ref = ib > 0 ? BC[(16 * ib - 1) * 65 + d] : 0.f;
                        a[j] = Qs[(16 * ib + fr) * 65 + d] * expf(BC[(16 * ib + fr) * 65 + d] - ref);
                        b[j] = Ks[(16 * jb + fr) * 65 + d] * expf(ref - BC[(16 * jb + fr) * 65 + d]); }
                    v4u aw, bw; aw.x = pk2(a[0], a[1]); aw.y = pk2(a[2], a[3]); aw.z = pk2(a[4], a[5]); aw.w = pk2(a[6], a[7]);
                    bw.x = pk2(b[0], b[1]); bw.y = pk2(b[2], b[3]); bw.z = pk2(b[4], b[5]); bw.w = pk2(b[6], b[7]);
                    acc = MFMA16(__builtin_bit_cast(bf16x8, aw), __builtin_bit_cast(bf16x8, bw), acc); }
            }
#pragma unroll
            for (int r = 0; r < 4; ++r) { const int row = 4 * q + r; float v = acc[r]; if (jb == ib && fr > row) v = 0.f; AI[(16 * ib + row) * 64 + 16 * jb + fr] = (bf16)f2bf(v); }
        }
    }
}
constexpr int GLA_BUF = 3 * 64 * 144 + 256;
__device__ __forceinline__ void gla_scan_block(const unsigned char* img, const unsigned char* imgv, bf16* OC, int h, unsigned char* lds, int tid) {
    const int lane = tid & 63, ws = __builtin_amdgcn_readfirstlane(tid >> 6), q = lane >> 4, fr = lane & 15;
    f32x4 S[4];
#pragma unroll
    for (int i = 0; i < 4; ++i) S[i] = (f32x4){0.f, 0.f, 0.f, 0.f};
    v4u st[3]; v4u stc = {0u, 0u, 0u, 0u}; v4u vB[2];
#define GLA_FETCH(N) do { const int ch_ = (N) * 4 + h; \
        st[0] = *(const v4u*)(img + GLA_QD + (size_t)ch_ * 8192 + tid * 16); st[1] = *(const v4u*)(img + GLA_AI + (size_t)ch_ * 8192 + tid * 16); st[2] = *(const v4u*)(img + GLA_KT + (size_t)ch_ * 8192 + tid * 16); \
        if (tid < 16) stc = *(const v4u*)(img + GLA_CD + (size_t)ch_ * 256 + tid * 16); \
        vB[0] = *(const v4u*)(imgv + (size_t)ch_ * 16384 + (ws * 2 + 0) * 1024 + lane * 16); vB[1] = *(const v4u*)(imgv + (size_t)ch_ * 16384 + (ws * 2 + 1) * 1024 + lane * 16); } while (0)
#define GLA_PUT(B) do { unsigned char* b_ = lds + (B) * GLA_BUF; const int r_ = tid >> 3, c_ = tid & 7; \
        *(v4u*)(b_ + r_ * 144 + c_ * 16) = st[0]; *(v4u*)(b_ + 64 * 144 + r_ * 144 + c_ * 16) = st[1]; *(v4u*)(b_ + 2 * 64 * 144 + r_ * 144 + c_ * 16) = st[2]; \
        if (tid < 16) *(v4u*)(b_ + 3 * 64 * 144 + tid * 16) = stc; } while (0)
    __syncthreads();
    GLA_FETCH(0); GLA_PUT(0);
    __syncthreads();
    for (int n = 0; n < NCHUNK; ++n) {
        const unsigned char* b = lds + (n & 1) * GLA_BUF;
        const v4u vb0 = vB[0], vb1 = vB[1];
        if (n + 1 < NCHUNK) GLA_FETCH(n + 1);
        const bf16x8 v0 = __builtin_bit_cast(bf16x8, vb0), v1 = __builtin_bit_cast(bf16x8, vb1);
        const bf16x8 s0 = pack_ctiles(S[0], S[1]), s1 = pack_ctiles(S[2], S[3]);
        f32x4 o[4];
        bf16x8 qa[4][2], aa[6];
#pragma unroll
        for (int m = 0; m < 4; ++m) { const unsigned char* ar = b + (16 * m + fr) * 144 + q * 16;
            qa[m][0] = *(const bf16x8*)(ar); qa[m][1] = *(const bf16x8*)(ar + 64); aa[m] = *(const bf16x8*)(ar + 64 * 144); if (m >= 2) aa[2 + m] = *(const bf16x8*)(ar + 64 * 144 + 64); }
        __builtin_amdgcn_sched_barrier(0);
#pragma unroll
        for (int m = 0; m < 4; ++m) {
            f32x4 acc = {0.f, 0.f, 0.f, 0.f};
            acc = MFMA16(qa[m][0], s0, acc); acc = MFMA16(qa[m][1], s1, acc); acc = MFMA16(aa[m], v0, acc);
            if (m >= 2) acc = MFMA16(aa[2 + m], v1, acc);
            o[m] = acc;
        }
        bf16x8 kf[4][2]; f32x4 cdv[4];
#pragma unroll
        for (int dt = 0; dt < 4; ++dt) { const unsigned char* kr = b + 2 * 64 * 144 + (16 * dt + fr) * 144 + q * 16; kf[dt][0] = *(const bf16x8*)(kr); kf[dt][1] = *(const bf16x8*)(kr + 64);
            cdv[dt] = *(const f32x4*)(b + 3 * 64 * 144 + (16 * dt + 4 * q) * 4); }
        __builtin_amdgcn_sched_barrier(0);
#pragma unroll
        for (int dt = 0; dt < 4; ++dt) { f32x4 acc = S[dt] * cdv[dt]; acc = MFMA16(kf[dt][0], v0, acc); acc = MFMA16(kf[dt][1], v1, acc); S[dt] = acc; }
#pragma unroll
        for (int m = 0; m < 4; ++m)
#pragma unroll
            for (int r = 0; r < 4; ++r) OC[(size_t)(64 * n + 16 * m + 4 * q + r) * 512 + h * 128 + 16 * ws + fr] = (bf16)f2bf(o[m][r]);
        if (n + 1 < NCHUNK) GLA_PUT((n + 1) & 1);
        asm volatile("s_waitcnt lgkmcnt(0)" ::: "memory"); __builtin_amdgcn_s_barrier(); asm volatile("" ::: "memory");
    }
#undef GLA_FETCH
#undef GLA_PUT
}
__device__ __forceinline__ void out_norm_item(bf16* O, const bf16* PA, int gcol, const float* nw, int t, int h, int lane) {
    const unsigned ow = *(const unsigned*)(O + (size_t)t * 512 + h * 128 + 2 * lane);
    const float o0 = bflo(ow), o1 = bfhi(ow);
    const float rr = 1.f / sqrtf(wave_sum(o0 * o0 + o1 * o1) * (1.f / 128.f) + NORM_EPS);
    const unsigned z = *(const unsigned*)(PA + (size_t)t * NPA + gcol + h * 128 + 2 * lane);
    *(unsigned*)(O + (size_t)t * 512 + h * 128 + 2 * lane) = pk2(o0 * rr * nw[2 * lane] * siluf_(bflo(z)), o1 * rr * nw[2 * lane + 1] * siluf_(bfhi(z)));
}

constexpr size_t GDN_WI = 0, GDN_QI = GDN_WI + (size_t)NCHUNK * 4 * 16384, GDN_AT = GDN_QI + (size_t)NCHUNK * 4 * 16384, GDN_KT = GDN_AT + (size_t)NCHUNK * 4 * 8192,
                 GDN_UI = GDN_KT + (size_t)NCHUNK * 4 * 16384, GDN_DV = GDN_UI + (size_t)NCHUNK * 4 * 16384, GDN_BYTES = GDN_DV + (size_t)NCHUNK * 4 * 768;
__device__ __forceinline__ int pperm32(int k) { const int half = (k >> 4) & 1, fr = k & 15; return 8 * (fr >> 2) + 4 * half + (fr & 3); }
__device__ __forceinline__ void gdn_prep_chunk(const bf16* PA, const float* SM, const float* convw, const float* alog, const float* dtb, unsigned char* img, int n, int h, unsigned char* lds, int tid) {
    bf16* Qn = (bf16*)lds; bf16* Kn = (bf16*)(lds + 17408); bf16* Rt = (bf16*)(lds + 34816); bf16* Ts = (bf16*)(lds + 71680); float* Ls = (float*)(lds + 80896); float* gv = (float*)(lds + 98304);
    const int t0 = n * 64, ch = n * 4 + h, lane = tid & 63, wave = tid >> 6, q = lane >> 4, fr = lane & 15;
    __syncthreads();
    {
        const int c = tid >> 3, g8 = tid & 7, t = t0 + c;
        float val[3][16];
#pragma unroll
        for (int w = 0; w < 3; ++w) {
            const int c0 = w * 512 + h * 128 + g8 * 16;
#pragma unroll
            for (int i = 0; i < 16; ++i) val[w][i] = 0.f;
#pragma unroll
            for (int j = 0; j < 4; ++j) { const int tt = t - 3 + j;
                if (tt >= 0) {
                    const v4u xa = *(const v4u*)(PA + (size_t)tt * NPA + c0), xb = *(const v4u*)(PA + (size_t)tt * NPA + c0 + 8);
                    const float x[16] = {bflo(xa.x), bfhi(xa.x), bflo(xa.y), bfhi(xa.y), bflo(xa.z), bfhi(xa.z), bflo(xa.w), bfhi(xa.w), bflo(xb.x), bfhi(xb.x), bflo(xb.y), bfhi(xb.y), bflo(xb.z), bfhi(xb.z), bflo(xb.w), bfhi(xb.w)};
                    const f32x4* wp = (const f32x4*)(convw + j * 1536 + c0);
#pragma unroll
                    for (int i4 = 0; i4 < 4; ++i4) { const f32x4 wv = wp[i4]; val[w][4 * i4] += wv.x * x[4 * i4]; val[w][4 * i4 + 1] += wv.y * x[4 * i4 + 1]; val[w][4 * i4 + 2] += wv.z * x[4 * i4 + 2]; val[w][4 * i4 + 3] += wv.w * x[4 * i4 + 3]; }
                } }
#pragma unroll
            for (int i = 0; i < 16; ++i) val[w][i] = siluf_(val[w][i]);
        }
        float sq = 0.f, sk = 0.f;
#pragma unroll
        for (int i = 0; i < 16; ++i) { sq += val[0][i] * val[0][i]; sk += val[1][i] * val[1][i]; }
        sq += __shfl_xor(sq, 1); sq += __shfl_xor(sq, 2); sq += __shfl_xor(sq, 4);
        sk += __shfl_xor(sk, 1); sk += __shfl_xor(sk, 2); sk += __shfl_xor(sk, 4);
        const float rq = 0.08838834764831845f / sqrtf(sq + 1e-6f), rk = 1.f / sqrtf(sk + 1e-6f);
        const float beta = sigmoidf_(SM[(size_t)t * 64 + h]);
        v4u w0, w1;
        w0.x = pk2(val[0][0] * rq, val[0][1] * rq); w0.y = pk2(val[0][2] * rq, val[0][3] * rq); w0.z = pk2(val[0][4] * rq, val[0][5] * rq); w0.w = pk2(val[0][6] * rq, val[0][7] * rq);
        w1.x = pk2(val[0][8] * rq, val[0][9] * rq); w1.y = pk2(val[0][10] * rq, val[0][11] * rq); w1.z = pk2(val[0][12] * rq, val[0][13] * rq); w1.w = pk2(val[0][14] * rq, val[0][15] * rq);
        *(v4u*)(Qn + c * 136 + g8 * 16) = w0; *(v4u*)(Qn + c * 136 + g8 * 16 + 8) = w1;
        w0.x = pk2(val[1][0] * rk, val[1][1] * rk); w0.y = pk2(val[1][2] * rk, val[1][3] * rk); w0.z = pk2(val[1][4] * rk, val[1][5] * rk); w0.w = pk2(val[1][6] * rk, val[1][7] * rk);
        w1.x = pk2(val[1][8] * rk, val[1][9] * rk); w1.y = pk2(val[1][10] * rk, val[1][11] * rk); w1.z = pk2(val[1][12] * rk, val[1][13] * rk); w1.w = pk2(val[1][14] * rk, val[1][15] * rk);
        *(v4u*)(Kn + c * 136 + g8 * 16) = w0; *(v4u*)(Kn + c * 136 + g8 * 16 + 8) = w1;
#pragma unroll
        for (int i = 0; i < 16; ++i) Rt[(g8 * 16 + i) * 72 + c] = (bf16)f2bf(beta * val[2][i]);
        if (g8 == 0) { gv[c] = -expf(alog[h]) * softplusf_(SM[(size_t)t * 64 + 4 + h] + dtb[h]); gv[64 + c] = beta; }
    }
    __syncthreads();
    if (wave == 0) {
        float x = gv[lane];
#pragma unroll
        for (int off = 1; off < 64; off <<= 1) { const float y = __shfl_up(x, off); if (lane >= off) x += y; }
        gv[128 + lane] = x; gv[192 + lane] = expf(x);
    }
    __syncthreads();
    {
        const int c = tid >> 3, g8 = tid & 7; const float s = gv[64 + c] * gv[192 + c];
#pragma unroll
        for (int i = 0; i < 16; ++i) Rt[(128 + g8 * 16 + i) * 72 + c] = (bf16)f2bf(s * bf2f(Kn[c * 136 + g8 * 16 + i]));
    }
    {
        bf16* AT = (bf16*)(img + GDN_AT) + (size_t)ch * 4096;
#pragma unroll 1
        for (int job = wave; job < 26; job += 8) {
            int ib, jb; const bool isq = job >= 10;
            if (!isq) { int r = job; ib = 0; while (r > ib) { r -= ib + 1; ++ib; } jb = r; } else { ib = (job - 10) >> 2; jb = (job - 10) & 3; }
            f32x4 acc = {0.f, 0.f, 0.f, 0.f};
            if (jb <= ib) {
                const bf16* ap = (isq ? Qn : Kn) + (16 * ib + fr) * 136 + q * 8; const bf16* bp = Kn + (16 * jb + fr) * 136 + q * 8;
#pragma unroll
                for (int kk = 0; kk < 4; ++kk) acc = MFMA16(*(const bf16x8*)(ap + 32 * kk), *(const bf16x8*)(bp + 32 * kk), acc);
            }
            const int j = 16 * jb + fr; const float gj = gv[128 + j];
#pragma unroll
            for (int r = 0; r < 4; ++r) { const int i = 16 * ib + 4 * q + r; const float dec = expf(fminf(gv[128 + i] - gj, 0.f));
                if (!isq) Ls[i * 68 + j] = (j < i) ? gv[64 + i] * acc[r] * dec : 0.f;
                else AT[i * 64 + 32 * (jb >> 1) + 8 * (fr >> 2) + 4 * (jb & 1) + (fr & 3)] = (bf16)f2bf(j <= i ? acc[r] * dec : 0.f); }
        }
    }
    __syncthreads();
    if (wave == 0) {
        float T[64];
        int vz = 0; asm volatile("" : "+v"(vz));
        const float* Lz = Ls + vz;
#pragma unroll
        for (int i = 0; i < 64; ++i) {
            float a0 = fmaxf(0.f, 1.f - fabsf((float)(lane - i))), a1 = 0.f, a2 = 0.f, a3 = 0.f;
#pragma unroll
            for (int m4 = 0; m4 < (i + 3) / 4; ++m4) { const f32x4 lv = *(const f32x4*)(Lz + i * 68 + 4 * m4);
                if (4 * m4 < i) a0 -= lv.x * T[4 * m4]; if (4 * m4 + 1 < i) a1 -= lv.y * T[4 * m4 + 1]; if (4 * m4 + 2 < i) a2 -= lv.z * T[4 * m4 + 2]; if (4 * m4 + 3 < i) a3 -= lv.w * T[4 * m4 + 3]; }
            T[i] = (a0 + a1) + (a2 + a3);
            Ts[i * 72 + lane] = (bf16)f2bf(T[i]);
        }
    } else {
        const int t2 = tid - 64;
        bf16* QI = (bf16*)(img + GDN_QI) + (size_t)ch * 8192; bf16* KT = (bf16*)(img + GDN_KT) + (size_t)ch * 8192; float* DV = (float*)(img + GDN_DV) + (size_t)ch * 192;
        for (int it = t2; it < 64 * 16; it += 448) { const int c = it >> 4, pg = it & 15;
            unsigned short e[8];
#pragma unroll
            for (int j = 0; j < 8; ++j) { const int p = pg * 8 + j; e[j] = Qn[c * 136 + (p & ~31) + kperm32(p & 31)]; }
            v4u w; w.x = e[0] | ((unsigned)e[1] << 16); w.y = e[2] | ((unsigned)e[3] << 16); w.z = e[4] | ((unsigned)e[5] << 16); w.w = e[6] | ((unsigned)e[7] << 16);
            *(v4u*)(QI + c * 128 + pg * 8) = w; }
        for (int it = t2; it < 128 * 8; it += 448) { const int d = it >> 3, pg = it & 7;
            unsigned short e[8];
#pragma unroll
            for (int j = 0; j < 8; ++j) { const int p = pg * 8 + j; e[j] = Kn[((p & ~31) + kperm32(p & 31)) * 136 + d]; }
            v4u w; w.x = e[0] | ((unsigned)e[1] << 16); w.y = e[2] | ((unsigned)e[3] << 16); w.z = e[4] | ((unsigned)e[5] << 16); w.w = e[6] | ((unsigned)e[7] << 16);
            *(v4u*)(KT + d * 64 + pg * 8) = w; }
        if (t2 < 64) { DV[t2] = gv[192 + t2]; DV[64 + t2] = expf(gv[128 + 63] - gv[128 + t2]); if (t2 == 0) DV[128] = gv[192 + 63]; }
    }
    __syncthreads();
    {
        bf16x8 tf[4][2];
#pragma unroll
        for (int m = 0; m < 4; ++m)
#pragma unroll
            for (int kk = 0; kk < 2; ++kk) tf[m][kk] = *(const bf16x8*)(Ts + (16 * m + fr) * 72 + 32 * kk + q * 8);
#pragma unroll
        for (int cc = 0; cc < 2; ++cc) { const int ct = 2 * wave + cc;
            const bf16x8 r0 = *(const bf16x8*)(Rt + (16 * ct + fr) * 72 + q * 8), r1 = *(const bf16x8*)(Rt + (16 * ct + fr) * 72 + 32 + q * 8);
#pragma unroll
            for (int m = 0; m < 4; ++m) { f32x4 acc = {0.f, 0.f, 0.f, 0.f}; acc = MFMA16(tf[m][0], r0, acc); acc = MFMA16(tf[m][1], r1, acc);
                if (ct < 8) { v2u w; w.x = pk2(acc[0], acc[1]); w.y = pk2(acc[2], acc[3]); *(v2u*)(img + GDN_UI + (size_t)ch * 16384 + ((ct * 4 + m) * 64 + lane) * 8) = w; }
                else { const int dt = ct - 8; bf16* WI = (bf16*)(img + GDN_WI) + (size_t)ch * 8192;
#pragma unroll
                    for (int r = 0; r < 4; ++r) WI[(16 * m + 4 * q + r) * 128 + 32 * (dt >> 1) + 8 * (fr >> 2) + 4 * (dt & 1) + (fr & 3)] = (bf16)f2bf(-acc[r]); }
            } }
    }
}
__device__ __forceinline__ void gdn_step_math2(const unsigned char* b, const float* DV, f32x4 (&S)[2][8], f32x4 (&vn)[2][4], bf16* Orow, int wv, int q, int fr) {
    bf16x8 sB[2][4];
#pragma unroll
    for (int c = 0; c < 2; ++c)
#pragma unroll
        for (int kk = 0; kk < 4; ++kk) sB[c][kk] = pack_ctiles(S[c][2 * kk], S[c][2 * kk + 1]);
#pragma unroll
    for (int m = 0; m < 4; ++m) {
        bf16x8 wf[4];
        const unsigned char* wr_ = b + (16 * m + fr) * 272 + q * 16;
#pragma unroll
        for (int kk = 0; kk < 4; ++kk) wf[kk] = *(const bf16x8*)(wr_ + 64 * kk);
        __builtin_amdgcn_sched_barrier(0);
#pragma unroll
        for (int kk = 0; kk < 4; ++kk) { vn[0][m] = MFMA16(wf[kk], sB[0][kk], vn[0][m]); vn[1][m] = MFMA16(wf[kk], sB[1][kk], vn[1][m]); }
    }
    bf16x8 vb[2][2];
#pragma unroll
    for (int c = 0; c < 2; ++c) { vb[c][0] = pack_ctiles(vn[c][0], vn[c][1]); vb[c][1] = pack_ctiles(vn[c][2], vn[c][3]); }
#pragma unroll
    for (int m = 0; m < 4; ++m) {
        bf16x8 qq[4], af[2];
        const unsigned char* wr_ = b + 17408 + (16 * m + fr) * 272 + q * 16; const unsigned char* ar = b + 34816 + (16 * m + fr) * 144 + q * 16;
#pragma unroll
        for (int kk = 0; kk < 4; ++kk) qq[kk] = *(const bf16x8*)(wr_ + 64 * kk);
        af[0] = *(const bf16x8*)(ar); if (m >= 2) af[1] = *(const bf16x8*)(ar + 64);
        const f32x4 eg = *(const f32x4*)(DV + 16 * m + 4 * q);
        __builtin_amdgcn_sched_barrier(0);
#pragma unroll
        for (int c = 0; c < 2; ++c) {
            f32x4 oi = {0.f, 0.f, 0.f, 0.f};
#pragma unroll
            for (int kk = 0; kk < 4; ++kk) oi = MFMA16(qq[kk], sB[c][kk], oi);
            oi = oi * eg;
            oi = MFMA16(af[0], vb[c][0], oi); if (m >= 2) oi = MFMA16(af[1], vb[c][1], oi);
#pragma unroll
            for (int r = 0; r < 4; ++r) Orow[(size_t)(16 * m + 4 * q + r) * 512 + 16 * (wv + 4 * c) + fr] = (bf16)f2bf(oi[r]);
        }
    }
    bf16x8 xs[2][2];
#pragma unroll
    for (int c = 0; c < 2; ++c) {
#pragma unroll
        for (int m = 0; m < 4; ++m) vn[c][m] = vn[c][m] * *(const f32x4*)(DV + 64 + 16 * m + 4 * q);
        xs[c][0] = pack_ctiles(vn[c][0], vn[c][1]); xs[c][1] = pack_ctiles(vn[c][2], vn[c][3]); }
    const float cdec = DV[128];
#pragma unroll
    for (int dh = 0; dh < 4; ++dh) {
        bf16x8 kf[2][2];
#pragma unroll
        for (int di = 0; di < 2; ++di) { const unsigned char* kr = b + 44032 + (16 * (2 * dh + di) + fr) * 144 + q * 16; kf[di][0] = *(const bf16x8*)(kr); kf[di][1] = *(const bf16x8*)(kr + 64); }
        __builtin_amdgcn_sched_barrier(0);
#pragma unroll
        for (int di = 0; di < 2; ++di) { const int dt = 2 * dh + di;
#pragma unroll
            for (int c = 0; c < 2; ++c) { f32x4 acc = S[c][dt] * cdec; acc = MFMA16(kf[di][0], xs[c][0], acc); acc = MFMA16(kf[di][1], xs[c][1], acc); S[c][dt] = acc; } }
    }
}
constexpr int GDN_BUF = 2 * 17408 + 9216 + 18432 + 768;
__device__ __forceinline__ void gdn_scan_block(const unsigned char* img, bf16* OA, int h, unsigned char* lds, int tid) {
    const int lane = tid & 63, wv = __builtin_amdgcn_readfirstlane(tid >> 6), q = lane >> 4, fr = lane & 15;
#define GDN_BAR() do { asm volatile("s_waitcnt lgkmcnt(0)" ::: "memory"); __builtin_amdgcn_s_barrier(); asm volatile("" ::: "memory"); } while (0)
    __syncthreads();
    if (wv >= 4) {
        const int lt = tid - 256;
        v4u stA[14], stB[14]; v4u scA = {0u, 0u, 0u, 0u}, scB = {0u, 0u, 0u, 0u};
#define GDN_LFETCH(N, st, stc) do { const int ch_ = (N) * 4 + h; \
        _Pragma("unroll") for (int i_ = 0; i_ < 4; ++i_) { st[i_] = *(const v4u*)(img + GDN_WI + (size_t)ch_ * 16384 + (lt + 256 * i_) * 16); st[4 + i_] = *(const v4u*)(img + GDN_QI + (size_t)ch_ * 16384 + (lt + 256 * i_) * 16); \
            st[10 + i_] = *(const v4u*)(img + GDN_KT + (size_t)ch_ * 16384 + (lt + 256 * i_) * 16); } \
        st[8] = *(const v4u*)(img + GDN_AT + (size_t)ch_ * 8192 + lt * 16); st[9] = *(const v4u*)(img + GDN_AT + (size_t)ch_ * 8192 + (lt + 256) * 16); \
        if (lt < 48) stc = *(const v4u*)(img + GDN_DV + (size_t)ch_ * 768 + lt * 16); } while (0)
#define GDN_LPUT(B, st, stc) do { unsigned char* b_ = lds + (B) * GDN_BUF; \
        _Pragma("unroll") for (int i_ = 0; i_ < 4; ++i_) { const int p16 = lt + 256 * i_; \
            *(v4u*)(b_ + (p16 >> 4) * 272 + (p16 & 15) * 16) = st[i_]; *(v4u*)(b_ + 17408 + (p16 >> 4) * 272 + (p16 & 15) * 16) = st[4 + i_]; \
            *(v4u*)(b_ + 44032 + (p16 >> 3) * 144 + (p16 & 7) * 16) = st[10 + i_]; } \
        *(v4u*)(b_ + 34816 + (lt >> 3) * 144 + (lt & 7) * 16) = st[8]; *(v4u*)(b_ + 34816 + ((lt + 256) >> 3) * 144 + (lt & 7) * 16) = st[9]; \
        if (lt < 48) *(v4u*)(b_ + 62464 + lt * 16) = stc; } while (0)
        GDN_LFETCH(0, stA, scA); GDN_LFETCH(1, stB, scB); GDN_LPUT(0, stA, scA);
        GDN_BAR();
#pragma unroll 1
        for (int n = 0; n < NCHUNK; n += 2) {
            if (n + 2 < NCHUNK) GDN_LFETCH(n + 2, stA, scA);
            GDN_LPUT(1, stB, scB);
            GDN_BAR();
            if (n + 3 < NCHUNK) GDN_LFETCH(n + 3, stB, scB);
            if (n + 2 < NCHUNK) GDN_LPUT(0, stA, scA);
            GDN_BAR();
        }
#undef GDN_LFETCH
#undef GDN_LPUT
    } else {
        f32x4 S[2][8];
#pragma unroll
        for (int c = 0; c < 2; ++c)
#pragma unroll
            for (int i = 0; i < 8; ++i) S[c][i] = (f32x4){0.f, 0.f, 0.f, 0.f};
        v2u ub[2][4];
        const GAS unsigned char* ubase = (const GAS unsigned char*)(img + GDN_UI + (size_t)h * 16384 + (wv * 256 + lane) * 8);
#define GDN_UFETCH(N) do { const GAS unsigned char* p_ = ubase + (size_t)(N) * 65536; asm volatile("" : "+v"(p_)); _Pragma("unroll") for (int c_ = 0; c_ < 2; ++c_) _Pragma("unroll") for (int m_ = 0; m_ < 4; ++m_) \
        ub[c_][m_] = *(const GAS v2u*)(p_ + c_ * 8192 + m_ * 512); } while (0)
        GDN_UFETCH(0);
        GDN_BAR();
#pragma unroll 1
        for (int n = 0; n < NCHUNK; ++n) {
            const unsigned char* b = lds + (n & 1) * GDN_BUF; const float* DV = (const float*)(b + 62464);
            f32x4 vn[2][4];
#pragma unroll
            for (int c = 0; c < 2; ++c)
#pragma unroll
                for (int m = 0; m < 4; ++m) vn[c][m] = (f32x4){bflo(ub[c][m].x), bfhi(ub[c][m].x), bflo(ub[c][m].y), bfhi(ub[c][m].y)};
            if (n + 1 < NCHUNK) GDN_UFETCH(n + 1);
            gdn_step_math2(b, DV, S, vn, OA + (size_t)(64 * n) * 512 + h * 128, wv, q, fr);
            GDN_BAR();
        }
#undef GDN_UFETCH
    }
#undef GDN_BAR
}

constexpr int NSA_BUF = 64 * 208 + 64 * 144, NSA_WOFF = 2 * NSA_BUF, NSA_UOFF = NSA_WOFF + 8 * 2048;
__device__ __forceinline__ float col_max4(const f32x4 (&s)[4]) {
    float a = fmaxf(fmaxf(s[0][0], s[0][1]), fmaxf(s[0][2], s[0][3]));
#pragma unroll
    for (int i = 1; i < 4; ++i) a = fmaxf(a, fmaxf(fmaxf(s[i][0], s[i][1]), fmaxf(s[i][2], s[i][3])));
    a = fmaxf(a, __shfl_xor(a, 16)); a = fmaxf(a, __shfl_xor(a, 32)); return a;
}
constexpr float NSA_SC2 = 0.10206207261596577f * 1.4426950408889634f, NSA_MASK = -1.0e30f;
template <bool WINDOW>
__device__ __forceinline__ void nsa_lds_block(const unsigned char* kb, int pos0, int t, int t0, bool colsel, int head, const bf16x8 (&qf)[3],
                                              const LAS float* relb, const LAS int* btab, float& m, float& l, f32x4 (&o)[4], int lane) {
    const int q = lane >> 4, fr = lane & 15;
    f32x4 s[4];
#pragma unroll
    for (int rp = 0; rp < 2; ++rp) {
        bf16x8 kfr[2][3];
#pragma unroll
        for (int ri = 0; ri < 2; ++ri) { const unsigned char* kp = kb + (16 * (2 * rp + ri) + fr) * 208 + q * 16;
#pragma unroll
            for (int kk = 0; kk < 3; ++kk) kfr[ri][kk] = *(const bf16x8*)(kp + 64 * kk); }
        __builtin_amdgcn_sched_barrier(0);
#pragma unroll
        for (int ri = 0; ri < 2; ++ri) { f32x4 acc = {0.f, 0.f, 0.f, 0.f};
#pragma unroll
            for (int kk = 0; kk < 3; ++kk) acc = MFMA16(kfr[ri][kk], qf[kk], acc);
            s[2 * rp + ri] = acc; }
    }
    v2u va[2][4];
#pragma unroll
    for (int dt = 0; dt < 2; ++dt) { const unsigned char* vp = kb + 64 * 208 + (16 * dt + fr) * 144 + q * 8;
        va[dt][0] = *(const v2u*)(vp); va[dt][1] = *(const v2u*)(vp + 32); va[dt][2] = *(const v2u*)(vp + 64); va[dt][3] = *(const v2u*)(vp + 96); }
    __builtin_amdgcn_sched_barrier(0);
    const float bfar = relb[31 * 8 + head];
    const bool fast = (pos0 + 63 + 128 <= t0) && (!WINDOW || pos0 >= t0 + 3 - 511);
    if (fast) {
        const float bc = colsel ? bfar : NSA_MASK;
#pragma unroll
        for (int rt = 0; rt < 4; ++rt)
#pragma unroll
            for (int r = 0; r < 4; ++r) s[rt][r] = colsel ? s[rt][r] * NSA_SC2 + bc : NSA_MASK;
    } else {
#pragma unroll
        for (int rt = 0; rt < 4; ++rt)
#pragma unroll
            for (int r = 0; r < 4; ++r) { const int pos = pos0 + 16 * rt + 4 * q + r, dist = t - pos;
                bool ok = colsel && dist >= 0; if (WINDOW) ok = ok && dist < 512;
                const int dd = dist < 0 ? 0 : dist; const float bias = relb[(dd < 128 ? btab[dd] : 31) * 8 + head];
                s[rt][r] = ok ? s[rt][r] * NSA_SC2 + bias : NSA_MASK; }
    }
    const float bm = col_max4(s);
    const float mn = fmaxf(m, bm);
    const float corr = __builtin_amdgcn_exp2f(m - mn);
    float ps = 0.f;
#pragma unroll
    for (int rt = 0; rt < 4; ++rt)
#pragma unroll
        for (int r = 0; r < 4; ++r) { const float p = __builtin_amdgcn_exp2f(s[rt][r] - mn); s[rt][r] = p; ps += p; }
    ps += __shfl_xor(ps, 16); ps += __shfl_xor(ps, 32);
    l = l * corr + ps; m = mn;
    const bf16x8 pb0 = pack_ctiles(s[0], s[1]), pb1 = pack_ctiles(s[2], s[3]);
    v2u vb[2][4];
#pragma unroll
    for (int dt = 0; dt < 2; ++dt) { const unsigned char* vp = kb + 64 * 208 + (16 * (2 + dt) + fr) * 144 + q * 8;
        vb[dt][0] = *(const v2u*)(vp); vb[dt][1] = *(const v2u*)(vp + 32); vb[dt][2] = *(const v2u*)(vp + 64); vb[dt][3] = *(const v2u*)(vp + 96); }
#pragma unroll
    for (int dt = 0; dt < 2; ++dt) {
        v4u w0; w0.x = va[dt][0].x; w0.y = va[dt][0].y; w0.z = va[dt][1].x; w0.w = va[dt][1].y;
        v4u w1; w1.x = va[dt][2].x; w1.y = va[dt][2].y; w1.z = va[dt][3].x; w1.w = va[dt][3].y;
        f32x4 acc = o[dt] * corr;
        acc = MFMA16(__builtin_bit_cast(bf16x8, w0), pb0, acc); acc = MFMA16(__builtin_bit_cast(bf16x8, w1), pb1, acc);
        o[dt] = acc;
    }
#pragma unroll
    for (int dt = 0; dt < 2; ++dt) {
        v4u w0; w0.x = vb[dt][0].x; w0.y = vb[dt][0].y; w0.z = vb[dt][1].x; w0.w = vb[dt][1].y;
        v4u w1; w1.x = vb[dt][2].x; w1.y = vb[dt][2].y; w1.z = vb[dt][3].x; w1.w = vb[dt][3].y;
        f32x4 acc = o[2 + dt] * corr;
        acc = MFMA16(__builtin_bit_cast(bf16x8, w0), pb0, acc); acc = MFMA16(__builtin_bit_cast(bf16x8, w1), pb1, acc);
        o[2 + dt] = acc;
    }
}
#define NSA_FETCH_KV(KCOL, VT, POS0, sg) do { \
        { const int c_ = tid, r_ = c_ / 12, x_ = c_ % 12; sg[0] = *(const v4u*)(PA + (size_t)((POS0) + r_) * NPA + (KCOL) + g * 160 + x_ * 8); } \
        { const int c_ = tid + 512; if (c_ < 768) { const int r_ = c_ / 12, x_ = c_ % 12; sg[1] = *(const v4u*)(PA + (size_t)((POS0) + r_) * NPA + (KCOL) + g * 160 + x_ * 8); } \
          else { const int v_ = c_ - 768, r_ = v_ >> 3, x_ = v_ & 7; sg[1] = *(const v4u*)((VT) + (size_t)(g * 64 + r_) * SEQ + (POS0) + x_ * 8); } } \
        if (tid < 256) { const int v_ = tid + 256, r_ = v_ >> 3, x_ = v_ & 7; sg[2] = *(const v4u*)((VT) + (size_t)(g * 64 + r_) * SEQ + (POS0) + x_ * 8); } } while (0)
#define NSA_PUT_KV(B, sg) do { unsigned char* b_ = lds + (B) * NSA_BUF; \
        { const int c_ = tid, r_ = c_ / 12, x_ = c_ % 12; *(v4u*)(b_ + r_ * 208 + x_ * 16) = sg[0]; } \
        { const int c_ = tid + 512; if (c_ < 768) { const int r_ = c_ / 12, x_ = c_ % 12; *(v4u*)(b_ + r_ * 208 + x_ * 16) = sg[1]; } \
          else { const int v_ = c_ - 768, r_ = v_ >> 3, x_ = v_ & 7; *(v4u*)(b_ + 64 * 208 + r_ * 144 + x_ * 16) = sg[1]; } } \
        if (tid < 256) { const int v_ = tid + 256, r_ = v_ >> 3, x_ = v_ & 7; *(v4u*)(b_ + 64 * 208 + r_ * 144 + x_ * 16) = sg[2]; } } while (0)
#define NSA_FETCH_C(PR, sg) do { \
        { const int c_ = tid, hl_ = c_ / 384, r_ = (c_ % 384) / 12, x_ = c_ % 12; sg[0] = *(const v4u*)((hl_ ? KCL : KCH) + (size_t)((32 * (PR) + r_) * 2 + g) * 96 + x_ * 8); } \
        { const int c_ = tid + 512; if (c_ < 768) { const int hl_ = c_ / 384, r_ = (c_ % 384) / 12, x_ = c_ % 12; sg[1] = *(const v4u*)((hl_ ? KCL : KCH) + (size_t)((32 * (PR) + r_) * 2 + g) * 96 + x_ * 8); } \
          else { const int v_ = c_ - 768, r_ = v_ >> 2, x_ = v_ & 3; sg[1] = *(const v4u*)(VCT + (size_t)(g * 64 + r_) * 512 + 32 * (PR) + x_ * 8); } } } while (0)
#define NSA_PUT_C(B, sg) do { unsigned char* b_ = lds + (B) * NSA_BUF; \
        { const int c_ = tid, hl_ = c_ / 384, r_ = (c_ % 384) / 12, x_ = c_ % 12; *(v4u*)(b_ + (hl_ * 32 + r_) * 208 + x_ * 16) = sg[0]; } \
        { const int c_ = tid + 512; if (c_ < 768) { const int hl_ = c_ / 384, r_ = (c_ % 384) / 12, x_ = c_ % 12; *(v4u*)(b_ + (hl_ * 32 + r_) * 208 + x_ * 16) = sg[1]; } \
          else { const int v_ = c_ - 768, r_ = v_ >> 2, x_ = v_ & 3; *(v4u*)(b_ + 64 * 208 + r_ * 80 + x_ * 16) = sg[1]; } } } while (0)
#define NSA_PIPELINE(NS, FETCH, PUT, COMPUTE) do { const int ns_ = (NS); \
        FETCH(0, sgA); if (ns_ > 1) FETCH(1, sgB); PUT(0, sgA); __syncthreads(); \
        _Pragma("unroll 1") for (int i_ = 0; i_ < ns_; i_ += 2) { \
            if (i_ + 2 < ns_) FETCH(i_ + 2, sgA); COMPUTE(i_, 0); if (i_ + 1 < ns_) PUT(1, sgB); __syncthreads(); \
            if (i_ + 1 < ns_) { if (i_ + 3 < ns_) FETCH(i_ + 3, sgB); COMPUTE(i_ + 1, 1); if (i_ + 2 < ns_) PUT(0, sgA); } __syncthreads(); \
        } } while (0)
struct NsaCmp { float m, l, M, inv, carry; };
__device__ __forceinline__ float nsa_cmp_score(float acc, int n, int ncv, int t, int head, const LAS float* relb, const LAS int* btab) {
    const int dist = t - (16 * n + 31); const int dd = dist < 0 ? 0 : dist;
    return (n < ncv) ? acc * NSA_SC2 + relb[(dd < 128 ? btab[dd] : 31) * 8 + head] : NSA_MASK;
}
__device__ __forceinline__ void nsa_cmp_tile(const unsigned char* kb, int u, int T, int ncv, int t, int t0, int head, const bf16x8 (&qf)[3], const LAS float* relb, const LAS int* btab, float (&sv)[4], int lane) {
    const int q = lane >> 4, fr = lane & 15;
    const unsigned char* kp = kb + (16 * u + fr) * 208 + q * 16;
    bf16x8 kh[3], kl[3];
#pragma unroll
    for (int kk = 0; kk < 3; ++kk) { kh[kk] = *(const bf16x8*)(kp + 64 * kk); kl[kk] = *(const bf16x8*)(kp + 32 * 208 + 64 * kk); }
    __builtin_amdgcn_sched_barrier(0);
    f32x4 acc = {0.f, 0.f, 0.f, 0.f};
#pragma unroll
    for (int kk = 0; kk < 3; ++kk) { acc = MFMA16(kh[kk], qf[kk], acc); acc = MFMA16(kl[kk], qf[kk], acc); }
    const int nlast = 16 * T + 15;
    if (16 * nlast + 31 + 128 <= t0) {
        const float bfar = relb[31 * 8 + head];
#pragma unroll
        for (int r = 0; r < 4; ++r) sv[r] = acc[r] * NSA_SC2 + bfar;
    } else {
#pragma unroll
        for (int r = 0; r < 4; ++r) sv[r] = nsa_cmp_score(acc[r], 16 * T + 4 * q + r, ncv, t, head, relb, btab);
    }
}
__device__ __forceinline__ void nsa_cmp_pass1(const unsigned char* kb, int pr, int ntile, int ncv, int t, int t0, int head, const bf16x8 (&qf)[3], const LAS float* relb, const LAS int* btab, NsaCmp& c, int lane) {
#pragma unroll
    for (int u = 0; u < 2; ++u) { const int T = 2 * pr + u;
        if (T < ntile) {
            float sv[4]; nsa_cmp_tile(kb, u, T, ncv, t, t0, head, qf, relb, btab, sv, lane);
            const float mn = fmaxf(c.m, fmaxf(fmaxf(sv[0], sv[1]), fmaxf(sv[2], sv[3])));
            const float ps = (__builtin_amdgcn_exp2f(sv[0] - mn) + __builtin_amdgcn_exp2f(sv[1] - mn)) + (__builtin_amdgcn_exp2f(sv[2] - mn) + __builtin_amdgcn_exp2f(sv[3] - mn));
            c.l = c.l * __builtin_amdgcn_exp2f(c.m - mn) + ps; c.m = mn;
        } }
}
__device__ __forceinline__ void nsa_cmp_pass2(const unsigned char* kb, int pr, int ntile, int ncv, int t, int t0, int head, const bf16x8 (&qf)[3], const LAS float* relb, const LAS int* btab, NsaCmp& c, f32x4 (&oc)[4], float* imp, int lane) {
    const int q = lane >> 4, fr = lane & 15, tl = fr >> 2, hh = fr & 3;
    if (2 * pr >= ntile) return;
    f32x4 pt[2];
#pragma unroll
    for (int u = 0; u < 2; ++u) { const int T = 2 * pr + u;
        float sv[4] = {NSA_MASK, NSA_MASK, NSA_MASK, NSA_MASK};
        if (T < ntile) nsa_cmp_tile(kb, u, T, ncv, t, t0, head, qf, relb, btab, sv, lane);
#pragma unroll
        for (int r = 0; r < 4; ++r) pt[u][r] = (sv[r] > -1.0e29f) ? __builtin_amdgcn_exp2f(sv[r] - c.M) * c.inv : 0.f;
        const float x3 = pt[u][3];
        float prev = __shfl(x3, (lane + 48) & 63);
        const float nxt = __shfl(x3, 48 + fr);
        if (q == 0) prev = c.carry;
        c.carry = nxt;
        float v = ((pt[u][0] + pt[u][1]) + (pt[u][2] + pt[u][3])) + prev;
        v += __shfl_xor(v, 1); v += __shfl_xor(v, 2);
        if (hh == 0 && T < ntile) imp[tl * 128 + 4 * T + q] = v;
    }
    const bf16x8 pb = pack_ctiles(pt[0], pt[1]);
    v2u va[4][2];
#pragma unroll
    for (int dt = 0; dt < 4; ++dt) { const unsigned char* vp = kb + 64 * 208 + (16 * dt + fr) * 80 + q * 8; va[dt][0] = *(const v2u*)(vp); va[dt][1] = *(const v2u*)(vp + 32); }
    __builtin_amdgcn_sched_barrier(0);
#pragma unroll
    for (int dt = 0; dt < 4; ++dt) { v4u w0; w0.x = va[dt][0].x; w0.y = va[dt][0].y; w0.z = va[dt][1].x; w0.w = va[dt][1].y;
        oc[dt] = MFMA16(__builtin_bit_cast(bf16x8, w0), pb, oc[dt]); }
}
__device__ __forceinline__ void nsa_unit(const bf16* PA, const float* SM, const bf16* KCH, const bf16* KCL, const bf16* VCT, const bf16* VTS, const bf16* VTW,
                                         const LAS float* relb, const LAS int* btab, bf16* OB, int T0, int g, unsigned char* lds, int tid, int abl) {
    asm volatile("" : "+v"(tid));
    const int lane = tid & 63, wave = __builtin_amdgcn_readfirstlane(tid >> 6), q = lane >> 4, fr = lane & 15, tl = fr >> 2, hh = fr & 3;
    const int t0 = T0 + 4 * wave, t = t0 + tl, head = g * 4 + hh;
    v4u sgA[3] = {}, sgB[3] = {};
    bf16x8 qf[3];
#pragma unroll
    for (int kk = 0; kk < 3; ++kk) qf[kk] = *(const bf16x8*)(PA + (size_t)t * NPA + PA_NQ + head * 96 + 32 * kk + q * 8);
    float* imp = (float*)(lds + NSA_WOFF + wave * 2048);
    __syncthreads();
#pragma unroll
    for (int i = 0; i < 8; ++i) imp[lane + 64 * i] = 0.f;
    const int ncv = t >= 31 ? (t - 31) / 16 + 1 : 0;
    const int ncvw = (t0 + 3) >= 31 ? (t0 + 3 - 31) / 16 + 1 : 0;
    const int ncvu = (T0 + 31) >= 31 ? (T0 + 31 - 31) / 16 + 1 : 0;
    const int ntile = (ncvw + 15) >> 4, npair = (ncvu + 31) >> 5;
    f32x4 oc[4];
#pragma unroll
    for (int dt = 0; dt < 4; ++dt) oc[dt] = (f32x4){0.f, 0.f, 0.f, 0.f};
    if (npair > 0) {
        NsaCmp c; c.m = NSA_MASK; c.l = 0.f; c.M = 0.f; c.inv = 0.f; c.carry = 0.f;
#define F_C(i, sg) NSA_FETCH_C((i), sg)
#define P_C(b, sg) NSA_PUT_C((b), sg)
#define C_P1(i, b) if (!(abl & 4)) nsa_cmp_pass1(lds + (b) * NSA_BUF, (i), ntile, ncv, t, t0, head, qf, relb, btab, c, lane)
        NSA_PIPELINE(npair, F_C, P_C, C_P1);
        c.M = fmaxf(c.m, __shfl_xor(c.m, 16)); c.M = fmaxf(c.M, __shfl_xor(c.M, 32));
        float lt = c.l * __builtin_amdgcn_exp2f(c.m - c.M);
        lt += __shfl_xor(lt, 16); lt += __shfl_xor(lt, 32);
        c.inv = lt > 0.f ? 1.f / lt : 0.f;
#define C_P2(i, b) if (!(abl & 4)) nsa_cmp_pass2(lds + (b) * NSA_BUF, (i), ntile, ncv, t, t0, head, qf, relb, btab, c, oc, imp, lane)
        NSA_PIPELINE(npair, F_C, P_C, C_P2);
#undef F_C
#undef P_C
#undef C_P1
#undef C_P2
    }
    LDS_WAIT(); asm volatile("" ::: "memory");
    const int blk_t = T0 >> 6; const int nsel = blk_t + 1 < 16 ? blk_t + 1 : 16;
    unsigned long long msk_lo[4], msk_hi[4];
#pragma unroll
    for (int tk = 0; tk < 4; ++tk) {
        unsigned k0, k1; { const int s0 = lane, s1 = lane + 64;
            k0 = (s0 == 0 || s0 == blk_t || s0 == blk_t - 1) ? 0xffffffffu : (s0 > blk_t ? 0u : __float_as_uint(imp[tk * 128 + s0]) + 1u);
            k1 = (s1 == blk_t || s1 == blk_t - 1) ? 0xffffffffu : (s1 > blk_t ? 0u : __float_as_uint(imp[tk * 128 + s1]) + 1u); }
        unsigned th = 0u;
#pragma unroll 1
        for (int bit = 31; bit >= 0; --bit) { const unsigned cand = th | (1u << bit);
            const int cnt = __builtin_popcountll(__ballot(k0 >= cand)) + __builtin_popcountll(__ballot(k1 >= cand));
            if (cnt >= nsel) th = cand; }
        const unsigned long long g0 = __ballot(k0 > th), g1 = __ballot(k1 > th), e0 = __ballot(k0 == th), e1 = __ballot(k1 == th);
        int need = nsel - (__builtin_popcountll(g0) + __builtin_popcountll(g1));
        unsigned long long t0m = 0ull, t1m = 0ull;
        { unsigned long long r = e0; while (need > 0 && r) { const unsigned long long low = r & (~r + 1ull); t0m |= low; r ^= low; --need; } }
        { unsigned long long r = e1; while (need > 0 && r) { const unsigned long long low = r & (~r + 1ull); t1m |= low; r ^= low; --need; } }
        msk_lo[tk] = g0 | t0m; msk_hi[tk] = g1 | t1m;
    }
    const unsigned long long wlo = (msk_lo[0] | msk_lo[1]) | (msk_lo[2] | msk_lo[3]), whi = (msk_hi[0] | msk_hi[1]) | (msk_hi[2] | msk_hi[3]);
    unsigned char* sel4 = lds + NSA_UOFF + 1024 + wave * 128;
    { const unsigned n0 = (unsigned)(((msk_lo[0] >> lane) & 1ull) | (((msk_lo[1] >> lane) & 1ull) << 1) | (((msk_lo[2] >> lane) & 1ull) << 2) | (((msk_lo[3] >> lane) & 1ull) << 3));
      const unsigned n1 = (unsigned)(((msk_hi[0] >> lane) & 1ull) | (((msk_hi[1] >> lane) & 1ull) << 1) | (((msk_hi[2] >> lane) & 1ull) << 2) | (((msk_hi[3] >> lane) & 1ull) << 3));
      sel4[lane] = (unsigned char)n0; sel4[lane + 64] = (unsigned char)n1; }
    unsigned long long* um = (unsigned long long*)(lds + NSA_UOFF);
    unsigned char* blist = lds + NSA_UOFF + 512;
    if (lane == 0) { um[wave * 2] = wlo; um[wave * 2 + 1] = whi; }
    __syncthreads();
    int nblk;
    {
        unsigned long long ulo = 0ull, uhi = 0ull;
#pragma unroll
        for (int w = 0; w < 8; ++w) { ulo |= um[w * 2]; uhi |= um[w * 2 + 1]; }
        nblk = __builtin_popcountll(ulo) + __builtin_popcountll(uhi);
        if (tid < 128) { const bool in = tid < 64 ? ((ulo >> tid) & 1ull) : ((uhi >> (tid - 64)) & 1ull);
            if (in) { const int rank = tid < 64 ? __builtin_popcountll(ulo & ((1ull << tid) - 1ull)) : __builtin_popcountll(ulo) + __builtin_popcountll(uhi & ((1ull << (tid - 64)) - 1ull));
                blist[rank] = (unsigned char)tid; } }
        nblk = __builtin_amdgcn_readfirstlane(nblk);
    }
    __syncthreads();
    f32x4 os[4]; float ms = NSA_MASK, ls = 0.f;
#pragma unroll
    for (int dt = 0; dt < 4; ++dt) os[dt] = (f32x4){0.f, 0.f, 0.f, 0.f};
#define F_S(i, sg) do { if (!(abl & 8)) { const int sb_ = blist[(i)]; NSA_FETCH_KV(PA_KS, VTS, 64 * sb_, sg); } } while (0)
#define P_S(b, sg) NSA_PUT_KV((b), sg)
#define C_S(i, b) do { const int cur_ = __builtin_amdgcn_readfirstlane((int)blist[(i)]); const unsigned s4_ = __builtin_amdgcn_readfirstlane((unsigned)sel4[cur_]); \
        if (s4_ && !(abl & 1)) nsa_lds_block<false>(lds + (b) * NSA_BUF, 64 * cur_, t, t0, (s4_ >> tl) & 1u, head, qf, relb, btab, ms, ls, os, lane); } while (0)
    NSA_PIPELINE(nblk, F_S, P_S, C_S);
#undef F_S
#undef P_S
#undef C_S
    f32x4 ow[4]; float mw = NSA_MASK, lw = 0.f;
#pragma unroll
    for (int dt = 0; dt < 4; ++dt) ow[dt] = (f32x4){0.f, 0.f, 0.f, 0.f};
    const int wb0 = (T0 - 511) < 0 ? 0 : (T0 - 511) >> 6, wb1 = (T0 + 31) >> 6;
#define F_W(i, sg) NSA_FETCH_KV(PA_KW, VTW, 64 * (wb0 + (i)), sg)
#define P_W(b, sg) NSA_PUT_KV((b), sg)
#define C_W(i, b) do { const int bi_ = wb0 + (i); if (64 * bi_ + 63 >= t0 - 511 && 64 * bi_ <= t0 + 3 && !(abl & 2)) \
        nsa_lds_block<true>(lds + (b) * NSA_BUF, 64 * bi_, t, t0, true, head, qf, relb, btab, mw, lw, ow, lane); } while (0)
    NSA_PIPELINE(wb1 - wb0 + 1, F_W, P_W, C_W);
#undef F_W
#undef P_W
#undef C_W
    const float* gl = SM + (size_t)t * 64 + 8 + head * 3;
    const float gc = sigmoidf_(gl[0]), gs = sigmoidf_(gl[1]) / ls, gw = sigmoidf_(gl[2]) / lw;
#pragma unroll
    for (int dt = 0; dt < 4; ++dt) { const f32x4 o = oc[dt] * gc + os[dt] * gs + ow[dt] * gw;
        v2u w; w.x = pk2(o[0], o[1]); w.y = pk2(o[2], o[3]);
        *(v2u*)(OB + (size_t)t * 512 + head * 64 + 16 * dt + 4 * q) = w; }
    asm volatile("" ::: "memory");
}
__device__ __forceinline__ void nsa_vt_item(const bf16* PA, bf16* VTS, bf16* VTW, int item, unsigned short* wl, int lane) {
    const int chunk = item >> 2, g = (item >> 1) & 1, which = item & 1;
    const int kcol = which ? PA_KW : PA_KS; bf16* VT = which ? VTW : VTS;
    for (int i = 0; i < 8; ++i) { const int tt = i * 8 + (lane >> 3), c8 = lane & 7;
        const v4u x = *(const v4u*)(PA + (size_t)(chunk * 64 + tt) * NPA + kcol + g * 160 + 96 + c8 * 8);
        unsigned* d = (unsigned*)(wl + tt * 66 + c8 * 8); d[0] = x.x; d[1] = x.y; d[2] = x.z; d[3] = x.w; }
    LDS_WAIT(); asm volatile("" ::: "memory");
    for (int i = 0; i < 8; ++i) { const int dv = i * 8 + (lane >> 3), c8 = lane & 7;
        unsigned short e[8];
#pragma unroll
        for (int j = 0; j < 8; ++j) e[j] = wl[(c8 * 8 + j) * 66 + dv];
        v4u w; w.x = e[0] | ((unsigned)e[1] << 16); w.y = e[2] | ((unsigned)e[3] << 16); w.z = e[4] | ((unsigned)e[5] << 16); w.w = e[6] | ((unsigned)e[7] << 16);
        *(v4u*)(VT + (size_t)(g * 64 + dv) * SEQ + chunk * 64 + c8 * 8) = w; }
    LDS_WAIT(); asm volatile("" ::: "memory");
}

constexpr size_t CMP_KCF = 0, CMP_VCF = 3328 * 1024, CMP_H1K = 5632 * 1024, CMP_H1V = 6144 * 1024;
constexpr size_t CW_W1K = 0, CW_W1V = 1536 * 1024, CW_BPART = 2560 * 1024, CW_BIAS = CW_BPART + 2 * 16 * 256 * 4, CW_W2K = 2688 * 1024, CW_W2V = CW_W2K + 96 * 256 * 2;
constexpr size_t CMP_PART = 8 * 1024 * 1024;
template <int ND>
__device__ __forceinline__ void cmp_layer2(const float* hrow, const float* w2, int nd_total, float (&acc)[ND]) {
#pragma unroll
    for (int i = 0; i < ND; ++i) acc[i] = 0.f;
#pragma unroll 4
    for (int j = 0; j < 256; ++j) {
        const float hv = hrow[j];
        const f32x4* wp = (const f32x4*)(w2 + (size_t)j * nd_total);
#pragma unroll
        for (int i4 = 0; i4 < ND / 4; ++i4) { const f32x4 wv = wp[i4]; acc[4 * i4] += hv * wv.x; acc[4 * i4 + 1] += hv * wv.y; acc[4 * i4 + 2] += hv * wv.z; acc[4 * i4 + 3] += hv * wv.w; }
    }
}

constexpr int PH_PER_LAYER = 22, NPHASES = DEPTH * PH_PER_LAYER;
#ifndef PROBE_ABL
#define PROBE_ABL 0
#endif
enum { K_CONV = 0, K_F1, K_GF32, K_ROWS, K_M1, K_M2, K_M3, K_M4, K_M5, K_M2B };
constexpr size_t ALPHA_OFF = 276 * MiB;
static_assert(ALPHA_OFF + GLA_BYTES <= 290 * MiB && WS_WGU + GLA_VBYTES <= WS_WD && WS_QKV + GDN_BYTES <= WS_KCMP, "gla/gdn images");
__global__ void __launch_bounds__(NTHR, 2) mk_fwd(Args args) {
    extern __shared__ __attribute__((aligned(16))) unsigned char lds[];
    LAS unsigned char* ldsl = (LAS unsigned char*)lds;
    {
        const int tid = threadIdx.x;
        for (int u = tid; u < (LDS_BYTES - LDSCTL_OFF) / 4; u += NTHR) ((LAS unsigned*)(ldsl + LDSCTL_OFF))[u] = 0u;
        __syncthreads();
        LAS int* btab = (LAS int*)(ldsl + BTAB_OFF);
        if (tid < 128) { int b = tid; if (tid >= 16) { const float v = logf((float)tid / 16.f) / 2.0794415416798357f * 16.f; b = 16 + (int)v; if (b > 31) b = 31; } btab[tid] = b; }
        if (tid < 256) ((LAS float*)(ldsl + RELB_OFF))[tid] = args.in[I_RELB][tid] * 1.4426950408889634f;
        __syncthreads();
    }
#if MK_ONE_LAUNCH
    XcdBarrier bar = xcd_barrier_post((unsigned*)(args.ws + WS_CTL) + CW_BAR, (volatile LAS unsigned*)(ldsl + MISC_OFF) + 8);
#endif
#pragma unroll 1
    for (int pc = args.ph_lo; pc < args.ph_hi; ++pc) {
        const __attribute__((address_space(4))) Args* ap = (const __attribute__((address_space(4))) Args*)__builtin_amdgcn_kernarg_segment_ptr();
        asm volatile("" : "+s"(ap));
#define args (*ap)
        const unsigned pe = args.prog[pc];
        const int kind = pe & 15, sub = (pe >> 4) & 1, b = (pe >> 5) & 1, l = (pe >> 6) & 1, pmode = (pe >> 8) & 3; const bool mixer = (pe >> 7) & 1;
        unsigned char* ws = args.ws;
        int tid_ = threadIdx.x; asm volatile("" : "+v"(tid_));
        const int tid = tid_, lane = tid & 63, wave = __builtin_amdgcn_readfirstlane(tid >> 6);
        const int G = gridDim.x, bx = blockIdx.x;
        const int vcu = (G % 8 == 0) ? (bx % 8) * (G / 8) + bx / 8 : bx;
        const int gw = vcu * NWAVES + wave, NGW = G * NWAVES;
        switch (kind) {
        case K_CONV: {
            bf16* WGU = (bf16*)(ws + WS_WGU); bf16* WD = (bf16*)(ws + WS_WD); bf16* WIN = (bf16*)(ws + WS_WIN); bf16* WB = (bf16*)(ws + WS_WB); bf16* WO = (bf16*)(ws + WS_WO);
            LAS float* scr = (LAS float*)(ldsl + wave * 16384);
            const float* w_gu = args.in[sub ? I_F2GU : I_F1GU] + (size_t)l * DM * 2 * DFF;
            const float* w_dn = args.in[sub ? I_F2D : I_F1D] + (size_t)l * DFF * DM;
            constexpr int I_GU = (DM / 64) * (2 * DFF / 32), I_DN = (DFF / 64) * (DM / 32), I_IN = (DM / 64) * ((DIN_SRC + 31) / 32), I_BR = (512 / 64) * (DM / 32), I_OUT = (DM / 64) * (DM / 32);
            const int nitems = I_GU + I_DN + (sub == 0 ? I_IN + 3 * I_BR + I_OUT : 0);
            for (int it = gw; it < nitems; it += NGW) {
                int r = it;
                if (r < I_GU) { transpose_item(w_gu, DM, 2 * DFF, WGU, scr, r, lane, MapGU()); continue; } r -= I_GU;
                if (r < I_DN) { transpose_item(w_dn, DFF, DM, WD, scr, r, lane, MapId()); continue; } r -= I_DN;
                if (r < I_IN) { transpose_item(args.in[I_WIN] + (size_t)l * DM * DIN_SRC, DM, DIN_SRC, WIN, scr, r, lane, MapWin()); continue; } r -= I_IN;
                if (r < 3 * I_BR) { const int br = r / I_BR; transpose_item(args.in[I_WBG + br] + (size_t)l * 512 * DM, 512, DM, WB + (size_t)br * 512 * 1024, scr, r % I_BR, lane, MapId()); continue; } r -= 3 * I_BR;
                transpose_item(args.in[I_WOUT] + (size_t)l * DM * DM, DM, DM, WO, scr, r, lane, MapId());
            }
            if (sub == 0) { for (int i = gw * 64 + lane; i < 16 * DM / 2; i += NGW * 64) ((unsigned*)(WIN + (size_t)(PA_SM + 48) * DM))[i] = 0u; }
            if (l == 0 && sub == 0) { const float* n_pre = args.in[I_F1PRE]; bf16* XN = (bf16*)(ws + WS_XN);
                for (int m = gw; m < MTOK; m += NGW) row_pass(args.in[I_X] + (size_t)m * DM, nullptr, nullptr, 0.f, nullptr, n_pre, XN + (size_t)m * DM, lane); }
        } break;
        case K_F1: {
            pg8::Gemm g{(const bf16*)(ws + WS_XN), (const bf16*)(ws + WS_WGU), MTOK, 2 * DFF, DM, DM, DM}; pg8::StaticOrder S; S.init(MTOK, 2 * DFF, G, bx); pg8::EpiSwiglu E{(bf16*)(ws + WS_H), DFF};
            pg8::gemm_phase<pg8::EpiSwiglu, pg8::StaticOrder, true, true>(ldsl, g, S, E);
        } break;
        case K_GF32: {
            pg8::Gemm g; pg8::EpiY16 E; pg8::StaticOrder S;
            if (mixer) { g = pg8::Gemm{(const bf16*)(ws + WS_MG), (const bf16*)(ws + WS_WO), SEQ, DM, DM, DM, DM}; E = pg8::EpiY16{(bf16*)(ws + WS_YB), DM}; S.init(SEQ, DM, G, bx); }
            else { g = pg8::Gemm{(const bf16*)(ws + WS_H), (const bf16*)(ws + WS_WD), MTOK, DM, DFF, DFF, DFF}; E = pg8::EpiY16{(bf16*)(ws + WS_Y), DM}; S.init(MTOK, DM, G, bx); }
            pg8::gemm_phase<pg8::EpiY16, pg8::StaticOrder, true, true>(ldsl, g, S, E);
        } break;
        case K_ROWS: {
            float* xres = args.out; bf16* XN = (bf16*)(ws + WS_XN);
            if (mixer) {
                const bf16* YB = (const bf16*)(ws + WS_YB);
                for (int m = gw; m < SEQ; m += NGW) { const size_t r = (size_t)b * SEQ + m;
                    row_pass(xres + r * DM, YB + (size_t)m * DM, args.in[I_MPOST] + l * DM, 1.0f, xres + r * DM, args.in[I_F2PRE] + l * DM, XN + r * DM, lane); }
            } else {
                const bf16* Y = (const bf16*)(ws + WS_Y);
                const float* n_post = args.in[sub ? I_F2POST : I_F1POST] + l * DM;
                const float* xin = (l == 0 && sub == 0) ? args.in[I_X] : xres;
                const float* wnext = sub == 0 ? args.in[I_MPRE] + l * DM : (l + 1 < DEPTH ? args.in[I_F1PRE] + (l + 1) * DM : nullptr);
                for (int m = gw; m < MTOK; m += NGW) row_pass(xin + (size_t)m * DM, Y + (size_t)m * DM, n_post, 0.5f, xres + (size_t)m * DM, wnext, wnext ? XN + (size_t)m * DM : nullptr, lane);
                if (sub == 0) {
                    LAS float* scr = (LAS float*)(ldsl + wave * 16384);
                    const float* w1k = args.in[I_W1K] + (size_t)l * 3072 * 256; const float* w1v = args.in[I_W1V] + (size_t)l * 2048 * 256;
                    for (int it = gw; it < 48 * 8 + 32 * 8 + 12 + 8; it += NGW) {
                        if (it < 384) transpose_item(w1k, 3072, 256, (bf16*)(ws + WS_WD + CW_W1K), scr, it, lane, MapId());
                        else if (it < 640) transpose_item(w1v, 2048, 256, (bf16*)(ws + WS_WD + CW_W1V), scr, it - 384, lane, MapId());
                        else if (it < 652) transpose_item(args.in[I_W2K] + l * 256 * 96, 256, 96, (bf16*)(ws + WS_WD + CW_W2K), scr, it - 640, lane, MapId());
                        else transpose_item(args.in[I_W2V] + l * 256 * 64, 256, 64, (bf16*)(ws + WS_WD + CW_W2V), scr, it - 652, lane, MapId()); }
                    if (bx < 32) { const int which = bx >> 4, part = bx & 15, j = tid & 255, hf = tid >> 8;
                        const int per = which ? 128 : 192, i0 = part * per + hf * (per / 2);
                        const float* pe = which ? args.in[I_PEV] + l * 32 * 64 : args.in[I_PEK] + l * 32 * 96; const float* w1 = which ? w1v : w1k;
                        float a = 0.f;
                        for (int i = i0; i < i0 + per / 2; ++i) a += pe[i] * w1[(size_t)i * 256 + j];
                        float* red = (float*)lds; __syncthreads(); red[tid] = a; __syncthreads();
                        if (tid < 256) ((float*)(ws + WS_WD + CW_BPART))[(which * 16 + part) * 256 + tid] = red[tid] + red[tid + 256];
                    }
                }
            }
        } break;
        case K_M1: {
            pg8::Gemm g{(const bf16*)(ws + WS_XN) + (size_t)b * SEQ * DM, (const bf16*)(ws + WS_WIN), SEQ, NIN, DM, DM, DM}; pg8::StaticOrder S; S.init(SEQ, NIN, G, bx);
            pg8::EpiWin E{(bf16*)(ws + WS_A), (float*)(ws + WS_SM), (bf16*)(ws + WS_G), (bf16*)(ws + WS_O + CMP_KCF), (bf16*)(ws + WS_O + CMP_VCF)};
            if (bx == 1) { bf16* KCF = (bf16*)(ws + WS_O + CMP_KCF); bf16* VCF = (bf16*)(ws + WS_O + CMP_VCF);
                for (int i = tid; i < 768; i += NTHR) ((unsigned*)(KCF + (size_t)2 * SEQ * 96))[i] = 0u; for (int i = tid; i < 512; i += NTHR) ((unsigned*)(VCF + (size_t)2 * SEQ * 64))[i] = 0u; }
            pg8::gemm_phase<pg8::EpiWin, pg8::StaticOrder, true, true>(ldsl, g, S, E);
        } break;
        case K_M2: {
            const bf16* PA = (const bf16*)(ws + WS_A); const float* SM = (const float*)(ws + WS_SM);
            if (bx == 0) { const int which = tid >> 8, j = tid & 255; float a = 0.f; const float* bp = (const float*)(ws + WS_WD + CW_BPART) + which * 16 * 256 + j;
                for (int p = 0; p < 16; ++p) a += bp[p * 256];
                ((float*)(ws + WS_WD + CW_BIAS))[which * 256 + j] = a; }
            if (bx < 32) {
                const int kv = bx >> 4, pm = (bx >> 2) & 3, ks = bx & 3;
                pg8::Gemm g = kv ? pg8::Gemm{(const bf16*)(ws + WS_O + CMP_VCF) + ks * 512, (const bf16*)(ws + WS_WD + CW_W1V) + ks * 512, 1024, 256, 512, 1024, 2048}
                                 : pg8::Gemm{(const bf16*)(ws + WS_O + CMP_KCF) + ks * 768, (const bf16*)(ws + WS_WD + CW_W1K) + ks * 768, 1024, 256, 768, 1536, 3072};
                pg8::OneTile S{pm, 0}; pg8::EpiF32 E{(float*)(ws + WS_O + CMP_PART) + ((size_t)kv * 4 + ks) * 1024 * 256, 256};
                pg8::gemm_phase<pg8::EpiF32, pg8::OneTile, false, true>(ldsl, g, S, E);
                __syncthreads();
            }
            for (int it = gw; it < NCHUNK * 4; it += NGW) nsa_vt_item(PA, (bf16*)(ws + WS_VTS), (bf16*)(ws + WS_VTW), it, (unsigned short*)(lds + wave * 16384), lane);
            for (int it = bx; it < NCHUNK * 4; it += G)
                gla_prep_item(PA, SM, args.in[I_GGW] + l * 16 * 256, args.in[I_GGB] + l * 256, ws + ALPHA_OFF, ws + WS_WGU, it >> 2, it & 3, (float*)lds, tid);
        } break;
        case K_M2B: {
            if (bx < 32) {
                const int kv = bx >> 4, rg = bx & 15;
                bf16* Hs = (bf16*)lds;
                const float* part = (const float*)(ws + WS_O + CMP_PART) + (size_t)kv * 4 * 1024 * 256; const float* bias = (const float*)(ws + WS_WD + CW_BIAS) + kv * 256;
                __syncthreads();
                for (int i = tid; i < 64 * 64; i += NTHR) { const int r = i >> 6, c4 = (i & 63) * 4; const size_t o = (size_t)(rg * 64 + r) * 256 + c4;
                    f32x4 v = *(const f32x4*)(part + o) + *(const f32x4*)(part + 262144 + o) + *(const f32x4*)(part + 2 * 262144 + o) + *(const f32x4*)(part + 3 * 262144 + o) + *(const f32x4*)(bias + c4);
#pragma unroll
                    for (int e = 0; e < 4; ++e) v[e] = gelu_tanhf_(v[e]);
                    v2u w; w.x = pk2(v[0], v[1]); w.y = pk2(v[2], v[3]); *(v2u*)(Hs + r * 264 + c4) = w; }
                __syncthreads();
                {
                    const int q = lane >> 4, fr = lane & 15, rt = wave & 3, nct = kv ? 2 : 3;
                    const bf16* w2t = (const bf16*)(ws + WS_WD + (kv ? CW_W2V : CW_W2K));
                    bf16x8 af[8];
#pragma unroll
                    for (int kk = 0; kk < 8; ++kk) af[kk] = *(const bf16x8*)(Hs + (16 * rt + fr) * 264 + 32 * kk + 8 * q);
#pragma unroll 1
                    for (int ci = 0; ci < nct; ++ci) { const int ct = (wave >> 2) * nct + ci;
                        f32x4 acc = {0.f, 0.f, 0.f, 0.f};
#pragma unroll
                        for (int kk = 0; kk < 8; ++kk) acc = MFMA16(af[kk], *(const bf16x8*)(w2t + (size_t)(16 * ct + fr) * 256 + 32 * kk + 8 * q), acc);
#pragma unroll
                        for (int r = 0; r < 4; ++r) { const int row = rg * 64 + 16 * rt + 4 * q + r, gg = row >> 9, n = row & 511, dd = 16 * ct + fr;
                            if (n < 511) {
                                if (kv == 0) { const unsigned hi = f2bf(acc[r]); ((bf16*)(ws + WS_KCMP))[(size_t)(n * 2 + gg) * 96 + dd] = (bf16)hi; ((bf16*)(ws + WS_KCL))[(size_t)(n * 2 + gg) * 96 + dd] = (bf16)f2bf(acc[r] - __uint_as_float(hi << 16)); }
                                else ((bf16*)(ws + WS_VCT))[(size_t)(gg * 64 + dd) * 512 + n] = (bf16)f2bf(acc[r]); } }
                    }
                }
                if (bx == 0) { if (tid < 192) { ((bf16*)(ws + WS_KCMP))[511 * 192 + tid] = 0; ((bf16*)(ws + WS_KCL))[511 * 192 + tid] = 0; } if (tid < 128) ((bf16*)(ws + WS_VCT))[tid * 512 + 511] = 0; }
            }
            {
                const bf16* PA = (const bf16*)(ws + WS_A); const float* SM = (const float*)(ws + WS_SM);
                for (int it = bx; it < NCHUNK * 4; it += G)
                    gdn_prep_chunk(PA, SM, args.in[I_CONVW] + l * 4 * 1536, args.in[I_ALOG] + l * 4, args.in[I_DTB] + l * 4, ws + WS_QKV, it >> 2, it & 3, lds, tid);
            }
        } break;
        case K_M3: {
            const bf16* PA = (const bf16*)(ws + WS_A); bf16* OB3 = (bf16*)(ws + WS_O);
            float* wl = (float*)(lds + wave * 16384);
            if (bx < 4) { if (pmode == 0 || pmode == 1) gdn_scan_block(ws + WS_QKV, OB3, bx, lds, tid); }
            else if (bx < 8) { if (pmode == 0 || pmode == 2) gla_scan_block(ws + ALPHA_OFF, ws + WS_WGU, OB3 + 2 * (size_t)SEQ * 512, bx - 4, lds, tid); }
            else if (pmode == 0 || pmode == 3) { const LAS int* btab = (const LAS int*)(ldsl + BTAB_OFF); const LAS float* relb = (const LAS float*)(ldsl + RELB_OFF);
                unsigned* qctr = (unsigned*)(ws + WS_CTL) + CW_Q + 64 * (l * 2 + b + 4 * pmode);
                volatile unsigned* qw = (volatile unsigned*)(lds + NSA_UOFF + 256);
                for (;;) {
                    __syncthreads();
                    if (tid == 0) *qw = __hip_atomic_fetch_add(qctr, 1u, __ATOMIC_RELAXED, __HIP_MEMORY_SCOPE_AGENT);
                    __syncthreads();
                    const unsigned u = *qw;
                    if (u >= (unsigned)(SEQ / 32 * 2)) break;
                    nsa_unit(PA, (const float*)(ws + WS_SM), (const bf16*)(ws + WS_KCMP), (const bf16*)(ws + WS_KCL), (const bf16*)(ws + WS_VCT), (const bf16*)(ws + WS_VTS), (const bf16*)(ws + WS_VTW),
                             relb, btab, pmode == 3 ? (bf16*)(ws + WS_QKV) : OB3 + (size_t)SEQ * 512, SEQ - 32 - 32 * (int)(u >> 1), (int)(u & 1), lds, tid, pmode == 3 ? PROBE_ABL : 0);
                } }
        } break;
        case K_M4: {
            for (int it = gw; it < SEQ * 4; it += NGW) out_norm_item((bf16*)(ws + WS_O), (const bf16*)(ws + WS_A), PA_GZ, args.in[I_GDNNW] + l * 128, it >> 2, it & 3, lane);
            for (int it = gw; it < SEQ * 4; it += NGW) out_norm_item((bf16*)(ws + WS_O) + 2 * (size_t)SEQ * 512, (const bf16*)(ws + WS_A), PA_LR, args.in[I_GLANW] + l * 128, it >> 2, it & 3, lane);
        } break;
        case K_M5: {
#pragma unroll 1
            for (int br = 0; br < 3; ++br) {
                pg8::StaticOrder S; S.init(SEQ, DM, G, bx);
                pg8::Gemm g{(const bf16*)(ws + WS_O) + (size_t)br * SEQ * 512, (const bf16*)(ws + WS_WB) + (size_t)br * 512 * 1024, SEQ, DM, 512, 512, 512};
                pg8::EpiMerge E{(const bf16*)(ws + WS_G) + br * 1024, (bf16*)(ws + WS_RMW), (bf16*)(ws + WS_MG), br};
                pg8::gemm_phase<pg8::EpiMerge, pg8::StaticOrder, true, true>(ldsl, g, S, E);
            }
        } break;
        default: break;
        }
#if MK_ONE_LAUNCH
        if (pc + 1 < args.ph_hi) xcd_barrier(bar);
#endif
#undef args
    }
}

extern "C" void kernel_launch(void* const* d_in, const int* in_sizes, int n_in, void* d_out, int out_size, void* d_ws, size_t ws_size, hipStream_t stream) {
    static int grid = 0;
    if (grid == 0) {
        if (n_in != 30 || out_size != MTOK * DM || ws_size < 292 * MiB) { fprintf(stderr, "kernel_launch: unexpected shapes (n_in %d out %d ws %zu)\n", n_in, out_size, ws_size); grid = -1; return; }
        int dev = 0, cus = 0, per_cu = 0;
        if (hipGetDevice(&dev) != hipSuccess || hipDeviceGetAttribute(&cus, hipDeviceAttributeMultiprocessorCount, dev) != hipSuccess) { grid = -1; return; }
        if (hipFuncSetAttribute((const void*)mk_fwd, hipFuncAttributeMaxDynamicSharedMemorySize, LDS_BYTES) != hipSuccess) { fprintf(stderr, "kernel_launch: hipFuncSetAttribute failed\n"); grid = -1; return; }
        if (hipOccupancyMaxActiveBlocksPerMultiprocessor(&per_cu, (const void*)mk_fwd, NTHR, LDS_BYTES) != hipSuccess || per_cu < 1) { fprintf(stderr, "kernel_launch: occupancy query says %d blocks per CU\n", per_cu); grid = -1; (void)hipGetLastError(); return; }
        (void)hipGetLastError();
        grid = cus;
    }
    if (grid < 0) return;
    (void)hipMemsetAsync((char*)d_ws + WS_CTL, 0, CTL_ZERO_BYTES, stream);
    Args a{};
    for (int i = 0; i < 30; ++i) a.in[i] = (const float*)d_in[i];
    a.out = (float*)d_out; a.ws = (unsigned char*)d_ws;
    int np = 0;
#ifndef PROBE_KIND
#define PROBE_KIND -1
#endif
    auto push = [&](int kind, int sub, int b, int l, int mixer) { const int reps = (kind == PROBE_KIND) ? 2 : 1; for (int r = 0; r < reps; ++r) a.prog[np++] = (unsigned short)(kind | sub << 4 | b << 5 | l << 6 | mixer << 7);
#ifdef PROBE_M3MODE
        if (kind == K_M3) a.prog[np++] = (unsigned short)(kind | sub << 4 | b << 5 | l << 6 | mixer << 7 | PROBE_M3MODE << 8);
#endif
    };
    for (int l = 0; l < DEPTH; ++l) {
        push(K_CONV, 0, 0, l, 0); push(K_F1, 0, 0, l, 0); push(K_GF32, 0, 0, l, 0); push(K_ROWS, 0, 0, l, 0);
        for (int b = 0; b < NBATCH; ++b) { push(K_M1, 0, b, l, 1); push(K_M2, 0, b, l, 1); push(K_M2B, 0, b, l, 1); push(K_M3, 0, b, l, 1); push(K_M4, 0, b, l, 1); push(K_M5, 0, b, l, 1); push(K_GF32, 0, b, l, 1); push(K_ROWS, 0, b, l, 1); }
        push(K_CONV, 1, 0, l, 0); push(K_F1, 1, 0, l, 0); push(K_GF32, 1, 0, l, 0); push(K_ROWS, 1, 0, l, 0);
    }
    const int NPH = np;
#if MK_ONE_LAUNCH
    a.ph_lo = 0; a.ph_hi = NPH;
    hipLaunchKernelGGL(mk_fwd, dim3(grid), dim3(NTHR), LDS_BYTES, stream, a);
#else
    for (int p = 0; p < NPH; ++p) { a.ph_lo = p; a.ph_hi = p + 1; hipLaunchKernelGGL(mk_fwd, dim3(grid), dim3(NTHR), LDS_BYTES, stream, a); }
#endif
}
```
